# Optimizing an MI355X kernel written in HIP

```python
import math
import jax
import jax.numpy as jnp
from jax import lax
import numpy as np

D_MODEL = 1024
BATCH = 1
SEQ = 16384
DEPTH = 2

GRID_W = 64
CTX_LEN = 256
N_EVEN = (DEPTH + 1) // 2
N_ODD = DEPTH // 2
MIX_W = D_MODEL
EPS = 1e-6
CONV_W = 3

HY_W = MIX_W // 2
HY_ORDER = 2
HY_EMB = 33
HY_FFN = 64
HY_TARGET = 1e-2
HY_SHORT_PCT = 0.3
HY_LONG_PCT = 1.5

HEAD_DIM = 64
ATT_HEADS = (MIX_W // 2) // HEAD_DIM
ATT_KV_HEADS = 2
ATT_GROUP = ATT_HEADS // ATT_KV_HEADS
ATT_WINDOW = 128
ATT_BLOCK = 128
ROPE_BASE = 10000.0
ATT_Q_W = ATT_HEADS * HEAD_DIM
ATT_KV_W = ATT_KV_HEADS * HEAD_DIM

SSD_W = MIX_W // 2
SSD_HEAD_DIM = 64
SSD_HEADS = SSD_W // SSD_HEAD_DIM
SSD_GROUPS = 2
SSD_STATE = 128
SSD_CHUNK = 128
SSD_CONV_CH = SSD_W + 2 * SSD_GROUPS * SSD_STATE

HG_W = MIX_W // 2
HG_EXPAND = 128
HG_HEADS = HG_W // HG_EXPAND
HG_VDIM = HG_W // HG_HEADS
HG_CHUNK = 64

N_EXPERTS = 32
TOP_K = 4
D_EXPERT = D_MODEL
SWIGLU_ALPHA = 1.702
SWIGLU_LIMIT = 7.0
MOE_BLOCK = 128

EVEN_IN = 2 * ATT_KV_W + ATT_Q_W + 3 * HY_W
ODD_STATE_COLS = SSD_CONV_CH + 2 * SSD_HEADS + 3 * HG_W
ODD_IN = ODD_STATE_COLS + SSD_W + 2 * HG_W

kernel_name = 'hybrid_hyena_swa_ssd_hgrn2_moe_dit'


def rms_norm(x, g):
    xf = x.astype(jnp.float32)
    y = xf * lax.rsqrt(jnp.mean(xf * xf, axis=-1, keepdims=True) + EPS)
    return (y * g.astype(jnp.float32)).astype(x.dtype)


def modulate(h, shift, scale):
    return h * (1.0 + scale) + shift


def adaln(cond, w, b, j):
    lo, hi = 3 * j * D_MODEL, 3 * (j + 1) * D_MODEL
    m = jax.nn.silu(cond) @ w[:, lo:hi] + b[lo:hi]
    return jnp.split(m, 3, axis=-1)


def dwconv_centred(u, w, b):
    ch = u.shape[-1]
    y = lax.conv_general_dilated(u, w[:, None, :].astype(u.dtype), window_strides=(1,),
                                 padding=[(CONV_W // 2, CONV_W // 2)],
                                 dimension_numbers=('NWC', 'WIO', 'NWC'), feature_group_count=ch)
    return y + b.astype(u.dtype)


def axial_rope_tables(length):
    rows = length // GRID_W
    n_pairs = HEAD_DIM // 4
    inv = ROPE_BASE ** (-jnp.arange(n_pairs, dtype=jnp.float32) / n_pairs)
    row_ang = jnp.arange(rows, dtype=jnp.float32)[:, None] * inv
    col_ang = jnp.arange(GRID_W, dtype=jnp.float32)[:, None] * inv
    ang_r = jnp.broadcast_to(row_ang[:, None], (rows, GRID_W, n_pairs)).reshape(length, n_pairs)
    ang_c = jnp.broadcast_to(col_ang[None], (rows, GRID_W, n_pairs)).reshape(length, n_pairs)
    return jnp.cos(ang_r), jnp.sin(ang_r), jnp.cos(ang_c), jnp.sin(ang_c)


def _rotate(u, cos, sin):
    n = u.shape[-1] // 2
    u1, u2 = u[..., :n], u[..., n:]
    cos = cos[None, :, None, :]
    sin = sin[None, :, None, :]
    return jnp.concatenate([u1 * cos - u2 * sin, u1 * sin + u2 * cos], axis=-1)


def apply_axial_rope(u, tables):
    cr, sr, cc, sc = tables
    half = HEAD_DIM // 2
    return jnp.concatenate([_rotate(u[..., :half], cr, sr), _rotate(u[..., half:], cc, sc)], axis=-1)


def hyena_filters(length, w1, b1, w2, b2, w3, b3, w4, freq):
    f32 = jnp.float32
    t = jnp.linspace(0.0, 1.0, length, dtype=f32)[:, None]
    bands = (HY_EMB - 1) // 2
    w_ang = 2.0 * math.pi * jnp.arange(length, dtype=f32)[:, None] / length
    fr = jnp.linspace(1e-4, bands - 1, bands, dtype=f32)[None]
    z = jnp.concatenate([t, jnp.cos(fr * w_ang), -jnp.sin(fr * w_ang)], axis=-1)
    fq = freq.astype(f32)
    hdn = jnp.sin(fq * (z @ w1.astype(f32) + b1.astype(f32)))
    hdn = jnp.sin(fq * (hdn @ w2.astype(f32) + b2.astype(f32)))
    hdn = jnp.sin(fq * (hdn @ w3.astype(f32) + b3.astype(f32)))
    h = (hdn @ w4.astype(f32)).reshape(length, HY_ORDER, 2, HY_W)
    max_decay = math.log(HY_TARGET) / HY_SHORT_PCT
    min_decay = math.log(HY_TARGET) / HY_LONG_PCT
    deltas = jnp.abs(jnp.linspace(min_decay, max_decay, HY_W, dtype=f32))
    h = h * jnp.exp(-t * deltas)[:, None, None, :]
    h2 = jnp.concatenate([h[:, :, 0], jnp.zeros((1, HY_ORDER, HY_W), f32), h[:0:-1, :, 1]], axis=0)
    h2 = h2 / jnp.sum(jnp.abs(h2), axis=0, keepdims=True)
    return jnp.fft.rfft(h2, axis=0)


def hyena_mix(u, hf, filter_bias, conv_w, conv_b):
    length = u.shape[1]
    u = dwconv_centred(u.astype(jnp.float32), conv_w, conv_b)
    v, x1, x2 = jnp.split(u, 3, axis=-1)
    z = v
    for o, gate in enumerate((x1, x2)):
        zf = jnp.fft.rfft(z, n=2 * length, axis=1)
        zc = jnp.fft.irfft(zf * hf[None, :, o], n=2 * length, axis=1)[:, :length]
        z = gate * (zc + z * filter_bias[o].astype(jnp.float32))
    return z


def window_attention(q, k, v, k_c, v_c, sink):
    bsz, length = q.shape[:2]
    nb = length // ATT_BLOCK
    scale = HEAD_DIM ** -0.5
    qb = q.reshape(bsz, nb, ATT_BLOCK, ATT_KV_HEADS, ATT_GROUP, HEAD_DIM)
    pad = ((0, 0), (ATT_BLOCK, ATT_BLOCK), (0, 0), (0, 0))

    def band(a):
        ap = jnp.pad(a, pad).reshape(bsz, nb + 2, ATT_BLOCK, ATT_KV_HEADS, HEAD_DIM)
        return jnp.concatenate([ap[:, :-2], ap[:, 1:-1], ap[:, 2:]], axis=2)

    kw, vw = band(k), band(v)
    s_loc = jnp.einsum('bnqhgd,bnkhd->bnhgqk', qb, kw) * scale
    s_ctx = jnp.einsum('bnqhgd,bchd->bnhgqc', qb, k_c) * scale
    qpos = jnp.arange(nb)[:, None] * ATT_BLOCK + jnp.arange(ATT_BLOCK)[None]
    kpos = (jnp.arange(nb)[:, None] - 1) * ATT_BLOCK + jnp.arange(3 * ATT_BLOCK)[None]
    rel = kpos[:, None, :] - qpos[:, :, None]
    valid = (jnp.abs(rel) <= ATT_WINDOW) & (kpos[:, None, :] >= 0) & (kpos[:, None, :] < length)
    s_loc = jnp.where(valid[None, :, None, None], s_loc, -jnp.inf)
    sink_l = jnp.broadcast_to(sink.astype(jnp.float32).reshape(1, 1, ATT_KV_HEADS, ATT_GROUP, 1, 1),
                              s_loc.shape[:-1] + (1,))
    p = jax.nn.softmax(jnp.concatenate([s_loc, s_ctx, sink_l], axis=-1), axis=-1)
    n_loc = 3 * ATT_BLOCK
    n_ctx = k_c.shape[1]
    o = (jnp.einsum('bnhgqk,bnkhd->bnqhgd', p[..., :n_loc], vw)
         + jnp.einsum('bnhgqc,bchd->bnqhgd', p[..., n_loc:n_loc + n_ctx], v_c))
    return o.reshape(bsz, length, ATT_Q_W)


def context_attention(q_c, k_c, v_c, sink):
    bsz, n_ctx = q_c.shape[:2]
    s = jnp.einsum('bqhgd,bkhd->bhgqk', q_c, k_c) * HEAD_DIM ** -0.5
    sink_l = jnp.broadcast_to(sink.astype(jnp.float32).reshape(1, ATT_KV_HEADS, ATT_GROUP, 1, 1),
                              s.shape[:-1] + (1,))
    p = jax.nn.softmax(jnp.concatenate([s, sink_l], axis=-1), axis=-1)[..., :-1]
    return jnp.einsum('bhgqk,bkhd->bqhgd', p, v_c).reshape(bsz, n_ctx, ATT_Q_W)


def ssd_scan(x, dt, a, bm, cm, d_skip, init, need_y):
    bsz, length, n_heads, hd = x.shape
    nc = length // SSD_CHUNK
    hpg = n_heads // SSD_GROUPS
    da = (dt * a).reshape(bsz, nc, SSD_CHUNK, SSD_GROUPS, hpg)
    cs = jnp.cumsum(da, axis=2)
    xdt = (x * dt[..., None]).reshape(bsz, nc, SSD_CHUNK, SSD_GROUPS, hpg, hd)
    bc = bm.reshape(bsz, nc, SSD_CHUNK, SSD_GROUPS, SSD_STATE)
    cc = cm.reshape(bsz, nc, SSD_CHUNK, SSD_GROUPS, SSD_STATE)
    to_end = jnp.exp(cs[:, :, -1:] - cs)
    states = jnp.einsum('bcsgn,bcsgh,bcsghp->bcghpn', bc, to_end, xdt)
    chunk_decay = jnp.exp(cs[:, :, -1])

    def step(s, inp):
        st, dec = inp
        return s * dec[..., None, None] + st, s

    s_final, s_in = lax.scan(step, init, (jnp.moveaxis(states, 1, 0), jnp.moveaxis(chunk_decay, 1, 0)))
    if not need_y:
        return None, s_final
    s_in = jnp.moveaxis(s_in, 0, 1)
    cs_t = jnp.moveaxis(cs, 2, -1)
    diff = cs_t[..., :, None] - cs_t[..., None, :]
    lower = jnp.tril(jnp.ones((SSD_CHUNK, SSD_CHUNK), bool))
    decay = jnp.where(lower, jnp.exp(jnp.where(lower, diff, 0.0)), 0.0)
    scores = jnp.einsum('bclgn,bcsgn->bcgls', cc, bc)
    y_diag = jnp.einsum('bcgls,bcghls,bcsghp->bclghp', scores, decay, xdt)
    y_off = jnp.einsum('bclgn,bcghpn,bclgh->bclghp', cc, s_in, jnp.exp(cs))
    y = (y_diag + y_off).reshape(bsz, length, n_heads, hd) + d_skip[:, None] * x
    return y, s_final


def hgrn2_scan(q, k, v, g, init, need_o):
    bsz, length, n_heads, _ = k.shape
    nc = length // HG_CHUNK

    def chunks(a):
        return a.reshape(bsz, nc, HG_CHUNK, n_heads, a.shape[-1]).transpose(1, 0, 3, 2, 4)

    lower = jnp.tril(jnp.ones((HG_CHUNK, HG_CHUNK), bool))[:, :, None]

    def update(s, kc, vc, cum):
        last = cum[:, :, -1]
        return (s * jnp.exp(last)[..., None]
                + jnp.einsum('bhsk,bhsv->bhkv', kc * jnp.exp(last[:, :, None] - cum), vc))

    if not need_o:
        def step_state(s, inp):
            kc, vc, gc = inp
            return update(s, kc, vc, jnp.cumsum(gc, axis=2)), None
        s_final, _ = lax.scan(step_state, init, (chunks(k), chunks(v), chunks(g)))
        return None, s_final

    def step(s, inp):
        qc, kc, vc, gc = inp
        cum = jnp.cumsum(gc, axis=2)
        diff = cum[:, :, :, None, :] - cum[:, :, None, :, :]
        decay = jnp.where(lower, jnp.exp(jnp.where(lower, diff, 0.0)), 0.0)
        att = jnp.einsum('bhtk,bhsk,bhtsk->bhts', qc, kc, decay)
        o = (jnp.einsum('bhtk,bhkv->bhtv', qc * jnp.exp(cum), s)
             + jnp.einsum('bhts,bhsv->bhtv', att, vc))
        return update(s, kc, vc, cum), o

    s_final, o = lax.scan(step, init, (chunks(q), chunks(k), chunks(v), chunks(g)))
    return o.transpose(1, 0, 3, 2, 4).reshape(bsz, length, n_heads, v.shape[-1]), s_final


def even_mixer(h, hc, w_in, conv_w, conv_b, f_w1, f_b1, f_w2, f_b2, f_w3, f_b3, f_w4, f_freq, f_bias,
               q_norm, k_norm, sink, ctx_out):
    f32 = jnp.float32
    bsz, length, _ = h.shape
    n_ctx = hc.shape[1]
    filt = (f_w1, f_b1, f_w2, f_b2, f_w3, f_b3, f_w4, f_freq)
    o_v = ATT_KV_W
    o_q = 2 * ATT_KV_W
    o_hy = o_q + ATT_Q_W
    p = (h @ w_in).astype(f32)
    pc = (hc @ (w_in if ctx_out else w_in[:, :o_q])).astype(f32)

    def heads(a, n_heads):
        return a.reshape(a.shape[0], a.shape[1], n_heads, HEAD_DIM)

    k_c = rms_norm(heads(pc[..., :o_v], ATT_KV_HEADS), k_norm)
    v_c = heads(pc[..., o_v:o_q], ATT_KV_HEADS)
    rope = axial_rope_tables(length)
    k = apply_axial_rope(rms_norm(heads(p[..., :o_v], ATT_KV_HEADS), k_norm), rope)
    v = heads(p[..., o_v:o_q], ATT_KV_HEADS)
    q = apply_axial_rope(rms_norm(heads(p[..., o_q:o_hy], ATT_HEADS), q_norm), rope)
    att = window_attention(q.reshape(bsz, length, ATT_KV_HEADS, ATT_GROUP, HEAD_DIM), k, v, k_c, v_c, sink)
    hy = hyena_mix(p[..., o_hy:], hyena_filters(length, *filt), f_bias, conv_w, conv_b)
    out = jnp.concatenate([hy, att], axis=-1).astype(h.dtype)
    if not ctx_out:
        return out, None
    q_c = rms_norm(heads(pc[..., o_q:o_hy], ATT_HEADS), q_norm).reshape(bsz, n_ctx, ATT_KV_HEADS, ATT_GROUP, HEAD_DIM)
    att_c = context_attention(q_c, k_c, v_c, sink)
    hy_c = hyena_mix(pc[..., o_hy:], hyena_filters(n_ctx, *filt), f_bias, conv_w, conv_b)
    return out, jnp.concatenate([hy_c, att_c], axis=-1).astype(hc.dtype)


def odd_mixer(h, hc, lb, w_in, conv_w, conv_b, dt_bias, a_log, d_skip, ssd_norm, hg_norm, ctx_out):
    f32 = jnp.float32
    bsz, length, _ = h.shape
    n_ctx = hc.shape[1]
    p = (h @ w_in).astype(f32)
    pc = (hc @ (w_in if ctx_out else w_in[:, :ODD_STATE_COLS])).astype(f32)
    o_dt = SSD_CONV_CH
    o_f = SSD_CONV_CH + 2 * SSD_HEADS
    o_i = o_f + 2 * HG_W
    o_z = ODD_STATE_COLS
    o_q = o_z + SSD_W
    o_g = o_q + HG_W
    gn = SSD_GROUPS * SSD_STATE

    def streams(pp):
        n = pp.shape[1]
        xbc = jax.nn.silu(dwconv_centred(pp[..., :SSD_CONV_CH], conv_w, conv_b))
        xs = xbc[..., :SSD_W].reshape(bsz, n, SSD_HEADS, SSD_HEAD_DIM)
        bm = xbc[..., SSD_W:SSD_W + gn].reshape(bsz, n, SSD_GROUPS, SSD_STATE)
        cm = xbc[..., SSD_W + gn:].reshape(bsz, n, SSD_GROUPS, SSD_STATE)
        dt_raw = pp[..., o_dt:o_f].reshape(bsz, n, 2, SSD_HEADS)
        f_raw = pp[..., o_f:o_i].reshape(bsz, n, 2, HG_HEADS, HG_EXPAND)
        iv = pp[..., o_i:o_i + HG_W].reshape(bsz, n, HG_HEADS, HG_VDIM)
        return xs, bm, cm, dt_raw, f_raw, iv

    xs, bm, cm, dt_raw, f_raw, iv = streams(p)
    xs_c, bm_c, cm_c, dt_raw_c, f_raw_c, iv_c = streams(pc)
    q = jax.nn.silu(p[..., o_q:o_g]).reshape(bsz, length, HG_HEADS, HG_EXPAND)
    q_c = jax.nn.silu(pc[..., o_q:o_g]).reshape(bsz, n_ctx, HG_HEADS, HG_EXPAND) if ctx_out else None
    lb = lb.astype(f32).reshape(HG_HEADS, HG_EXPAND)
    ssd0 = jnp.zeros((bsz, SSD_GROUPS, SSD_HEADS // SSD_GROUPS, SSD_HEAD_DIM, SSD_STATE), f32)
    hg0 = jnp.zeros((bsz, HG_HEADS, HG_EXPAND, HG_VDIM), f32)
    y_dirs, o_dirs, yc_dirs, oc_dirs = [], [], [], []
    for d in range(2):
        fl = (lambda a: jnp.flip(a, axis=1)) if d == 1 else (lambda a: a)
        a = -jnp.exp(a_log[d].astype(f32))
        dsk = d_skip[d].astype(f32)
        dtb = dt_bias[d].astype(f32)
        dt_l = jax.nn.softplus(dt_raw[:, :, d] + dtb)
        dt_c = jax.nn.softplus(dt_raw_c[:, :, d] + dtb)
        yc, s_ctx = ssd_scan(fl(xs_c), fl(dt_c), a, fl(bm_c), fl(cm_c), dsk, ssd0, ctx_out)
        yl, _ = ssd_scan(fl(xs), fl(dt_l), a, fl(bm), fl(cm), dsk, s_ctx, True)
        y_dirs.append(fl(yl))
        f_l = lb + (1.0 - lb) * jax.nn.sigmoid(f_raw[:, :, d])
        f_c = lb + (1.0 - lb) * jax.nn.sigmoid(f_raw_c[:, :, d])
        oc, s_hg = hgrn2_scan(fl(q_c) if ctx_out else None, fl(1.0 - f_c), fl(iv_c), fl(jnp.log(f_c)), hg0, ctx_out)
        ol, _ = hgrn2_scan(fl(q), fl(1.0 - f_l), fl(iv), fl(jnp.log(f_l)), s_hg, True)
        o_dirs.append(fl(ol))
        if ctx_out:
            yc_dirs.append(fl(yc))
            oc_dirs.append(fl(oc))

    def merge(yy, oo, pp, n):
        z = pp[..., o_z:o_q]
        g = pp[..., o_g:]
        ys = (yy.reshape(bsz, n, SSD_W) * jax.nn.silu(z)).reshape(bsz, n, SSD_GROUPS, SSD_W // SSD_GROUPS)
        ys = rms_norm(ys, ssd_norm.reshape(SSD_GROUPS, SSD_W // SSD_GROUPS)).reshape(bsz, n, SSD_W)
        hs = rms_norm(oo, hg_norm.reshape(HG_HEADS, HG_VDIM)).reshape(bsz, n, HG_W) * jax.nn.silu(g)
        return jnp.concatenate([ys, hs], axis=-1)

    out = merge(y_dirs[0] + y_dirs[1], o_dirs[0] + o_dirs[1], p, length).astype(h.dtype)
    if not ctx_out:
        return out, None
    out_c = merge(yc_dirs[0] + yc_dirs[1], oc_dirs[0] + oc_dirs[1], pc, n_ctx).astype(hc.dtype)
    return out, out_c


def moe_ffn(t, router_w, router_b, w_gu, b_gu, w_dn, b_dn):
    n_tok, d = t.shape
    logits = (t @ router_w).astype(jnp.float32) + router_b.astype(jnp.float32)
    top_val, top_idx = lax.top_k(logits, TOP_K)
    gates = jax.nn.softmax(top_val, axis=-1)
    flat_e = top_idx.reshape(-1)
    order = jnp.argsort(flat_e)
    e_sorted = flat_e[order]
    counts = jnp.bincount(flat_e, length=N_EXPERTS)
    padded = (counts + MOE_BLOCK - 1) // MOE_BLOCK * MOE_BLOCK
    pad_end = jnp.cumsum(padded)
    first = jnp.cumsum(counts) - counts
    dest = pad_end[e_sorted] - padded[e_sorted] + jnp.arange(n_tok * TOP_K) - first[e_sorted]
    n_blk = -(-(n_tok * TOP_K) // MOE_BLOCK) + N_EXPERTS
    n_rows = n_blk * MOE_BLOCK
    row_tok = jnp.full((n_rows,), n_tok, jnp.int32).at[dest].set((order // TOP_K).astype(jnp.int32))
    row_gate = jnp.zeros((n_rows,), jnp.float32).at[dest].set(gates.reshape(-1)[order])
    blk_e = jnp.minimum(jnp.searchsorted(pad_end, jnp.arange(n_blk) * MOE_BLOCK, side='right'), N_EXPERTS - 1)
    x_rows = jnp.concatenate([t, jnp.zeros((1, d), t.dtype)], axis=0)[row_tok].reshape(n_blk, MOE_BLOCK, d)

    def expert_block(args):
        xb, e = args
        gu = xb @ w_gu[e] + b_gu[e]
        gate = jnp.minimum(gu[:, :D_EXPERT], SWIGLU_LIMIT)
        up = jnp.clip(gu[:, D_EXPERT:], -SWIGLU_LIMIT, SWIGLU_LIMIT)
        act = (up + 1.0) * gate * jax.nn.sigmoid(SWIGLU_ALPHA * gate)
        return act @ w_dn[e] + b_dn[e]

    y_rows = lax.map(expert_block, (x_rows, blk_e)).reshape(n_rows, d)
    y = jax.ops.segment_sum(y_rows * row_gate[:, None].astype(y_rows.dtype), row_tok, num_segments=n_tok + 1)
    return y[:n_tok]


def setup_inputs(seed: int = 0) -> dict:
    key = jax.random.key(seed)
    keys = iter(jax.random.split(key, 48))
    f32 = jnp.float32

    def nrm(shape, scale):
        return jax.random.normal(next(keys), shape, f32) * scale

    def gain(shape):
        return 1.0 + nrm(shape, 0.05)

    dt0 = jnp.exp(jax.random.uniform(next(keys), (N_ODD, 2, SSD_HEADS), f32, math.log(1e-3), math.log(1e-1)))
    a0 = jax.random.uniform(next(keys), (N_ODD, 2, SSD_HEADS), f32, 1.0, 16.0)
    return {
        'x': nrm((BATCH, SEQ, D_MODEL), 1.0),
        'c': nrm((BATCH, D_MODEL), 1.0),
        'ctx': nrm((BATCH, CTX_LEN, D_MODEL), 1.0),
        'c_ctx': nrm((D_MODEL,), 1.0),
        'norm_g': gain((DEPTH, 2, D_MODEL)),
        'ada_w': nrm((DEPTH, D_MODEL, 6 * D_MODEL), 0.5 * D_MODEL ** -0.5),
        'ada_b': nrm((DEPTH, 6 * D_MODEL), 0.02),
        'w_out': nrm((DEPTH, MIX_W, D_MODEL), MIX_W ** -0.5),
        'w_in_even': nrm((N_EVEN, D_MODEL, EVEN_IN), D_MODEL ** -0.5),
        'hy_conv_w': nrm((N_EVEN, CONV_W, 3 * HY_W), CONV_W ** -0.5),
        'hy_conv_b': nrm((N_EVEN, 3 * HY_W), 0.02),
        'hy_w1': nrm((N_EVEN, HY_EMB, HY_FFN), HY_EMB ** -0.5),
        'hy_b1': nrm((N_EVEN, HY_FFN), 0.1),
        'hy_w2': nrm((N_EVEN, HY_FFN, HY_FFN), HY_FFN ** -0.5),
        'hy_b2': nrm((N_EVEN, HY_FFN), 0.1),
        'hy_w3': nrm((N_EVEN, HY_FFN, HY_FFN), HY_FFN ** -0.5),
        'hy_b3': nrm((N_EVEN, HY_FFN), 0.1),
        'hy_w4': nrm((N_EVEN, HY_FFN, HY_ORDER * 2 * HY_W), HY_FFN ** -0.5),
        'hy_freq': gain((N_EVEN, HY_FFN)),
        'hy_filter_bias': nrm((N_EVEN, HY_ORDER, HY_W), 0.5),
        'att_q_norm': gain((N_EVEN, HEAD_DIM)),
        'att_k_norm': gain((N_EVEN, HEAD_DIM)),
        'att_sink': nrm((N_EVEN, ATT_HEADS), 0.5),
        'w_in_odd': nrm((N_ODD, D_MODEL, ODD_IN), D_MODEL ** -0.5),
        'ssd_conv_w': nrm((N_ODD, CONV_W, SSD_CONV_CH), CONV_W ** -0.5),
        'ssd_conv_b': nrm((N_ODD, SSD_CONV_CH), 0.02),
        'ssd_dt_bias': dt0 + jnp.log(-jnp.expm1(-dt0)),
        'ssd_A_log': jnp.log(a0),
        'ssd_D': 1.0 + nrm((N_ODD, 2, SSD_HEADS), 0.1),
        'ssd_norm': gain((N_ODD, SSD_W)),
        'hg_lower_bounds': nrm((DEPTH, HG_W), 0.5),
        'hg_norm': gain((N_ODD, HG_W)),
        'router_w': nrm((DEPTH, D_MODEL, N_EXPERTS), D_MODEL ** -0.5),
        'router_b': nrm((DEPTH, N_EXPERTS), 0.01),
        'moe_w_gu': nrm((DEPTH, N_EXPERTS, D_MODEL, 2 * D_EXPERT), D_MODEL ** -0.5),
        'moe_b_gu': nrm((DEPTH, N_EXPERTS, 2 * D_EXPERT), 0.02),
        'moe_w_dn': nrm((DEPTH, N_EXPERTS, D_EXPERT, D_MODEL), D_EXPERT ** -0.5),
        'moe_b_dn': nrm((DEPTH, N_EXPERTS, D_MODEL), 0.02),
    }


def reference(x, c, ctx, c_ctx, norm_g, ada_w, ada_b, w_out, w_in_even, hy_conv_w, hy_conv_b,
              hy_w1, hy_b1, hy_w2, hy_b2, hy_w3, hy_b3, hy_w4, hy_freq, hy_filter_bias,
              att_q_norm, att_k_norm, att_sink, w_in_odd, ssd_conv_w, ssd_conv_b, ssd_dt_bias,
              ssd_A_log, ssd_D, ssd_norm, hg_lower_bounds, hg_norm, router_w, router_b,
              moe_w_gu, moe_b_gu, moe_w_dn, moe_b_dn):
    lbs = jax.nn.softmax(hg_lower_bounds.astype(jnp.float32), axis=0)
    lbs = jnp.cumsum(lbs, axis=0) - lbs[0]
    xc = ctx
    for layer in range(DEPTH):
        ctx_out = layer < DEPTH - 1
        i = layer // 2
        sh, sc, gt = adaln(c, ada_w[layer], ada_b[layer], 0)
        sh_c, sc_c, gt_c = adaln(c_ctx, ada_w[layer], ada_b[layer], 0)
        h = modulate(rms_norm(x, norm_g[layer, 0]), sh[:, None], sc[:, None])
        hc = modulate(rms_norm(xc, norm_g[layer, 0]), sh_c, sc_c)
        if layer % 2 == 0:
            m, m_c = even_mixer(h, hc, w_in_even[i], hy_conv_w[i], hy_conv_b[i], hy_w1[i], hy_b1[i],
                                hy_w2[i], hy_b2[i], hy_w3[i], hy_b3[i], hy_w4[i], hy_freq[i],
                                hy_filter_bias[i], att_q_norm[i], att_k_norm[i], att_sink[i], ctx_out)
        else:
            m, m_c = odd_mixer(h, hc, lbs[layer], w_in_odd[i], ssd_conv_w[i], ssd_conv_b[i], ssd_dt_bias[i],
                               ssd_A_log[i], ssd_D[i], ssd_norm[i], hg_norm[i], ctx_out)
        x = x + gt[:, None] * (m @ w_out[layer])
        if ctx_out:
            xc = xc + gt_c * (m_c @ w_out[layer])
        sh, sc, gt = adaln(c, ada_w[layer], ada_b[layer], 1)
        h = modulate(rms_norm(x, norm_g[layer, 1]), sh[:, None], sc[:, None])
        moe_params = (router_w[layer], router_b[layer], moe_w_gu[layer], moe_b_gu[layer],
                      moe_w_dn[layer], moe_b_dn[layer])
        n_lat = x.shape[0] * x.shape[1]
        if ctx_out:
            sh_c, sc_c, gt_c = adaln(c_ctx, ada_w[layer], ada_b[layer], 1)
            hc = modulate(rms_norm(xc, norm_g[layer, 1]), sh_c, sc_c)
            y = moe_ffn(jnp.concatenate([h.reshape(n_lat, D_MODEL), hc.reshape(-1, D_MODEL)], axis=0), *moe_params)
            x = x + gt[:, None] * y[:n_lat].reshape(x.shape)
            xc = xc + gt_c * y[n_lat:].reshape(xc.shape)
        else:
            x = x + gt[:, None] * moe_ffn(h.reshape(n_lat, D_MODEL), *moe_params).reshape(x.shape)
    return x
```

```cpp
#include <hip/hip_runtime.h>
#include <hip/hip_cooperative_groups.h>
#include <cstdio>
#include <cstdint>
namespace cg = cooperative_groups;

constexpr int L = 16384, NCX = 256, R = L + NCX, D = 1024;
constexpr int EVEN_IN = 2304, ODD_IN = 4112;
constexpr int NT = 512, NWAVE = 8;
constexpr int NEXP = 32;
constexpr int NROWS = 70656;
constexpr float EPS = 1e-6f;

enum { I_X = 0, I_C, I_CTX, I_CCTX, I_NORMG, I_ADAW, I_ADAB, I_WOUT, I_WINE, I_HYCW, I_HYCB, I_HYW1, I_HYB1, I_HYW2, I_HYB2,
       I_HYW3, I_HYB3, I_HYW4, I_HYFREQ, I_HYFB, I_QNORM, I_KNORM, I_SINK, I_WINO, I_SSDCW, I_SSDCB, I_DTB, I_ALOG, I_SSDD,
       I_SSDN, I_HGLB, I_HGN, I_RW, I_RB, I_WGU, I_BGU, I_WDN, I_BDN, N_IN };

constexpr size_t al256(size_t x) { return (x + 255) & ~(size_t)255; }
constexpr size_t OFF_CTL = 0;
constexpr size_t OFF_MOD = 65536;
constexpr size_t OFF_LB = OFF_MOD + al256(4 * 24576);
constexpr size_t OFF_STARTS = OFF_LB + 4096;
constexpr size_t OFF_HNP = OFF_STARTS + 4096;
constexpr size_t OFF_HD3 = OFF_HNP + al256(4 * 130 * 1024);
constexpr size_t OFF_HH = OFF_HD3 + al256(4ull * R * 64);
constexpr size_t OFF_HHC = OFF_HH + al256(4ull * 2 * L * 1024);
constexpr size_t OFF_XA = OFF_HHC + al256(4ull * 512 * 1024);
constexpr size_t OFF_XB = OFF_XA + al256(4ull * R * D);
constexpr size_t OFF_XC = OFF_XB + al256(4ull * R * D);
constexpr size_t OFF_H = OFF_XC + al256(4ull * R * D);
constexpr size_t OFF_P = OFF_H + al256(4ull * R * D);
constexpr size_t OFF_QN = OFF_P + al256(4ull * R * ODD_IN);
constexpr size_t OFF_KN = OFF_QN + al256(4ull * R * 512);
constexpr size_t OFF_M = OFF_KN + al256(4ull * R * 128);
constexpr size_t OFF_U = OFF_M + al256(4ull * R * D);
constexpr size_t OFF_Z1 = OFF_U + al256(4ull * R * 1536);
constexpr size_t OFF_TOPE = OFF_Z1 + al256(4ull * R * 512);
constexpr size_t OFF_TOPG = OFF_TOPE + al256(4ull * R * 4);
constexpr size_t OFF_TOPP = OFF_TOPG + al256(4ull * R * 4);
constexpr size_t OFF_ROWTOK = OFF_TOPP + al256(4ull * R * 4);
constexpr size_t OFF_ACT = OFF_ROWTOK + al256(4ull * 2 * NROWS);
constexpr size_t OFF_YR = OFF_ACT + al256(4ull * NROWS * 1024);
constexpr size_t OFF_XBC = OFF_YR + al256(4ull * NROWS * 1024);
constexpr size_t OFF_DT = OFF_XBC + al256(4ull * R * 1024);
constexpr size_t OFF_F = OFF_DT + al256(4ull * 2 * R * 8);
constexpr size_t OFF_Q1 = OFF_F + al256(4ull * 2 * R * 512);
constexpr size_t OFF_Y = OFF_Q1 + al256(4ull * R * 512);
constexpr size_t OFF_O = OFF_Y + al256(4ull * 2 * R * 512);
constexpr size_t WS_END = OFF_O + al256(4ull * 2 * R * 512);

struct Params {
    const float* in[N_IN];
    float* out;
    unsigned char* ws;
    int ph_lo, ph_hi;
};

__device__ __forceinline__ float silu_f(float x) { return x / (1.f + expf(-x)); }
__device__ __forceinline__ float sigmoid_f(float x) { return 1.f / (1.f + expf(-x)); }
__device__ __forceinline__ float softplus_f(float x) { return x > 20.f ? x : log1pf(expf(x)); }
__device__ __forceinline__ float wave_sum(float v) {
#pragma unroll
    for (int o = 32; o; o >>= 1) v += __shfl_xor(v, o);
    return v;
}
__device__ __forceinline__ float wave_max(float v) {
#pragma unroll
    for (int o = 32; o; o >>= 1) v = fmaxf(v, __shfl_xor(v, o));
    return v;
}
template <class T> __device__ __forceinline__ T* wsp(const Params& p, size_t off) { return (T*)(p.ws + off); }
__device__ __forceinline__ const float* modp(const Params& p, int layer, int cond, int j) {
    return wsp<float>(p, OFF_MOD) + (layer * 2 + cond) * 6144 + j * 3072;
}

template <class AL, class BL, class EP>
__device__ __forceinline__ void gemm_tile_f32(float* lds, int K, AL aload, BL bload, EP epi) {
    float(*As)[132] = (float(*)[132])lds;
    float(*Bs)[132] = (float(*)[132])(lds + 16 * 132);
    const int tid = threadIdx.x, tx = tid & 15, ty = tid >> 4;
    float acc[4][8];
#pragma unroll
    for (int i = 0; i < 4; i++)
#pragma unroll
        for (int j = 0; j < 8; j++) acc[i][j] = 0.f;
    for (int k0 = 0; k0 < K; k0 += 16) {
        float av[4], bv[4];
#pragma unroll
        for (int i = 0; i < 4; i++) av[i] = aload((tid >> 4) + 32 * i, k0 + (tid & 15));
#pragma unroll
        for (int i = 0; i < 4; i++) bv[i] = bload(k0 + (tid >> 7) + 4 * i, tid & 127);
        __syncthreads();
#pragma unroll
        for (int i = 0; i < 4; i++) As[tid & 15][(tid >> 4) + 32 * i] = av[i];
#pragma unroll
        for (int i = 0; i < 4; i++) Bs[(tid >> 7) + 4 * i][tid & 127] = bv[i];
        __syncthreads();
#pragma unroll
        for (int k = 0; k < 16; k++) {
            const float4 a = *(const float4*)&As[k][ty * 4];
            const float4 b0 = *(const float4*)&Bs[k][tx * 4];
            const float4 b1 = *(const float4*)&Bs[k][64 + tx * 4];
            const float aa[4] = {a.x, a.y, a.z, a.w};
            const float bb[8] = {b0.x, b0.y, b0.z, b0.w, b1.x, b1.y, b1.z, b1.w};
#pragma unroll
            for (int i = 0; i < 4; i++)
#pragma unroll
                for (int j = 0; j < 8; j++) acc[i][j] = fmaf(aa[i], bb[j], acc[i][j]);
        }
    }
    __syncthreads();
#pragma unroll
    for (int i = 0; i < 4; i++) epi(ty * 4 + i, tx, acc[i]);
}
__device__ __forceinline__ int lcol(int tx, int jc) { return tx * 4 + (jc & 3) + 64 * (jc >> 2); }

template <class EP>
__device__ void gemm_dense(float* lds, const float* A, int lda, const float* B, int N, int M, int K, EP epi) {
    const int tm = M / 128, tn = (N + 127) / 128;
    for (int t = blockIdx.x; t < tm * tn; t += gridDim.x) {
        const int m0 = (t / tn) * 128, n0 = (t % tn) * 128;
        gemm_tile_f32(
            lds, K, [&](int r, int k) { return A[(size_t)(m0 + r) * lda + k]; },
            [&](int k, int c) { return (n0 + c < N) ? B[(size_t)k * N + n0 + c] : 0.f; },
            [&](int r, int tx, const float(&a)[8]) {
#pragma unroll
                for (int jc = 0; jc < 8; jc++) {
                    const int c = n0 + lcol(tx, jc);
                    if (c < N) epi(m0 + r, c, a[jc]);
                }
            });
    }
}

__device__ void ph_prologue(const Params& p, float* lds) {
    const int tid = threadIdx.x, lane = tid & 63, wave = tid >> 6;
    const int gthreads = gridDim.x * NT, gtid = blockIdx.x * NT + tid;
    float* mod = wsp<float>(p, OFF_MOD);
    for (int it = gtid; it < 2 * 6144; it += gthreads) {
        const int layer = it / 6144, n = it % 6144;
        const float* w = p.in[I_ADAW] + (size_t)layer * 1024 * 6144 + n;
        float a0 = 0.f, a1 = 0.f;
#pragma unroll 8
        for (int k = 0; k < 1024; k++) {
            const float wv = w[(size_t)k * 6144];
            a0 = fmaf(silu_f(p.in[I_C][k]), wv, a0);
            a1 = fmaf(silu_f(p.in[I_CCTX][k]), wv, a1);
        }
        const float b = p.in[I_ADAB][layer * 6144 + n];
        mod[(layer * 2 + 0) * 6144 + n] = a0 + b;
        mod[(layer * 2 + 1) * 6144 + n] = a1 + b;
    }
    for (int it = gtid; it < 512; it += gthreads) {
        const float b0 = p.in[I_HGLB][it], b1 = p.in[I_HGLB][512 + it];
        wsp<float>(p, OFF_LB)[it] = 1.f / (1.f + expf(b0 - b1));
    }
    int* rt = wsp<int>(p, OFF_ROWTOK);
    for (int it = gtid; it < 2 * NROWS; it += gthreads) rt[it] = -1;
    float* zb = lds + wave * 64;
    float* hd3 = wsp<float>(p, OFF_HD3);
    const float fq = p.in[I_HYFREQ][lane];
    for (int row = blockIdx.x * NWAVE + wave; row < R; row += gridDim.x * NWAVE) {
        const int Ls = row < L ? L : NCX, t = row < L ? row : row - L;
        const float tn = (float)t / (float)(Ls - 1);
        const float wang = 6.283185307179586f * (float)t / (float)Ls;
        if (lane < 33) {
            float z;
            if (lane == 0) z = tn;
            else {
                const int b = (lane - 1) & 15;
                const float fr = 1e-4f + (float)b * ((15.f - 1e-4f) / 15.f);
                z = (lane <= 16) ? cosf(fr * wang) : -sinf(fr * wang);
            }
            zb[lane] = z;
        }
        __builtin_amdgcn_wave_barrier();
        float a = p.in[I_HYB1][lane];
#pragma unroll 1
        for (int i = 0; i < 33; i++) a = fmaf(zb[i], p.in[I_HYW1][i * 64 + lane], a);
        float h = sinf(fq * a);
        __builtin_amdgcn_wave_barrier();
        zb[lane] = h;
        __builtin_amdgcn_wave_barrier();
        a = p.in[I_HYB2][lane];
#pragma unroll 1
        for (int i = 0; i < 64; i++) a = fmaf(zb[i], p.in[I_HYW2][i * 64 + lane], a);
        h = sinf(fq * a);
        __builtin_amdgcn_wave_barrier();
        zb[lane] = h;
        __builtin_amdgcn_wave_barrier();
        a = p.in[I_HYB3][lane];
#pragma unroll 1
        for (int i = 0; i < 64; i++) a = fmaf(zb[i], p.in[I_HYW3][i * 64 + lane], a);
        h = sinf(fq * a);
        hd3[(size_t)row * 64 + lane] = h;
        __builtin_amdgcn_wave_barrier();
    }
}

template <bool ROUTER>
__device__ void prep_rows(const Params& p, const float* xl, const float* xc, int nrows, const float* g, int layer, int j, float* hout) {
    const int lane = threadIdx.x & 63, wave = threadIdx.x >> 6;
    for (int r = blockIdx.x * NWAVE + wave; r < nrows; r += gridDim.x * NWAVE) {
        const float* src = r < L ? xl + (size_t)r * D : xc + (size_t)(r - L) * D;
        const float* md = modp(p, layer, r < L ? 0 : 1, j);
        float v[16];
        float ss = 0.f;
#pragma unroll
        for (int i = 0; i < 16; i++) { v[i] = src[lane + 64 * i]; ss = fmaf(v[i], v[i], ss); }
        ss = wave_sum(ss);
        const float rinv = rsqrtf(ss * (1.f / 1024.f) + EPS);
#pragma unroll
        for (int i = 0; i < 16; i++) {
            const int c = lane + 64 * i;
            v[i] = v[i] * rinv * g[c] * (1.f + md[1024 + c]) + md[c];
            hout[(size_t)r * D + c] = v[i];
        }
        if (ROUTER) {
            const float* rw = p.in[I_RW] + (size_t)layer * 1024 * 32;
            float lg[32];
#pragma unroll
            for (int e = 0; e < 32; e++) lg[e] = 0.f;
#pragma unroll 1
            for (int i = 0; i < 16; i++) {
                const float* wr = rw + (size_t)(lane + 64 * i) * 32;
                const float hv = hout[(size_t)r * D + lane + 64 * i];
#pragma unroll
                for (int e4 = 0; e4 < 8; e4++) {
                    const float4 w4 = *(const float4*)(wr + e4 * 4);
                    lg[e4 * 4 + 0] = fmaf(hv, w4.x, lg[e4 * 4 + 0]);
                    lg[e4 * 4 + 1] = fmaf(hv, w4.y, lg[e4 * 4 + 1]);
                    lg[e4 * 4 + 2] = fmaf(hv, w4.z, lg[e4 * 4 + 2]);
                    lg[e4 * 4 + 3] = fmaf(hv, w4.w, lg[e4 * 4 + 3]);
                }
            }
#pragma unroll
            for (int e = 0; e < 32; e++) lg[e] = wave_sum(lg[e]) + p.in[I_RB][layer * 32 + e];
            unsigned used = 0u;
            float tv[4];
            int ti[4];
#pragma unroll
            for (int k = 0; k < 4; k++) {
                float best = -INFINITY;
                int bi = 0;
#pragma unroll
                for (int e = 0; e < 32; e++) {
                    const bool ok = !((used >> e) & 1u) && (lg[e] > best);
                    best = ok ? lg[e] : best;
                    bi = ok ? e : bi;
                }
                used |= 1u << bi;
                tv[k] = best;
                ti[k] = bi;
            }
            float es[4], den = 0.f;
#pragma unroll
            for (int k = 0; k < 4; k++) { es[k] = expf(tv[k] - tv[0]); den += es[k]; }
            if (lane < 4) {
                int e = ti[0];
                float gg = es[0];
#pragma unroll
                for (int k = 1; k < 4; k++) { e = (lane == k) ? ti[k] : e; gg = (lane == k) ? es[k] : gg; }
                int* cnt = wsp<int>(p, OFF_CTL) + layer * 32;
                const int pos = atomicAdd(&cnt[e], 1);
                wsp<int>(p, OFF_TOPE)[r * 4 + lane] = e;
                wsp<float>(p, OFF_TOPG)[r * 4 + lane] = gg / den;
                wsp<int>(p, OFF_TOPP)[r * 4 + lane] = pos;
            }
        }
    }
}

__device__ void ph_filter_gemm(const Params& p, float* lds) {
    const float* hd3 = wsp<float>(p, OFF_HD3);
    float* hh = wsp<float>(p, OFF_HH);
    float* hhc = wsp<float>(p, OFF_HHC);
    const float mind = logf(1e-2f) / 1.5f, maxd = logf(1e-2f) / 0.3f;
    gemm_dense(lds, hd3, 64, p.in[I_HYW4], 2048, R, 64, [&](int row, int col, float v) {
        const int Ls = row < L ? L : NCX, t = row < L ? row : row - L;
        float* dst = row < L ? hh : hhc;
        const int o = col >> 10, side = (col >> 9) & 1, ch = col & 511;
        const float delta = fabsf(mind + (float)ch * ((maxd - mind) / 511.f));
        const float tn = (float)t / (float)(Ls - 1);
        const float val = v * expf(-tn * delta);
        if (side == 0) dst[(size_t)(Ls + t) * 1024 + o * 512 + ch] = val;
        else if (t > 0) dst[(size_t)(Ls - t) * 1024 + o * 512 + ch] = val;
        else dst[o * 512 + ch] = 0.f;
    });
}
__device__ void ph_filter_abs(const Params& p) {
    const float* hh = wsp<float>(p, OFF_HH);
    const float* hhc = wsp<float>(p, OFF_HHC);
    float* hnp = wsp<float>(p, OFF_HNP);
    for (int it = blockIdx.x; it < 130 * 2; it += gridDim.x) {
        const int chunk = it >> 1, col = (it & 1) * 512 + threadIdx.x;
        const float* src = chunk < 128 ? hh + (size_t)chunk * 256 * 1024 : hhc + (size_t)(chunk - 128) * 256 * 1024;
        float s = 0.f;
        for (int i = 0; i < 256; i++) s += fabsf(src[(size_t)i * 1024 + col]);
        hnp[chunk * 1024 + col] = s;
    }
}

__device__ void ph_qk_dwconv(const Params& p) {
    const int lane = threadIdx.x & 63, wave = threadIdx.x >> 6;
    const float* P0 = wsp<float>(p, OFF_P);
    float* qn = wsp<float>(p, OFF_QN);
    float* kn = wsp<float>(p, OFF_KN);
    for (int it = blockIdx.x * NWAVE + wave; it < R * 10; it += gridDim.x * NWAVE) {
        const int r = it / 10, s = it % 10;
        const int off = s < 2 ? s * 64 : 256 + (s - 2) * 64;
        const float v = P0[(size_t)r * EVEN_IN + off + lane];
        const float ss = wave_sum(v * v);
        const float gain = s < 2 ? p.in[I_KNORM][lane] : p.in[I_QNORM][lane];
        float n = v * rsqrtf(ss * (1.f / 64.f) + EPS) * gain;
        if (r < L) {
            const float partner = __shfl_xor(n, 16);
            const int pos = lane < 32 ? (r >> 6) : (r & 63);
            const int i = lane & 15;
            const float inv = powf(10000.f, -(float)i / 16.f);
            const float ang = (float)pos * inv;
            const float cs = cosf(ang), sn = sinf(ang);
            n = ((lane & 16) == 0) ? n * cs - partner * sn : partner * sn + n * cs;
        }
        if (s < 2) kn[(size_t)r * 128 + s * 64 + lane] = n;
        else qn[(size_t)r * 512 + (s - 2) * 64 + lane] = n;
    }
    float* U = wsp<float>(p, OFF_U);
    const float* cw = p.in[I_HYCW];
    const float* cb = p.in[I_HYCB];
    const size_t tot = (size_t)R * 1536;
    for (size_t it = (size_t)blockIdx.x * NT + threadIdx.x; it < tot; it += (size_t)gridDim.x * NT) {
        const int r = (int)(it / 1536), c = (int)(it % 1536);
        const int lo = r < L ? 0 : L, hi = r < L ? L : R;
        float a = cb[c];
#pragma unroll
        for (int j = 0; j < 3; j++) {
            const int rr = r + j - 1;
            if (rr >= lo && rr < hi) a = fmaf(cw[j * 1536 + c], P0[(size_t)rr * EVEN_IN + 768 + c], a);
        }
        U[it] = a;
    }
}

__device__ void ph_attention(const Params& p, float* lds) {
    const int lane = threadIdx.x & 63, wave = threadIdx.x >> 6;
    const float* P0 = wsp<float>(p, OFF_P);
    const float* qn = wsp<float>(p, OFF_QN);
    const float* kn = wsp<float>(p, OFF_KN);
    float* M = wsp<float>(p, OFF_M);
    float* sc = lds + wave * 576;
    for (int it = blockIdx.x * NWAVE + wave; it < R * 8; it += gridDim.x * NWAVE) {
        const int r = it >> 3, hq = it & 7, kvh = hq >> 2;
        int lo = 0, nloc = 0;
        if (r < L) { lo = max(0, r - 128); nloc = min(L - 1, r + 128) - lo + 1; }
        const int ntot = nloc + NCX;
        float q[64];
#pragma unroll
        for (int d4 = 0; d4 < 16; d4++) {
            const float4 t = *(const float4*)(qn + (size_t)r * 512 + hq * 64 + d4 * 4);
            q[d4 * 4] = t.x; q[d4 * 4 + 1] = t.y; q[d4 * 4 + 2] = t.z; q[d4 * 4 + 3] = t.w;
        }
        float mx = -INFINITY;
        for (int j = lane; j < ntot; j += 64) {
            const int krow = j < nloc ? lo + j : L + (j - nloc);
            const float* kp = kn + (size_t)krow * 128 + kvh * 64;
            float dot = 0.f;
#pragma unroll
            for (int d4 = 0; d4 < 16; d4++) {
                const float4 t = *(const float4*)(kp + d4 * 4);
                dot = fmaf(q[d4 * 4], t.x, dot); dot = fmaf(q[d4 * 4 + 1], t.y, dot);
                dot = fmaf(q[d4 * 4 + 2], t.z, dot); dot = fmaf(q[d4 * 4 + 3], t.w, dot);
            }
            dot *= 0.125f;
            sc[j] = dot;
            mx = fmaxf(mx, dot);
        }
        const float sink = p.in[I_SINK][hq];
        mx = fmaxf(wave_max(mx), sink);
        float sum = 0.f;
        for (int j = lane; j < ntot; j += 64) { const float e = expf(sc[j] - mx); sc[j] = e; sum += e; }
        sum = wave_sum(sum) + expf(sink - mx);
        const float rs = 1.f / sum;
        __builtin_amdgcn_wave_barrier();
        float o = 0.f;
        for (int j = 0; j < ntot; j++) {
            const int krow = j < nloc ? lo + j : L + (j - nloc);
            o = fmaf(sc[j], P0[(size_t)krow * EVEN_IN + 128 + kvh * 64 + lane], o);
        }
        M[(size_t)r * D + 512 + hq * 64 + lane] = o * rs;
        __builtin_amdgcn_wave_barrier();
    }
}

__device__ void ph_hyena_conv(const Params& p, int o) {
    const int lane = threadIdx.x & 63, wave = threadIdx.x >> 6;
    const float* U = wsp<float>(p, OFF_U);
    const float* hnp = wsp<float>(p, OFF_HNP);
    float* Z1 = wsp<float>(p, OFF_Z1);
    float* M = wsp<float>(p, OFF_M);
    const float* zin = o == 0 ? U : Z1;
    const int zld = o == 0 ? 1536 : 512;
    const int nlat = 8 * (L / 64), nctx = 8 * (NCX / 64);
    for (int it = blockIdx.x; it < nlat + nctx; it += gridDim.x) {
        const bool lat = it < nlat;
        const int ii = lat ? it : it - nlat;
        const int Ls = lat ? L : NCX, base = lat ? 0 : L;
        const int ch = (ii & 7) * 64 + lane, t0 = (ii >> 3) * 64 + wave * 8;
        const float* hf = (lat ? wsp<float>(p, OFF_HH) : wsp<float>(p, OFF_HHC)) + o * 512 + ch;
        float nrm = 0.f;
        if (lat) { for (int c = 0; c < 128; c++) nrm += hnp[c * 1024 + o * 512 + ch]; }
        else { nrm = hnp[128 * 1024 + o * 512 + ch] + hnp[129 * 1024 + o * 512 + ch]; }
        float acc[8];
#pragma unroll
        for (int i = 0; i < 8; i++) acc[i] = 0.f;
        for (int s0 = 0; s0 < Ls; s0 += 8) {
            float zv[8], hv[15];
#pragma unroll
            for (int j = 0; j < 8; j++) zv[j] = zin[(size_t)(base + s0 + j) * zld + ch];
#pragma unroll
            for (int e = 0; e < 15; e++) hv[e] = hf[(size_t)(t0 - s0 + e - 7 + Ls) * 1024];
#pragma unroll
            for (int i = 0; i < 8; i++)
#pragma unroll
                for (int j = 0; j < 8; j++) acc[i] = fmaf(hv[i - j + 7], zv[j], acc[i]);
        }
        const float inv = 1.f / nrm;
        const float bias = p.in[I_HYFB][o * 512 + ch];
#pragma unroll
        for (int i = 0; i < 8; i++) {
            const int r = base + t0 + i;
            const float zc = acc[i] * inv;
            const float z = zin[(size_t)r * zld + ch];
            const float gate = U[(size_t)r * 1536 + 512 * (o + 1) + ch];
            const float res = gate * (zc + z * bias);
            if (o == 0) Z1[(size_t)r * 512 + ch] = res;
            else M[(size_t)r * D + ch] = res;
        }
    }
}

__device__ void ph_moe_scatter(const Params& p, int layer, int ntok) {
    __shared__ int sst[33];
    const int* cnt = wsp<int>(p, OFF_CTL) + layer * 32;
    if (threadIdx.x == 0) {
        int a = 0;
        for (int e = 0; e < 32; e++) { sst[e] = a; a += (cnt[e] + 127) / 128 * 128; }
        sst[32] = a;
    }
    __syncthreads();
    if (blockIdx.x == 0 && threadIdx.x < 33) wsp<int>(p, OFF_STARTS)[layer * 64 + threadIdx.x] = sst[threadIdx.x];
    int* rt = wsp<int>(p, OFF_ROWTOK) + (size_t)layer * NROWS;
    const int* te = wsp<int>(p, OFF_TOPE);
    const int* tp = wsp<int>(p, OFF_TOPP);
    for (int it = blockIdx.x * NT + threadIdx.x; it < ntok * 4; it += gridDim.x * NT) rt[sst[te[it]] + tp[it]] = it >> 2;
    __syncthreads();
}
__device__ void ph_moe_gemm1(const Params& p, float* lds, int layer) {
    __shared__ int stok[128];
    const int* starts = wsp<int>(p, OFF_STARTS) + layer * 64;
    const int* rt = wsp<int>(p, OFF_ROWTOK) + (size_t)layer * NROWS;
    const float* H = wsp<float>(p, OFF_H);
    float* ACT = wsp<float>(p, OFF_ACT);
    const int total = starts[32];
    const int ntiles = (total / 128) * 16;
    for (int t = blockIdx.x; t < ntiles; t += gridDim.x) {
        const int m0 = (t >> 4) * 128, j = t & 15;
        int e = 0;
        for (int q = 1; q < 32; q++) e = (m0 >= starts[q]) ? q : e;
        __syncthreads();
        if (threadIdx.x < 128) stok[threadIdx.x] = rt[m0 + threadIdx.x];
        __syncthreads();
        const float* W = p.in[I_WGU] + ((size_t)layer * 32 + e) * 1024 * 2048;
        const float* bg = p.in[I_BGU] + ((size_t)layer * 32 + e) * 2048;
        gemm_tile_f32(
            lds, 1024, [&](int r, int k) { const int tok = stok[r]; return tok < 0 ? 0.f : H[(size_t)tok * D + k]; },
            [&](int k, int c) { return W[(size_t)k * 2048 + (c < 64 ? j * 64 + c : 1024 + j * 64 + (c - 64))]; },
            [&](int r, int tx, const float(&a)[8]) {
#pragma unroll
                for (int c = 0; c < 4; c++) {
                    const int col = j * 64 + tx * 4 + c;
                    const float gate = fminf(a[c] + bg[col], 7.f);
                    const float up = fminf(fmaxf(a[4 + c] + bg[1024 + col], -7.f), 7.f);
                    ACT[(size_t)(m0 + r) * 1024 + col] = (up + 1.f) * gate * sigmoid_f(1.702f * gate);
                }
            });
    }
}
__device__ void ph_moe_gemm2(const Params& p, float* lds, int layer) {
    const int* starts = wsp<int>(p, OFF_STARTS) + layer * 64;
    const float* ACT = wsp<float>(p, OFF_ACT);
    float* YR = wsp<float>(p, OFF_YR);
    const int total = starts[32];
    const int ntiles = (total / 128) * 8;
    for (int t = blockIdx.x; t < ntiles; t += gridDim.x) {
        const int m0 = (t >> 3) * 128, n0 = (t & 7) * 128;
        int e = 0;
        for (int q = 1; q < 32; q++) e = (m0 >= starts[q]) ? q : e;
        const float* W = p.in[I_WDN] + ((size_t)layer * 32 + e) * 1024 * 1024;
        const float* bd = p.in[I_BDN] + ((size_t)layer * 32 + e) * 1024;
        gemm_tile_f32(
            lds, 1024, [&](int r, int k) { return ACT[(size_t)(m0 + r) * 1024 + k]; },
            [&](int k, int c) { return W[(size_t)k * 1024 + n0 + c]; },
            [&](int r, int tx, const float(&a)[8]) {
#pragma unroll
                for (int jc = 0; jc < 8; jc++) {
                    const int col = n0 + lcol(tx, jc);
                    YR[(size_t)(m0 + r) * 1024 + col] = a[jc] + bd[col];
                }
            });
    }
}
template <bool NEXTPREP>
__device__ void ph_moe_combine(const Params& p, int layer, int nrows, const float* xi, float* xo, int nlayer) {
    const int lane = threadIdx.x & 63, wave = threadIdx.x >> 6;
    const int* starts = wsp<int>(p, OFF_STARTS) + layer * 64;
    const int* te = wsp<int>(p, OFF_TOPE);
    const int* tp = wsp<int>(p, OFF_TOPP);
    const float* tg = wsp<float>(p, OFF_TOPG);
    const float* YR = wsp<float>(p, OFF_YR);
    float* H = wsp<float>(p, OFF_H);
    for (int r = blockIdx.x * NWAVE + wave; r < nrows; r += gridDim.x * NWAVE) {
        const float* gt = modp(p, layer, r < L ? 0 : 1, 1) + 2048;
        float v[16];
#pragma unroll
        for (int i = 0; i < 16; i++) v[i] = 0.f;
#pragma unroll
        for (int k = 0; k < 4; k++) {
            const int row = starts[te[r * 4 + k]] + tp[r * 4 + k];
            const float g = tg[r * 4 + k];
#pragma unroll
            for (int i = 0; i < 16; i++) v[i] = fmaf(g, YR[(size_t)row * 1024 + lane + 64 * i], v[i]);
        }
        float ss = 0.f;
#pragma unroll
        for (int i = 0; i < 16; i++) {
            const int c = lane + 64 * i;
            v[i] = xi[(size_t)r * D + c] + gt[c] * v[i];
            xo[(size_t)r * D + c] = v[i];
            ss = fmaf(v[i], v[i], ss);
        }
        if (NEXTPREP) {
            ss = wave_sum(ss);
            const float rinv = rsqrtf(ss * (1.f / 1024.f) + EPS);
            const float* md = modp(p, nlayer, r < L ? 0 : 1, 0);
            const float* g = p.in[I_NORMG] + (nlayer * 2 + 0) * 1024;
#pragma unroll
            for (int i = 0; i < 16; i++) {
                const int c = lane + 64 * i;
                H[(size_t)r * D + c] = v[i] * rinv * g[c] * (1.f + md[1024 + c]) + md[c];
            }
        }
    }
}

__device__ void ph_streams(const Params& p) {
    const float* P1 = wsp<float>(p, OFF_P);
    float* XBC = wsp<float>(p, OFF_XBC);
    float* DT = wsp<float>(p, OFF_DT);
    float* F = wsp<float>(p, OFF_F);
    float* Q1 = wsp<float>(p, OFF_Q1);
    const float* cw = p.in[I_SSDCW];
    const float* cb = p.in[I_SSDCB];
    const float* lb = wsp<float>(p, OFF_LB);
    const size_t gsz = (size_t)gridDim.x * NT, g0 = (size_t)blockIdx.x * NT + threadIdx.x;
    for (size_t it = g0; it < (size_t)R * 1024; it += gsz) {
        const int r = (int)(it >> 10), c = (int)(it & 1023);
        const int lo = r < L ? 0 : L, hi = r < L ? L : R;
        float a = cb[c];
#pragma unroll
        for (int j = 0; j < 3; j++) {
            const int rr = r + j - 1;
            if (rr >= lo && rr < hi) a = fmaf(cw[j * 1024 + c], P1[(size_t)rr * ODD_IN + c], a);
        }
        XBC[it] = silu_f(a);
        if (c < 512) {
            F[(size_t)r * 512 + c] = lb[c] + (1.f - lb[c]) * sigmoid_f(P1[(size_t)r * ODD_IN + 1040 + c]);
            F[(size_t)R * 512 + (size_t)r * 512 + c] = lb[c] + (1.f - lb[c]) * sigmoid_f(P1[(size_t)r * ODD_IN + 1040 + 512 + c]);
            Q1[(size_t)r * 512 + c] = silu_f(P1[(size_t)r * ODD_IN + 3088 + c]);
        }
        if (c < 16) {
            const int d = c >> 3, h = c & 7;
            DT[(size_t)d * R * 8 + (size_t)r * 8 + h] = softplus_f(P1[(size_t)r * ODD_IN + 1024 + c] + p.in[I_DTB][d * 8 + h]);
        }
    }
}
__device__ void ph_scans(const Params& p) {
    const int lane = threadIdx.x & 63, wave = threadIdx.x >> 6;
    const float* P1 = wsp<float>(p, OFF_P);
    const float* XBC = wsp<float>(p, OFF_XBC);
    const float* DT = wsp<float>(p, OFF_DT);
    const float* F = wsp<float>(p, OFF_F);
    const float* Q1 = wsp<float>(p, OFF_Q1);
    float* Y = wsp<float>(p, OFF_Y);
    float* O = wsp<float>(p, OFF_O);
    for (int it = blockIdx.x * NWAVE + wave; it < 2048; it += gridDim.x * NWAVE) {
        if (it < 1024) {
            const int d = it >> 9, h = (it >> 6) & 7, pp = it & 63, g = h >> 2;
            const float A = -expf(p.in[I_ALOG][d * 8 + h]);
            const float Dk = p.in[I_SSDD][d * 8 + h];
            float S0 = 0.f, S1 = 0.f;
#pragma unroll 4
            for (int s = 0; s < R; s++) {
                const int row = d == 0 ? (s < NCX ? L + s : s - NCX) : (R - 1 - s);
                const float dt = DT[(size_t)d * R * 8 + (size_t)row * 8 + h];
                const float* xr = XBC + (size_t)row * 1024;
                const float x = xr[h * 64 + pp];
                const float dec = expf(dt * A);
                const float B0 = xr[512 + g * 128 + lane], B1 = xr[512 + g * 128 + 64 + lane];
                const float C0 = xr[768 + g * 128 + lane], C1 = xr[768 + g * 128 + 64 + lane];
                S0 = fmaf(S0, dec, dt * x * B0);
                S1 = fmaf(S1, dec, dt * x * B1);
                if (row < L) {
                    const float y = wave_sum(C0 * S0 + C1 * S1) + Dk * x;
                    if (lane == 0) Y[(size_t)d * R * 512 + (size_t)row * 512 + h * 64 + pp] = y;
                }
            }
        } else {
            const int i2 = it - 1024;
            const int d = i2 >> 9, h = (i2 >> 7) & 3, v = i2 & 127;
            float S0 = 0.f, S1 = 0.f;
#pragma unroll 4
            for (int s = 0; s < R; s++) {
                const int row = d == 0 ? (s < NCX ? L + s : s - NCX) : (R - 1 - s);
                const float* fr = F + (size_t)d * R * 512 + (size_t)row * 512 + h * 128;
                const float f0 = fr[lane], f1 = fr[64 + lane];
                const float iv = P1[(size_t)row * ODD_IN + 2064 + h * 128 + v];
                S0 = fmaf(f0, S0, (1.f - f0) * iv);
                S1 = fmaf(f1, S1, (1.f - f1) * iv);
                if (row < L) {
                    const float* qr = Q1 + (size_t)row * 512 + h * 128;
                    const float o = wave_sum(qr[lane] * S0 + qr[64 + lane] * S1);
                    if (lane == 0) O[(size_t)d * R * 512 + (size_t)row * 512 + h * 128 + v] = o;
                }
            }
        }
    }
}
__device__ void ph_merge(const Params& p) {
    const int lane = threadIdx.x & 63, wave = threadIdx.x >> 6;
    const float* P1 = wsp<float>(p, OFF_P);
    const float* Y = wsp<float>(p, OFF_Y);
    const float* O = wsp<float>(p, OFF_O);
    float* M = wsp<float>(p, OFF_M);
    for (int r = blockIdx.x * NWAVE + wave; r < L; r += gridDim.x * NWAVE) {
        float ys[8], os[8];
        float sy0 = 0.f, sy1 = 0.f, so[4] = {0.f, 0.f, 0.f, 0.f};
#pragma unroll
        for (int i = 0; i < 8; i++) {
            const int c = lane + 64 * i;
            const float y = Y[(size_t)r * 512 + c] + Y[(size_t)R * 512 + (size_t)r * 512 + c];
            ys[i] = y * silu_f(P1[(size_t)r * ODD_IN + 2576 + c]);
            if (i < 4) sy0 = fmaf(ys[i], ys[i], sy0); else sy1 = fmaf(ys[i], ys[i], sy1);
            os[i] = O[(size_t)r * 512 + c] + O[(size_t)R * 512 + (size_t)r * 512 + c];
            so[i >> 1] = fmaf(os[i], os[i], so[i >> 1]);
        }
        sy0 = rsqrtf(wave_sum(sy0) * (1.f / 256.f) + EPS);
        sy1 = rsqrtf(wave_sum(sy1) * (1.f / 256.f) + EPS);
#pragma unroll
        for (int k = 0; k < 4; k++) so[k] = rsqrtf(wave_sum(so[k]) * (1.f / 128.f) + EPS);
#pragma unroll
        for (int i = 0; i < 8; i++) {
            const int c = lane + 64 * i;
            M[(size_t)r * D + c] = ys[i] * (i < 4 ? sy0 : sy1) * p.in[I_SSDN][c];
            M[(size_t)r * D + 512 + c] = os[i] * so[i >> 1] * p.in[I_HGN][c] * silu_f(P1[(size_t)r * ODD_IN + 3600 + c]);
        }
    }
}

constexpr int N_PHASES = 22;
__global__ void __launch_bounds__(NT) mega(Params p) {
    __shared__ __attribute__((aligned(16))) float lds[8192];
    cg::grid_group grid = cg::this_grid();
    float* XA = wsp<float>(p, OFF_XA);
    float* XB = wsp<float>(p, OFF_XB);
    float* XC = wsp<float>(p, OFF_XC);
    float* H = wsp<float>(p, OFF_H);
    float* PP = wsp<float>(p, OFF_P);
    float* M = wsp<float>(p, OFF_M);
#ifndef ONLY
#define ONLY -1
#endif
    const int lo = p.ph_lo, hi = p.ph_hi;
#define IN(k) ((ONLY < 0 || ONLY == (k)) && lo <= (k) && (k) < hi)
#define SEAM(k) do { if ((k) + 1 < hi) grid.sync(); } while (0)
    if (IN(0)) { ph_prologue(p, lds);
    }
    if (lo <= 0 && 0 < hi) SEAM(0);
    if (IN(1)) {
            prep_rows<false>(p, p.in[I_X], p.in[I_CTX], R, p.in[I_NORMG] + 0, 0, 0, H);
            ph_filter_gemm(p, lds);
    }
    if (lo <= 1 && 1 < hi) SEAM(1);
    if (IN(2)) {
            gemm_dense(lds, H, D, p.in[I_WINE], EVEN_IN, R, D, [&](int r, int c, float v) { PP[(size_t)r * EVEN_IN + c] = v; });
            ph_filter_abs(p);
    }
    if (lo <= 2 && 2 < hi) SEAM(2);
    if (IN(3)) { ph_qk_dwconv(p);
    }
    if (lo <= 3 && 3 < hi) SEAM(3);
    if (IN(4)) { ph_attention(p, lds); ph_hyena_conv(p, 0);
    }
    if (lo <= 4 && 4 < hi) SEAM(4);
    if (IN(5)) { ph_hyena_conv(p, 1);
    }
    if (lo <= 5 && 5 < hi) SEAM(5);
    if (IN(6)) {
            gemm_dense(lds, M, D, p.in[I_WOUT], D, R, D, [&](int r, int c, float v) {
                const float* src = r < L ? p.in[I_X] + (size_t)r * D : p.in[I_CTX] + (size_t)(r - L) * D;
                XA[(size_t)r * D + c] = src[c] + modp(p, 0, r < L ? 0 : 1, 0)[2048 + c] * v;
            });
    }
    if (lo <= 6 && 6 < hi) SEAM(6);
    if (IN(7)) { prep_rows<true>(p, XA, XA + (size_t)L * D, R, p.in[I_NORMG] + 1024, 0, 1, H);
    }
    if (lo <= 7 && 7 < hi) SEAM(7);
    if (IN(8)) { ph_moe_scatter(p, 0, R);
    }
    if (lo <= 8 && 8 < hi) SEAM(8);
    if (IN(9)) { ph_moe_gemm1(p, lds, 0);
    }
    if (lo <= 9 && 9 < hi) SEAM(9);
    if (IN(10)) { ph_moe_gemm2(p, lds, 0);
    }
    if (lo <= 10 && 10 < hi) SEAM(10);
    if (IN(11)) { ph_moe_combine<true>(p, 0, R, XA, XB, 1);
    }
    if (lo <= 11 && 11 < hi) SEAM(11);
    if (IN(12)) {
            gemm_dense(lds, H, D, p.in[I_WINO], ODD_IN, R, D, [&](int r, int c, float v) { PP[(size_t)r * ODD_IN + c] = v; });
    }
    if (lo <= 12 && 12 < hi) SEAM(12);
    if (IN(13)) { ph_streams(p);
    }
    if (lo <= 13 && 13 < hi) SEAM(13);
    if (IN(14)) { ph_scans(p);
    }
    if (lo <= 14 && 14 < hi) SEAM(14);
    if (IN(15)) { ph_merge(p);
    }
    if (lo <= 15 && 15 < hi) SEAM(15);
    if (IN(16)) {
            gemm_dense(lds, M, D, p.in[I_WOUT] + (size_t)D * D, D, L, D, [&](int r, int c, float v) {
                XC[(size_t)r * D + c] = XB[(size_t)r * D + c] + modp(p, 1, 0, 0)[2048 + c] * v;
            });
    }
    if (lo <= 16 && 16 < hi) SEAM(16);
    if (IN(17)) { prep_rows<true>(p, XC, XC, L, p.in[I_NORMG] + 3 * 1024, 1, 1, H);
    }
    if (lo <= 17 && 17 < hi) SEAM(17);
    if (IN(18)) { ph_moe_scatter(p, 1, L);
    }
    if (lo <= 18 && 18 < hi) SEAM(18);
    if (IN(19)) { ph_moe_gemm1(p, lds, 1);
    }
    if (lo <= 19 && 19 < hi) SEAM(19);
    if (IN(20)) { ph_moe_gemm2(p, lds, 1);
    }
    if (lo <= 20 && 20 < hi) SEAM(20);
    if (IN(21)) { ph_moe_combine<false>(p, 1, L, XC, p.out, 0);
    }
    if (lo <= 21 && 21 < hi) SEAM(21);
#undef IN
#undef SEAM
}

extern "C" void kernel_launch(void* const* d_in, const int* in_sizes, int n_in, void* d_out, int out_size, void* d_ws, size_t ws_size,
                              hipStream_t stream) {
    static int grid_blocks = 0;
    if (!grid_blocks) {
        int dev = 0, cus = 0, per_cu = 0;
        hipGetDevice(&dev);
        hipDeviceGetAttribute(&cus, hipDeviceAttributeMultiprocessorCount, dev);
        hipOccupancyMaxActiveBlocksPerMultiprocessor(&per_cu, mega, NT, 0);
        if (per_cu < 1) per_cu = 1;
        grid_blocks = cus;
        if (ws_size < WS_END) fprintf(stderr, "kernel_launch: workspace too small: %zu < %zu\n", ws_size, (size_t)WS_END);
    }
    hipMemsetAsync((char*)d_ws + OFF_CTL, 0, 65536, stream);
    Params p{};
    for (int i = 0; i < N_IN; i++) p.in[i] = (const float*)d_in[i];
    p.out = (float*)d_out;
    p.ws = (unsigned char*)d_ws;
    p.ph_lo = 0;
    p.ph_hi = N_PHASES;
    void* args[] = {&p};
    hipError_t e = hipLaunchCooperativeKernel((void*)mega, dim3(grid_blocks), dim3(NT), args, 0, stream);
    if (e != hipSuccess) fprintf(stderr, "cooperative launch failed: %s (grid %d)\n", hipGetErrorString(e), grid_blocks);
}
```

```cpp
#include <hip/hip_runtime.h>
#include <hip/hip_cooperative_groups.h>
#include <cstdio>
#include <cstdint>
namespace cg = cooperative_groups;

constexpr int L = 16384, NCX = 256, R = L + NCX, D = 1024;
constexpr int EVEN_IN = 2304, ODD_IN = 4112;
constexpr int NT = 512, NWAVE = 8;
constexpr int NEXP = 32;
constexpr int NROWS = 74752;
constexpr int ODD_PAD = 4352;
constexpr int LDS_BYTES = 147456;
typedef unsigned short bf16_t;
constexpr float EPS = 1e-6f;

enum { I_X = 0, I_C, I_CTX, I_CCTX, I_NORMG, I_ADAW, I_ADAB, I_WOUT, I_WINE, I_HYCW, I_HYCB, I_HYW1, I_HYB1, I_HYW2, I_HYB2,
       I_HYW3, I_HYB3, I_HYW4, I_HYFREQ, I_HYFB, I_QNORM, I_KNORM, I_SINK, I_WINO, I_SSDCW, I_SSDCB, I_DTB, I_ALOG, I_SSDD,
       I_SSDN, I_HGLB, I_HGN, I_RW, I_RB, I_WGU, I_BGU, I_WDN, I_BDN, N_IN };

constexpr size_t al256(size_t x) { return (x + 255) & ~(size_t)255; }
constexpr size_t OFF_CTL = 0;
constexpr size_t OFF_MOD = 65536;
constexpr size_t OFF_LB = OFF_MOD + al256(4 * 24576);
constexpr size_t OFF_STARTS = OFF_LB + 4096;
constexpr size_t OFF_HNP = OFF_STARTS + 4096;
constexpr size_t OFF_HD3 = OFF_HNP + al256(4 * 130 * 1024);
constexpr size_t OFF_HH = OFF_HD3 + al256(4ull * R * 64);
constexpr size_t OFF_HHC = OFF_HH + al256(4ull * 2 * L * 1024);
constexpr size_t OFF_XA = OFF_HHC + al256(4ull * 512 * 1024);
constexpr size_t OFF_XB = OFF_XA + al256(4ull * R * D);
constexpr size_t OFF_XC = OFF_XA;
constexpr size_t OFF_H = OFF_XB + al256(4ull * R * D);
constexpr size_t OFF_P = OFF_H + al256(4ull * R * D);
constexpr size_t OFF_QN = OFF_P + al256(4ull * R * ODD_IN);
constexpr size_t OFF_KN = OFF_QN + al256(4ull * R * 512);
constexpr size_t OFF_U = OFF_KN + al256(4ull * R * 128);
constexpr size_t OFF_Z1 = OFF_U + al256(4ull * R * 1536);
constexpr size_t OFF_TOPE = OFF_Z1 + al256(4ull * R * 512);
constexpr size_t OFF_TOPG = OFF_TOPE + al256(4ull * R * 4);
constexpr size_t OFF_TOPP = OFF_TOPG + al256(4ull * R * 4);
constexpr size_t OFF_ROWTOK = OFF_TOPP + al256(4ull * R * 4);
constexpr size_t OFF_YR = OFF_ROWTOK + al256(4ull * 2 * NROWS);
constexpr size_t OFF_XBC = OFF_U;
constexpr size_t OFF_DT = OFF_YR + al256(4ull * NROWS * 1024);
constexpr size_t OFF_F = OFF_HH;
constexpr size_t OFF_Q1 = OFF_F + al256(4ull * 2 * R * 512);
constexpr size_t OFF_Y = OFF_DT + al256(4ull * 2 * R * 8);
constexpr size_t OFF_O = OFF_Y + al256(4ull * 2 * R * 512);
constexpr size_t OFF_TILEE = OFF_O + al256(4ull * 2 * R * 512);
constexpr size_t OFF_HB = OFF_TILEE + 4096;
constexpr size_t OFF_MB = OFF_HB + al256(2ull * R * D);
constexpr size_t OFF_XG = OFF_MB + al256(2ull * R * D);
constexpr size_t OFF_ACTB = OFF_XG + al256(2ull * NROWS * D);
constexpr size_t OFF_WINE = OFF_ACTB + al256(2ull * NROWS * D);
constexpr size_t OFF_WINO = OFF_WINE + al256(2ull * EVEN_IN * D);
constexpr size_t OFF_WOUT = OFF_WINO + al256(2ull * ODD_PAD * D);
constexpr size_t OFF_WGU = OFF_WOUT + al256(2ull * 2 * D * D);
constexpr size_t OFF_WDN = OFF_WGU + al256(2ull * 2 * 32 * 2048 * D);
constexpr size_t WS_END = OFF_WDN + al256(2ull * 2 * 32 * 1024 * D);

struct Params {
    const float* in[N_IN];
    float* out;
    unsigned char* ws;
    int ph_lo, ph_hi;
};

__device__ __forceinline__ float silu_f(float x) { return x / (1.f + expf(-x)); }
__device__ __forceinline__ float sigmoid_f(float x) { return 1.f / (1.f + expf(-x)); }
__device__ __forceinline__ float softplus_f(float x) { return x > 20.f ? x : log1pf(expf(x)); }
__device__ __forceinline__ float wave_sum(float v) {
#pragma unroll
    for (int o = 32; o; o >>= 1) v += __shfl_xor(v, o);
    return v;
}
__device__ __forceinline__ float wave_max(float v) {
#pragma unroll
    for (int o = 32; o; o >>= 1) v = fmaxf(v, __shfl_xor(v, o));
    return v;
}
template <class T> __device__ __forceinline__ T* wsp(const Params& p, size_t off) { return (T*)(p.ws + off); }
__device__ __forceinline__ const float* modp(const Params& p, int layer, int cond, int j) {
    return wsp<float>(p, OFF_MOD) + (layer * 2 + cond) * 6144 + j * 3072;
}

__device__ __forceinline__ bf16_t f2bf(float f) { unsigned u = __float_as_uint(f); u += 0x7FFFu + ((u >> 16) & 1u); return (bf16_t)(u >> 16); }
__device__ __forceinline__ unsigned pack_bf16(float lo, float hi) { return (unsigned)f2bf(lo) | ((unsigned)f2bf(hi) << 16); }

namespace pg8 {
#define PG8_LAS __attribute__((address_space(3)))
typedef short bf16x8 __attribute__((ext_vector_type(8)));
typedef float f32x4 __attribute__((ext_vector_type(4)));
typedef unsigned u32x4 __attribute__((ext_vector_type(4)));
constexpr int BM = 256, BK = 64, HALF = 128, HTB = HALF * BK * 2, STAGE_BYTES = 8 * HTB, NXCD = 8, WGM = 8;
__device__ __forceinline__ int lds_byte(int r, int c) { const int st = (r >> 4) * 2 + (c >> 5), rr = r & 15, cc = c & 31, ob = rr * 64 + cc * 2; return st * 1024 + (ob ^ (((ob >> 9) & 1) << 5)); }
__device__ __forceinline__ void stage_rc(int b, int& Rr, int& C) { const int st = b / 1024, sb = b % 1024, swz = sb ^ (((sb >> 9) & 1) << 5); Rr = (st >> 1) * 16 + swz / 64; C = (st & 1) * 32 + (swz % 64) / 2; }
__device__ __forceinline__ int perm32(int rho) { const int n = rho >> 4, i = rho & 15; return 8 * (i >> 2) + 4 * n + (i & 3); }
struct Unit { int pm, pn, pb, e; };
struct Gemm { const bf16_t* A; const bf16_t* Bt; int K; };
struct StaticOrder {
    int nM, nN, nwg, G, c;
    __device__ void init(int M, int N, int G_, int c_) { nM = M / BM; nN = N / BM; nwg = nM * nN; G = G_; c = c_; }
    __device__ bool next(int i, Unit& u) const {
        const long Lx = (long)i * G + c; if (Lx >= nwg) return false;
        int wgid = (int)Lx; { const int q = nwg / NXCD, r = nwg % NXCD, xcd = wgid % NXCD, off = wgid / NXCD; wgid = (xcd < r ? xcd * (q + 1) : r * (q + 1) + (xcd - r) * q) + off; }
        const int nig = WGM * nN, gid = wgid / nig, fm = gid * WGM, gsz = (nM - fm) < WGM ? (nM - fm) : WGM;
        u.pm = fm + ((wgid % nig) % gsz); u.pn = (wgid % nig) / gsz; u.pb = u.pn; u.e = 0; return true;
    }
};
struct MoeOrder {
    const int* tile_e; int ntile, nN, G, c;
    __device__ bool next(int i, Unit& u) const {
        const long Lx = (long)i * G + c; if (Lx >= (long)ntile * nN) return false;
        u.pm = (int)(Lx / nN); u.pn = (int)(Lx % nN); u.e = tile_e[u.pm]; u.pb = u.e * nN + u.pn; return true;
    }
};
struct EpiStoreF32 {
    static constexpr bool PERM = false;
    float* C; int ldc; int nvalid;
    __device__ __forceinline__ void operator()(const f32x4 (&acc)[2][2][4][2], const Unit& u, int wr, int wc, int fr, int fq) const {
        const int row0 = u.pm * BM + wr * 64 + fr, col0 = u.pn * BM + wc * 32 + 4 * fq;
#pragma unroll
        for (int ai = 0; ai < 2; ++ai)
#pragma unroll
            for (int m = 0; m < 4; ++m) { float* rowp = C + (size_t)(row0 + ai * HALF + m * 16) * ldc + col0;
#pragma unroll
                for (int bj = 0; bj < 2; ++bj)
#pragma unroll
                    for (int n = 0; n < 2; ++n) if (col0 + bj * HALF + n * 16 < nvalid) *(f32x4*)(rowp + bj * HALF + n * 16) = acc[ai][bj][m][n]; }
    }
};
struct EpiResid {
    static constexpr bool PERM = false;
    const float* res_lat; const float* res_ctx; const float* gt_lat; const float* gt_ctx; float* out;
    __device__ __forceinline__ void operator()(const f32x4 (&acc)[2][2][4][2], const Unit& u, int wr, int wc, int fr, int fq) const {
        const int row0 = u.pm * BM + wr * 64 + fr, col0 = u.pn * BM + wc * 32 + 4 * fq;
        const bool ctx = (u.pm * BM) >= L;
        const float* gt = ctx ? gt_ctx : gt_lat;
        f32x4 gv[2][2];
#pragma unroll
        for (int bj = 0; bj < 2; ++bj)
#pragma unroll
            for (int n = 0; n < 2; ++n) gv[bj][n] = *(const f32x4*)(gt + col0 + bj * HALF + n * 16);
#pragma unroll
        for (int ai = 0; ai < 2; ++ai)
#pragma unroll
            for (int m = 0; m < 4; ++m) { const int row = row0 + ai * HALF + m * 16;
                const float* rp = (ctx ? res_ctx + (size_t)(row - L) * D : res_lat + (size_t)row * D) + col0;
                float* op = out + (size_t)row * D + col0;
#pragma unroll
                for (int bj = 0; bj < 2; ++bj)
#pragma unroll
                    for (int n = 0; n < 2; ++n) *(f32x4*)(op + bj * HALF + n * 16) = *(const f32x4*)(rp + bj * HALF + n * 16) + gv[bj][n] * acc[ai][bj][m][n]; }
    }
};
struct EpiMoe1 {
    static constexpr bool PERM = true;
    bf16_t* ACT; const float* bgu;
    __device__ __forceinline__ void operator()(const f32x4 (&acc)[2][2][4][2], const Unit& u, int wr, int wc, int fr, int fq) const {
        const int row0 = u.pm * BM + wr * 64 + fr, col0 = u.pn * HALF + wc * 32 + 8 * fq;
        const float* bg = bgu + (size_t)u.e * 2048 + col0;
        f32x4 bgv[2], buv[2];
#pragma unroll
        for (int n = 0; n < 2; ++n) { bgv[n] = *(const f32x4*)(bg + 4 * n); buv[n] = *(const f32x4*)(bg + 1024 + 4 * n); }
#pragma unroll
        for (int ai = 0; ai < 2; ++ai)
#pragma unroll
            for (int m = 0; m < 4; ++m) {
                float a[8];
#pragma unroll
                for (int n = 0; n < 2; ++n) { const f32x4 g4 = acc[ai][0][m][n] + bgv[n], u4 = acc[ai][1][m][n] + buv[n];
#pragma unroll
                    for (int j = 0; j < 4; ++j) { const float gate = fminf(g4[j], 7.f), up = fminf(fmaxf(u4[j], -7.f), 7.f);
                        a[n * 4 + j] = (up + 1.f) * gate / (1.f + __expf(-1.702f * gate)); } }
                u32x4 w; w.x = pack_bf16(a[0], a[1]); w.y = pack_bf16(a[2], a[3]); w.z = pack_bf16(a[4], a[5]); w.w = pack_bf16(a[6], a[7]);
                *(u32x4*)(ACT + (size_t)(row0 + ai * HALF + m * 16) * 1024 + col0) = w; }
    }
};
struct EpiMoe2 {
    static constexpr bool PERM = false;
    float* YR; const float* bdn;
    __device__ __forceinline__ void operator()(const f32x4 (&acc)[2][2][4][2], const Unit& u, int wr, int wc, int fr, int fq) const {
        const int row0 = u.pm * BM + wr * 64 + fr, col0 = u.pn * BM + wc * 32 + 4 * fq;
        const float* bd = bdn + (size_t)u.e * 1024 + col0;
        f32x4 bv[2][2];
#pragma unroll
        for (int bj = 0; bj < 2; ++bj)
#pragma unroll
            for (int n = 0; n < 2; ++n) bv[bj][n] = *(const f32x4*)(bd + bj * HALF + n * 16);
#pragma unroll
        for (int ai = 0; ai < 2; ++ai)
#pragma unroll
            for (int m = 0; m < 4; ++m) { float* rowp = YR + (size_t)(row0 + ai * HALF + m * 16) * 1024 + col0;
#pragma unroll
                for (int bj = 0; bj < 2; ++bj)
#pragma unroll
                    for (int n = 0; n < 2; ++n) *(f32x4*)(rowp + bj * HALF + n * 16) = acc[ai][bj][m][n] + bv[bj][n]; }
    }
};
template <class Epi, class Sched>
__device__ __forceinline__ void gemm_phase(PG8_LAS unsigned char* lds, const Gemm g, const Sched& S, const Epi& E) {
    const int tid = threadIdx.x, wid = __builtin_amdgcn_readfirstlane(tid >> 6), lane = tid & 63, wr = wid >> 2, wc = wid & 3, fr = lane & 15, fq = lane >> 4;
    const int K = g.K, nt = K / BK;
    unsigned voffA[2], voffB[2];
#pragma unroll
    for (int i = 0; i < 2; ++i) { int Rr, C; stage_rc(tid * 16 + i * 8192, Rr, C); const int Rb = Epi::PERM ? ((Rr & ~31) + perm32(Rr & 31)) : Rr;
        voffA[i] = (unsigned)(Rr * K + C) * 2u; voffB[i] = (unsigned)(Rb * K + C) * 2u; }
    const size_t kstep = (size_t)(BK * 2);
    const size_t hstep = (size_t)HALF * K * 2;
    const size_t tstep = 2 * hstep;
    const unsigned ldsw = (unsigned)wid * 1024u;
    const int aoff = lds_byte(wr * 64 + fr, fq * 8), boff = lds_byte(wc * 32 + fr, fq * 8);
#define PG8_SA(b, h) (((b) * 2 + (h)) * HTB)
#define PG8_SB(b, h) ((4 + (b) * 2 + (h)) * HTB)
#define PG8_STAGE(bufoff, gbase, voff) do { _Pragma("unroll") for (int _i = 0; _i < 2; ++_i) \
        __builtin_amdgcn_global_load_lds((const unsigned*)((const char*)(gbase) + (voff)[_i]), (PG8_LAS unsigned*)(lds + (bufoff) + ldsw + _i * 8192), 16, 0, 0); } while (0)
#define PG8_LDA(dst, b, h) do { _Pragma("unroll") for (int m = 0; m < 4; ++m) _Pragma("unroll") for (int k = 0; k < 2; ++k) dst[m][k] = *(const PG8_LAS bf16x8*)(lds + PG8_SA(b, h) + aoff + m * 2048 + k * 1024); } while (0)
#define PG8_LDB(dst, b, h) do { _Pragma("unroll") for (int n = 0; n < 2; ++n) _Pragma("unroll") for (int k = 0; k < 2; ++k) dst[n][k] = *(const PG8_LAS bf16x8*)(lds + PG8_SB(b, h) + boff + n * 2048 + k * 1024); } while (0)
#define PG8_MMA(ai, bj, At, Bt) do { __builtin_amdgcn_s_setprio(1); _Pragma("unroll") for (int m = 0; m < 4; ++m) _Pragma("unroll") for (int n = 0; n < 2; ++n) _Pragma("unroll") for (int k = 0; k < 2; ++k) \
        acc[ai][bj][m][n] = __builtin_amdgcn_mfma_f32_16x16x32_bf16(Bt[n][k], At[m][k], acc[ai][bj][m][n], 0, 0, 0); __builtin_amdgcn_s_setprio(0); } while (0)
#define PG8_WAIT_V(n) asm volatile("s_waitcnt vmcnt(" #n ")" ::: "memory")
#define PG8_WAIT_L(n) asm volatile("s_waitcnt lgkmcnt(" #n ")" ::: "memory")
#define PG8_BAR __builtin_amdgcn_s_barrier()
#define PG8_SCHED __builtin_amdgcn_sched_barrier(0)
    Unit cur, nxt; int ui = 0;
    if (!S.next(0, cur)) return;
    f32x4 acc[2][2][4][2];
#pragma unroll
    for (int a = 0; a < 2; ++a)
#pragma unroll
        for (int b = 0; b < 2; ++b)
#pragma unroll
            for (int m = 0; m < 4; ++m)
#pragma unroll
                for (int n = 0; n < 2; ++n) acc[a][b][m][n] = (f32x4){0.f, 0.f, 0.f, 0.f};
    bf16x8 At[4][2], B0[2][2], B1[2][2];
    const char* cA = (const char*)g.A + (size_t)cur.pm * tstep; const char* cB = (const char*)g.Bt + (size_t)cur.pb * tstep;
    PG8_STAGE(PG8_SB(0, 0), cB, voffB); PG8_STAGE(PG8_SA(0, 0), cA, voffA); PG8_STAGE(PG8_SB(0, 1), cB + hstep, voffB); PG8_STAGE(PG8_SA(0, 1), cA + hstep, voffA);
    if (wr == 1) PG8_BAR;
    PG8_WAIT_V(4); PG8_BAR;
    PG8_STAGE(PG8_SB(1, 0), cB + kstep, voffB); PG8_STAGE(PG8_SA(1, 0), cA + kstep, voffA); PG8_STAGE(PG8_SB(1, 1), cB + hstep + kstep, voffB);
    PG8_WAIT_V(6); PG8_BAR;
    for (;;) {
        const bool has_next = S.next(ui + 1, nxt);
        const char* nA = has_next ? (const char*)g.A + (size_t)nxt.pm * tstep : cA; const char* nB = has_next ? (const char*)g.Bt + (size_t)nxt.pb * tstep : cB;
        for (int t = 0; t < nt; t += 2) {
            const bool last = (t == nt - 2);
            const char* a1 = cA + (size_t)(t + 1) * kstep;
            const char* a2 = last ? nA : cA + (size_t)(t + 2) * kstep; const char* b2 = last ? nB : cB + (size_t)(t + 2) * kstep;
            const char* a3 = a2 + kstep; const char* b3 = b2 + kstep;
            PG8_LDB(B0, 0, 0); PG8_SCHED; PG8_LDA(At, 0, 0); PG8_STAGE(PG8_SA(1, 1), a1 + hstep, voffA);
            PG8_WAIT_L(8); PG8_BAR; PG8_WAIT_L(0); PG8_MMA(0, 0, At, B0); PG8_BAR; PG8_SCHED;
            PG8_LDB(B1, 0, 1); PG8_STAGE(PG8_SB(0, 0), b2, voffB);
            PG8_BAR; PG8_WAIT_L(0); PG8_MMA(0, 1, At, B1); PG8_BAR;
            PG8_LDA(At, 0, 1); PG8_STAGE(PG8_SA(0, 0), a2, voffA);
            PG8_BAR; PG8_WAIT_L(0); PG8_MMA(1, 0, At, B0); PG8_BAR; PG8_SCHED;
            PG8_STAGE(PG8_SB(0, 1), b2 + hstep, voffB);
            PG8_WAIT_V(6); PG8_BAR; PG8_MMA(1, 1, At, B1); PG8_BAR;
            PG8_LDB(B0, 1, 0); PG8_SCHED; PG8_LDA(At, 1, 0); PG8_STAGE(PG8_SA(0, 1), a2 + hstep, voffA);
            PG8_WAIT_L(8); PG8_BAR; PG8_WAIT_L(0); PG8_MMA(0, 0, At, B0); PG8_BAR; PG8_SCHED;
            PG8_LDB(B1, 1, 1); PG8_STAGE(PG8_SB(1, 0), b3, voffB);
            PG8_BAR; PG8_WAIT_L(0); PG8_MMA(0, 1, At, B1); PG8_BAR;
            PG8_LDA(At, 1, 1); PG8_STAGE(PG8_SA(1, 0), a3, voffA);
            PG8_BAR; PG8_WAIT_L(0); PG8_MMA(1, 0, At, B0); PG8_BAR; PG8_SCHED;
            PG8_STAGE(PG8_SB(1, 1), b3 + hstep, voffB);
            PG8_WAIT_V(6); PG8_BAR; PG8_MMA(1, 1, At, B1); PG8_BAR;
        }
        E(acc, cur, wr, wc, fr, fq);
        if (!has_next) break;
#pragma unroll
        for (int a = 0; a < 2; ++a)
#pragma unroll
            for (int b = 0; b < 2; ++b)
#pragma unroll
                for (int m = 0; m < 4; ++m)
#pragma unroll
                    for (int n = 0; n < 2; ++n) acc[a][b][m][n] = (f32x4){0.f, 0.f, 0.f, 0.f};
        cur = nxt; cA = nA; cB = nB; ++ui;
    }
    PG8_WAIT_V(0);
    if (wr == 0) PG8_BAR;
    PG8_BAR;
#undef PG8_SA
#undef PG8_SB
#undef PG8_STAGE
#undef PG8_LDA
#undef PG8_LDB
#undef PG8_MMA
#undef PG8_WAIT_V
#undef PG8_WAIT_L
#undef PG8_BAR
#undef PG8_SCHED
}
}

__device__ __forceinline__ void convert_tile(float* lds, const float* src, int N, int k0, int n0, bf16_t* dstrow0) {
    const int t = threadIdx.x;
#pragma unroll
    for (int i = 0; i < 4; i++) {
        const int kr = (t >> 5) + 16 * i, c4 = (t & 31) * 4;
        float4 v = make_float4(0.f, 0.f, 0.f, 0.f);
        if (n0 + c4 < N) v = *(const float4*)(src + (size_t)(k0 + kr) * N + n0 + c4);
        float* d = lds + kr * 129 + c4;
        d[0] = v.x; d[1] = v.y; d[2] = v.z; d[3] = v.w;
    }
    __syncthreads();
#pragma unroll
    for (int j = 0; j < 2; j++) {
        const int n = (t >> 3) + 64 * j, k8 = (t & 7) * 8;
        float a[8];
#pragma unroll
        for (int q = 0; q < 8; q++) a[q] = lds[(k8 + q) * 129 + n];
        pg8::u32x4 w; w.x = pack_bf16(a[0], a[1]); w.y = pack_bf16(a[2], a[3]); w.z = pack_bf16(a[4], a[5]); w.w = pack_bf16(a[6], a[7]);
        *(pg8::u32x4*)(dstrow0 + (size_t)n * 1024 + k0 + k8) = w;
    }
    __syncthreads();
}
__device__ __forceinline__ void ph_convert_weights(const Params& p, float* lds) {
    constexpr int T_INE = 16 * 18, T_INO = 16 * 34, T_OUT = 2 * 16 * 8, T_GU = 2 * 32 * 16 * 16, T_DN = 2 * 32 * 16 * 8;
    constexpr int TOT = T_INE + T_INO + T_OUT + T_GU + T_DN;
    for (int it = blockIdx.x; it < TOT; it += gridDim.x) {
        int q = it;
        if (q < T_INE) { const int kt = q / 18, nt = q % 18; convert_tile(lds, p.in[I_WINE], EVEN_IN, kt * 64, nt * 128, wsp<bf16_t>(p, OFF_WINE) + (size_t)nt * 128 * 1024); continue; }
        q -= T_INE;
        if (q < T_INO) { const int kt = q / 34, nt = q % 34; convert_tile(lds, p.in[I_WINO], ODD_IN, kt * 64, nt * 128, wsp<bf16_t>(p, OFF_WINO) + (size_t)nt * 128 * 1024); continue; }
        q -= T_INO;
        if (q < T_OUT) { const int l = q / 128, kt = (q % 128) / 8, nt = q % 8;
            convert_tile(lds, p.in[I_WOUT] + (size_t)l * D * D, D, kt * 64, nt * 128, wsp<bf16_t>(p, OFF_WOUT) + ((size_t)l * 1024 + nt * 128) * 1024); continue; }
        q -= T_OUT;
        if (q < T_GU) { const int le = q / 256, kt = (q % 256) / 16, nt = q % 16;
            const int drow = nt < 8 ? 256 * nt : 256 * (nt - 8) + 128;
            convert_tile(lds, p.in[I_WGU] + (size_t)le * 1024 * 2048, 2048, kt * 64, nt * 128, wsp<bf16_t>(p, OFF_WGU) + ((size_t)le * 2048 + drow) * 1024); continue; }
        q -= T_GU;
        { const int le = q / 128, kt = (q % 128) / 8, nt = q % 8;
            convert_tile(lds, p.in[I_WDN] + (size_t)le * 1024 * 1024, 1024, kt * 64, nt * 128, wsp<bf16_t>(p, OFF_WDN) + ((size_t)le * 1024 + nt * 128) * 1024); }
    }
}

template <class AL, class BL, class EP>
__device__ __forceinline__ void gemm_tile_f32(float* lds, int K, AL aload, BL bload, EP epi) {
    float(*As)[132] = (float(*)[132])lds;
    float(*Bs)[132] = (float(*)[132])(lds + 16 * 132);
    const int tid = threadIdx.x, tx = tid & 15, ty = tid >> 4;
    float acc[4][8];
#pragma unroll
    for (int i = 0; i < 4; i++)
#pragma unroll
        for (int j = 0; j < 8; j++) acc[i][j] = 0.f;
    for (int k0 = 0; k0 < K; k0 += 16) {
        float av[4], bv[4];
#pragma unroll
        for (int i = 0; i < 4; i++) av[i] = aload((tid >> 4) + 32 * i, k0 + (tid & 15));
#pragma unroll
        for (int i = 0; i < 4; i++) bv[i] = bload(k0 + (tid >> 7) + 4 * i, tid & 127);
        __syncthreads();
#pragma unroll
        for (int i = 0; i < 4; i++) As[tid & 15][(tid >> 4) + 32 * i] = av[i];
#pragma unroll
        for (int i = 0; i < 4; i++) Bs[(tid >> 7) + 4 * i][tid & 127] = bv[i];
        __syncthreads();
#pragma unroll
        for (int k = 0; k < 16; k++) {
            const float4 a = *(const float4*)&As[k][ty * 4];
            const float4 b0 = *(const float4*)&Bs[k][tx * 4];
            const float4 b1 = *(const float4*)&Bs[k][64 + tx * 4];
            const float aa[4] = {a.x, a.y, a.z, a.w};
            const float bb[8] = {b0.x, b0.y, b0.z, b0.w, b1.x, b1.y, b1.z, b1.w};
#pragma unroll
            for (int i = 0; i < 4; i++)
#pragma unroll
                for (int j = 0; j < 8; j++) acc[i][j] = fmaf(aa[i], bb[j], acc[i][j]);
        }
    }
    __syncthreads();
#pragma unroll
    for (int i = 0; i < 4; i++) epi(ty * 4 + i, tx, acc[i]);
}
__device__ __forceinline__ int lcol(int tx, int jc) { return tx * 4 + (jc & 3) + 64 * (jc >> 2); }

template <class EP>
__device__ __forceinline__ void gemm_dense(float* lds, const float* A, int lda, const float* B, int N, int M, int K, EP epi) {
    const int tm = M / 128, tn = (N + 127) / 128;
    for (int t = blockIdx.x; t < tm * tn; t += gridDim.x) {
        const int m0 = (t / tn) * 128, n0 = (t % tn) * 128;
        gemm_tile_f32(
            lds, K, [&](int r, int k) { return A[(size_t)(m0 + r) * lda + k]; },
            [&](int k, int c) { return (n0 + c < N) ? B[(size_t)k * N + n0 + c] : 0.f; },
            [&](int r, int tx, const float(&a)[8]) {
#pragma unroll
                for (int jc = 0; jc < 8; jc++) {
                    const int c = n0 + lcol(tx, jc);
                    if (c < N) epi(m0 + r, c, a[jc]);
                }
            });
    }
}

__device__ __forceinline__ void ph_prologue(const Params& p, float* lds) {
    const int tid = threadIdx.x, lane = tid & 63, wave = tid >> 6;
    const int gthreads = gridDim.x * NT, gtid = blockIdx.x * NT + tid;
    float* mod = wsp<float>(p, OFF_MOD);
    for (int it = gtid; it < 2 * 6144; it += gthreads) {
        const int layer = it / 6144, n = it % 6144;
        const float* w = p.in[I_ADAW] + (size_t)layer * 1024 * 6144 + n;
        float a0 = 0.f, a1 = 0.f;
#pragma unroll 8
        for (int k = 0; k < 1024; k++) {
            const float wv = w[(size_t)k * 6144];
            a0 = fmaf(silu_f(p.in[I_C][k]), wv, a0);
            a1 = fmaf(silu_f(p.in[I_CCTX][k]), wv, a1);
        }
        const float b = p.in[I_ADAB][layer * 6144 + n];
        mod[(layer * 2 + 0) * 6144 + n] = a0 + b;
        mod[(layer * 2 + 1) * 6144 + n] = a1 + b;
    }
    for (int it = gtid; it < 512; it += gthreads) {
        const float b0 = p.in[I_HGLB][it], b1 = p.in[I_HGLB][512 + it];
        wsp<float>(p, OFF_LB)[it] = 1.f / (1.f + expf(b0 - b1));
    }
    float* zb = lds + wave * 64;
    float* hd3 = wsp<float>(p, OFF_HD3);
    const float fq = p.in[I_HYFREQ][lane];
    for (int row = blockIdx.x * NWAVE + wave; row < R; row += gridDim.x * NWAVE) {
        const int Ls = row < L ? L : NCX, t = row < L ? row : row - L;
        const float tn = (float)t / (float)(Ls - 1);
        const float wang = 6.283185307179586f * (float)t / (float)Ls;
        if (lane < 33) {
            float z;
            if (lane == 0) z = tn;
            else {
                const int b = (lane - 1) & 15;
                const float fr = 1e-4f + (float)b * ((15.f - 1e-4f) / 15.f);
                z = (lane <= 16) ? cosf(fr * wang) : -sinf(fr * wang);
            }
            zb[lane] = z;
        }
        __builtin_amdgcn_wave_barrier();
        float a = p.in[I_HYB1][lane];
#pragma unroll 1
        for (int i = 0; i < 33; i++) a = fmaf(zb[i], p.in[I_HYW1][i * 64 + lane], a);
        float h = sinf(fq * a);
        __builtin_amdgcn_wave_barrier();
        zb[lane] = h;
        __builtin_amdgcn_wave_barrier();
        a = p.in[I_HYB2][lane];
#pragma unroll 1
        for (int i = 0; i < 64; i++) a = fmaf(zb[i], p.in[I_HYW2][i * 64 + lane], a);
        h = sinf(fq * a);
        __builtin_amdgcn_wave_barrier();
        zb[lane] = h;
        __builtin_amdgcn_wave_barrier();
        a = p.in[I_HYB3][lane];
#pragma unroll 1
        for (int i = 0; i < 64; i++) a = fmaf(zb[i], p.in[I_HYW3][i * 64 + lane], a);
        h = sinf(fq * a);
        hd3[(size_t)row * 64 + lane] = h;
        __builtin_amdgcn_wave_barrier();
    }
}

template <bool ROUTER>
__device__ __forceinline__ void prep_rows(const Params& p, const float* xl, const float* xc, int nrows, const float* g, int layer, int j, float* hout) {
    const int lane = threadIdx.x & 63, wave = threadIdx.x >> 6;
    for (int r = blockIdx.x * NWAVE + wave; r < nrows; r += gridDim.x * NWAVE) {
        const float* src = r < L ? xl + (size_t)r * D : xc + (size_t)(r - L) * D;
        const float* md = modp(p, layer, r < L ? 0 : 1, j);
        float v[16];
        float ss = 0.f;
#pragma unroll
        for (int i = 0; i < 16; i++) { v[i] = src[lane + 64 * i]; ss = fmaf(v[i], v[i], ss); }
        ss = wave_sum(ss);
        const float rinv = rsqrtf(ss * (1.f / 1024.f) + EPS);
#pragma unroll
        for (int i = 0; i < 16; i++) {
            const int c = lane + 64 * i;
            v[i] = v[i] * rinv * g[c] * (1.f + md[1024 + c]) + md[c];
            hout[(size_t)r * D + c] = v[i];
            wsp<bf16_t>(p, OFF_HB)[(size_t)r * D + c] = f2bf(v[i]);
        }
        if (ROUTER) {
            const float* rw = p.in[I_RW] + (size_t)layer * 1024 * 32;
            float lg[32];
#pragma unroll
            for (int e = 0; e < 32; e++) lg[e] = 0.f;
#pragma unroll 1
            for (int i = 0; i < 16; i++) {
                const float* wr = rw + (size_t)(lane + 64 * i) * 32;
                const float hv = hout[(size_t)r * D + lane + 64 * i];
#pragma unroll
                for (int e4 = 0; e4 < 8; e4++) {
                    const float4 w4 = *(const float4*)(wr + e4 * 4);
                    lg[e4 * 4 + 0] = fmaf(hv, w4.x, lg[e4 * 4 + 0]);
                    lg[e4 * 4 + 1] = fmaf(hv, w4.y, lg[e4 * 4 + 1]);
                    lg[e4 * 4 + 2] = fmaf(hv, w4.z, lg[e4 * 4 + 2]);
                    lg[e4 * 4 + 3] = fmaf(hv, w4.w, lg[e4 * 4 + 3]);
                }
            }
#pragma unroll
            for (int e = 0; e < 32; e++) lg[e] = wave_sum(lg[e]) + p.in[I_RB][layer * 32 + e];
            unsigned used = 0u;
            float tv[4];
            int ti[4];
#pragma unroll
            for (int k = 0; k < 4; k++) {
                float best = -INFINITY;
                int bi = 0;
#pragma unroll
                for (int e = 0; e < 32; e++) {
                    const bool ok = !((used >> e) & 1u) && (lg[e] > best);
                    best = ok ? lg[e] : best;
                    bi = ok ? e : bi;
                }
                used |= 1u << bi;
                tv[k] = best;
                ti[k] = bi;
            }
            float es[4], den = 0.f;
#pragma unroll
            for (int k = 0; k < 4; k++) { es[k] = expf(tv[k] - tv[0]); den += es[k]; }
            if (lane < 4) {
                int e = ti[0];
                float gg = es[0];
#pragma unroll
                for (int k = 1; k < 4; k++) { e = (lane == k) ? ti[k] : e; gg = (lane == k) ? es[k] : gg; }
                int* cnt = wsp<int>(p, OFF_CTL) + layer * 32;
                const int pos = atomicAdd(&cnt[e], 1);
                wsp<int>(p, OFF_TOPE)[r * 4 + lane] = e;
                wsp<float>(p, OFF_TOPG)[r * 4 + lane] = gg / den;
                wsp<int>(p, OFF_TOPP)[r * 4 + lane] = pos;
            }
        }
    }
}

__device__ __forceinline__ void ph_filter_gemm(const Params& p, float* lds) {
    const float* hd3 = wsp<float>(p, OFF_HD3);
    float* hh = wsp<float>(p, OFF_HH);
    float* hhc = wsp<float>(p, OFF_HHC);
    const float mind = logf(1e-2f) / 1.5f, maxd = logf(1e-2f) / 0.3f;
    gemm_dense(lds, hd3, 64, p.in[I_HYW4], 2048, R, 64, [&](int row, int col, float v) {
        const int Ls = row < L ? L : NCX, t = row < L ? row : row - L;
        float* dst = row < L ? hh : hhc;
        const int o = col >> 10, side = (col >> 9) & 1, ch = col & 511;
        const float delta = fabsf(mind + (float)ch * ((maxd - mind) / 511.f));
        const float tn = (float)t / (float)(Ls - 1);
        const float val = v * expf(-tn * delta);
        if (side == 0) dst[(size_t)(Ls + t) * 1024 + o * 512 + ch] = val;
        else if (t > 0) dst[(size_t)(Ls - t) * 1024 + o * 512 + ch] = val;
        else dst[o * 512 + ch] = 0.f;
    });
}
__device__ __forceinline__ void ph_filter_abs(const Params& p) {
    const float* hh = wsp<float>(p, OFF_HH);
    const float* hhc = wsp<float>(p, OFF_HHC);
    float* hnp = wsp<float>(p, OFF_HNP);
    for (int it = blockIdx.x; it < 130 * 2; it += gridDim.x) {
        const int chunk = it >> 1, col = (it & 1) * 512 + threadIdx.x;
        const float* src = chunk < 128 ? hh + (size_t)chunk * 256 * 1024 : hhc + (size_t)(chunk - 128) * 256 * 1024;
        float s = 0.f;
        for (int i = 0; i < 256; i++) s += fabsf(src[(size_t)i * 1024 + col]);
        hnp[chunk * 1024 + col] = s;
    }
}

__device__ __forceinline__ void ph_qk_dwconv(const Params& p) {
    const int lane = threadIdx.x & 63, wave = threadIdx.x >> 6;
    const float* P0 = wsp<float>(p, OFF_P);
    float* qn = wsp<float>(p, OFF_QN);
    float* kn = wsp<float>(p, OFF_KN);
    for (int it = blockIdx.x * NWAVE + wave; it < R * 10; it += gridDim.x * NWAVE) {
        const int r = it / 10, s = it % 10;
        const int off = s < 2 ? s * 64 : 256 + (s - 2) * 64;
        const float v = P0[(size_t)r * EVEN_IN + off + lane];
        const float ss = wave_sum(v * v);
        const float gain = s < 2 ? p.in[I_KNORM][lane] : p.in[I_QNORM][lane];
        float n = v * rsqrtf(ss * (1.f / 64.f) + EPS) * gain;
        if (r < L) {
            const float partner = __shfl_xor(n, 16);
            const int pos = lane < 32 ? (r >> 6) : (r & 63);
            const int i = lane & 15;
            const float inv = powf(10000.f, -(float)i / 16.f);
            const float ang = (float)pos * inv;
            const float cs = cosf(ang), sn = sinf(ang);
            n = ((lane & 16) == 0) ? n * cs - partner * sn : partner * sn + n * cs;
        }
        if (s < 2) kn[(size_t)r * 128 + s * 64 + lane] = n;
        else qn[(size_t)r * 512 + (s - 2) * 64 + lane] = n;
    }
    float* U = wsp<float>(p, OFF_U);
    const float* cw = p.in[I_HYCW];
    const float* cb = p.in[I_HYCB];
    const size_t tot = (size_t)R * 1536;
    for (size_t it = (size_t)blockIdx.x * NT + threadIdx.x; it < tot; it += (size_t)gridDim.x * NT) {
        const int r = (int)(it / 1536), c = (int)(it % 1536);
        const int lo = r < L ? 0 : L, hi = r < L ? L : R;
        float a = cb[c];
#pragma unroll
        for (int j = 0; j < 3; j++) {
            const int rr = r + j - 1;
            if (rr >= lo && rr < hi) a = fmaf(cw[j * 1536 + c], P0[(size_t)rr * EVEN_IN + 768 + c], a);
        }
        U[it] = a;
    }
}

__device__ __forceinline__ void ph_attention(const Params& p, float* lds) {
    const int lane = threadIdx.x & 63, wave = threadIdx.x >> 6;
    const float* P0 = wsp<float>(p, OFF_P);
    const float* qn = wsp<float>(p, OFF_QN);
    const float* kn = wsp<float>(p, OFF_KN);
    float* sc = lds + wave * 576;
    for (int it = blockIdx.x * NWAVE + wave; it < R * 8; it += gridDim.x * NWAVE) {
        const int r = it >> 3, hq = it & 7, kvh = hq >> 2;
        int lo = 0, nloc = 0;
        if (r < L) { lo = max(0, r - 128); nloc = min(L - 1, r + 128) - lo + 1; }
        const int ntot = nloc + NCX;
        float q[64];
#pragma unroll
        for (int d4 = 0; d4 < 16; d4++) {
            const float4 t = *(const float4*)(qn + (size_t)r * 512 + hq * 64 + d4 * 4);
            q[d4 * 4] = t.x; q[d4 * 4 + 1] = t.y; q[d4 * 4 + 2] = t.z; q[d4 * 4 + 3] = t.w;
        }
        float mx = -INFINITY;
        for (int j = lane; j < ntot; j += 64) {
            const int krow = j < nloc ? lo + j : L + (j - nloc);
            const float* kp = kn + (size_t)krow * 128 + kvh * 64;
            float dot = 0.f;
#pragma unroll
            for (int d4 = 0; d4 < 16; d4++) {
                const float4 t = *(const float4*)(kp + d4 * 4);
                dot = fmaf(q[d4 * 4], t.x, dot); dot = fmaf(q[d4 * 4 + 1], t.y, dot);
                dot = fmaf(q[d4 * 4 + 2], t.z, dot); dot = fmaf(q[d4 * 4 + 3], t.w, dot);
            }
            dot *= 0.125f;
            sc[j] = dot;
            mx = fmaxf(mx, dot);
        }
        const float sink = p.in[I_SINK][hq];
        mx = fmaxf(wave_max(mx), sink);
        float sum = 0.f;
        for (int j = lane; j < ntot; j += 64) { const float e = expf(sc[j] - mx); sc[j] = e; sum += e; }
        sum = wave_sum(sum) + expf(sink - mx);
        const float rs = 1.f / sum;
        __builtin_amdgcn_wave_barrier();
        float o = 0.f;
        for (int j = 0; j < ntot; j++) {
            const int krow = j < nloc ? lo + j : L + (j - nloc);
            o = fmaf(sc[j], P0[(size_t)krow * EVEN_IN + 128 + kvh * 64 + lane], o);
        }
        wsp<bf16_t>(p, OFF_MB)[(size_t)r * D + 512 + hq * 64 + lane] = f2bf(o * rs);
        __builtin_amdgcn_wave_barrier();
    }
}

__device__ __forceinline__ void ph_hyena_conv(const Params& p, int o) {
    const int lane = threadIdx.x & 63, wave = threadIdx.x >> 6;
    const float* U = wsp<float>(p, OFF_U);
    const float* hnp = wsp<float>(p, OFF_HNP);
    float* Z1 = wsp<float>(p, OFF_Z1);
    const float* zin = o == 0 ? U : Z1;
    const int zld = o == 0 ? 1536 : 512;
    const int nlat = 8 * (L / 64), nctx = 8 * (NCX / 64);
    for (int it = blockIdx.x; it < nlat + nctx; it += gridDim.x) {
        const bool lat = it < nlat;
        const int ii = lat ? it : it - nlat;
        const int Ls = lat ? L : NCX, base = lat ? 0 : L;
        const int ch = (ii & 7) * 64 + lane, t0 = (ii >> 3) * 64 + wave * 8;
        const float* hf = (lat ? wsp<float>(p, OFF_HH) : wsp<float>(p, OFF_HHC)) + o * 512 + ch;
        float nrm = 0.f;
        if (lat) { for (int c = 0; c < 128; c++) nrm += hnp[c * 1024 + o * 512 + ch]; }
        else { nrm = hnp[128 * 1024 + o * 512 + ch] + hnp[129 * 1024 + o * 512 + ch]; }
        float acc[8];
#pragma unroll
        for (int i = 0; i < 8; i++) acc[i] = 0.f;
        for (int s0 = 0; s0 < Ls; s0 += 8) {
            float zv[8], hv[15];
#pragma unroll
            for (int j = 0; j < 8; j++) zv[j] = zin[(size_t)(base + s0 + j) * zld + ch];
#pragma unroll
            for (int e = 0; e < 15; e++) hv[e] = hf[(size_t)(t0 - s0 + e - 7 + Ls) * 1024];
#pragma unroll
            for (int i = 0; i < 8; i++)
#pragma unroll
                for (int j = 0; j < 8; j++) acc[i] = fmaf(hv[i - j + 7], zv[j], acc[i]);
        }
        const float inv = 1.f / nrm;
        const float bias = p.in[I_HYFB][o * 512 + ch];
#pragma unroll
        for (int i = 0; i < 8; i++) {
            const int r = base + t0 + i;
            const float zc = acc[i] * inv;
            const float z = zin[(size_t)r * zld + ch];
            const float gate = U[(size_t)r * 1536 + 512 * (o + 1) + ch];
            const float res = gate * (zc + z * bias);
            if (o == 0) Z1[(size_t)r * 512 + ch] = res;
            else wsp<bf16_t>(p, OFF_MB)[(size_t)r * D + ch] = f2bf(res);
        }
    }
}

__device__ __forceinline__ void ph_moe_scatter(const Params& p, float* lds, int layer, int ntok) {
    int* sst = (int*)lds;
    const int* cnt = wsp<int>(p, OFF_CTL) + layer * 32;
    int* tile_e = wsp<int>(p, OFF_TILEE) + layer * 512;
    __syncthreads();
    if (threadIdx.x == 0) {
        int a = 0;
        for (int e = 0; e < 32; e++) {
            sst[e] = a;
            const int nt = (cnt[e] + 255) / 256;
            if (blockIdx.x == 0) for (int q = 0; q < nt; q++) tile_e[a / 256 + q] = e;
            a += nt * 256;
        }
        sst[32] = a;
    }
    __syncthreads();
    if (blockIdx.x == 0 && threadIdx.x < 33) wsp<int>(p, OFF_STARTS)[layer * 64 + threadIdx.x] = sst[threadIdx.x];
    const int* te = wsp<int>(p, OFF_TOPE);
    const int* tp = wsp<int>(p, OFF_TOPP);
    const bf16_t* HB = wsp<bf16_t>(p, OFF_HB);
    bf16_t* XG = wsp<bf16_t>(p, OFF_XG);
    const int lane = threadIdx.x & 63, wave = threadIdx.x >> 6;
    for (int it = blockIdx.x * NWAVE + wave; it < ntok * 4; it += gridDim.x * NWAVE) {
        const int row = sst[te[it]] + tp[it];
        const pg8::u32x4* src = (const pg8::u32x4*)(HB + (size_t)(it >> 2) * D);
        pg8::u32x4* dst = (pg8::u32x4*)(XG + (size_t)row * D);
        dst[lane] = src[lane];
        dst[lane + 64] = src[lane + 64];
    }
    __syncthreads();
}
__device__ __forceinline__ void ph_moe_gemm1(const Params& p, PG8_LAS unsigned char* lds, int layer) {
    const int total = wsp<int>(p, OFF_STARTS)[layer * 64 + 32];
    pg8::MoeOrder S{wsp<int>(p, OFF_TILEE) + layer * 512, total / 256, 8, (int)gridDim.x, (int)blockIdx.x};
    pg8::Gemm g{wsp<bf16_t>(p, OFF_XG), wsp<bf16_t>(p, OFF_WGU) + (size_t)layer * 32 * 2048 * 1024, 1024};
    pg8::EpiMoe1 E{wsp<bf16_t>(p, OFF_ACTB), p.in[I_BGU] + (size_t)layer * 32 * 2048};
    pg8::gemm_phase(lds, g, S, E);
}
__device__ __forceinline__ void ph_moe_gemm2(const Params& p, PG8_LAS unsigned char* lds, int layer) {
    const int total = wsp<int>(p, OFF_STARTS)[layer * 64 + 32];
    pg8::MoeOrder S{wsp<int>(p, OFF_TILEE) + layer * 512, total / 256, 4, (int)gridDim.x, (int)blockIdx.x};
    pg8::Gemm g{wsp<bf16_t>(p, OFF_ACTB), wsp<bf16_t>(p, OFF_WDN) + (size_t)layer * 32 * 1024 * 1024, 1024};
    pg8::EpiMoe2 E{wsp<float>(p, OFF_YR), p.in[I_BDN] + (size_t)layer * 32 * 1024};
    pg8::gemm_phase(lds, g, S, E);
}
template <bool NEXTPREP>
__device__ __forceinline__ void ph_moe_combine(const Params& p, int layer, int nrows, const float* xi, float* xo, int nlayer) {
    const int lane = threadIdx.x & 63, wave = threadIdx.x >> 6;
    const int* starts = wsp<int>(p, OFF_STARTS) + layer * 64;
    const int* te = wsp<int>(p, OFF_TOPE);
    const int* tp = wsp<int>(p, OFF_TOPP);
    const float* tg = wsp<float>(p, OFF_TOPG);
    const float* YR = wsp<float>(p, OFF_YR);
    float* H = wsp<float>(p, OFF_H);
    for (int r = blockIdx.x * NWAVE + wave; r < nrows; r += gridDim.x * NWAVE) {
        const float* gt = modp(p, layer, r < L ? 0 : 1, 1) + 2048;
        float v[16];
#pragma unroll
        for (int i = 0; i < 16; i++) v[i] = 0.f;
#pragma unroll
        for (int k = 0; k < 4; k++) {
            const int row = starts[te[r * 4 + k]] + tp[r * 4 + k];
            const float g = tg[r * 4 + k];
#pragma unroll
            for (int i = 0; i < 16; i++) v[i] = fmaf(g, YR[(size_t)row * 1024 + lane + 64 * i], v[i]);
        }
        float ss = 0.f;
#pragma unroll
        for (int i = 0; i < 16; i++) {
            const int c = lane + 64 * i;
            v[i] = xi[(size_t)r * D + c] + gt[c] * v[i];
            xo[(size_t)r * D + c] = v[i];
            ss = fmaf(v[i], v[i], ss);
        }
        if (NEXTPREP) {
            ss = wave_sum(ss);
            const float rinv = rsqrtf(ss * (1.f / 1024.f) + EPS);
            const float* md = modp(p, nlayer, r < L ? 0 : 1, 0);
            const float* g = p.in[I_NORMG] + (nlayer * 2 + 0) * 1024;
#pragma unroll
            for (int i = 0; i < 16; i++) {
                const int c = lane + 64 * i;
                const float hv = v[i] * rinv * g[c] * (1.f + md[1024 + c]) + md[c];
                H[(size_t)r * D + c] = hv;
                wsp<bf16_t>(p, OFF_HB)[(size_t)r * D + c] = f2bf(hv);
            }
        }
    }
}

__device__ __forceinline__ void ph_streams(const Params& p) {
    const float* P1 = wsp<float>(p, OFF_P);
    float* XBC = wsp<float>(p, OFF_XBC);
    float* DT = wsp<float>(p, OFF_DT);
    float* F = wsp<float>(p, OFF_F);
    float* Q1 = wsp<float>(p, OFF_Q1);
    const float* cw = p.in[I_SSDCW];
    const float* cb = p.in[I_SSDCB];
    const float* lb = wsp<float>(p, OFF_LB);
    const size_t gsz = (size_t)gridDim.x * NT, g0 = (size_t)blockIdx.x * NT + threadIdx.x;
    for (size_t it = g0; it < (size_t)R * 1024; it += gsz) {
        const int r = (int)(it >> 10), c = (int)(it & 1023);
        const int lo = r < L ? 0 : L, hi = r < L ? L : R;
        float a = cb[c];
#pragma unroll
        for (int j = 0; j < 3; j++) {
            const int rr = r + j - 1;
            if (rr >= lo && rr < hi) a = fmaf(cw[j * 1024 + c], P1[(size_t)rr * ODD_IN + c], a);
        }
        XBC[it] = silu_f(a);
        if (c < 512) {
            F[(size_t)r * 512 + c] = lb[c] + (1.f - lb[c]) * sigmoid_f(P1[(size_t)r * ODD_IN + 1040 + c]);
            F[(size_t)R * 512 + (size_t)r * 512 + c] = lb[c] + (1.f - lb[c]) * sigmoid_f(P1[(size_t)r * ODD_IN + 1040 + 512 + c]);
            Q1[(size_t)r * 512 + c] = silu_f(P1[(size_t)r * ODD_IN + 3088 + c]);
        }
        if (c < 16) {
            const int d = c >> 3, h = c & 7;
            DT[(size_t)d * R * 8 + (size_t)r * 8 + h] = softplus_f(P1[(size_t)r * ODD_IN + 1024 + c] + p.in[I_DTB][d * 8 + h]);
        }
    }
}
__device__ __forceinline__ void ph_scans(const Params& p) {
    const int lane = threadIdx.x & 63, wave = threadIdx.x >> 6;
    const float* P1 = wsp<float>(p, OFF_P);
    const float* XBC = wsp<float>(p, OFF_XBC);
    const float* DT = wsp<float>(p, OFF_DT);
    const float* F = wsp<float>(p, OFF_F);
    const float* Q1 = wsp<float>(p, OFF_Q1);
    float* Y = wsp<float>(p, OFF_Y);
    float* O = wsp<float>(p, OFF_O);
    for (int it = blockIdx.x * NWAVE + wave; it < 2048; it += gridDim.x * NWAVE) {
        if (it < 1024) {
            const int d = it >> 9, h = (it >> 6) & 7, pp = it & 63, g = h >> 2;
            const float A = -expf(p.in[I_ALOG][d * 8 + h]);
            const float Dk = p.in[I_SSDD][d * 8 + h];
            float S0 = 0.f, S1 = 0.f;
#pragma unroll 4
            for (int s = 0; s < R; s++) {
                const int row = d == 0 ? (s < NCX ? L + s : s - NCX) : (R - 1 - s);
                const float dt = DT[(size_t)d * R * 8 + (size_t)row * 8 + h];
                const float* xr = XBC + (size_t)row * 1024;
                const float x = xr[h * 64 + pp];
                const float dec = expf(dt * A);
                const float B0 = xr[512 + g * 128 + lane], B1 = xr[512 + g * 128 + 64 + lane];
                const float C0 = xr[768 + g * 128 + lane], C1 = xr[768 + g * 128 + 64 + lane];
                S0 = fmaf(S0, dec, dt * x * B0);
                S1 = fmaf(S1, dec, dt * x * B1);
                if (row < L) {
                    const float y = wave_sum(C0 * S0 + C1 * S1) + Dk * x;
                    if (lane == 0) Y[(size_t)d * R * 512 + (size_t)row * 512 + h * 64 + pp] = y;
                }
            }
        } else {
            const int i2 = it - 1024;
            const int d = i2 >> 9, h = (i2 >> 7) & 3, v = i2 & 127;
            float S0 = 0.f, S1 = 0.f;
#pragma unroll 4
            for (int s = 0; s < R; s++) {
                const int row = d == 0 ? (s < NCX ? L + s : s - NCX) : (R - 1 - s);
                const float* fr = F + (size_t)d * R * 512 + (size_t)row * 512 + h * 128;
                const float f0 = fr[lane], f1 = fr[64 + lane];
                const float iv = P1[(size_t)row * ODD_IN + 2064 + h * 128 + v];
                S0 = fmaf(f0, S0, (1.f - f0) * iv);
                S1 = fmaf(f1, S1, (1.f - f1) * iv);
                if (row < L) {
                    const float* qr = Q1 + (size_t)row * 512 + h * 128;
                    const float o = wave_sum(qr[lane] * S0 + qr[64 + lane] * S1);
                    if (lane == 0) O[(size_t)d * R * 512 + (size_t)row * 512 + h * 128 + v] = o;
                }
            }
        }
    }
}
__device__ __forceinline__ void ph_merge(const Params& p) {
    const int lane = threadIdx.x & 63, wave = threadIdx.x >> 6;
    const float* P1 = wsp<float>(p, OFF_P);
    const float* Y = wsp<float>(p, OFF_Y);
    const float* O = wsp<float>(p, OFF_O);
    for (int r = blockIdx.x * NWAVE + wave; r < L; r += gridDim.x * NWAVE) {
        float ys[8], os[8];
        float sy0 = 0.f, sy1 = 0.f, so[4] = {0.f, 0.f, 0.f, 0.f};
#pragma unroll
        for (int i = 0; i < 8; i++) {
            const int c = lane + 64 * i;
            const float y = Y[(size_t)r * 512 + c] + Y[(size_t)R * 512 + (size_t)r * 512 + c];
            ys[i] = y * silu_f(P1[(size_t)r * ODD_IN + 2576 + c]);
            if (i < 4) sy0 = fmaf(ys[i], ys[i], sy0); else sy1 = fmaf(ys[i], ys[i], sy1);
            os[i] = O[(size_t)r * 512 + c] + O[(size_t)R * 512 + (size_t)r * 512 + c];
            so[i >> 1] = fmaf(os[i], os[i], so[i >> 1]);
        }
        sy0 = rsqrtf(wave_sum(sy0) * (1.f / 256.f) + EPS);
        sy1 = rsqrtf(wave_sum(sy1) * (1.f / 256.f) + EPS);
#pragma unroll
        for (int k = 0; k < 4; k++) so[k] = rsqrtf(wave_sum(so[k]) * (1.f / 128.f) + EPS);
#pragma unroll
        for (int i = 0; i < 8; i++) {
            const int c = lane + 64 * i;
            const float mv0 = ys[i] * (i < 4 ? sy0 : sy1) * p.in[I_SSDN][c];
            const float mv1 = os[i] * so[i >> 1] * p.in[I_HGN][c] * silu_f(P1[(size_t)r * ODD_IN + 3600 + c]);
            wsp<bf16_t>(p, OFF_MB)[(size_t)r * D + c] = f2bf(mv0);
            wsp<bf16_t>(p, OFF_MB)[(size_t)r * D + 512 + c] = f2bf(mv1);
        }
    }
}

constexpr int N_PHASES = 22;
__global__ void __launch_bounds__(NT, 2) mega(Params p) {
    extern __shared__ __attribute__((aligned(16))) unsigned char smem[];
    float* lds = (float*)smem;
    PG8_LAS unsigned char* glds = (PG8_LAS unsigned char*)smem;
    cg::grid_group grid = cg::this_grid();
    float* XA = wsp<float>(p, OFF_XA);
    float* XB = wsp<float>(p, OFF_XB);
    float* XC = wsp<float>(p, OFF_XC);
    float* H = wsp<float>(p, OFF_H);
    float* PP = wsp<float>(p, OFF_P);
    const int G = gridDim.x, bid = blockIdx.x;
#ifndef ONLY
#define ONLY -1
#endif
    const int lo = p.ph_lo, hi = p.ph_hi;
#define IN(k) ((ONLY < 0 || ONLY == (k)) && lo <= (k) && (k) < hi)
#define SEAM(k) do { if ((k) + 1 < hi) grid.sync(); } while (0)
    if (IN(0)) { ph_prologue(p, lds); __syncthreads(); ph_convert_weights(p, lds);
    }
    if (lo <= 0 && 0 < hi) SEAM(0);
    if (IN(1)) {
            prep_rows<false>(p, p.in[I_X], p.in[I_CTX], R, p.in[I_NORMG] + 0, 0, 0, H);
            ph_filter_gemm(p, lds);
    }
    if (lo <= 1 && 1 < hi) SEAM(1);
    if (IN(2)) {
            { pg8::StaticOrder S; S.init(R, EVEN_IN, G, bid);
              pg8::gemm_phase(glds, pg8::Gemm{wsp<bf16_t>(p, OFF_HB), wsp<bf16_t>(p, OFF_WINE), D}, S, pg8::EpiStoreF32{PP, EVEN_IN, EVEN_IN}); }
            ph_filter_abs(p);
    }
    if (lo <= 2 && 2 < hi) SEAM(2);
    if (IN(3)) { ph_qk_dwconv(p);
    }
    if (lo <= 3 && 3 < hi) SEAM(3);
    if (IN(4)) { ph_attention(p, lds); ph_hyena_conv(p, 0);
    }
    if (lo <= 4 && 4 < hi) SEAM(4);
    if (IN(5)) { ph_hyena_conv(p, 1);
    }
    if (lo <= 5 && 5 < hi) SEAM(5);
    if (IN(6)) {
            { pg8::StaticOrder S; S.init(R, D, G, bid);
              pg8::gemm_phase(glds, pg8::Gemm{wsp<bf16_t>(p, OFF_MB), wsp<bf16_t>(p, OFF_WOUT), D}, S,
                              pg8::EpiResid{p.in[I_X], p.in[I_CTX], modp(p, 0, 0, 0) + 2048, modp(p, 0, 1, 0) + 2048, XA}); }
    }
    if (lo <= 6 && 6 < hi) SEAM(6);
    if (IN(7)) { prep_rows<true>(p, XA, XA + (size_t)L * D, R, p.in[I_NORMG] + 1024, 0, 1, H);
    }
    if (lo <= 7 && 7 < hi) SEAM(7);
    if (IN(8)) { ph_moe_scatter(p, lds, 0, R);
    }
    if (lo <= 8 && 8 < hi) SEAM(8);
    if (IN(9)) { ph_moe_gemm1(p, glds, 0);
    }
    if (lo <= 9 && 9 < hi) SEAM(9);
    if (IN(10)) { ph_moe_gemm2(p, glds, 0);
    }
    if (lo <= 10 && 10 < hi) SEAM(10);
    if (IN(11)) { ph_moe_combine<true>(p, 0, R, XA, XB, 1);
    }
    if (lo <= 11 && 11 < hi) SEAM(11);
    if (IN(12)) {
            { pg8::StaticOrder S; S.init(R, ODD_PAD, G, bid);
              pg8::gemm_phase(glds, pg8::Gemm{wsp<bf16_t>(p, OFF_HB), wsp<bf16_t>(p, OFF_WINO), D}, S, pg8::EpiStoreF32{PP, ODD_IN, ODD_IN}); }
    }
    if (lo <= 12 && 12 < hi) SEAM(12);
    if (IN(13)) { ph_streams(p);
    }
    if (lo <= 13 && 13 < hi) SEAM(13);
    if (IN(14)) { ph_scans(p);
    }
    if (lo <= 14 && 14 < hi) SEAM(14);
    if (IN(15)) { ph_merge(p);
    }
    if (lo <= 15 && 15 < hi) SEAM(15);
    if (IN(16)) {
            { pg8::StaticOrder S; S.init(L, D, G, bid);
              pg8::gemm_phase(glds, pg8::Gemm{wsp<bf16_t>(p, OFF_MB), wsp<bf16_t>(p, OFF_WOUT) + (size_t)D * D, D}, S,
                              pg8::EpiResid{XB, XB, modp(p, 1, 0, 0) + 2048, modp(p, 1, 0, 0) + 2048, XC}); }
    }
    if (lo <= 16 && 16 < hi) SEAM(16);
    if (IN(17)) { prep_rows<true>(p, XC, XC, L, p.in[I_NORMG] + 3 * 1024, 1, 1, H);
    }
    if (lo <= 17 && 17 < hi) SEAM(17);
    if (IN(18)) { ph_moe_scatter(p, lds, 1, L);
    }
    if (lo <= 18 && 18 < hi) SEAM(18);
    if (IN(19)) { ph_moe_gemm1(p, glds, 1);
    }
    if (lo <= 19 && 19 < hi) SEAM(19);
    if (IN(20)) { ph_moe_gemm2(p, glds, 1);
    }
    if (lo <= 20 && 20 < hi) SEAM(20);
    if (IN(21)) { ph_moe_combine<false>(p, 1, L, XC, p.out, 0);
    }
    if (lo <= 21 && 21 < hi) SEAM(21);
#undef IN
#undef SEAM
}

extern "C" void kernel_launch(void* const* d_in, const int* in_sizes, int n_in, void* d_out, int out_size, void* d_ws, size_t ws_size,
                              hipStream_t stream) {
    static int grid_blocks = 0;
    if (!grid_blocks) {
        int dev = 0, cus = 0, per_cu = 0;
        hipGetDevice(&dev);
        hipDeviceGetAttribute(&cus, hipDeviceAttributeMultiprocessorCount, dev);
        hipFuncSetAttribute((const void*)mega, hipFuncAttributeMaxDynamicSharedMemorySize, LDS_BYTES);
        hipOccupancyMaxActiveBlocksPerMultiprocessor(&per_cu, mega, NT, LDS_BYTES);
        if (per_cu < 1) per_cu = 1;
        grid_blocks = cus;
        if (ws_size < WS_END) fprintf(stderr, "kernel_launch: workspace too small: %zu < %zu\n", ws_size, (size_t)WS_END);
    }
    hipMemsetAsync((char*)d_ws + OFF_CTL, 0, 65536, stream);
    Params p{};
    for (int i = 0; i < N_IN; i++) p.in[i] = (const float*)d_in[i];
    p.out = (float*)d_out;
    p.ws = (unsigned char*)d_ws;
    p.ph_lo = 0;
    p.ph_hi = N_PHASES;
    void* args[] = {&p};
    hipError_t e = hipLaunchCooperativeKernel((void*)mega, dim3(grid_blocks), dim3(NT), args, LDS_BYTES, stream);
    if (e != hipSuccess) fprintf(stderr, "cooperative launch failed: %s (grid %d)\n", hipGetErrorString(e), grid_blocks);
}
```

```cpp
#include <hip/hip_runtime.h>
#include <hip/hip_cooperative_groups.h>
#include <cstdio>
#include <cstdint>
namespace cg = cooperative_groups;

constexpr int L = 16384, NCX = 256, R = L + NCX, D = 1024;
constexpr int EVEN_IN = 2304, ODD_IN = 4112;
constexpr int NT = 512, NWAVE = 8;
constexpr int NEXP = 32;
constexpr int NROWS = 74752;
constexpr int ODD_PAD = 4352;
constexpr int LDS_BYTES = 147456;
typedef unsigned short bf16_t;
constexpr float EPS = 1e-6f;

enum { I_X = 0, I_C, I_CTX, I_CCTX, I_NORMG, I_ADAW, I_ADAB, I_WOUT, I_WINE, I_HYCW, I_HYCB, I_HYW1, I_HYB1, I_HYW2, I_HYB2,
       I_HYW3, I_HYB3, I_HYW4, I_HYFREQ, I_HYFB, I_QNORM, I_KNORM, I_SINK, I_WINO, I_SSDCW, I_SSDCB, I_DTB, I_ALOG, I_SSDD,
       I_SSDN, I_HGLB, I_HGN, I_RW, I_RB, I_WGU, I_BGU, I_WDN, I_BDN, N_IN };

constexpr size_t al256(size_t x) { return (x + 255) & ~(size_t)255; }
constexpr size_t OFF_CTL = 0;
constexpr size_t OFF_TAB = 32768;
constexpr size_t OFF_MOD = 65536;
constexpr size_t OFF_LB = OFF_MOD + al256(4 * 24576);
constexpr size_t OFF_STARTS = OFF_LB + 4096;
constexpr size_t OFF_HNP = OFF_STARTS + 4096;
constexpr size_t OFF_HD3 = OFF_HNP + al256(4 * 130 * 1024);
constexpr size_t OFF_HH = OFF_HD3 + al256(4ull * R * 64);
constexpr size_t OFF_HHC = OFF_HH + al256(4ull * 2 * L * 1024);
constexpr size_t OFF_XA = OFF_HHC + al256(4ull * 512 * 1024);
constexpr size_t OFF_XB = OFF_XA + al256(4ull * R * D);
constexpr size_t OFF_XC = OFF_XA;
constexpr size_t OFF_H = OFF_XB + al256(4ull * R * D);
constexpr size_t OFF_P = OFF_H + al256(4ull * R * D);
constexpr size_t OFF_QN = OFF_P + al256(4ull * R * ODD_IN);
constexpr size_t OFF_KN = OFF_QN + al256(4ull * R * 512);
constexpr size_t OFF_U = OFF_KN + al256(4ull * R * 128);
constexpr size_t OFF_Z1 = OFF_U + al256(4ull * R * 1536);
constexpr size_t OFF_TOPE = OFF_Z1 + al256(4ull * R * 512);
constexpr size_t OFF_TOPG = OFF_TOPE + al256(4ull * R * 4);
constexpr size_t OFF_TOPP = OFF_TOPG + al256(4ull * R * 4);
constexpr size_t OFF_ROWTOK = OFF_TOPP + al256(4ull * R * 4);
constexpr size_t OFF_YR = OFF_ROWTOK + al256(4ull * 2 * NROWS);
constexpr size_t OFF_XBC = OFF_U;
constexpr size_t OFF_DT = OFF_YR + al256(4ull * NROWS * 1024);
constexpr size_t OFF_F = OFF_HH;
constexpr size_t OFF_Q1 = OFF_F + al256(4ull * 2 * R * 512);
constexpr size_t OFF_Y = OFF_DT + al256(4ull * 2 * R * 8);
constexpr size_t OFF_O = OFF_Y + al256(4ull * 2 * R * 512);
constexpr size_t OFF_TILEE = OFF_O + al256(4ull * 2 * R * 512);
constexpr size_t OFF_SDEC = OFF_TILEE + 4096;
constexpr size_t OFF_HDEC = OFF_SDEC + 16384;
constexpr size_t OFF_HB = OFF_HDEC + al256(4ull * 2 * 260 * 4 * 128);
constexpr size_t OFF_MB = OFF_HB + al256(2ull * R * D);
constexpr size_t OFF_XG = OFF_MB + al256(2ull * R * D);
constexpr size_t OFF_ACTB = OFF_XG + al256(2ull * NROWS * D);
constexpr size_t OFF_SST = OFF_XG;
constexpr size_t OFF_SSIN = OFF_SST + al256(2ull * 2 * 130 * 8 * 64 * 128);
constexpr size_t OFF_HST = OFF_SSIN + al256(2ull * 2 * 130 * 8 * 64 * 128);
constexpr size_t OFF_HSIN = OFF_ACTB;
constexpr size_t OFF_WINE = OFF_ACTB + al256(2ull * NROWS * D);
constexpr size_t OFF_WINO = OFF_WINE + al256(2ull * EVEN_IN * D);
constexpr size_t OFF_WOUT = OFF_WINO + al256(2ull * ODD_PAD * D);
constexpr size_t OFF_WGU = OFF_WOUT + al256(2ull * 2 * D * D);
constexpr size_t OFF_WDN = OFF_WGU + al256(2ull * 2 * 32 * 2048 * D);
constexpr size_t WS_END = OFF_WDN + al256(2ull * 2 * 32 * 1024 * D);

struct KArgs {
    const float* in[N_IN];
    float* out;
    unsigned char* ws;
};
struct Params {
    const float* const* in;
    float* out;
    unsigned char* ws;
};

__device__ __forceinline__ int tid_opaque() { int t = threadIdx.x; asm volatile("" : "+v"(t)); return t; }
__device__ __forceinline__ float silu_f(float x) { return x / (1.f + expf(-x)); }
__device__ __forceinline__ float sigmoid_f(float x) { return 1.f / (1.f + expf(-x)); }
__device__ __forceinline__ float softplus_f(float x) { return x > 20.f ? x : log1pf(expf(x)); }
__device__ __forceinline__ float wave_sum(float v) {
#pragma unroll
    for (int o = 32; o; o >>= 1) v += __shfl_xor(v, o);
    return v;
}
__device__ __forceinline__ float wave_max(float v) {
#pragma unroll
    for (int o = 32; o; o >>= 1) v = fmaxf(v, __shfl_xor(v, o));
    return v;
}
template <class T, class PT> __device__ __forceinline__ T* wsp(const PT& p, size_t off) { return (T*)(p.ws + off); }
__device__ __forceinline__ const float* modp(const Params& p, int layer, int cond, int j) {
    return wsp<float>(p, OFF_MOD) + (layer * 2 + cond) * 6144 + j * 3072;
}

__device__ __forceinline__ bf16_t f2bf(float f) { unsigned u = __float_as_uint(f); u += 0x7FFFu + ((u >> 16) & 1u); return (bf16_t)(u >> 16); }
__device__ __forceinline__ unsigned pack_bf16(float lo, float hi) { return (unsigned)f2bf(lo) | ((unsigned)f2bf(hi) << 16); }

namespace pg8 {
#define PG8_LAS __attribute__((address_space(3)))
typedef short bf16x8 __attribute__((ext_vector_type(8)));
typedef float f32x4 __attribute__((ext_vector_type(4)));
typedef unsigned u32x4 __attribute__((ext_vector_type(4)));
constexpr int BM = 256, BK = 64, HALF = 128, HTB = HALF * BK * 2, STAGE_BYTES = 8 * HTB, NXCD = 8, WGM = 8;
__device__ __forceinline__ int lds_byte(int r, int c) { const int st = (r >> 4) * 2 + (c >> 5), rr = r & 15, cc = c & 31, ob = rr * 64 + cc * 2; return st * 1024 + (ob ^ (((ob >> 9) & 1) << 5)); }
__device__ __forceinline__ void stage_rc(int b, int& Rr, int& C) { const int st = b / 1024, sb = b % 1024, swz = sb ^ (((sb >> 9) & 1) << 5); Rr = (st >> 1) * 16 + swz / 64; C = (st & 1) * 32 + (swz % 64) / 2; }
__device__ __forceinline__ int perm32(int rho) { const int n = rho >> 4, i = rho & 15; return 8 * (i >> 2) + 4 * n + (i & 3); }
struct Unit { int pm, pn, pb, e; };
struct Gemm { const bf16_t* A; const bf16_t* Bt; int K; };
struct StaticOrder {
    int nM, nN, nwg, G, c;
    __device__ void init(int M, int N, int G_, int c_) { nM = M / BM; nN = N / BM; nwg = nM * nN; G = G_; c = c_; }
    __device__ bool next(int i, Unit& u) const {
        const long Lx = (long)i * G + c; if (Lx >= nwg) return false;
        int wgid = (int)Lx; { const int q = nwg / NXCD, r = nwg % NXCD, xcd = wgid % NXCD, off = wgid / NXCD; wgid = (xcd < r ? xcd * (q + 1) : r * (q + 1) + (xcd - r) * q) + off; }
        const int nig = WGM * nN, gid = wgid / nig, fm = gid * WGM, gsz = (nM - fm) < WGM ? (nM - fm) : WGM;
        u.pm = fm + ((wgid % nig) % gsz); u.pn = (wgid % nig) / gsz; u.pb = u.pn; u.e = 0; return true;
    }
};
struct MoeOrder {
    const int* tile_e; int ntile, nN, G, c;
    __device__ bool next(int i, Unit& u) const {
        const long Lx = (long)i * G + c; if (Lx >= (long)ntile * nN) return false;
        u.pm = (int)(Lx / nN); u.pn = (int)(Lx % nN); u.e = tile_e[u.pm]; u.pb = u.e * nN + u.pn; return true;
    }
};
struct EpiStoreF32 {
    static constexpr bool PERM = false;
    float* C; int ldc; int nvalid;
    __device__ __forceinline__ void operator()(const f32x4 (&acc)[2][2][4][2], const Unit& u, int wr, int wc, int fr, int fq) const {
        const int row0 = u.pm * BM + wr * 64 + fr, col0 = u.pn * BM + wc * 32 + 4 * fq;
#pragma unroll
        for (int ai = 0; ai < 2; ++ai)
#pragma unroll
            for (int m = 0; m < 4; ++m) { float* rowp = C + (size_t)(row0 + ai * HALF + m * 16) * ldc + col0;
#pragma unroll
                for (int bj = 0; bj < 2; ++bj)
#pragma unroll
                    for (int n = 0; n < 2; ++n) if (col0 + bj * HALF + n * 16 < nvalid) *(f32x4*)(rowp + bj * HALF + n * 16) = acc[ai][bj][m][n]; }
    }
};
struct EpiResid {
    static constexpr bool PERM = false;
    const float* res_lat; const float* res_ctx; const float* gt_lat; const float* gt_ctx; float* out;
    __device__ __forceinline__ void operator()(const f32x4 (&acc)[2][2][4][2], const Unit& u, int wr, int wc, int fr, int fq) const {
        const int row0 = u.pm * BM + wr * 64 + fr, col0 = u.pn * BM + wc * 32 + 4 * fq;
        const bool ctx = (u.pm * BM) >= L;
        const float* gt = ctx ? gt_ctx : gt_lat;
        f32x4 gv[2][2];
#pragma unroll
        for (int bj = 0; bj < 2; ++bj)
#pragma unroll
            for (int n = 0; n < 2; ++n) gv[bj][n] = *(const f32x4*)(gt + col0 + bj * HALF + n * 16);
#pragma unroll
        for (int ai = 0; ai < 2; ++ai)
#pragma unroll
            for (int m = 0; m < 4; ++m) { const int row = row0 + ai * HALF + m * 16;
                const float* rp = (ctx ? res_ctx + (size_t)(row - L) * D : res_lat + (size_t)row * D) + col0;
                float* op = out + (size_t)row * D + col0;
#pragma unroll
                for (int bj = 0; bj < 2; ++bj)
#pragma unroll
                    for (int n = 0; n < 2; ++n) *(f32x4*)(op + bj * HALF + n * 16) = *(const f32x4*)(rp + bj * HALF + n * 16) + gv[bj][n] * acc[ai][bj][m][n]; }
    }
};
struct EpiMoe1 {
    static constexpr bool PERM = true;
    bf16_t* ACT; const float* bgu;
    __device__ __forceinline__ void operator()(const f32x4 (&acc)[2][2][4][2], const Unit& u, int wr, int wc, int fr, int fq) const {
        const int row0 = u.pm * BM + wr * 64 + fr, col0 = u.pn * HALF + wc * 32 + 8 * fq;
        const float* bg = bgu + (size_t)u.e * 2048 + col0;
        f32x4 bgv[2], buv[2];
#pragma unroll
        for (int n = 0; n < 2; ++n) { bgv[n] = *(const f32x4*)(bg + 4 * n); buv[n] = *(const f32x4*)(bg + 1024 + 4 * n); }
#pragma unroll
        for (int ai = 0; ai < 2; ++ai)
#pragma unroll
            for (int m = 0; m < 4; ++m) {
                float a[8];
#pragma unroll
                for (int n = 0; n < 2; ++n) { const f32x4 g4 = acc[ai][0][m][n] + bgv[n], u4 = acc[ai][1][m][n] + buv[n];
#pragma unroll
                    for (int j = 0; j < 4; ++j) { const float gate = fminf(g4[j], 7.f), up = fminf(fmaxf(u4[j], -7.f), 7.f);
                        a[n * 4 + j] = (up + 1.f) * gate / (1.f + __expf(-1.702f * gate)); } }
                u32x4 w; w.x = pack_bf16(a[0], a[1]); w.y = pack_bf16(a[2], a[3]); w.z = pack_bf16(a[4], a[5]); w.w = pack_bf16(a[6], a[7]);
                *(u32x4*)(ACT + (size_t)(row0 + ai * HALF + m * 16) * 1024 + col0) = w; }
    }
};
struct EpiMoe2 {
    static constexpr bool PERM = false;
    float* YR; const float* bdn;
    __device__ __forceinline__ void operator()(const f32x4 (&acc)[2][2][4][2], const Unit& u, int wr, int wc, int fr, int fq) const {
        const int row0 = u.pm * BM + wr * 64 + fr, col0 = u.pn * BM + wc * 32 + 4 * fq;
        const float* bd = bdn + (size_t)u.e * 1024 + col0;
        f32x4 bv[2][2];
#pragma unroll
        for (int bj = 0; bj < 2; ++bj)
#pragma unroll
            for (int n = 0; n < 2; ++n) bv[bj][n] = *(const f32x4*)(bd + bj * HALF + n * 16);
#pragma unroll
        for (int ai = 0; ai < 2; ++ai)
#pragma unroll
            for (int m = 0; m < 4; ++m) { float* rowp = YR + (size_t)(row0 + ai * HALF + m * 16) * 1024 + col0;
#pragma unroll
                for (int bj = 0; bj < 2; ++bj)
#pragma unroll
                    for (int n = 0; n < 2; ++n) *(f32x4*)(rowp + bj * HALF + n * 16) = acc[ai][bj][m][n] + bv[bj][n]; }
    }
};
template <class Epi, class Sched>
__device__ __forceinline__ void gemm_phase(PG8_LAS unsigned char* lds, const Gemm g, const Sched& S, const Epi& E) {
    const int TIDX = tid_opaque();
    const int tid = TIDX, wid = __builtin_amdgcn_readfirstlane(tid >> 6), lane = tid & 63, wr = wid >> 2, wc = wid & 3, fr = lane & 15, fq = lane >> 4;
    const int K = g.K, nt = K / BK;
    unsigned voffA[2], voffB[2];
#pragma unroll
    for (int i = 0; i < 2; ++i) { int Rr, C; stage_rc(tid * 16 + i * 8192, Rr, C); const int Rb = Epi::PERM ? ((Rr & ~31) + perm32(Rr & 31)) : Rr;
        voffA[i] = (unsigned)(Rr * K + C) * 2u; voffB[i] = (unsigned)(Rb * K + C) * 2u; }
    const size_t kstep = (size_t)(BK * 2);
    const size_t hstep = (size_t)HALF * K * 2;
    const size_t tstep = 2 * hstep;
    const unsigned ldsw = (unsigned)wid * 1024u;
    const int aoff = lds_byte(wr * 64 + fr, fq * 8), boff = lds_byte(wc * 32 + fr, fq * 8);
#define PG8_SA(b, h) (((b) * 2 + (h)) * HTB)
#define PG8_SB(b, h) ((4 + (b) * 2 + (h)) * HTB)
#define PG8_STAGE(bufoff, gbase, voff) do { _Pragma("unroll") for (int _i = 0; _i < 2; ++_i) \
        __builtin_amdgcn_global_load_lds((const unsigned*)((const char*)(gbase) + (voff)[_i]), (PG8_LAS unsigned*)(lds + (bufoff) + ldsw + _i * 8192), 16, 0, 0); } while (0)
#define PG8_LDA(dst, b, h) do { _Pragma("unroll") for (int m = 0; m < 4; ++m) _Pragma("unroll") for (int k = 0; k < 2; ++k) dst[m][k] = *(const PG8_LAS bf16x8*)(lds + PG8_SA(b, h) + aoff + m * 2048 + k * 1024); } while (0)
#define PG8_LDB(dst, b, h) do { _Pragma("unroll") for (int n = 0; n < 2; ++n) _Pragma("unroll") for (int k = 0; k < 2; ++k) dst[n][k] = *(const PG8_LAS bf16x8*)(lds + PG8_SB(b, h) + boff + n * 2048 + k * 1024); } while (0)
#define PG8_MMA(ai, bj, At, Bt) do { __builtin_amdgcn_s_setprio(1); _Pragma("unroll") for (int m = 0; m < 4; ++m) _Pragma("unroll") for (int n = 0; n < 2; ++n) _Pragma("unroll") for (int k = 0; k < 2; ++k) \
        acc[ai][bj][m][n] = __builtin_amdgcn_mfma_f32_16x16x32_bf16(Bt[n][k], At[m][k], acc[ai][bj][m][n], 0, 0, 0); __builtin_amdgcn_s_setprio(0); } while (0)
#define PG8_WAIT_V(n) asm volatile("s_waitcnt vmcnt(" #n ")" ::: "memory")
#define PG8_WAIT_L(n) asm volatile("s_waitcnt lgkmcnt(" #n ")" ::: "memory")
#define PG8_BAR __builtin_amdgcn_s_barrier()
#define PG8_SCHED __builtin_amdgcn_sched_barrier(0)
    Unit cur, nxt; int ui = 0;
    if (!S.next(0, cur)) return;
    f32x4 acc[2][2][4][2];
#pragma unroll
    for (int a = 0; a < 2; ++a)
#pragma unroll
        for (int b = 0; b < 2; ++b)
#pragma unroll
            for (int m = 0; m < 4; ++m)
#pragma unroll
                for (int n = 0; n < 2; ++n) acc[a][b][m][n] = (f32x4){0.f, 0.f, 0.f, 0.f};
    bf16x8 At[4][2], B0[2][2], B1[2][2];
    const char* cA = (const char*)g.A + (size_t)cur.pm * tstep; const char* cB = (const char*)g.Bt + (size_t)cur.pb * tstep;
    PG8_STAGE(PG8_SB(0, 0), cB, voffB); PG8_STAGE(PG8_SA(0, 0), cA, voffA); PG8_STAGE(PG8_SB(0, 1), cB + hstep, voffB); PG8_STAGE(PG8_SA(0, 1), cA + hstep, voffA);
    if (wr == 1) PG8_BAR;
    PG8_WAIT_V(4); PG8_BAR;
    PG8_STAGE(PG8_SB(1, 0), cB + kstep, voffB); PG8_STAGE(PG8_SA(1, 0), cA + kstep, voffA); PG8_STAGE(PG8_SB(1, 1), cB + hstep + kstep, voffB);
    PG8_WAIT_V(6); PG8_BAR;
    for (;;) {
        const bool has_next = S.next(ui + 1, nxt);
        const char* nA = has_next ? (const char*)g.A + (size_t)nxt.pm * tstep : cA; const char* nB = has_next ? (const char*)g.Bt + (size_t)nxt.pb * tstep : cB;
        for (int t = 0; t < nt; t += 2) {
            const bool last = (t == nt - 2);
            const char* a1 = cA + (size_t)(t + 1) * kstep;
            const char* a2 = last ? nA : cA + (size_t)(t + 2) * kstep; const char* b2 = last ? nB : cB + (size_t)(t + 2) * kstep;
            const char* a3 = a2 + kstep; const char* b3 = b2 + kstep;
            PG8_LDB(B0, 0, 0); PG8_SCHED; PG8_LDA(At, 0, 0); PG8_STAGE(PG8_SA(1, 1), a1 + hstep, voffA);
            PG8_WAIT_L(8); PG8_BAR; PG8_WAIT_L(0); PG8_MMA(0, 0, At, B0); PG8_BAR; PG8_SCHED;
            PG8_LDB(B1, 0, 1); PG8_STAGE(PG8_SB(0, 0), b2, voffB);
            PG8_BAR; PG8_WAIT_L(0); PG8_MMA(0, 1, At, B1); PG8_BAR;
            PG8_LDA(At, 0, 1); PG8_STAGE(PG8_SA(0, 0), a2, voffA);
            PG8_BAR; PG8_WAIT_L(0); PG8_MMA(1, 0, At, B0); PG8_BAR; PG8_SCHED;
            PG8_STAGE(PG8_SB(0, 1), b2 + hstep, voffB);
            PG8_WAIT_V(6); PG8_BAR; PG8_MMA(1, 1, At, B1); PG8_BAR;
            PG8_LDB(B0, 1, 0); PG8_SCHED; PG8_LDA(At, 1, 0); PG8_STAGE(PG8_SA(0, 1), a2 + hstep, voffA);
            PG8_WAIT_L(8); PG8_BAR; PG8_WAIT_L(0); PG8_MMA(0, 0, At, B0); PG8_BAR; PG8_SCHED;
            PG8_LDB(B1, 1, 1); PG8_STAGE(PG8_SB(1, 0), b3, voffB);
            PG8_BAR; PG8_WAIT_L(0); PG8_MMA(0, 1, At, B1); PG8_BAR;
            PG8_LDA(At, 1, 1); PG8_STAGE(PG8_SA(1, 0), a3, voffA);
            PG8_BAR; PG8_WAIT_L(0); PG8_MMA(1, 0, At, B0); PG8_BAR; PG8_SCHED;
            PG8_STAGE(PG8_SB(1, 1), b3 + hstep, voffB);
            PG8_WAIT_V(6); PG8_BAR; PG8_MMA(1, 1, At, B1); PG8_BAR;
        }
        E(acc, cur, wr, wc, fr, fq);
        if (!has_next) break;
#pragma unroll
        for (int a = 0; a < 2; ++a)
#pragma unroll
            for (int b = 0; b < 2; ++b)
#pragma unroll
                for (int m = 0; m < 4; ++m)
#pragma unroll
                    for (int n = 0; n < 2; ++n) acc[a][b][m][n] = (f32x4){0.f, 0.f, 0.f, 0.f};
        cur = nxt; cA = nA; cB = nB; ++ui;
    }
    PG8_WAIT_V(0);
    if (wr == 0) PG8_BAR;
    PG8_BAR;
#undef PG8_SA
#undef PG8_SB
#undef PG8_STAGE
#undef PG8_LDA
#undef PG8_LDB
#undef PG8_MMA
#undef PG8_WAIT_V
#undef PG8_WAIT_L
#undef PG8_BAR
#undef PG8_SCHED
}
}

__device__ __forceinline__ void convert_tile(float* lds, const float* src, int N, int k0, int n0, bf16_t* dstrow0) {
    const int TIDX = tid_opaque();
    const int t = TIDX;
#pragma unroll
    for (int i = 0; i < 4; i++) {
        const int kr = (t >> 5) + 16 * i, c4 = (t & 31) * 4;
        float4 v = make_float4(0.f, 0.f, 0.f, 0.f);
        if (n0 + c4 < N) v = *(const float4*)(src + (size_t)(k0 + kr) * N + n0 + c4);
        float* d = lds + kr * 129 + c4;
        d[0] = v.x; d[1] = v.y; d[2] = v.z; d[3] = v.w;
    }
    __syncthreads();
#pragma unroll
    for (int j = 0; j < 2; j++) {
        const int n = (t >> 3) + 64 * j, k8 = (t & 7) * 8;
        float a[8];
#pragma unroll
        for (int q = 0; q < 8; q++) a[q] = lds[(k8 + q) * 129 + n];
        pg8::u32x4 w; w.x = pack_bf16(a[0], a[1]); w.y = pack_bf16(a[2], a[3]); w.z = pack_bf16(a[4], a[5]); w.w = pack_bf16(a[6], a[7]);
        *(pg8::u32x4*)(dstrow0 + (size_t)n * 1024 + k0 + k8) = w;
    }
    __syncthreads();
}
template <class PT>
__device__ __forceinline__ void ph_convert_weights(const PT& p, float* lds) {
    const int TIDX = tid_opaque();
    constexpr int T_INE = 16 * 18, T_INO = 16 * 34, T_OUT = 2 * 16 * 8, T_GU = 2 * 32 * 16 * 16, T_DN = 2 * 32 * 16 * 8;
    constexpr int TOT = T_INE + T_INO + T_OUT + T_GU + T_DN;
    for (int it = blockIdx.x; it < TOT; it += gridDim.x) {
        int q = it;
        if (q < T_INE) { const int kt = q / 18, nt = q % 18; convert_tile(lds, p.in[I_WINE], EVEN_IN, kt * 64, nt * 128, wsp<bf16_t>(p, OFF_WINE) + (size_t)nt * 128 * 1024); continue; }
        q -= T_INE;
        if (q < T_INO) { const int kt = q / 34, nt = q % 34; convert_tile(lds, p.in[I_WINO], ODD_IN, kt * 64, nt * 128, wsp<bf16_t>(p, OFF_WINO) + (size_t)nt * 128 * 1024); continue; }
        q -= T_INO;
        if (q < T_OUT) { const int l = q / 128, kt = (q % 128) / 8, nt = q % 8;
            convert_tile(lds, p.in[I_WOUT] + (size_t)l * D * D, D, kt * 64, nt * 128, wsp<bf16_t>(p, OFF_WOUT) + ((size_t)l * 1024 + nt * 128) * 1024); continue; }
        q -= T_OUT;
        if (q < T_GU) { const int le = q / 256, kt = (q % 256) / 16, nt = q % 16;
            const int drow = nt < 8 ? 256 * nt : 256 * (nt - 8) + 128;
            convert_tile(lds, p.in[I_WGU] + (size_t)le * 1024 * 2048, 2048, kt * 64, nt * 128, wsp<bf16_t>(p, OFF_WGU) + ((size_t)le * 2048 + drow) * 1024); continue; }
        q -= T_GU;
        { const int le = q / 128, kt = (q % 128) / 8, nt = q % 8;
            convert_tile(lds, p.in[I_WDN] + (size_t)le * 1024 * 1024, 1024, kt * 64, nt * 128, wsp<bf16_t>(p, OFF_WDN) + ((size_t)le * 1024 + nt * 128) * 1024); }
    }
}

template <class AL, class BL, class EP>
__device__ __forceinline__ void gemm_tile_f32(float* lds, int K, AL aload, BL bload, EP epi) {
    const int TIDX = tid_opaque();
    float(*As)[132] = (float(*)[132])lds;
    float(*Bs)[132] = (float(*)[132])(lds + 16 * 132);
    const int tid = TIDX, tx = tid & 15, ty = tid >> 4;
    float acc[4][8];
#pragma unroll
    for (int i = 0; i < 4; i++)
#pragma unroll
        for (int j = 0; j < 8; j++) acc[i][j] = 0.f;
    for (int k0 = 0; k0 < K; k0 += 16) {
        float av[4], bv[4];
#pragma unroll
        for (int i = 0; i < 4; i++) av[i] = aload((tid >> 4) + 32 * i, k0 + (tid & 15));
#pragma unroll
        for (int i = 0; i < 4; i++) bv[i] = bload(k0 + (tid >> 7) + 4 * i, tid & 127);
        __syncthreads();
#pragma unroll
        for (int i = 0; i < 4; i++) As[tid & 15][(tid >> 4) + 32 * i] = av[i];
#pragma unroll
        for (int i = 0; i < 4; i++) Bs[(tid >> 7) + 4 * i][tid & 127] = bv[i];
        __syncthreads();
#pragma unroll
        for (int k = 0; k < 16; k++) {
            const float4 a = *(const float4*)&As[k][ty * 4];
            const float4 b0 = *(const float4*)&Bs[k][tx * 4];
            const float4 b1 = *(const float4*)&Bs[k][64 + tx * 4];
            const float aa[4] = {a.x, a.y, a.z, a.w};
            const float bb[8] = {b0.x, b0.y, b0.z, b0.w, b1.x, b1.y, b1.z, b1.w};
#pragma unroll
            for (int i = 0; i < 4; i++)
#pragma unroll
                for (int j = 0; j < 8; j++) acc[i][j] = fmaf(aa[i], bb[j], acc[i][j]);
        }
    }
    __syncthreads();
#pragma unroll
    for (int i = 0; i < 4; i++) epi(ty * 4 + i, tx, acc[i]);
}
__device__ __forceinline__ int lcol(int tx, int jc) { return tx * 4 + (jc & 3) + 64 * (jc >> 2); }

template <class EP>
__device__ __forceinline__ void gemm_dense(float* lds, const float* A, int lda, const float* B, int N, int M, int K, EP epi) {
    const int tm = M / 128, tn = (N + 127) / 128;
    for (int t = blockIdx.x; t < tm * tn; t += gridDim.x) {
        const int m0 = (t / tn) * 128, n0 = (t % tn) * 128;
        gemm_tile_f32(
            lds, K, [&](int r, int k) { return A[(size_t)(m0 + r) * lda + k]; },
            [&](int k, int c) { return (n0 + c < N) ? B[(size_t)k * N + n0 + c] : 0.f; },
            [&](int r, int tx, const float(&a)[8]) {
#pragma unroll
                for (int jc = 0; jc < 8; jc++) {
                    const int c = n0 + lcol(tx, jc);
                    if (c < N) epi(m0 + r, c, a[jc]);
                }
            });
    }
}

template <class PT>
__device__ __forceinline__ void ph_prologue(const PT& p, float* lds) {
    const int TIDX = tid_opaque();
    const int tid = TIDX, lane = tid & 63, wave = tid >> 6;
    const int gthreads = gridDim.x * NT, gtid = blockIdx.x * NT + tid;
    float* mod = wsp<float>(p, OFF_MOD);
    for (int it = gtid; it < 2 * 6144; it += gthreads) {
        const int layer = it / 6144, n = it % 6144;
        const float* w = p.in[I_ADAW] + (size_t)layer * 1024 * 6144 + n;
        float a0 = 0.f, a1 = 0.f;
#pragma unroll 8
        for (int k = 0; k < 1024; k++) {
            const float wv = w[(size_t)k * 6144];
            a0 = fmaf(silu_f(p.in[I_C][k]), wv, a0);
            a1 = fmaf(silu_f(p.in[I_CCTX][k]), wv, a1);
        }
        const float b = p.in[I_ADAB][layer * 6144 + n];
        mod[(layer * 2 + 0) * 6144 + n] = a0 + b;
        mod[(layer * 2 + 1) * 6144 + n] = a1 + b;
    }
    for (int it = gtid; it < 512; it += gthreads) {
        const float b0 = p.in[I_HGLB][it], b1 = p.in[I_HGLB][512 + it];
        wsp<float>(p, OFF_LB)[it] = 1.f / (1.f + expf(b0 - b1));
    }
    float* zb = lds + wave * 64;
    float* hd3 = wsp<float>(p, OFF_HD3);
    const float fq = p.in[I_HYFREQ][lane];
    float w1r[33], w2r[64], w3r[64];
#pragma unroll
    for (int i = 0; i < 33; i++) w1r[i] = p.in[I_HYW1][i * 64 + lane];
#pragma unroll
    for (int i = 0; i < 64; i++) { w2r[i] = p.in[I_HYW2][i * 64 + lane]; w3r[i] = p.in[I_HYW3][i * 64 + lane]; }
    const float b1 = p.in[I_HYB1][lane], b2 = p.in[I_HYB2][lane], b3 = p.in[I_HYB3][lane];
    for (int row = blockIdx.x * NWAVE + wave; row < R; row += gridDim.x * NWAVE) {
        const int Ls = row < L ? L : NCX, t = row < L ? row : row - L;
        const float tn = (float)t / (float)(Ls - 1);
        const float wang = 6.283185307179586f * (float)t / (float)Ls;
        if (lane < 33) {
            float z;
            if (lane == 0) z = tn;
            else {
                const int b = (lane - 1) & 15;
                const float fr = 1e-4f + (float)b * ((15.f - 1e-4f) / 15.f);
                z = (lane <= 16) ? cosf(fr * wang) : -sinf(fr * wang);
            }
            zb[lane] = z;
        }
        __builtin_amdgcn_wave_barrier();
        float a = b1;
#pragma unroll
        for (int i = 0; i < 33; i++) a = fmaf(zb[i], w1r[i], a);
        float h = sinf(fq * a);
        __builtin_amdgcn_wave_barrier();
        zb[lane] = h;
        __builtin_amdgcn_wave_barrier();
        a = b2;
#pragma unroll
        for (int i = 0; i < 64; i++) a = fmaf(zb[i], w2r[i], a);
        h = sinf(fq * a);
        __builtin_amdgcn_wave_barrier();
        zb[lane] = h;
        __builtin_amdgcn_wave_barrier();
        a = b3;
#pragma unroll
        for (int i = 0; i < 64; i++) a = fmaf(zb[i], w3r[i], a);
        h = sinf(fq * a);
        hd3[(size_t)row * 64 + lane] = h;
        __builtin_amdgcn_wave_barrier();
    }
}

template <bool ROUTER>
__device__ __forceinline__ void prep_rows(const Params& p, const float* xl, const float* xc, int nrows, const float* g, int layer, int j, float* hout) {
    const int TIDX = tid_opaque();
    const int lane = TIDX & 63, wave = TIDX >> 6;
    for (int r = blockIdx.x * NWAVE + wave; r < nrows; r += gridDim.x * NWAVE) {
        const float* src = r < L ? xl + (size_t)r * D : xc + (size_t)(r - L) * D;
        const float* md = modp(p, layer, r < L ? 0 : 1, j);
        float v[16];
        float ss = 0.f;
#pragma unroll
        for (int i = 0; i < 16; i++) { v[i] = src[lane + 64 * i]; ss = fmaf(v[i], v[i], ss); }
        ss = wave_sum(ss);
        const float rinv = rsqrtf(ss * (1.f / 1024.f) + EPS);
#pragma unroll
        for (int i = 0; i < 16; i++) {
            const int c = lane + 64 * i;
            v[i] = v[i] * rinv * g[c] * (1.f + md[1024 + c]) + md[c];
            hout[(size_t)r * D + c] = v[i];
            wsp<bf16_t>(p, OFF_HB)[(size_t)r * D + c] = f2bf(v[i]);
        }
        if (ROUTER) {
            const float* rw = p.in[I_RW] + (size_t)layer * 1024 * 32;
            float lg[32];
#pragma unroll
            for (int e = 0; e < 32; e++) lg[e] = 0.f;
#pragma unroll 1
            for (int i = 0; i < 16; i++) {
                const float* wr = rw + (size_t)(lane + 64 * i) * 32;
                const float hv = hout[(size_t)r * D + lane + 64 * i];
#pragma unroll
                for (int e4 = 0; e4 < 8; e4++) {
                    const float4 w4 = *(const float4*)(wr + e4 * 4);
                    lg[e4 * 4 + 0] = fmaf(hv, w4.x, lg[e4 * 4 + 0]);
                    lg[e4 * 4 + 1] = fmaf(hv, w4.y, lg[e4 * 4 + 1]);
                    lg[e4 * 4 + 2] = fmaf(hv, w4.z, lg[e4 * 4 + 2]);
                    lg[e4 * 4 + 3] = fmaf(hv, w4.w, lg[e4 * 4 + 3]);
                }
            }
#pragma unroll
            for (int e = 0; e < 32; e++) lg[e] = wave_sum(lg[e]) + p.in[I_RB][layer * 32 + e];
            unsigned used = 0u;
            float tv[4];
            int ti[4];
#pragma unroll
            for (int k = 0; k < 4; k++) {
                float best = -INFINITY;
                int bi = 0;
#pragma unroll
                for (int e = 0; e < 32; e++) {
                    const bool ok = !((used >> e) & 1u) && (lg[e] > best);
                    best = ok ? lg[e] : best;
                    bi = ok ? e : bi;
                }
                used |= 1u << bi;
                tv[k] = best;
                ti[k] = bi;
            }
            float es[4], den = 0.f;
#pragma unroll
            for (int k = 0; k < 4; k++) { es[k] = expf(tv[k] - tv[0]); den += es[k]; }
            if (lane < 4) {
                int e = ti[0];
                float gg = es[0];
#pragma unroll
                for (int k = 1; k < 4; k++) { e = (lane == k) ? ti[k] : e; gg = (lane == k) ? es[k] : gg; }
                int* cnt = wsp<int>(p, OFF_CTL) + layer * 32;
                const int pos = atomicAdd(&cnt[e], 1);
                wsp<int>(p, OFF_TOPE)[r * 4 + lane] = e;
                wsp<float>(p, OFF_TOPG)[r * 4 + lane] = gg / den;
                wsp<int>(p, OFF_TOPP)[r * 4 + lane] = pos;
            }
        }
    }
}

__device__ __forceinline__ void ph_filter_gemm(const Params& p, float* lds) {
    const int TIDX = tid_opaque();
    const float* hd3 = wsp<float>(p, OFF_HD3);
    float* hh = wsp<float>(p, OFF_HH);
    float* hhc = wsp<float>(p, OFF_HHC);
    const float mind = logf(1e-2f) / 1.5f, maxd = logf(1e-2f) / 0.3f;
    gemm_dense(lds, hd3, 64, p.in[I_HYW4], 2048, R, 64, [&](int row, int col, float v) {
        const int Ls = row < L ? L : NCX, t = row < L ? row : row - L;
        float* dst = row < L ? hh : hhc;
        const int o = col >> 10, side = (col >> 9) & 1, ch = col & 511;
        const float delta = fabsf(mind + (float)ch * ((maxd - mind) / 511.f));
        const float tn = (float)t / (float)(Ls - 1);
        const float val = v * expf(-tn * delta);
        if (side == 0) dst[(size_t)(Ls + t) * 1024 + o * 512 + ch] = val;
        else if (t > 0) dst[(size_t)(Ls - t) * 1024 + o * 512 + ch] = val;
        else dst[o * 512 + ch] = 0.f;
    });
}
__device__ __forceinline__ void ph_filter_abs(const Params& p) {
    const int TIDX = tid_opaque();
    const float* hh = wsp<float>(p, OFF_HH);
    const float* hhc = wsp<float>(p, OFF_HHC);
    float* hnp = wsp<float>(p, OFF_HNP);
    for (int it = blockIdx.x; it < 130 * 2; it += gridDim.x) {
        const int chunk = it >> 1, col = (it & 1) * 512 + TIDX;
        const float* src = chunk < 128 ? hh + (size_t)chunk * 256 * 1024 : hhc + (size_t)(chunk - 128) * 256 * 1024;
        float s = 0.f;
        for (int i = 0; i < 256; i++) s += fabsf(src[(size_t)i * 1024 + col]);
        hnp[chunk * 1024 + col] = s;
    }
}

__device__ __forceinline__ void ph_qk_dwconv(const Params& p) {
    const int TIDX = tid_opaque();
    const int lane = TIDX & 63, wave = TIDX >> 6;
    const float* P0 = wsp<float>(p, OFF_P);
    float* qn = wsp<float>(p, OFF_QN);
    float* kn = wsp<float>(p, OFF_KN);
    for (int it = blockIdx.x * NWAVE + wave; it < R * 10; it += gridDim.x * NWAVE) {
        const int r = it / 10, s = it % 10;
        const int off = s < 2 ? s * 64 : 256 + (s - 2) * 64;
        const float v = P0[(size_t)r * EVEN_IN + off + lane];
        const float ss = wave_sum(v * v);
        const float gain = s < 2 ? p.in[I_KNORM][lane] : p.in[I_QNORM][lane];
        float n = v * rsqrtf(ss * (1.f / 64.f) + EPS) * gain;
        if (r < L) {
            const float partner = __shfl_xor(n, 16);
            const int pos = lane < 32 ? (r >> 6) : (r & 63);
            const int i = lane & 15;
            const float inv = powf(10000.f, -(float)i / 16.f);
            const float ang = (float)pos * inv;
            const float cs = cosf(ang), sn = sinf(ang);
            n = ((lane & 16) == 0) ? n * cs - partner * sn : partner * sn + n * cs;
        }
        if (s < 2) kn[(size_t)r * 128 + s * 64 + lane] = n;
        else qn[(size_t)r * 512 + (s - 2) * 64 + lane] = n;
    }
    float* U = wsp<float>(p, OFF_U);
    const float* cw = p.in[I_HYCW];
    const float* cb = p.in[I_HYCB];
    const size_t tot = (size_t)R * 1536;
    for (size_t it = (size_t)blockIdx.x * NT + TIDX; it < tot; it += (size_t)gridDim.x * NT) {
        const int r = (int)(it / 1536), c = (int)(it % 1536);
        const int lo = r < L ? 0 : L, hi = r < L ? L : R;
        float a = cb[c];
#pragma unroll
        for (int j = 0; j < 3; j++) {
            const int rr = r + j - 1;
            if (rr >= lo && rr < hi) a = fmaf(cw[j * 1536 + c], P0[(size_t)rr * EVEN_IN + 768 + c], a);
        }
        U[it] = a;
    }
}

__device__ __forceinline__ void ph_attention(const Params& p, float* lds) {
    const int TIDX = tid_opaque();
    const int lane = TIDX & 63, wave = TIDX >> 6;
    const float* P0 = wsp<float>(p, OFF_P);
    const float* qn = wsp<float>(p, OFF_QN);
    const float* kn = wsp<float>(p, OFF_KN);
    float* sc = lds + wave * 576;
    for (int it = blockIdx.x * NWAVE + wave; it < R * 8; it += gridDim.x * NWAVE) {
        const int r = it >> 3, hq = it & 7, kvh = hq >> 2;
        int lo = 0, nloc = 0;
        if (r < L) { lo = max(0, r - 128); nloc = min(L - 1, r + 128) - lo + 1; }
        const int ntot = nloc + NCX;
        float q[64];
#pragma unroll
        for (int d4 = 0; d4 < 16; d4++) {
            const float4 t = *(const float4*)(qn + (size_t)r * 512 + hq * 64 + d4 * 4);
            q[d4 * 4] = t.x; q[d4 * 4 + 1] = t.y; q[d4 * 4 + 2] = t.z; q[d4 * 4 + 3] = t.w;
        }
        float mx = -INFINITY;
        for (int j = lane; j < ntot; j += 64) {
            const int krow = j < nloc ? lo + j : L + (j - nloc);
            const float* kp = kn + (size_t)krow * 128 + kvh * 64;
            float dot = 0.f;
#pragma unroll
            for (int d4 = 0; d4 < 16; d4++) {
                const float4 t = *(const float4*)(kp + d4 * 4);
                dot = fmaf(q[d4 * 4], t.x, dot); dot = fmaf(q[d4 * 4 + 1], t.y, dot);
                dot = fmaf(q[d4 * 4 + 2], t.z, dot); dot = fmaf(q[d4 * 4 + 3], t.w, dot);
            }
            dot *= 0.125f;
            sc[j] = dot;
            mx = fmaxf(mx, dot);
        }
        const float sink = p.in[I_SINK][hq];
        mx = fmaxf(wave_max(mx), sink);
        float sum = 0.f;
        for (int j = lane; j < ntot; j += 64) { const float e = expf(sc[j] - mx); sc[j] = e; sum += e; }
        sum = wave_sum(sum) + expf(sink - mx);
        const float rs = 1.f / sum;
        __builtin_amdgcn_wave_barrier();
        float o = 0.f;
        for (int j = 0; j < ntot; j++) {
            const int krow = j < nloc ? lo + j : L + (j - nloc);
            o = fmaf(sc[j], P0[(size_t)krow * EVEN_IN + 128 + kvh * 64 + lane], o);
        }
        wsp<bf16_t>(p, OFF_MB)[(size_t)r * D + 512 + hq * 64 + lane] = f2bf(o * rs);
        __builtin_amdgcn_wave_barrier();
    }
}

__device__ __forceinline__ void ph_hyena_conv(const Params& p, int o) {
    const int TIDX = tid_opaque();
    const int lane = TIDX & 63, wave = TIDX >> 6;
    const float* U = wsp<float>(p, OFF_U);
    const float* hnp = wsp<float>(p, OFF_HNP);
    float* Z1 = wsp<float>(p, OFF_Z1);
    const float* zin = o == 0 ? U : Z1;
    const int zld = o == 0 ? 1536 : 512;
    const int nlat = 8 * (L / 64), nctx = 8 * (NCX / 64);
    for (int it = blockIdx.x; it < nlat + nctx; it += gridDim.x) {
        const bool lat = it < nlat;
        const int ii = lat ? it : it - nlat;
        const int Ls = lat ? L : NCX, base = lat ? 0 : L;
        const int ch = (ii & 7) * 64 + lane, t0 = (ii >> 3) * 64 + wave * 8;
        const float* hf = (lat ? wsp<float>(p, OFF_HH) : wsp<float>(p, OFF_HHC)) + o * 512 + ch;
        float nrm = 0.f;
        if (lat) { for (int c = 0; c < 128; c++) nrm += hnp[c * 1024 + o * 512 + ch]; }
        else { nrm = hnp[128 * 1024 + o * 512 + ch] + hnp[129 * 1024 + o * 512 + ch]; }
        float acc[8];
#pragma unroll
        for (int i = 0; i < 8; i++) acc[i] = 0.f;
        for (int s0 = 0; s0 < Ls; s0 += 8) {
            float zv[8], hv[15];
#pragma unroll
            for (int j = 0; j < 8; j++) zv[j] = zin[(size_t)(base + s0 + j) * zld + ch];
#pragma unroll
            for (int e = 0; e < 15; e++) hv[e] = hf[(size_t)(t0 - s0 + e - 7 + Ls) * 1024];
#pragma unroll
            for (int i = 0; i < 8; i++)
#pragma unroll
                for (int j = 0; j < 8; j++) acc[i] = fmaf(hv[i - j + 7], zv[j], acc[i]);
        }
        const float inv = 1.f / nrm;
        const float bias = p.in[I_HYFB][o * 512 + ch];
#pragma unroll
        for (int i = 0; i < 8; i++) {
            const int r = base + t0 + i;
            const float zc = acc[i] * inv;
            const float z = zin[(size_t)r * zld + ch];
            const float gate = U[(size_t)r * 1536 + 512 * (o + 1) + ch];
            const float res = gate * (zc + z * bias);
            if (o == 0) Z1[(size_t)r * 512 + ch] = res;
            else wsp<bf16_t>(p, OFF_MB)[(size_t)r * D + ch] = f2bf(res);
        }
    }
}

__device__ __forceinline__ void ph_moe_scatter(const Params& p, float* lds, int layer, int ntok) {
    const int TIDX = tid_opaque();
    int* sst = (int*)lds;
    const int* cnt = wsp<int>(p, OFF_CTL) + layer * 32;
    int* tile_e = wsp<int>(p, OFF_TILEE) + layer * 512;
    __syncthreads();
    if (TIDX == 0) {
        int a = 0;
        for (int e = 0; e < 32; e++) {
            sst[e] = a;
            const int nt = (cnt[e] + 255) / 256;
            if (blockIdx.x == 0) for (int q = 0; q < nt; q++) tile_e[a / 256 + q] = e;
            a += nt * 256;
        }
        sst[32] = a;
    }
    __syncthreads();
    if (blockIdx.x == 0 && TIDX < 33) wsp<int>(p, OFF_STARTS)[layer * 64 + TIDX] = sst[TIDX];
    const int* te = wsp<int>(p, OFF_TOPE);
    const int* tp = wsp<int>(p, OFF_TOPP);
    const bf16_t* HB = wsp<bf16_t>(p, OFF_HB);
    bf16_t* XG = wsp<bf16_t>(p, OFF_XG);
    const int lane = TIDX & 63, wave = TIDX >> 6;
    for (int it = blockIdx.x * NWAVE + wave; it < ntok * 4; it += gridDim.x * NWAVE) {
        const int row = sst[te[it]] + tp[it];
        const pg8::u32x4* src = (const pg8::u32x4*)(HB + (size_t)(it >> 2) * D);
        pg8::u32x4* dst = (pg8::u32x4*)(XG + (size_t)row * D);
        dst[lane] = src[lane];
        dst[lane + 64] = src[lane + 64];
    }
    __syncthreads();
}
__device__ __forceinline__ void ph_moe_gemm1(const Params& p, PG8_LAS unsigned char* lds, int layer) {
    const int total = wsp<int>(p, OFF_STARTS)[layer * 64 + 32];
    pg8::MoeOrder S{wsp<int>(p, OFF_TILEE) + layer * 512, total / 256, 8, (int)gridDim.x, (int)blockIdx.x};
    pg8::Gemm g{wsp<bf16_t>(p, OFF_XG), wsp<bf16_t>(p, OFF_WGU) + (size_t)layer * 32 * 2048 * 1024, 1024};
    pg8::EpiMoe1 E{wsp<bf16_t>(p, OFF_ACTB), p.in[I_BGU] + (size_t)layer * 32 * 2048};
    pg8::gemm_phase(lds, g, S, E);
}
__device__ __forceinline__ void ph_moe_gemm2(const Params& p, PG8_LAS unsigned char* lds, int layer) {
    const int total = wsp<int>(p, OFF_STARTS)[layer * 64 + 32];
    pg8::MoeOrder S{wsp<int>(p, OFF_TILEE) + layer * 512, total / 256, 4, (int)gridDim.x, (int)blockIdx.x};
    pg8::Gemm g{wsp<bf16_t>(p, OFF_ACTB), wsp<bf16_t>(p, OFF_WDN) + (size_t)layer * 32 * 1024 * 1024, 1024};
    pg8::EpiMoe2 E{wsp<float>(p, OFF_YR), p.in[I_BDN] + (size_t)layer * 32 * 1024};
    pg8::gemm_phase(lds, g, S, E);
}
template <bool NEXTPREP>
__device__ __forceinline__ void ph_moe_combine(const Params& p, int layer, int nrows, const float* xi, float* xo, int nlayer) {
    const int TIDX = tid_opaque();
    const int lane = TIDX & 63, wave = TIDX >> 6;
    const int* starts = wsp<int>(p, OFF_STARTS) + layer * 64;
    const int* te = wsp<int>(p, OFF_TOPE);
    const int* tp = wsp<int>(p, OFF_TOPP);
    const float* tg = wsp<float>(p, OFF_TOPG);
    const float* YR = wsp<float>(p, OFF_YR);
    float* H = wsp<float>(p, OFF_H);
    for (int r = blockIdx.x * NWAVE + wave; r < nrows; r += gridDim.x * NWAVE) {
        const float* gt = modp(p, layer, r < L ? 0 : 1, 1) + 2048;
        float v[16];
#pragma unroll
        for (int i = 0; i < 16; i++) v[i] = 0.f;
#pragma unroll
        for (int k = 0; k < 4; k++) {
            const int row = starts[te[r * 4 + k]] + tp[r * 4 + k];
            const float g = tg[r * 4 + k];
#pragma unroll
            for (int i = 0; i < 16; i++) v[i] = fmaf(g, YR[(size_t)row * 1024 + lane + 64 * i], v[i]);
        }
        float ss = 0.f;
#pragma unroll
        for (int i = 0; i < 16; i++) {
            const int c = lane + 64 * i;
            v[i] = xi[(size_t)r * D + c] + gt[c] * v[i];
            xo[(size_t)r * D + c] = v[i];
            ss = fmaf(v[i], v[i], ss);
        }
        if (NEXTPREP) {
            ss = wave_sum(ss);
            const float rinv = rsqrtf(ss * (1.f / 1024.f) + EPS);
            const float* md = modp(p, nlayer, r < L ? 0 : 1, 0);
            const float* g = p.in[I_NORMG] + (nlayer * 2 + 0) * 1024;
#pragma unroll
            for (int i = 0; i < 16; i++) {
                const int c = lane + 64 * i;
                const float hv = v[i] * rinv * g[c] * (1.f + md[1024 + c]) + md[c];
                H[(size_t)r * D + c] = hv;
                wsp<bf16_t>(p, OFF_HB)[(size_t)r * D + c] = f2bf(hv);
            }
        }
    }
}

__device__ __forceinline__ void ph_streams(const Params& p) {
    const int TIDX = tid_opaque();
    const float* P1 = wsp<float>(p, OFF_P);
    float* XBC = wsp<float>(p, OFF_XBC);
    float* DT = wsp<float>(p, OFF_DT);
    float* F = wsp<float>(p, OFF_F);
    float* Q1 = wsp<float>(p, OFF_Q1);
    const float* cw = p.in[I_SSDCW];
    const float* cb = p.in[I_SSDCB];
    const float* lb = wsp<float>(p, OFF_LB);
    const size_t gsz = (size_t)gridDim.x * NT, g0 = (size_t)blockIdx.x * NT + TIDX;
    for (size_t it = g0; it < (size_t)R * 1024; it += gsz) {
        const int r = (int)(it >> 10), c = (int)(it & 1023);
        const int lo = r < L ? 0 : L, hi = r < L ? L : R;
        float a = cb[c];
#pragma unroll
        for (int j = 0; j < 3; j++) {
            const int rr = r + j - 1;
            if (rr >= lo && rr < hi) a = fmaf(cw[j * 1024 + c], P1[(size_t)rr * ODD_IN + c], a);
        }
        XBC[it] = silu_f(a);
        if (c < 512) {
            F[(size_t)r * 512 + c] = lb[c] + (1.f - lb[c]) * sigmoid_f(P1[(size_t)r * ODD_IN + 1040 + c]);
            F[(size_t)R * 512 + (size_t)r * 512 + c] = lb[c] + (1.f - lb[c]) * sigmoid_f(P1[(size_t)r * ODD_IN + 1040 + 512 + c]);
            Q1[(size_t)r * 512 + c] = silu_f(P1[(size_t)r * ODD_IN + 3088 + c]);
        }
        if (c < 16) {
            const int d = c >> 3, h = c & 7;
            DT[(size_t)d * R * 8 + (size_t)r * 8 + h] = softplus_f(P1[(size_t)r * ODD_IN + 1024 + c] + p.in[I_DTB][d * 8 + h]);
        }
    }
}
typedef short bf16x8_t __attribute__((ext_vector_type(8)));
typedef float f32x16 __attribute__((ext_vector_type(16)));
constexpr int LDP = 136;
template <int KSTEPS>
__device__ __forceinline__ f32x16 mma32(int lane, const bf16_t* As, int lda, const bf16_t* Bs, int ldb, f32x16 acc) {
    const int r = lane & 31, hh = lane >> 5;
    const bf16_t* ap = As + r * lda + 8 * hh;
    const bf16_t* bp = Bs + r * ldb + 8 * hh;
#pragma unroll 2
    for (int ks = 0; ks < KSTEPS; ks++) {
        const bf16x8_t a = *(const bf16x8_t*)(ap + ks * 16);
        const bf16x8_t b = *(const bf16x8_t*)(bp + ks * 16);
        acc = __builtin_amdgcn_mfma_f32_32x32x16_bf16(a, b, acc, 0, 0, 0);
    }
    return acc;
}
#define CROW(reg, hf) (((reg) & 3) + 8 * ((reg) >> 2) + 4 * (hf))
__device__ __forceinline__ float bf2f(unsigned short b) { return __uint_as_float(((unsigned)b) << 16); }

__device__ __forceinline__ float chunk_cumsum128(float a0, float a1, int lane, int d, float& c0, float& c1) {
    const float s = a0 + a1;
    float incl = s;
#pragma unroll
    for (int o = 1; o < 64; o <<= 1) { const float t = __shfl_up(incl, o); if (lane >= o) incl += t; }
    const float total = __shfl(incl, 63);
    c0 = incl - s + a0; c1 = incl;
    if (d == 1) { c0 = total - (c0 - a0); c1 = total - (c1 - a1); }
    return total;
}

__device__ __forceinline__ void ph_ssd_s1(const Params& p, unsigned char* smem) {
    const int TIDX = tid_opaque();
    bf16_t* Bt = (bf16_t*)smem;
    bf16_t* XW = Bt + 128 * LDP;
    float* csb = (float*)(XW + 64 * LDP);
    const float* XBC = wsp<float>(p, OFF_XBC);
    const float* DT = wsp<float>(p, OFF_DT);
    bf16_t* ST = wsp<bf16_t>(p, OFF_SST);
    float* DEC = wsp<float>(p, OFF_SDEC);
    const int tid = TIDX, lane = tid & 63, wave = tid >> 6;
    for (int it = blockIdx.x; it < 130 * 8; it += gridDim.x) {
        const int c = it >> 3, hh = it & 7, g = hh >> 2, r0 = c * 128;
        __syncthreads();
#pragma unroll 4
        for (int i = 0; i < 32; i++) { const int idx = tid + 512 * i, s = idx >> 7, n = idx & 127;
            Bt[n * LDP + s] = f2bf(XBC[(size_t)(r0 + s) * 1024 + 512 + g * 128 + n]); }
#pragma unroll 1
        for (int d = 0; d < 2; d++) {
            if (wave == 0) {
                const float a = -expf(p.in[I_ALOG][d * 8 + hh]);
                const float dt0 = DT[(size_t)d * R * 8 + (size_t)(r0 + 2 * lane) * 8 + hh], dt1 = DT[(size_t)d * R * 8 + (size_t)(r0 + 2 * lane + 1) * 8 + hh];
                float c0, c1;
                const float total = chunk_cumsum128(dt0 * a, dt1 * a, lane, d, c0, c1);
                csb[2 * lane] = expf(total - c0) * dt0;
                csb[2 * lane + 1] = expf(total - c1) * dt1;
                if (lane == 0) csb[128] = total;
            }
            __syncthreads();
#pragma unroll 4
            for (int i = 0; i < 16; i++) { const int idx = tid + 512 * i, s = idx >> 6, pp = idx & 63;
                XW[pp * LDP + s] = f2bf(XBC[(size_t)(r0 + s) * 1024 + hh * 64 + pp] * csb[s]); }
            __syncthreads();
            {
                const int mt = wave >> 2, nt = wave & 3, hf = lane >> 5;
                f32x16 acc;
#pragma unroll
                for (int q = 0; q < 16; q++) acc[q] = 0.f;
                acc = mma32<8>(lane, XW + mt * 32 * LDP, LDP, Bt + nt * 32 * LDP, LDP, acc);
                int rb = mt * 32 + 4 * hf;
                asm volatile("" : "+v"(rb));
                bf16_t* dst = ST + ((((size_t)d * 130 + c) * 8 + hh) * 64 + rb) * 128 + nt * 32 + (lane & 31);
#pragma unroll
                for (int q = 0; q < 16; q++) dst[((q & 3) + 8 * (q >> 2)) * 128] = f2bf(acc[q]);
                if (tid == 0) DEC[(d * 130 + c) * 8 + hh] = expf(csb[128]);
            }
            __syncthreads();
        }
    }
}
__device__ __forceinline__ void ph_ssd_s2(const Params& p) {
    const int TIDX = tid_opaque();
    const bf16_t* __restrict__ ST = wsp<bf16_t>(p, OFF_SST);
    bf16_t* __restrict__ SIN = wsp<bf16_t>(p, OFF_SSIN);
    const float* __restrict__ DEC = wsp<float>(p, OFF_SDEC);
    for (int it = blockIdx.x * NT + TIDX; it < 65536; it += gridDim.x * NT) {
        const int n2 = it & 63, pp = (it >> 6) & 63, hh = (it >> 12) & 7, d = it >> 15;
        float s0 = 0.f, s1 = 0.f;
#pragma unroll 8
        for (int step = 0; step < 130; step++) {
            const int c = d == 0 ? (step < 2 ? 128 + step : step - 2) : 129 - step;
            const size_t off = ((((size_t)d * 130 + c) * 8 + hh) * 64 + pp) * 128 + 2 * n2;
            const unsigned st = *(const unsigned*)(ST + off);
            const float dec = DEC[(d * 130 + c) * 8 + hh];
            *(unsigned*)(SIN + off) = pack_bf16(s0, s1);
            s0 = fmaf(s0, dec, bf2f((unsigned short)(st & 0xffff)));
            s1 = fmaf(s1, dec, bf2f((unsigned short)(st >> 16)));
        }
    }
}
__device__ __forceinline__ void ph_ssd_s3(const Params& p, unsigned char* smem) {
    const int TIDX = tid_opaque();
    bf16_t* Cm = (bf16_t*)smem;
    bf16_t* Bm = Cm + 128 * LDP;
    bf16_t* Wm = Bm + 128 * LDP;
    bf16_t* Xt = Wm + 128 * LDP;
    bf16_t* Sn = Xt + 64 * LDP;
    float* csb = (float*)(Sn + 64 * LDP);
    const float* XBC = wsp<float>(p, OFF_XBC);
    const float* DT = wsp<float>(p, OFF_DT);
    const bf16_t* SIN = wsp<bf16_t>(p, OFF_SSIN);
    float* Y = wsp<float>(p, OFF_Y);
    const int tid = TIDX, lane = tid & 63, wave = tid >> 6, hf = lane >> 5;
    for (int it = blockIdx.x; it < 256; it += gridDim.x) {
        const int c = it >> 1, g = it & 1, r0 = c * 128;
        __syncthreads();
#pragma unroll 4
        for (int i = 0; i < 32; i++) { const int idx = tid + 512 * i, s = idx >> 7, n = idx & 127;
            const float* xr = XBC + (size_t)(r0 + s) * 1024 + g * 128 + n;
            Bm[s * LDP + n] = f2bf(xr[512]); Cm[s * LDP + n] = f2bf(xr[768]); }
        __syncthreads();
        const int gmt = wave >> 1, gnt0 = (wave & 1) * 2;
        f32x16 G0, G1;
#pragma unroll
        for (int q = 0; q < 16; q++) { G0[q] = 0.f; G1[q] = 0.f; }
        G0 = mma32<8>(lane, Cm + gmt * 32 * LDP, LDP, Bm + gnt0 * 32 * LDP, LDP, G0);
        G1 = mma32<8>(lane, Cm + gmt * 32 * LDP, LDP, Bm + (gnt0 + 1) * 32 * LDP, LDP, G1);
#pragma unroll 1
        for (int h = 0; h < 4; h++) {
            const int hh = g * 4 + h;
            const int ymt = wave >> 1, ynt = wave & 1;
            f32x16 ytot;
#pragma unroll
            for (int q = 0; q < 16; q++) ytot[q] = 0.f;
#pragma unroll 1
            for (int d = 0; d < 2; d++) {
                __syncthreads();
                if (d == 0) {
#pragma unroll 4
                    for (int i = 0; i < 16; i++) { const int idx = tid + 512 * i, s = idx >> 6, pp = idx & 63;
                        Xt[pp * LDP + s] = f2bf(XBC[(size_t)(r0 + s) * 1024 + hh * 64 + pp]); }
                }
                {
                    const bf16_t* src = SIN + ((((size_t)d * 130 + c) * 8 + hh) * 64) * 128;
#pragma unroll
                    for (int i = 0; i < 2; i++) { const int v = tid + 512 * i, row = v >> 4, col8 = (v & 15) * 8;
                        *(pg8::u32x4*)(Sn + row * LDP + col8) = *(const pg8::u32x4*)(src + row * 128 + col8); }
                }
                if (wave == 0) {
                    const float a = -expf(p.in[I_ALOG][d * 8 + hh]);
                    const float dt0 = DT[(size_t)d * R * 8 + (size_t)(r0 + 2 * lane) * 8 + hh], dt1 = DT[(size_t)d * R * 8 + (size_t)(r0 + 2 * lane + 1) * 8 + hh];
                    float c0, c1;
                    chunk_cumsum128(dt0 * a, dt1 * a, lane, d, c0, c1);
                    csb[2 * lane] = c0; csb[2 * lane + 1] = c1;
                    csb[128 + 2 * lane] = dt0; csb[128 + 2 * lane + 1] = dt1;
                }
                __syncthreads();
#pragma unroll
                for (int t2 = 0; t2 < 2; t2++) {
                    const int s = (gnt0 + t2) * 32 + (lane & 31);
                    const float css = csb[s], dts = csb[128 + s];
#pragma unroll
                    for (int q = 0; q < 16; q++) {
                        const int l = gmt * 32 + CROW(q, hf);
                        const bool ok = d == 0 ? (s <= l) : (s >= l);
                        const float gv = t2 == 0 ? G0[q] : G1[q];
                        const float w = ok ? gv * __expf(csb[l] - css) * dts : 0.f;
                        Wm[l * LDP + s] = f2bf(w);
                    }
                }
                __syncthreads();
                f32x16 a2;
#pragma unroll
                for (int q = 0; q < 16; q++) a2[q] = 0.f;
                a2 = mma32<8>(lane, Cm + ymt * 32 * LDP, LDP, Sn + ynt * 32 * LDP, LDP, a2);
#pragma unroll
                for (int q = 0; q < 16; q++) ytot[q] += __expf(csb[ymt * 32 + CROW(q, hf)]) * a2[q];
                ytot = mma32<8>(lane, Wm + ymt * 32 * LDP, LDP, Xt + ynt * 32 * LDP, LDP, ytot);
            }
            const float Dsum = p.in[I_SSDD][hh] + p.in[I_SSDD][8 + hh];
            {
                int lbase = r0 + ymt * 32 + 4 * hf;
                asm volatile("" : "+v"(lbase));
                const int cbase = hh * 64 + ynt * 32 + (lane & 31);
                float* yb = Y + (size_t)lbase * 512 + cbase;
                const float* xb = XBC + (size_t)lbase * 1024 + cbase;
#pragma unroll
                for (int q = 0; q < 16; q++) {
                    const int lo = (q & 3) + 8 * (q >> 2);
                    yb[lo * 512] = ytot[q] + Dsum * xb[lo * 1024];
                }
            }
        }
    }
}

constexpr int LDQ = 72;
__device__ __forceinline__ void ph_hg_s1(const Params& p, unsigned char* smem) {
    const int TIDX = tid_opaque();
    bf16_t* KbT = (bf16_t*)smem;
    bf16_t* Vt = KbT + 2 * 128 * LDQ;
    const float* P1 = wsp<float>(p, OFF_P);
    const float* F = wsp<float>(p, OFF_F);
    bf16_t* ST = wsp<bf16_t>(p, OFF_HST);
    float* DEC = wsp<float>(p, OFF_HDEC);
    const int tid = TIDX, lane = tid & 63, wave = tid >> 6, hf = lane >> 5;
    for (int it = blockIdx.x; it < 260 * 4; it += gridDim.x) {
        const int c = it >> 2, h = it & 3, r0 = c * 64;
        __syncthreads();
        if (tid < 256) {
            const int d = tid >> 7, k = tid & 127;
            const float* fp = F + (size_t)d * R * 512 + (size_t)r0 * 512 + h * 128 + k;
            float total = 0.f;
#pragma unroll 8
            for (int i = 0; i < 64; i++) total += logf(fp[(size_t)i * 512]);
            float cum = 0.f;
            bf16_t* dst = KbT + (d * 128 + k) * LDQ;
#pragma unroll 8
            for (int i = 0; i < 64; i++) {
                const int row = d == 0 ? i : 63 - i;
                const float f = fp[(size_t)row * 512];
                cum += logf(f);
                dst[row] = f2bf((1.f - f) * __expf(total - cum));
            }
            DEC[(((size_t)d * 260 + c) * 4 + h) * 128 + k] = __expf(total);
        } else {
            const int t2 = tid - 256;
#pragma unroll 8
            for (int i = 0; i < 32; i++) { const int idx = t2 + 256 * i, s2 = idx >> 7, v = idx & 127;
                Vt[v * LDQ + s2] = f2bf(P1[(size_t)(r0 + s2) * ODD_IN + 2064 + h * 128 + v]); }
        }
        __syncthreads();
#pragma unroll 1
        for (int q4 = 0; q4 < 4; q4++) {
            const int tix = wave * 4 + q4, d = tix >> 4, vt = (tix >> 2) & 3, kt = tix & 3;
            f32x16 acc;
#pragma unroll
            for (int q = 0; q < 16; q++) acc[q] = 0.f;
            acc = mma32<4>(lane, Vt + vt * 32 * LDQ, LDQ, KbT + (d * 128 + kt * 32) * LDQ, LDQ, acc);
            int rb = vt * 32 + 4 * hf;
            asm volatile("" : "+v"(rb));
            bf16_t* dst = ST + ((((size_t)d * 260 + c) * 4 + h) * 128 + rb) * 128 + kt * 32 + (lane & 31);
#pragma unroll
            for (int q = 0; q < 16; q++) dst[((q & 3) + 8 * (q >> 2)) * 128] = f2bf(acc[q]);
        }
    }
}
__device__ __forceinline__ void ph_hg_s2(const Params& p) {
    const int TIDX = tid_opaque();
    const bf16_t* __restrict__ ST = wsp<bf16_t>(p, OFF_HST);
    bf16_t* __restrict__ SIN = wsp<bf16_t>(p, OFF_HSIN);
    const float* __restrict__ DEC = wsp<float>(p, OFF_HDEC);
    for (int it = blockIdx.x * NT + TIDX; it < 65536; it += gridDim.x * NT) {
        const int k2 = it & 63, v = (it >> 6) & 127, h = (it >> 13) & 3, d = it >> 15;
        float s0 = 0.f, s1 = 0.f;
#pragma unroll 8
        for (int step = 0; step < 260; step++) {
            const int c = d == 0 ? (step < 4 ? 256 + step : step - 4) : 259 - step;
            const size_t blk = ((size_t)d * 260 + c) * 4 + h;
            const size_t off = (blk * 128 + v) * 128 + 2 * k2;
            const unsigned st = *(const unsigned*)(ST + off);
            const float2 dec = *(const float2*)(DEC + blk * 128 + 2 * k2);
            *(unsigned*)(SIN + off) = pack_bf16(s0, s1);
            s0 = fmaf(s0, dec.x, bf2f((unsigned short)(st & 0xffff)));
            s1 = fmaf(s1, dec.y, bf2f((unsigned short)(st >> 16)));
        }
    }
}
__device__ __forceinline__ void ph_hg_s3(const Params& p, unsigned char* smem) {
    const int TIDX = tid_opaque();
    bf16_t* Qb = (bf16_t*)smem;
    bf16_t* Kh = Qb + 2 * 64 * LDP;
    bf16_t* Vt = Kh + 2 * 64 * LDP;
    bf16_t* Am = Vt + 128 * LDQ;
    bf16_t* Sn = Am + 64 * LDQ;
    const float* P1 = wsp<float>(p, OFF_P);
    const float* F = wsp<float>(p, OFF_F);
    const float* Q1 = wsp<float>(p, OFF_Q1);
    const bf16_t* SIN = wsp<bf16_t>(p, OFF_HSIN);
    float* O = wsp<float>(p, OFF_O);
    const int tid = TIDX, lane = tid & 63, wave = tid >> 6, hf = lane >> 5;
    for (int it = blockIdx.x; it < 256 * 4; it += gridDim.x) {
        const int c = it >> 2, h = it & 3, r0 = c * 64;
        __syncthreads();
        if (tid < 256) {
            const int d = tid >> 7, k = tid & 127;
            const float* fp = F + (size_t)d * R * 512 + (size_t)r0 * 512 + h * 128 + k;
            const float* qp = Q1 + (size_t)r0 * 512 + h * 128 + k;
            float cum = 0.f;
#pragma unroll 8
            for (int i = 0; i < 64; i++) {
                const int row = d == 0 ? i : 63 - i;
                const float f = fp[(size_t)row * 512];
                cum += logf(f);
                Qb[(d * 64 + row) * LDP + k] = f2bf(qp[(size_t)row * 512] * __expf(cum));
                Kh[(d * 64 + row) * LDP + k] = f2bf((1.f - f) * __expf(fminf(-cum, 80.f)));
            }
        } else {
            const int t2 = tid - 256;
#pragma unroll 8
            for (int i = 0; i < 32; i++) { const int idx = t2 + 256 * i, s2 = idx >> 7, v = idx & 127;
                Vt[v * LDQ + s2] = f2bf(P1[(size_t)(r0 + s2) * ODD_IN + 2064 + h * 128 + v]); }
        }
        const int omt = wave >> 2, ont = wave & 3;
        f32x16 otot;
#pragma unroll
        for (int q = 0; q < 16; q++) otot[q] = 0.f;
#pragma unroll 1
        for (int d = 0; d < 2; d++) {
            __syncthreads();
            {
                const bf16_t* src = SIN + ((((size_t)d * 260 + c) * 4 + h) * 128) * 128;
#pragma unroll
                for (int i = 0; i < 4; i++) { const int v = tid + 512 * i, row = v >> 4, col8 = (v & 15) * 8;
                    *(pg8::u32x4*)(Sn + row * LDP + col8) = *(const pg8::u32x4*)(src + row * 128 + col8); }
            }
            if (wave < 4) {
                const int amt = wave >> 1, ant = wave & 1;
                f32x16 a;
#pragma unroll
                for (int q = 0; q < 16; q++) a[q] = 0.f;
                a = mma32<8>(lane, Qb + (d * 64 + amt * 32) * LDP, LDP, Kh + (d * 64 + ant * 32) * LDP, LDP, a);
                const int s2 = ant * 32 + (lane & 31);
#pragma unroll
                for (int q = 0; q < 16; q++) {
                    const int t = amt * 32 + CROW(q, hf);
                    const bool ok = d == 0 ? (s2 <= t) : (s2 >= t);
                    Am[t * LDQ + s2] = f2bf(ok ? a[q] : 0.f);
                }
            }
            __syncthreads();
            otot = mma32<8>(lane, Qb + (d * 64 + omt * 32) * LDP, LDP, Sn + ont * 32 * LDP, LDP, otot);
            otot = mma32<4>(lane, Am + omt * 32 * LDQ, LDQ, Vt + ont * 32 * LDQ, LDQ, otot);
        }
        {
            int lbase = r0 + omt * 32 + 4 * hf;
            asm volatile("" : "+v"(lbase));
            float* ob = O + (size_t)lbase * 512 + h * 128 + ont * 32 + (lane & 31);
#pragma unroll
            for (int q = 0; q < 16; q++) ob[((q & 3) + 8 * (q >> 2)) * 512] = otot[q];
        }
    }
}

__device__ __forceinline__ void ph_merge(const Params& p) {
    const int TIDX = tid_opaque();
    const int lane = TIDX & 63, wave = TIDX >> 6;
    const float* P1 = wsp<float>(p, OFF_P);
    const float* Y = wsp<float>(p, OFF_Y);
    const float* O = wsp<float>(p, OFF_O);
    for (int r = blockIdx.x * NWAVE + wave; r < L; r += gridDim.x * NWAVE) {
        float ys[8], os[8];
        float sy0 = 0.f, sy1 = 0.f, so[4] = {0.f, 0.f, 0.f, 0.f};
#pragma unroll
        for (int i = 0; i < 8; i++) {
            const int c = lane + 64 * i;
            const float y = Y[(size_t)r * 512 + c];
            ys[i] = y * silu_f(P1[(size_t)r * ODD_IN + 2576 + c]);
            if (i < 4) sy0 = fmaf(ys[i], ys[i], sy0); else sy1 = fmaf(ys[i], ys[i], sy1);
            os[i] = O[(size_t)r * 512 + c];
            so[i >> 1] = fmaf(os[i], os[i], so[i >> 1]);
        }
        sy0 = rsqrtf(wave_sum(sy0) * (1.f / 256.f) + EPS);
        sy1 = rsqrtf(wave_sum(sy1) * (1.f / 256.f) + EPS);
#pragma unroll
        for (int k = 0; k < 4; k++) so[k] = rsqrtf(wave_sum(so[k]) * (1.f / 128.f) + EPS);
#pragma unroll
        for (int i = 0; i < 8; i++) {
            const int c = lane + 64 * i;
            const float mv0 = ys[i] * (i < 4 ? sy0 : sy1) * p.in[I_SSDN][c];
            const float mv1 = os[i] * so[i >> 1] * p.in[I_HGN][c] * silu_f(P1[(size_t)r * ODD_IN + 3600 + c]);
            wsp<bf16_t>(p, OFF_MB)[(size_t)r * D + c] = f2bf(mv0);
            wsp<bf16_t>(p, OFF_MB)[(size_t)r * D + 512 + c] = f2bf(mv1);
        }
    }
}

constexpr int N_PHASES = 22;
__global__ void __launch_bounds__(NT, 2) mega(KArgs ka) {
    extern __shared__ __attribute__((aligned(16))) unsigned char smem[];
    float* lds = (float*)smem;
    PG8_LAS unsigned char* glds = (PG8_LAS unsigned char*)smem;
    cg::grid_group grid = cg::this_grid();
    Params p;
    p.in = (const float* const*)(ka.ws + OFF_TAB); p.out = ka.out; p.ws = ka.ws;
    float* XA = wsp<float>(p, OFF_XA);
    float* XB = wsp<float>(p, OFF_XB);
    float* XC = wsp<float>(p, OFF_XC);
    float* H = wsp<float>(p, OFF_H);
    float* PP = wsp<float>(p, OFF_P);
    const int G = gridDim.x, bid = blockIdx.x;
#ifndef ONLY
#define ONLY -1
#endif
#ifndef PHMASK
#define PHMASK 0xFFFFFFFFull
#endif
#define IN(k) ((ONLY < 0 || ONLY == (k)) && ((PHMASK >> (k)) & 1ull))
#define SEAM(k) grid.sync()
    if (blockIdx.x == 0 && threadIdx.x == 0) {
#pragma unroll
        for (int i = 0; i < N_IN; i++) ((const float**)(ka.ws + OFF_TAB))[i] = ka.in[i];
    }
    if (IN(0)) { ph_prologue(ka, lds); __syncthreads(); ph_convert_weights(ka, lds);
    }
    SEAM(0);
    if (IN(1)) {
            prep_rows<false>(p, p.in[I_X], p.in[I_CTX], R, p.in[I_NORMG] + 0, 0, 0, H);
            ph_filter_gemm(p, lds);
    }
    SEAM(1);
    if (IN(2)) {
            { pg8::StaticOrder S; S.init(R, EVEN_IN, G, bid);
              pg8::gemm_phase(glds, pg8::Gemm{wsp<bf16_t>(p, OFF_HB), wsp<bf16_t>(p, OFF_WINE), D}, S, pg8::EpiStoreF32{PP, EVEN_IN, EVEN_IN}); }
            ph_filter_abs(p);
    }
    SEAM(2);
    if (IN(3)) { ph_qk_dwconv(p);
    }
    SEAM(3);
    if (IN(4)) { ph_attention(p, lds); ph_hyena_conv(p, 0);
    }
    SEAM(4);
    if (IN(5)) { ph_hyena_conv(p, 1);
    }
    SEAM(5);
    if (IN(6)) {
            { pg8::StaticOrder S; S.init(R, D, G, bid);
              pg8::gemm_phase(glds, pg8::Gemm{wsp<bf16_t>(p, OFF_MB), wsp<bf16_t>(p, OFF_WOUT), D}, S,
                              pg8::EpiResid{p.in[I_X], p.in[I_CTX], modp(p, 0, 0, 0) + 2048, modp(p, 0, 1, 0) + 2048, XA}); }
    }
    SEAM(6);
    if (IN(7)) { prep_rows<true>(p, XA, XA + (size_t)L * D, R, p.in[I_NORMG] + 1024, 0, 1, H);
    }
    SEAM(7);
    if (IN(8)) { ph_moe_scatter(p, lds, 0, R);
    }
    SEAM(8);
    if (IN(9)) { ph_moe_gemm1(p, glds, 0);
    }
    SEAM(9);
    if (IN(10)) { ph_moe_gemm2(p, glds, 0);
    }
    SEAM(10);
    if (IN(11)) { ph_moe_combine<true>(p, 0, R, XA, XB, 1);
    }
    SEAM(11);
    if (IN(12)) {
            { pg8::StaticOrder S; S.init(R, ODD_PAD, G, bid);
              pg8::gemm_phase(glds, pg8::Gemm{wsp<bf16_t>(p, OFF_HB), wsp<bf16_t>(p, OFF_WINO), D}, S, pg8::EpiStoreF32{PP, ODD_IN, ODD_IN}); }
    }
    SEAM(12);
    if (IN(13)) { ph_streams(p);
    }
    SEAM(13);
    if (IN(14)) { ph_ssd_s1(p, smem); ph_hg_s1(p, smem);
    }
    SEAM(14);
    if (IN(22)) { ph_ssd_s2(p); ph_hg_s2(p);
    }
    SEAM(22);
    if (IN(23)) { ph_ssd_s3(p, smem); ph_hg_s3(p, smem);
    }
    SEAM(23);
    if (IN(15)) { ph_merge(p);
    }
    SEAM(15);
    if (IN(16)) {
            { pg8::StaticOrder S; S.init(L, D, G, bid);
              pg8::gemm_phase(glds, pg8::Gemm{wsp<bf16_t>(p, OFF_MB), wsp<bf16_t>(p, OFF_WOUT) + (size_t)D * D, D}, S,
                              pg8::EpiResid{XB, XB, modp(p, 1, 0, 0) + 2048, modp(p, 1, 0, 0) + 2048, XC}); }
    }
    SEAM(16);
    if (IN(17)) { prep_rows<true>(p, XC, XC, L, p.in[I_NORMG] + 3 * 1024, 1, 1, H);
    }
    SEAM(17);
    if (IN(18)) { ph_moe_scatter(p, lds, 1, L);
    }
    SEAM(18);
    if (IN(19)) { ph_moe_gemm1(p, glds, 1);
    }
    SEAM(19);
    if (IN(20)) { ph_moe_gemm2(p, glds, 1);
    }
    SEAM(20);
    if (IN(21)) { ph_moe_combine<false>(p, 1, L, XC, p.out, 0);
    }
#undef IN
#undef SEAM
}

extern "C" void kernel_launch(void* const* d_in, const int* in_sizes, int n_in, void* d_out, int out_size, void* d_ws, size_t ws_size,
                              hipStream_t stream) {
    static int grid_blocks = 0;
    if (!grid_blocks) {
        int dev = 0, cus = 0, per_cu = 0;
        hipGetDevice(&dev);
        hipDeviceGetAttribute(&cus, hipDeviceAttributeMultiprocessorCount, dev);
        hipFuncSetAttribute((const void*)mega, hipFuncAttributeMaxDynamicSharedMemorySize, LDS_BYTES);
        hipOccupancyMaxActiveBlocksPerMultiprocessor(&per_cu, mega, NT, LDS_BYTES);
        if (per_cu < 1) per_cu = 1;
        grid_blocks = cus;
        if (ws_size < WS_END) fprintf(stderr, "kernel_launch: workspace too small: %zu < %zu\n", ws_size, (size_t)WS_END);
    }
    hipMemsetAsync((char*)d_ws + OFF_CTL, 0, 65536, stream);
    KArgs p{};
    for (int i = 0; i < N_IN; i++) p.in[i] = (const float*)d_in[i];
    p.out = (float*)d_out;
    p.ws = (unsigned char*)d_ws;
    void* args[] = {&p};
    hipError_t e = hipLaunchCooperativeKernel((void*)mega, dim3(grid_blocks), dim3(NT), args, LDS_BYTES, stream);
    if (e != hipSuccess) fprintf(stderr, "cooperative launch failed: %s (grid %d)\n", hipGetErrorString(e), grid_blocks);
}
```

```cpp
#include <hip/hip_runtime.h>
#include <hip/hip_cooperative_groups.h>
#include <cstdio>
#include <cstdint>
namespace cg = cooperative_groups;

constexpr int L = 16384, NCX = 256, R = L + NCX, D = 1024;
constexpr int EVEN_IN = 2304, ODD_IN = 4112;
constexpr int NT = 512, NWAVE = 8;
constexpr int NEXP = 32;
constexpr int NROWS = 74752;
constexpr int ODD_PAD = 4352;
constexpr int LDS_BYTES = 147456;
typedef unsigned short bf16_t;
constexpr float EPS = 1e-6f;

enum { I_X = 0, I_C, I_CTX, I_CCTX, I_NORMG, I_ADAW, I_ADAB, I_WOUT, I_WINE, I_HYCW, I_HYCB, I_HYW1, I_HYB1, I_HYW2, I_HYB2,
       I_HYW3, I_HYB3, I_HYW4, I_HYFREQ, I_HYFB, I_QNORM, I_KNORM, I_SINK, I_WINO, I_SSDCW, I_SSDCB, I_DTB, I_ALOG, I_SSDD,
       I_SSDN, I_HGLB, I_HGN, I_RW, I_RB, I_WGU, I_BGU, I_WDN, I_BDN, N_IN };

constexpr size_t al256(size_t x) { return (x + 255) & ~(size_t)255; }
constexpr size_t OFF_CTL = 0;
constexpr size_t OFF_TAB = 32768;
constexpr size_t OFF_MOD = 65536;
constexpr size_t OFF_LB = OFF_MOD + al256(4 * 24576);
constexpr size_t OFF_STARTS = OFF_LB + 4096;
constexpr size_t OFF_HNP = OFF_STARTS + 4096;
constexpr size_t OFF_HD3 = OFF_HNP + al256(4 * 130 * 1024);
constexpr size_t OFF_HH = OFF_HD3 + al256(4ull * R * 64);
constexpr size_t OFF_HHC = OFF_HH + al256(4ull * 2 * L * 1024);
constexpr size_t OFF_XA = OFF_HHC + al256(4ull * 512 * 1024);
constexpr size_t OFF_XB = OFF_XA + al256(4ull * R * D);
constexpr size_t OFF_XC = OFF_XA;
constexpr size_t OFF_H = OFF_XB + al256(4ull * R * D);
constexpr size_t OFF_P = OFF_H + al256(4ull * R * D);
constexpr size_t OFF_QN = OFF_P + al256(4ull * R * ODD_IN);
constexpr size_t OFF_KN = OFF_QN + al256(4ull * R * 512);
constexpr size_t OFF_U = OFF_KN + al256(4ull * R * 128);
constexpr size_t OFF_Z1 = OFF_U + al256(4ull * R * 1536);
constexpr size_t OFF_TOPE = OFF_Z1 + al256(4ull * R * 512);
constexpr size_t OFF_TOPG = OFF_TOPE + al256(4ull * R * 4);
constexpr size_t OFF_TOPP = OFF_TOPG + al256(4ull * R * 4);
constexpr size_t OFF_ROWTOK = OFF_TOPP + al256(4ull * R * 4);
constexpr size_t OFF_YR = OFF_ROWTOK + al256(4ull * 2 * NROWS);
constexpr size_t OFF_XBC = OFF_U;
constexpr size_t OFF_DT = OFF_YR + al256(4ull * NROWS * 1024);
constexpr size_t OFF_F = OFF_HH;
constexpr size_t OFF_Q1 = OFF_F + al256(4ull * 2 * R * 512);
constexpr size_t OFF_Y = OFF_DT + al256(4ull * 2 * R * 8);
constexpr size_t OFF_O = OFF_Y + al256(4ull * 2 * R * 512);
constexpr size_t OFF_TILEE = OFF_O + al256(4ull * 2 * R * 512);
constexpr size_t OFF_SDEC = OFF_TILEE + 4096;
constexpr size_t OFF_HDEC = OFF_SDEC + 16384;
constexpr size_t OFF_HB = OFF_HDEC + al256(4ull * 2 * 260 * 4 * 128);
constexpr size_t OFF_MB = OFF_HB + al256(2ull * R * D);
constexpr size_t OFF_XG = OFF_MB + al256(2ull * R * D);
constexpr size_t OFF_ACTB = OFF_XG + al256(2ull * NROWS * D);
constexpr size_t OFF_SST = OFF_XG;
constexpr size_t OFF_SSIN = OFF_SST + al256(2ull * 2 * 130 * 8 * 64 * 128);
constexpr size_t OFF_HST = OFF_SSIN + al256(2ull * 2 * 130 * 8 * 64 * 128);
constexpr size_t OFF_HSIN = OFF_ACTB;
constexpr size_t OFF_HT = OFF_ACTB;
constexpr size_t OFF_HF = OFF_XG;
constexpr size_t OFF_UC = OFF_U + 4ull * 1536 * L;
constexpr size_t OFF_HYT = OFF_Z1;
constexpr size_t OFF_WINE = OFF_ACTB + al256(2ull * NROWS * D);
constexpr size_t OFF_WINO = OFF_WINE + al256(2ull * EVEN_IN * D);
constexpr size_t OFF_WOUT = OFF_WINO + al256(2ull * ODD_PAD * D);
constexpr size_t OFF_WGU = OFF_WOUT + al256(2ull * 2 * D * D);
constexpr size_t OFF_WDN = OFF_WGU + al256(2ull * 2 * 32 * 2048 * D);
constexpr size_t WS_END = OFF_WDN + al256(2ull * 2 * 32 * 1024 * D);

struct KArgs {
    const float* in[N_IN];
    float* out;
    unsigned char* ws;
};
struct Params {
    const float* const* in;
    float* out;
    unsigned char* ws;
};

__device__ __forceinline__ int tid_opaque() { int t = threadIdx.x; asm volatile("" : "+v"(t)); return t; }
__device__ __forceinline__ float silu_f(float x) { return x / (1.f + expf(-x)); }
__device__ __forceinline__ float sigmoid_f(float x) { return 1.f / (1.f + expf(-x)); }
__device__ __forceinline__ float softplus_f(float x) { return x > 20.f ? x : log1pf(expf(x)); }
__device__ __forceinline__ float wave_sum(float v) {
#pragma unroll
    for (int o = 32; o; o >>= 1) v += __shfl_xor(v, o);
    return v;
}
__device__ __forceinline__ float wave_max(float v) {
#pragma unroll
    for (int o = 32; o; o >>= 1) v = fmaxf(v, __shfl_xor(v, o));
    return v;
}
template <class T, class PT> __device__ __forceinline__ T* wsp(const PT& p, size_t off) { return (T*)(p.ws + off); }
__device__ __forceinline__ const float* modp(const Params& p, int layer, int cond, int j) {
    return wsp<float>(p, OFF_MOD) + (layer * 2 + cond) * 6144 + j * 3072;
}

__device__ __forceinline__ bf16_t f2bf(float f) { unsigned u = __float_as_uint(f); u += 0x7FFFu + ((u >> 16) & 1u); return (bf16_t)(u >> 16); }
__device__ __forceinline__ unsigned pack_bf16(float lo, float hi) { return (unsigned)f2bf(lo) | ((unsigned)f2bf(hi) << 16); }

namespace pg8 {
#define PG8_LAS __attribute__((address_space(3)))
typedef short bf16x8 __attribute__((ext_vector_type(8)));
typedef float f32x4 __attribute__((ext_vector_type(4)));
typedef unsigned u32x4 __attribute__((ext_vector_type(4)));
constexpr int BM = 256, BK = 64, HALF = 128, HTB = HALF * BK * 2, STAGE_BYTES = 8 * HTB, NXCD = 8, WGM = 8;
__device__ __forceinline__ int lds_byte(int r, int c) { const int st = (r >> 4) * 2 + (c >> 5), rr = r & 15, cc = c & 31, ob = rr * 64 + cc * 2; return st * 1024 + (ob ^ (((ob >> 9) & 1) << 5)); }
__device__ __forceinline__ void stage_rc(int b, int& Rr, int& C) { const int st = b / 1024, sb = b % 1024, swz = sb ^ (((sb >> 9) & 1) << 5); Rr = (st >> 1) * 16 + swz / 64; C = (st & 1) * 32 + (swz % 64) / 2; }
__device__ __forceinline__ int perm32(int rho) { const int n = rho >> 4, i = rho & 15; return 8 * (i >> 2) + 4 * n + (i & 3); }
struct Unit { int pm, pn, pb, e; };
struct Gemm { const bf16_t* A; const bf16_t* Bt; int K; };
struct StaticOrder {
    int nM, nN, nwg, G, c;
    __device__ void init(int M, int N, int G_, int c_) { nM = M / BM; nN = N / BM; nwg = nM * nN; G = G_; c = c_; }
    __device__ bool next(int i, Unit& u) const {
        const long Lx = (long)i * G + c; if (Lx >= nwg) return false;
        int wgid = (int)Lx; { const int q = nwg / NXCD, r = nwg % NXCD, xcd = wgid % NXCD, off = wgid / NXCD; wgid = (xcd < r ? xcd * (q + 1) : r * (q + 1) + (xcd - r) * q) + off; }
        const int nig = WGM * nN, gid = wgid / nig, fm = gid * WGM, gsz = (nM - fm) < WGM ? (nM - fm) : WGM;
        u.pm = fm + ((wgid % nig) % gsz); u.pn = (wgid % nig) / gsz; u.pb = u.pn; u.e = 0; return true;
    }
};
struct MoeOrder {
    const int* tile_e; int ntile, nN, G, c;
    __device__ bool next(int i, Unit& u) const {
        const long Lx = (long)i * G + c; if (Lx >= (long)ntile * nN) return false;
        u.pm = (int)(Lx / nN); u.pn = (int)(Lx % nN); u.e = tile_e[u.pm]; u.pb = u.e * nN + u.pn; return true;
    }
};
struct EpiStoreF32 {
    static constexpr bool PERM = false;
    float* C; int ldc; int nvalid;
    __device__ __forceinline__ void operator()(const f32x4 (&acc)[2][2][4][2], const Unit& u, int wr, int wc, int fr, int fq) const {
        const int row0 = u.pm * BM + wr * 64 + fr, col0 = u.pn * BM + wc * 32 + 4 * fq;
#pragma unroll
        for (int ai = 0; ai < 2; ++ai)
#pragma unroll
            for (int m = 0; m < 4; ++m) { float* rowp = C + (size_t)(row0 + ai * HALF + m * 16) * ldc + col0;
#pragma unroll
                for (int bj = 0; bj < 2; ++bj)
#pragma unroll
                    for (int n = 0; n < 2; ++n) if (col0 + bj * HALF + n * 16 < nvalid) *(f32x4*)(rowp + bj * HALF + n * 16) = acc[ai][bj][m][n]; }
    }
};
struct EpiResid {
    static constexpr bool PERM = false;
    const float* res_lat; const float* res_ctx; const float* gt_lat; const float* gt_ctx; float* out;
    __device__ __forceinline__ void operator()(const f32x4 (&acc)[2][2][4][2], const Unit& u, int wr, int wc, int fr, int fq) const {
        const int row0 = u.pm * BM + wr * 64 + fr, col0 = u.pn * BM + wc * 32 + 4 * fq;
        const bool ctx = (u.pm * BM) >= L;
        const float* gt = ctx ? gt_ctx : gt_lat;
        f32x4 gv[2][2];
#pragma unroll
        for (int bj = 0; bj < 2; ++bj)
#pragma unroll
            for (int n = 0; n < 2; ++n) gv[bj][n] = *(const f32x4*)(gt + col0 + bj * HALF + n * 16);
#pragma unroll
        for (int ai = 0; ai < 2; ++ai)
#pragma unroll
            for (int m = 0; m < 4; ++m) { const int row = row0 + ai * HALF + m * 16;
                const float* rp = (ctx ? res_ctx + (size_t)(row - L) * D : res_lat + (size_t)row * D) + col0;
                float* op = out + (size_t)row * D + col0;
#pragma unroll
                for (int bj = 0; bj < 2; ++bj)
#pragma unroll
                    for (int n = 0; n < 2; ++n) *(f32x4*)(op + bj * HALF + n * 16) = *(const f32x4*)(rp + bj * HALF + n * 16) + gv[bj][n] * acc[ai][bj][m][n]; }
    }
};
struct EpiMoe1 {
    static constexpr bool PERM = true;
    bf16_t* ACT; const float* bgu;
    __device__ __forceinline__ void operator()(const f32x4 (&acc)[2][2][4][2], const Unit& u, int wr, int wc, int fr, int fq) const {
        const int row0 = u.pm * BM + wr * 64 + fr, col0 = u.pn * HALF + wc * 32 + 8 * fq;
        const float* bg = bgu + (size_t)u.e * 2048 + col0;
        f32x4 bgv[2], buv[2];
#pragma unroll
        for (int n = 0; n < 2; ++n) { bgv[n] = *(const f32x4*)(bg + 4 * n); buv[n] = *(const f32x4*)(bg + 1024 + 4 * n); }
#pragma unroll
        for (int ai = 0; ai < 2; ++ai)
#pragma unroll
            for (int m = 0; m < 4; ++m) {
                float a[8];
#pragma unroll
                for (int n = 0; n < 2; ++n) { const f32x4 g4 = acc[ai][0][m][n] + bgv[n], u4 = acc[ai][1][m][n] + buv[n];
#pragma unroll
                    for (int j = 0; j < 4; ++j) { const float gate = fminf(g4[j], 7.f), up = fminf(fmaxf(u4[j], -7.f), 7.f);
                        a[n * 4 + j] = (up + 1.f) * gate / (1.f + __expf(-1.702f * gate)); } }
                u32x4 w; w.x = pack_bf16(a[0], a[1]); w.y = pack_bf16(a[2], a[3]); w.z = pack_bf16(a[4], a[5]); w.w = pack_bf16(a[6], a[7]);
                *(u32x4*)(ACT + (size_t)(row0 + ai * HALF + m * 16) * 1024 + col0) = w; }
    }
};
struct EpiMoe2 {
    static constexpr bool PERM = false;
    float* YR; const float* bdn;
    __device__ __forceinline__ void operator()(const f32x4 (&acc)[2][2][4][2], const Unit& u, int wr, int wc, int fr, int fq) const {
        const int row0 = u.pm * BM + wr * 64 + fr, col0 = u.pn * BM + wc * 32 + 4 * fq;
        const float* bd = bdn + (size_t)u.e * 1024 + col0;
        f32x4 bv[2][2];
#pragma unroll
        for (int bj = 0; bj < 2; ++bj)
#pragma unroll
            for (int n = 0; n < 2; ++n) bv[bj][n] = *(const f32x4*)(bd + bj * HALF + n * 16);
#pragma unroll
        for (int ai = 0; ai < 2; ++ai)
#pragma unroll
            for (int m = 0; m < 4; ++m) { float* rowp = YR + (size_t)(row0 + ai * HALF + m * 16) * 1024 + col0;
#pragma unroll
                for (int bj = 0; bj < 2; ++bj)
#pragma unroll
                    for (int n = 0; n < 2; ++n) *(f32x4*)(rowp + bj * HALF + n * 16) = acc[ai][bj][m][n] + bv[bj][n]; }
    }
};
template <class Epi, class Sched>
__device__ __forceinline__ void gemm_phase(PG8_LAS unsigned char* lds, const Gemm g, const Sched& S, const Epi& E) {
    const int TIDX = tid_opaque();
    const int tid = TIDX, wid = __builtin_amdgcn_readfirstlane(tid >> 6), lane = tid & 63, wr = wid >> 2, wc = wid & 3, fr = lane & 15, fq = lane >> 4;
    const int K = g.K, nt = K / BK;
    unsigned voffA[2], voffB[2];
#pragma unroll
    for (int i = 0; i < 2; ++i) { int Rr, C; stage_rc(tid * 16 + i * 8192, Rr, C); const int Rb = Epi::PERM ? ((Rr & ~31) + perm32(Rr & 31)) : Rr;
        voffA[i] = (unsigned)(Rr * K + C) * 2u; voffB[i] = (unsigned)(Rb * K + C) * 2u; }
    const size_t kstep = (size_t)(BK * 2);
    const size_t hstep = (size_t)HALF * K * 2;
    const size_t tstep = 2 * hstep;
    const unsigned ldsw = (unsigned)wid * 1024u;
    const int aoff = lds_byte(wr * 64 + fr, fq * 8), boff = lds_byte(wc * 32 + fr, fq * 8);
#define PG8_SA(b, h) (((b) * 2 + (h)) * HTB)
#define PG8_SB(b, h) ((4 + (b) * 2 + (h)) * HTB)
#define PG8_STAGE(bufoff, gbase, voff) do { _Pragma("unroll") for (int _i = 0; _i < 2; ++_i) \
        __builtin_amdgcn_global_load_lds((const unsigned*)((const char*)(gbase) + (voff)[_i]), (PG8_LAS unsigned*)(lds + (bufoff) + ldsw + _i * 8192), 16, 0, 0); } while (0)
#define PG8_LDA(dst, b, h) do { _Pragma("unroll") for (int m = 0; m < 4; ++m) _Pragma("unroll") for (int k = 0; k < 2; ++k) dst[m][k] = *(const PG8_LAS bf16x8*)(lds + PG8_SA(b, h) + aoff + m * 2048 + k * 1024); } while (0)
#define PG8_LDB(dst, b, h) do { _Pragma("unroll") for (int n = 0; n < 2; ++n) _Pragma("unroll") for (int k = 0; k < 2; ++k) dst[n][k] = *(const PG8_LAS bf16x8*)(lds + PG8_SB(b, h) + boff + n * 2048 + k * 1024); } while (0)
#define PG8_MMA(ai, bj, At, Bt) do { __builtin_amdgcn_s_setprio(1); _Pragma("unroll") for (int m = 0; m < 4; ++m) _Pragma("unroll") for (int n = 0; n < 2; ++n) _Pragma("unroll") for (int k = 0; k < 2; ++k) \
        acc[ai][bj][m][n] = __builtin_amdgcn_mfma_f32_16x16x32_bf16(Bt[n][k], At[m][k], acc[ai][bj][m][n], 0, 0, 0); __builtin_amdgcn_s_setprio(0); } while (0)
#define PG8_WAIT_V(n) asm volatile("s_waitcnt vmcnt(" #n ")" ::: "memory")
#define PG8_WAIT_L(n) asm volatile("s_waitcnt lgkmcnt(" #n ")" ::: "memory")
#define PG8_BAR __builtin_amdgcn_s_barrier()
#define PG8_SCHED __builtin_amdgcn_sched_barrier(0)
    Unit cur, nxt; int ui = 0;
    if (!S.next(0, cur)) return;
    f32x4 acc[2][2][4][2];
#pragma unroll
    for (int a = 0; a < 2; ++a)
#pragma unroll
        for (int b = 0; b < 2; ++b)
#pragma unroll
            for (int m = 0; m < 4; ++m)
#pragma unroll
                for (int n = 0; n < 2; ++n) acc[a][b][m][n] = (f32x4){0.f, 0.f, 0.f, 0.f};
    bf16x8 At[4][2], B0[2][2], B1[2][2];
    const char* cA = (const char*)g.A + (size_t)cur.pm * tstep; const char* cB = (const char*)g.Bt + (size_t)cur.pb * tstep;
    PG8_STAGE(PG8_SB(0, 0), cB, voffB); PG8_STAGE(PG8_SA(0, 0), cA, voffA); PG8_STAGE(PG8_SB(0, 1), cB + hstep, voffB); PG8_STAGE(PG8_SA(0, 1), cA + hstep, voffA);
    if (wr == 1) PG8_BAR;
    PG8_WAIT_V(4); PG8_BAR;
    PG8_STAGE(PG8_SB(1, 0), cB + kstep, voffB); PG8_STAGE(PG8_SA(1, 0), cA + kstep, voffA); PG8_STAGE(PG8_SB(1, 1), cB + hstep + kstep, voffB);
    PG8_WAIT_V(6); PG8_BAR;
    for (;;) {
        const bool has_next = S.next(ui + 1, nxt);
        const char* nA = has_next ? (const char*)g.A + (size_t)nxt.pm * tstep : cA; const char* nB = has_next ? (const char*)g.Bt + (size_t)nxt.pb * tstep : cB;
        for (int t = 0; t < nt; t += 2) {
            const bool last = (t == nt - 2);
            const char* a1 = cA + (size_t)(t + 1) * kstep;
            const char* a2 = last ? nA : cA + (size_t)(t + 2) * kstep; const char* b2 = last ? nB : cB + (size_t)(t + 2) * kstep;
            const char* a3 = a2 + kstep; const char* b3 = b2 + kstep;
            PG8_LDB(B0, 0, 0); PG8_SCHED; PG8_LDA(At, 0, 0); PG8_STAGE(PG8_SA(1, 1), a1 + hstep, voffA);
            PG8_WAIT_L(8); PG8_BAR; PG8_WAIT_L(0); PG8_MMA(0, 0, At, B0); PG8_BAR; PG8_SCHED;
            PG8_LDB(B1, 0, 1); PG8_STAGE(PG8_SB(0, 0), b2, voffB);
            PG8_BAR; PG8_WAIT_L(0); PG8_MMA(0, 1, At, B1); PG8_BAR;
            PG8_LDA(At, 0, 1); PG8_STAGE(PG8_SA(0, 0), a2, voffA);
            PG8_BAR; PG8_WAIT_L(0); PG8_MMA(1, 0, At, B0); PG8_BAR; PG8_SCHED;
            PG8_STAGE(PG8_SB(0, 1), b2 + hstep, voffB);
            PG8_WAIT_V(6); PG8_BAR; PG8_MMA(1, 1, At, B1); PG8_BAR;
            PG8_LDB(B0, 1, 0); PG8_SCHED; PG8_LDA(At, 1, 0); PG8_STAGE(PG8_SA(0, 1), a2 + hstep, voffA);
            PG8_WAIT_L(8); PG8_BAR; PG8_WAIT_L(0); PG8_MMA(0, 0, At, B0); PG8_BAR; PG8_SCHED;
            PG8_LDB(B1, 1, 1); PG8_STAGE(PG8_SB(1, 0), b3, voffB);
            PG8_BAR; PG8_WAIT_L(0); PG8_MMA(0, 1, At, B1); PG8_BAR;
            PG8_LDA(At, 1, 1); PG8_STAGE(PG8_SA(1, 0), a3, voffA);
            PG8_BAR; PG8_WAIT_L(0); PG8_MMA(1, 0, At, B0); PG8_BAR; PG8_SCHED;
            PG8_STAGE(PG8_SB(1, 1), b3 + hstep, voffB);
            PG8_WAIT_V(6); PG8_BAR; PG8_MMA(1, 1, At, B1); PG8_BAR;
        }
        E(acc, cur, wr, wc, fr, fq);
        if (!has_next) break;
#pragma unroll
        for (int a = 0; a < 2; ++a)
#pragma unroll
            for (int b = 0; b < 2; ++b)
#pragma unroll
                for (int m = 0; m < 4; ++m)
#pragma unroll
                    for (int n = 0; n < 2; ++n) acc[a][b][m][n] = (f32x4){0.f, 0.f, 0.f, 0.f};
        cur = nxt; cA = nA; cB = nB; ++ui;
    }
    PG8_WAIT_V(0);
    if (wr == 0) PG8_BAR;
    PG8_BAR;
#undef PG8_SA
#undef PG8_SB
#undef PG8_STAGE
#undef PG8_LDA
#undef PG8_LDB
#undef PG8_MMA
#undef PG8_WAIT_V
#undef PG8_WAIT_L
#undef PG8_BAR
#undef PG8_SCHED
}
}

__device__ __forceinline__ void convert_tile(float* lds, const float* src, int N, int k0, int n0, bf16_t* dstrow0) {
    const int TIDX = tid_opaque();
    const int t = TIDX;
#pragma unroll
    for (int i = 0; i < 4; i++) {
        const int kr = (t >> 5) + 16 * i, c4 = (t & 31) * 4;
        float4 v = make_float4(0.f, 0.f, 0.f, 0.f);
        if (n0 + c4 < N) v = *(const float4*)(src + (size_t)(k0 + kr) * N + n0 + c4);
        float* d = lds + kr * 129 + c4;
        d[0] = v.x; d[1] = v.y; d[2] = v.z; d[3] = v.w;
    }
    __syncthreads();
#pragma unroll
    for (int j = 0; j < 2; j++) {
        const int n = (t >> 3) + 64 * j, k8 = (t & 7) * 8;
        float a[8];
#pragma unroll
        for (int q = 0; q < 8; q++) a[q] = lds[(k8 + q) * 129 + n];
        pg8::u32x4 w; w.x = pack_bf16(a[0], a[1]); w.y = pack_bf16(a[2], a[3]); w.z = pack_bf16(a[4], a[5]); w.w = pack_bf16(a[6], a[7]);
        *(pg8::u32x4*)(dstrow0 + (size_t)n * 1024 + k0 + k8) = w;
    }
    __syncthreads();
}
template <class PT>
__device__ __forceinline__ void ph_convert_weights(const PT& p, float* lds) {
    const int TIDX = tid_opaque();
    constexpr int T_INE = 16 * 18, T_INO = 16 * 34, T_OUT = 2 * 16 * 8, T_GU = 2 * 32 * 16 * 16, T_DN = 2 * 32 * 16 * 8;
    constexpr int TOT = T_INE + T_INO + T_OUT + T_GU + T_DN;
    for (int it = blockIdx.x; it < TOT; it += gridDim.x) {
        int q = it;
        if (q < T_INE) { const int kt = q / 18, nt = q % 18; convert_tile(lds, p.in[I_WINE], EVEN_IN, kt * 64, nt * 128, wsp<bf16_t>(p, OFF_WINE) + (size_t)nt * 128 * 1024); continue; }
        q -= T_INE;
        if (q < T_INO) { const int kt = q / 34, nt = q % 34; convert_tile(lds, p.in[I_WINO], ODD_IN, kt * 64, nt * 128, wsp<bf16_t>(p, OFF_WINO) + (size_t)nt * 128 * 1024); continue; }
        q -= T_INO;
        if (q < T_OUT) { const int l = q / 128, kt = (q % 128) / 8, nt = q % 8;
            convert_tile(lds, p.in[I_WOUT] + (size_t)l * D * D, D, kt * 64, nt * 128, wsp<bf16_t>(p, OFF_WOUT) + ((size_t)l * 1024 + nt * 128) * 1024); continue; }
        q -= T_OUT;
        if (q < T_GU) { const int le = q / 256, kt = (q % 256) / 16, nt = q % 16;
            const int drow = nt < 8 ? 256 * nt : 256 * (nt - 8) + 128;
            convert_tile(lds, p.in[I_WGU] + (size_t)le * 1024 * 2048, 2048, kt * 64, nt * 128, wsp<bf16_t>(p, OFF_WGU) + ((size_t)le * 2048 + drow) * 1024); continue; }
        q -= T_GU;
        { const int le = q / 128, kt = (q % 128) / 8, nt = q % 8;
            convert_tile(lds, p.in[I_WDN] + (size_t)le * 1024 * 1024, 1024, kt * 64, nt * 128, wsp<bf16_t>(p, OFF_WDN) + ((size_t)le * 1024 + nt * 128) * 1024); }
    }
}

template <class AL, class BL, class EP>
__device__ __forceinline__ void gemm_tile_f32(float* lds, int K, AL aload, BL bload, EP epi) {
    const int TIDX = tid_opaque();
    float(*As)[132] = (float(*)[132])lds;
    float(*Bs)[132] = (float(*)[132])(lds + 16 * 132);
    const int tid = TIDX, tx = tid & 15, ty = tid >> 4;
    float acc[4][8];
#pragma unroll
    for (int i = 0; i < 4; i++)
#pragma unroll
        for (int j = 0; j < 8; j++) acc[i][j] = 0.f;
    for (int k0 = 0; k0 < K; k0 += 16) {
        float av[4], bv[4];
#pragma unroll
        for (int i = 0; i < 4; i++) av[i] = aload((tid >> 4) + 32 * i, k0 + (tid & 15));
#pragma unroll
        for (int i = 0; i < 4; i++) bv[i] = bload(k0 + (tid >> 7) + 4 * i, tid & 127);
        __syncthreads();
#pragma unroll
        for (int i = 0; i < 4; i++) As[tid & 15][(tid >> 4) + 32 * i] = av[i];
#pragma unroll
        for (int i = 0; i < 4; i++) Bs[(tid >> 7) + 4 * i][tid & 127] = bv[i];
        __syncthreads();
#pragma unroll
        for (int k = 0; k < 16; k++) {
            const float4 a = *(const float4*)&As[k][ty * 4];
            const float4 b0 = *(const float4*)&Bs[k][tx * 4];
            const float4 b1 = *(const float4*)&Bs[k][64 + tx * 4];
            const float aa[4] = {a.x, a.y, a.z, a.w};
            const float bb[8] = {b0.x, b0.y, b0.z, b0.w, b1.x, b1.y, b1.z, b1.w};
#pragma unroll
            for (int i = 0; i < 4; i++)
#pragma unroll
                for (int j = 0; j < 8; j++) acc[i][j] = fmaf(aa[i], bb[j], acc[i][j]);
        }
    }
    __syncthreads();
#pragma unroll
    for (int i = 0; i < 4; i++) epi(ty * 4 + i, tx, acc[i]);
}
__device__ __forceinline__ int lcol(int tx, int jc) { return tx * 4 + (jc & 3) + 64 * (jc >> 2); }

template <class EP>
__device__ __forceinline__ void gemm_dense(float* lds, const float* A, int lda, const float* B, int N, int M, int K, EP epi) {
    const int tm = M / 128, tn = (N + 127) / 128;
    for (int t = blockIdx.x; t < tm * tn; t += gridDim.x) {
        const int m0 = (t / tn) * 128, n0 = (t % tn) * 128;
        gemm_tile_f32(
            lds, K, [&](int r, int k) { return A[(size_t)(m0 + r) * lda + k]; },
            [&](int k, int c) { return (n0 + c < N) ? B[(size_t)k * N + n0 + c] : 0.f; },
            [&](int r, int tx, const float(&a)[8]) {
#pragma unroll
                for (int jc = 0; jc < 8; jc++) {
                    const int c = n0 + lcol(tx, jc);
                    if (c < N) epi(m0 + r, c, a[jc]);
                }
            });
    }
}

template <class PT>
__device__ __forceinline__ void ph_prologue(const PT& p, float* lds) {
    const int TIDX = tid_opaque();
    const int tid = TIDX, lane = tid & 63, wave = tid >> 6;
    const int gthreads = gridDim.x * NT, gtid = blockIdx.x * NT + tid;
    float* mod = wsp<float>(p, OFF_MOD);
    for (int it = gtid; it < 2 * 6144; it += gthreads) {
        const int layer = it / 6144, n = it % 6144;
        const float* w = p.in[I_ADAW] + (size_t)layer * 1024 * 6144 + n;
        float a0 = 0.f, a1 = 0.f;
#pragma unroll 8
        for (int k = 0; k < 1024; k++) {
            const float wv = w[(size_t)k * 6144];
            a0 = fmaf(silu_f(p.in[I_C][k]), wv, a0);
            a1 = fmaf(silu_f(p.in[I_CCTX][k]), wv, a1);
        }
        const float b = p.in[I_ADAB][layer * 6144 + n];
        mod[(layer * 2 + 0) * 6144 + n] = a0 + b;
        mod[(layer * 2 + 1) * 6144 + n] = a1 + b;
    }
    for (int it = gtid; it < 512; it += gthreads) {
        const float b0 = p.in[I_HGLB][it], b1 = p.in[I_HGLB][512 + it];
        wsp<float>(p, OFF_LB)[it] = 1.f / (1.f + expf(b0 - b1));
    }
    float* zb = lds + wave * 64;
    float* hd3 = wsp<float>(p, OFF_HD3);
    const float fq = p.in[I_HYFREQ][lane];
    float w1r[33], w2r[64], w3r[64];
#pragma unroll
    for (int i = 0; i < 33; i++) w1r[i] = p.in[I_HYW1][i * 64 + lane];
#pragma unroll
    for (int i = 0; i < 64; i++) { w2r[i] = p.in[I_HYW2][i * 64 + lane]; w3r[i] = p.in[I_HYW3][i * 64 + lane]; }
    const float b1 = p.in[I_HYB1][lane], b2 = p.in[I_HYB2][lane], b3 = p.in[I_HYB3][lane];
    for (int row = blockIdx.x * NWAVE + wave; row < R; row += gridDim.x * NWAVE) {
        const int Ls = row < L ? L : NCX, t = row < L ? row : row - L;
        const float tn = (float)t / (float)(Ls - 1);
        const float wang = 6.283185307179586f * (float)t / (float)Ls;
        if (lane < 33) {
            float z;
            if (lane == 0) z = tn;
            else {
                const int b = (lane - 1) & 15;
                const float fr = 1e-4f + (float)b * ((15.f - 1e-4f) / 15.f);
                z = (lane <= 16) ? cosf(fr * wang) : -sinf(fr * wang);
            }
            zb[lane] = z;
        }
        __builtin_amdgcn_wave_barrier();
        float a = b1;
#pragma unroll
        for (int i = 0; i < 33; i++) a = fmaf(zb[i], w1r[i], a);
        float h = sinf(fq * a);
        __builtin_amdgcn_wave_barrier();
        zb[lane] = h;
        __builtin_amdgcn_wave_barrier();
        a = b2;
#pragma unroll
        for (int i = 0; i < 64; i++) a = fmaf(zb[i], w2r[i], a);
        h = sinf(fq * a);
        __builtin_amdgcn_wave_barrier();
        zb[lane] = h;
        __builtin_amdgcn_wave_barrier();
        a = b3;
#pragma unroll
        for (int i = 0; i < 64; i++) a = fmaf(zb[i], w3r[i], a);
        h = sinf(fq * a);
        hd3[(size_t)row * 64 + lane] = h;
        __builtin_amdgcn_wave_barrier();
    }
}

template <bool ROUTER>
__device__ __forceinline__ void prep_rows(const Params& p, const float* xl, const float* xc, int nrows, const float* g, int layer, int j, float* hout) {
    const int TIDX = tid_opaque();
    const int lane = TIDX & 63, wave = TIDX >> 6;
    for (int r = blockIdx.x * NWAVE + wave; r < nrows; r += gridDim.x * NWAVE) {
        const float* src = r < L ? xl + (size_t)r * D : xc + (size_t)(r - L) * D;
        const float* md = modp(p, layer, r < L ? 0 : 1, j);
        float v[16];
        float ss = 0.f;
#pragma unroll
        for (int i = 0; i < 16; i++) { v[i] = src[lane + 64 * i]; ss = fmaf(v[i], v[i], ss); }
        ss = wave_sum(ss);
        const float rinv = rsqrtf(ss * (1.f / 1024.f) + EPS);
#pragma unroll
        for (int i = 0; i < 16; i++) {
            const int c = lane + 64 * i;
            v[i] = v[i] * rinv * g[c] * (1.f + md[1024 + c]) + md[c];
            hout[(size_t)r * D + c] = v[i];
            wsp<bf16_t>(p, OFF_HB)[(size_t)r * D + c] = f2bf(v[i]);
        }
        if (ROUTER) {
            const float* rw = p.in[I_RW] + (size_t)layer * 1024 * 32;
            float lg[32];
#pragma unroll
            for (int e = 0; e < 32; e++) lg[e] = 0.f;
#pragma unroll 1
            for (int i = 0; i < 16; i++) {
                const float* wr = rw + (size_t)(lane + 64 * i) * 32;
                const float hv = hout[(size_t)r * D + lane + 64 * i];
#pragma unroll
                for (int e4 = 0; e4 < 8; e4++) {
                    const float4 w4 = *(const float4*)(wr + e4 * 4);
                    lg[e4 * 4 + 0] = fmaf(hv, w4.x, lg[e4 * 4 + 0]);
                    lg[e4 * 4 + 1] = fmaf(hv, w4.y, lg[e4 * 4 + 1]);
                    lg[e4 * 4 + 2] = fmaf(hv, w4.z, lg[e4 * 4 + 2]);
                    lg[e4 * 4 + 3] = fmaf(hv, w4.w, lg[e4 * 4 + 3]);
                }
            }
#pragma unroll
            for (int e = 0; e < 32; e++) lg[e] = wave_sum(lg[e]) + p.in[I_RB][layer * 32 + e];
            unsigned used = 0u;
            float tv[4];
            int ti[4];
#pragma unroll
            for (int k = 0; k < 4; k++) {
                float best = -INFINITY;
                int bi = 0;
#pragma unroll
                for (int e = 0; e < 32; e++) {
                    const bool ok = !((used >> e) & 1u) && (lg[e] > best);
                    best = ok ? lg[e] : best;
                    bi = ok ? e : bi;
                }
                used |= 1u << bi;
                tv[k] = best;
                ti[k] = bi;
            }
            float es[4], den = 0.f;
#pragma unroll
            for (int k = 0; k < 4; k++) { es[k] = expf(tv[k] - tv[0]); den += es[k]; }
            if (lane < 4) {
                int e = ti[0];
                float gg = es[0];
#pragma unroll
                for (int k = 1; k < 4; k++) { e = (lane == k) ? ti[k] : e; gg = (lane == k) ? es[k] : gg; }
                int* cnt = wsp<int>(p, OFF_CTL) + layer * 32;
                const int pos = atomicAdd(&cnt[e], 1);
                wsp<int>(p, OFF_TOPE)[r * 4 + lane] = e;
                wsp<float>(p, OFF_TOPG)[r * 4 + lane] = gg / den;
                wsp<int>(p, OFF_TOPP)[r * 4 + lane] = pos;
            }
        }
    }
}

__device__ __forceinline__ void ph_filter_gemm_ctx(const Params& p, float* lds) {
    const float* hd3 = wsp<float>(p, OFF_HD3) + (size_t)L * 64;
    float* hhc = wsp<float>(p, OFF_HHC);
    const float mind = logf(1e-2f) / 1.5f, maxd = logf(1e-2f) / 0.3f;
    gemm_dense(lds, hd3, 64, p.in[I_HYW4], 2048, NCX, 64, [&](int t, int col, float v) {
        const int o = col >> 10, side = (col >> 9) & 1, ch = col & 511;
        const float delta = fabsf(mind + (float)ch * ((maxd - mind) / 511.f));
        const float tn = (float)t / (float)(NCX - 1);
        const float val = v * expf(-tn * delta);
        if (side == 0) hhc[(size_t)(NCX + t) * 1024 + o * 512 + ch] = val;
        else if (t > 0) hhc[(size_t)(NCX - t) * 1024 + o * 512 + ch] = val;
        else hhc[o * 512 + ch] = 0.f;
    });
}
__device__ __forceinline__ void ph_filter_abs_ctx(const Params& p) {
    const int TIDX = tid_opaque();
    const float* hhc = wsp<float>(p, OFF_HHC);
    float* hnp = wsp<float>(p, OFF_HNP);
    for (int it = blockIdx.x; it < 4; it += gridDim.x) {
        const int chunk = it >> 1, col = (it & 1) * 512 + TIDX;
        const float* src = hhc + (size_t)chunk * 256 * 1024;
        float s = 0.f;
        for (int i = 0; i < 256; i++) s += fabsf(src[(size_t)i * 1024 + col]);
        hnp[(128 + chunk) * 1024 + col] = s;
    }
}
typedef float f32x16f __attribute__((ext_vector_type(16)));
__device__ __forceinline__ void ph_filter_gemm_lat(const Params& p, unsigned char* smem) {
    const int TIDX = tid_opaque();
    float* As = (float*)smem;
    float* Bs = As + 64 * 132;
    const float* hd3 = wsp<float>(p, OFF_HD3);
    const float* w4 = p.in[I_HYW4];
    float* HT = wsp<float>(p, OFF_HT);
    const float mind = logf(1e-2f) / 1.5f, maxd = logf(1e-2f) / 0.3f;
    const int tid = TIDX, lane = tid & 63, wave = tid >> 6, hf = lane >> 5;
    for (int it = blockIdx.x; it < 16 * 128; it += gridDim.x) {
        const int c0 = (it & 15) * 128, t0 = (it >> 4) * 128;
        __syncthreads();
#pragma unroll 4
        for (int q = 0; q < 16; q++) { const int idx = tid + 512 * q, k = idx >> 7, i = idx & 127; As[k * 132 + i] = w4[(size_t)k * 2048 + c0 + i]; }
#pragma unroll 4
        for (int q = 0; q < 16; q++) { const int idx = tid + 512 * q, j = idx >> 6, k = idx & 63; Bs[k * 132 + j] = hd3[(size_t)(t0 + j) * 64 + k]; }
        __syncthreads();
        const int mt = wave >> 1, nt0 = (wave & 1) * 2;
        f32x16f acc0, acc1;
#pragma unroll
        for (int q = 0; q < 16; q++) { acc0[q] = 0.f; acc1[q] = 0.f; }
        const float* ap = As + hf * 132 + mt * 32 + (lane & 31);
        const float* bp = Bs + hf * 132 + nt0 * 32 + (lane & 31);
#pragma unroll 4
        for (int k0 = 0; k0 < 64; k0 += 2) {
            const float a = ap[k0 * 132], b0 = bp[k0 * 132], b1 = bp[k0 * 132 + 32];
            acc0 = __builtin_amdgcn_mfma_f32_32x32x2f32(a, b0, acc0, 0, 0, 0);
            acc1 = __builtin_amdgcn_mfma_f32_32x32x2f32(a, b1, acc1, 0, 0, 0);
        }
#pragma unroll
        for (int t2 = 0; t2 < 2; t2++) {
            const int t = t0 + (nt0 + t2) * 32 + (lane & 31);
            const float tn = (float)t / (float)(L - 1);
            int cb = c0 + mt * 32 + 4 * hf;
            asm volatile("" : "+v"(cb));
#pragma unroll
            for (int q = 0; q < 16; q++) {
                const int col = cb + (q & 3) + 8 * (q >> 2), ch = col & 511;
                const float delta = fabsf(mind + (float)ch * ((maxd - mind) / 511.f));
                HT[(size_t)col * L + t] = (t2 == 0 ? acc0[q] : acc1[q]) * expf(-tn * delta);
            }
        }
    }
}

__device__ __forceinline__ float2 cmul(float2 a, float2 b) { return make_float2(a.x * b.x - a.y * b.y, a.x * b.y + a.y * b.x); }
__device__ __forceinline__ float2 cadd(float2 a, float2 b) { return make_float2(a.x + b.x, a.y + b.y); }
__device__ __forceinline__ float2 csub(float2 a, float2 b) { return make_float2(a.x - b.x, a.y - b.y); }
__device__ __forceinline__ float2 cconj(float2 a) { return make_float2(a.x, -a.y); }
__device__ __forceinline__ float2 twid(float frac) { return make_float2(__builtin_amdgcn_cosf(frac), -__builtin_amdgcn_sinf(frac)); }
constexpr int FM = 16384;
__device__ __forceinline__ void fft16k(float2* X, int tid) {
#pragma unroll 1
    for (int lp = 0; lp < 14; lp += 2) {
        const int pp = 1 << lp;
        float2 u[8][4];
#pragma unroll
        for (int b = 0; b < 8; b++)
#pragma unroll
            for (int r = 0; r < 4; r++) u[b][r] = X[tid + 512 * b + 4096 * r];
        __syncthreads();
#pragma unroll
        for (int b = 0; b < 8; b++) {
            const int i = tid + 512 * b, k = i & (pp - 1), j = ((i - k) << 2) + k;
            const float2 w1 = twid(ldexpf((float)k, -(lp + 2)));
            const float2 w2 = cmul(w1, w1), w3 = cmul(w2, w1);
            const float2 u0 = u[b][0], u1 = cmul(u[b][1], w1), u2 = cmul(u[b][2], w2), u3 = cmul(u[b][3], w3);
            const float2 v0 = cadd(u0, u2), v1 = csub(u0, u2), v2 = cadd(u1, u3), tt = csub(u1, u3), v3 = make_float2(tt.y, -tt.x);
            X[j] = cadd(v0, v2); X[j + pp] = cadd(v1, v3); X[j + 2 * pp] = csub(v0, v2); X[j + 3 * pp] = csub(v1, v3);
        }
        __syncthreads();
    }
}
__device__ __forceinline__ void ph_filter_fft(const Params& p, unsigned char* smem) {
    const int TIDX = tid_opaque();
    float2* X = (float2*)smem;
    float* red = (float*)(smem + 131072);
    const float* HT = wsp<float>(p, OFF_HT);
    float2* HF = wsp<float2>(p, OFF_HF);
    const int tid = TIDX, lane = tid & 63, wave = tid >> 6;
    constexpr int N2 = 2 * L;
    for (int it = blockIdx.x; it < 1024; it += gridDim.x) {
        const int o = it >> 9, ch = it & 511;
        const float* s0 = HT + ((size_t)(o * 2 + 0) * 512 + ch) * L;
        const float* s1 = HT + ((size_t)(o * 2 + 1) * 512 + ch) * L;
        __syncthreads();
        float sa = 0.f;
#pragma unroll 4
        for (int j = 0; j < 32; j++) {
            const int m = tid + 512 * j;
            float2 v;
            if (m < L / 2) { v = *(const float2*)(s0 + 2 * m); }
            else if (m == L / 2) { v = make_float2(0.f, s1[L - 1]); }
            else { v = make_float2(s1[N2 - 2 * m], s1[N2 - 2 * m - 1]); }
            sa += fabsf(v.x) + fabsf(v.y);
            X[m] = v;
        }
        sa = wave_sum(sa);
        if (lane == 0) red[wave] = sa;
        __syncthreads();
        float nrm = 0.f;
#pragma unroll
        for (int w = 0; w < 8; w++) nrm += red[w];
        const float scale = 1.f / (nrm * (float)FM);
        fft16k(X, tid);
        float2* dst = HF + (size_t)it * FM;
#pragma unroll 1
        for (int k = tid; k <= FM / 2; k += 512) {
            if (k == 0) { const float2 b0 = X[0]; dst[0] = make_float2((b0.x + b0.y) * scale, (b0.x - b0.y) * scale); }
            else if (k == FM / 2) { const float2 b = X[k]; dst[k] = make_float2(b.x * scale, -b.y * scale); }
            else {
                const float2 ak = X[k], am = cconj(X[FM - k]);
                const float2 e = make_float2(0.5f * (ak.x + am.x), 0.5f * (ak.y + am.y));
                const float2 od = make_float2(0.5f * (ak.x - am.x), 0.5f * (ak.y - am.y));
                const float2 oo = make_float2(od.y, -od.x);
                const float2 wo = cmul(twid(ldexpf((float)k, -15)), oo);
                const float2 hk = cadd(e, wo), hm = cconj(csub(e, wo));
                dst[k] = make_float2(hk.x * scale, hk.y * scale);
                dst[FM - k] = make_float2(hm.x * scale, hm.y * scale);
            }
        }
    }
}
__device__ __forceinline__ void hy_pointwise(float2* X, const float2* __restrict__ HFc, int tid) {
#pragma unroll 1
    for (int k = tid; k <= FM / 2; k += 512) {
        if (k == 0) {
            const float2 a0 = X[0], h = HFc[0];
            const float y0 = (a0.x + a0.y) * h.x, ym = (a0.x - a0.y) * h.y;
            X[0] = make_float2(0.5f * (y0 + ym), -0.5f * (y0 - ym));
        } else if (k == FM / 2) {
            X[k] = cmul(cconj(X[k]), HFc[k]);
        } else {
            const float2 ak = X[k], am = cconj(X[FM - k]);
            const float2 hk = HFc[k], hm = HFc[FM - k];
            const float2 e = make_float2(0.5f * (ak.x + am.x), 0.5f * (ak.y + am.y));
            const float2 od = make_float2(0.5f * (ak.x - am.x), 0.5f * (ak.y - am.y));
            const float2 oo = make_float2(od.y, -od.x);
            const float2 w = twid(ldexpf((float)k, -15));
            const float2 wo = cmul(w, oo);
            const float2 yk = cmul(cadd(e, wo), hk), ym = cmul(cconj(csub(e, wo)), hm);
            const float2 ymc = cconj(ym);
            const float2 P = make_float2(0.5f * (yk.x + ymc.x), 0.5f * (yk.y + ymc.y));
            const float2 Q = make_float2(0.5f * (yk.x - ymc.x), 0.5f * (yk.y - ymc.y));
            const float2 qw = cmul(Q, cconj(w));
            const float2 ck = make_float2(P.x - qw.y, P.y + qw.x);
            const float2 qcw = cmul(cconj(Q), w);
            const float2 cm = make_float2(P.x - qcw.y, -P.y + qcw.x);
            X[k] = cconj(ck); X[FM - k] = cconj(cm);
        }
    }
}
__device__ __forceinline__ void ph_hyena_fft(const Params& p, unsigned char* smem) {
    const int TIDX = tid_opaque();
    float2* X = (float2*)smem;
    const float* UT = wsp<float>(p, OFF_U);
    const float2* HF = wsp<float2>(p, OFF_HF);
    unsigned* HYT = wsp<unsigned>(p, OFF_HYT);
    const int tid = TIDX;
    for (int ch = blockIdx.x; ch < 512; ch += gridDim.x) {
        float2 z[16];
#pragma unroll
        for (int j = 0; j < 16; j++) z[j] = ((const float2*)(UT + (size_t)ch * L))[tid + 512 * j];
#pragma unroll 1
        for (int o = 0; o < 2; o++) {
            __syncthreads();
#pragma unroll
            for (int j = 0; j < 16; j++) { X[tid + 512 * j] = z[j]; X[8192 + tid + 512 * j] = make_float2(0.f, 0.f); }
            __syncthreads();
            fft16k(X, tid);
            hy_pointwise(X, HF + (size_t)(o * 512 + ch) * FM, tid);
            __syncthreads();
            fft16k(X, tid);
            const float bias = p.in[I_HYFB][o * 512 + ch];
            const float2* gate = (const float2*)(UT + (size_t)(512 * (o + 1) + ch) * L);
#pragma unroll
            for (int j = 0; j < 16; j++) {
                const int m = tid + 512 * j;
                const float2 r = X[m], g = gate[m];
                z[j] = make_float2(g.x * (r.x + z[j].x * bias), g.y * (-r.y + z[j].y * bias));
            }
        }
#pragma unroll
        for (int j = 0; j < 16; j++) HYT[(size_t)ch * (L / 2) + tid + 512 * j] = pack_bf16(z[j].x, z[j].y);
    }
}
__device__ __forceinline__ void ph_hy_transpose(const Params& p, unsigned char* smem) {
    const int TIDX = tid_opaque();
    bf16_t* T = (bf16_t*)smem;
    const bf16_t* HYT = wsp<bf16_t>(p, OFF_HYT);
    bf16_t* MB = wsp<bf16_t>(p, OFF_MB);
    const int tid = TIDX;
    for (int it = blockIdx.x; it < 8 * 256; it += gridDim.x) {
        const int c0 = (it & 7) * 64, t0 = (it >> 3) * 64;
        __syncthreads();
#pragma unroll
        for (int q = 0; q < 8; q++) { const int c = (tid >> 6) + 8 * q, t = tid & 63; T[c * 66 + t] = HYT[(size_t)(c0 + c) * L + t0 + t]; }
        __syncthreads();
#pragma unroll
        for (int q = 0; q < 8; q++) { const int t = (tid >> 6) + 8 * q, c = tid & 63; MB[(size_t)(t0 + t) * D + c0 + c] = T[c * 66 + t]; }
    }
}

__device__ __forceinline__ void ph_qk_dwconv(const Params& p) {
    const int TIDX = tid_opaque();
    const int lane = TIDX & 63, wave = TIDX >> 6;
    const float* P0 = wsp<float>(p, OFF_P);
    float* qn = wsp<float>(p, OFF_QN);
    float* kn = wsp<float>(p, OFF_KN);
    for (int it = blockIdx.x * NWAVE + wave; it < R * 10; it += gridDim.x * NWAVE) {
        const int r = it / 10, s = it % 10;
        const int off = s < 2 ? s * 64 : 256 + (s - 2) * 64;
        const float v = P0[(size_t)r * EVEN_IN + off + lane];
        const float ss = wave_sum(v * v);
        const float gain = s < 2 ? p.in[I_KNORM][lane] : p.in[I_QNORM][lane];
        float n = v * rsqrtf(ss * (1.f / 64.f) + EPS) * gain;
        if (r < L) {
            const float partner = __shfl_xor(n, 16);
            const int pos = lane < 32 ? (r >> 6) : (r & 63);
            const int i = lane & 15;
            const float inv = powf(10000.f, -(float)i / 16.f);
            const float ang = (float)pos * inv;
            const float cs = cosf(ang), sn = sinf(ang);
            n = ((lane & 16) == 0) ? n * cs - partner * sn : partner * sn + n * cs;
        }
        if (s < 2) kn[(size_t)r * 128 + s * 64 + lane] = n;
        else qn[(size_t)r * 512 + (s - 2) * 64 + lane] = n;
    }
    float* UC = wsp<float>(p, OFF_UC);
    const float* cw = p.in[I_HYCW];
    const float* cb = p.in[I_HYCB];
    for (int it = blockIdx.x * NT + TIDX; it < NCX * 1536; it += gridDim.x * NT) {
        const int r = L + it / 1536, c = it % 1536;
        float a = cb[c];
#pragma unroll
        for (int j = 0; j < 3; j++) {
            const int rr = r + j - 1;
            if (rr >= L && rr < R) a = fmaf(cw[j * 1536 + c], P0[(size_t)rr * EVEN_IN + 768 + c], a);
        }
        UC[it] = a;
    }
}
__device__ __forceinline__ void ph_dwconv_t(const Params& p, float* lds) {
    const int TIDX = tid_opaque();
    const float* P0 = wsp<float>(p, OFF_P);
    float* UT = wsp<float>(p, OFF_U);
    const float* cw = p.in[I_HYCW];
    const float* cb = p.in[I_HYCB];
    const int tid = TIDX;
    for (int it = blockIdx.x; it < 24 * 256; it += gridDim.x) {
        const int c0 = (it % 24) * 64, t0 = (it / 24) * 64;
        __syncthreads();
        {
            const int c = tid & 63, tr = tid >> 6;
            const float w0 = cw[c0 + c], w1 = cw[1536 + c0 + c], w2 = cw[3072 + c0 + c], bb = cb[c0 + c];
#pragma unroll
            for (int q = 0; q < 8; q++) {
                const int t = t0 + tr + 8 * q;
                const float* pp = P0 + (size_t)t * EVEN_IN + 768 + c0 + c;
                float a = fmaf(w1, pp[0], bb);
                if (t > 0) a = fmaf(w0, pp[-EVEN_IN], a);
                if (t < L - 1) a = fmaf(w2, pp[EVEN_IN], a);
                lds[c * 65 + tr + 8 * q] = a;
            }
        }
        __syncthreads();
        {
            const int t = tid & 63, cr = tid >> 6;
#pragma unroll
            for (int q = 0; q < 8; q++) { const int c = cr + 8 * q; UT[(size_t)(c0 + c) * L + t0 + t] = lds[c * 65 + t]; }
        }
    }
}

__device__ __forceinline__ void ph_attention(const Params& p, float* lds) {
    const int TIDX = tid_opaque();
    const int lane = TIDX & 63, wave = TIDX >> 6;
    const float* P0 = wsp<float>(p, OFF_P);
    const float* qn = wsp<float>(p, OFF_QN);
    const float* kn = wsp<float>(p, OFF_KN);
    float* sc = lds + wave * 576;
    for (int it = blockIdx.x * NWAVE + wave; it < R * 8; it += gridDim.x * NWAVE) {
        const int r = it >> 3, hq = it & 7, kvh = hq >> 2;
        int lo = 0, nloc = 0;
        if (r < L) { lo = max(0, r - 128); nloc = min(L - 1, r + 128) - lo + 1; }
        const int ntot = nloc + NCX;
        float q[64];
#pragma unroll
        for (int d4 = 0; d4 < 16; d4++) {
            const float4 t = *(const float4*)(qn + (size_t)r * 512 + hq * 64 + d4 * 4);
            q[d4 * 4] = t.x; q[d4 * 4 + 1] = t.y; q[d4 * 4 + 2] = t.z; q[d4 * 4 + 3] = t.w;
        }
        float mx = -INFINITY;
        for (int j = lane; j < ntot; j += 64) {
            const int krow = j < nloc ? lo + j : L + (j - nloc);
            const float* kp = kn + (size_t)krow * 128 + kvh * 64;
            float dot = 0.f;
#pragma unroll
            for (int d4 = 0; d4 < 16; d4++) {
                const float4 t = *(const float4*)(kp + d4 * 4);
                dot = fmaf(q[d4 * 4], t.x, dot); dot = fmaf(q[d4 * 4 + 1], t.y, dot);
                dot = fmaf(q[d4 * 4 + 2], t.z, dot); dot = fmaf(q[d4 * 4 + 3], t.w, dot);
            }
            dot *= 0.125f;
            sc[j] = dot;
            mx = fmaxf(mx, dot);
        }
        const float sink = p.in[I_SINK][hq];
        mx = fmaxf(wave_max(mx), sink);
        float sum = 0.f;
        for (int j = lane; j < ntot; j += 64) { const float e = expf(sc[j] - mx); sc[j] = e; sum += e; }
        sum = wave_sum(sum) + expf(sink - mx);
        const float rs = 1.f / sum;
        __builtin_amdgcn_wave_barrier();
        float o = 0.f;
        for (int j = 0; j < ntot; j++) {
            const int krow = j < nloc ? lo + j : L + (j - nloc);
            o = fmaf(sc[j], P0[(size_t)krow * EVEN_IN + 128 + kvh * 64 + lane], o);
        }
        wsp<bf16_t>(p, OFF_MB)[(size_t)r * D + 512 + hq * 64 + lane] = f2bf(o * rs);
        __builtin_amdgcn_wave_barrier();
    }
}

__device__ __forceinline__ void ph_hyena_conv(const Params& p, int o) {
    const int TIDX = tid_opaque();
    const int lane = TIDX & 63, wave = TIDX >> 6;
    const float* U = wsp<float>(p, OFF_UC) - (size_t)L * 1536;
    const float* hnp = wsp<float>(p, OFF_HNP);
    float* Z1 = wsp<float>(p, OFF_Z1);
    const float* zin = o == 0 ? U : Z1;
    const int zld = o == 0 ? 1536 : 512;
    const int nlat = 8 * (L / 64), nctx = 8 * (NCX / 64);
    for (int it = nlat + blockIdx.x; it < nlat + nctx; it += gridDim.x) {
        const bool lat = it < nlat;
        const int ii = lat ? it : it - nlat;
        const int Ls = lat ? L : NCX, base = lat ? 0 : L;
        const int ch = (ii & 7) * 64 + lane, t0 = (ii >> 3) * 64 + wave * 8;
        const float* hf = (lat ? wsp<float>(p, OFF_HH) : wsp<float>(p, OFF_HHC)) + o * 512 + ch;
        float nrm = 0.f;
        if (lat) { for (int c = 0; c < 128; c++) nrm += hnp[c * 1024 + o * 512 + ch]; }
        else { nrm = hnp[128 * 1024 + o * 512 + ch] + hnp[129 * 1024 + o * 512 + ch]; }
        float acc[8];
#pragma unroll
        for (int i = 0; i < 8; i++) acc[i] = 0.f;
        for (int s0 = 0; s0 < Ls; s0 += 8) {
            float zv[8], hv[15];
#pragma unroll
            for (int j = 0; j < 8; j++) zv[j] = zin[(size_t)(base + s0 + j) * zld + ch];
#pragma unroll
            for (int e = 0; e < 15; e++) hv[e] = hf[(size_t)(t0 - s0 + e - 7 + Ls) * 1024];
#pragma unroll
            for (int i = 0; i < 8; i++)
#pragma unroll
                for (int j = 0; j < 8; j++) acc[i] = fmaf(hv[i - j + 7], zv[j], acc[i]);
        }
        const float inv = 1.f / nrm;
        const float bias = p.in[I_HYFB][o * 512 + ch];
#pragma unroll
        for (int i = 0; i < 8; i++) {
            const int r = base + t0 + i;
            const float zc = acc[i] * inv;
            const float z = zin[(size_t)r * zld + ch];
            const float gate = U[(size_t)r * 1536 + 512 * (o + 1) + ch];
            const float res = gate * (zc + z * bias);
            if (o == 0) Z1[(size_t)r * 512 + ch] = res;
            else wsp<bf16_t>(p, OFF_MB)[(size_t)r * D + ch] = f2bf(res);
        }
    }
}

__device__ __forceinline__ void ph_moe_scatter(const Params& p, float* lds, int layer, int ntok) {
    const int TIDX = tid_opaque();
    int* sst = (int*)lds;
    const int* cnt = wsp<int>(p, OFF_CTL) + layer * 32;
    int* tile_e = wsp<int>(p, OFF_TILEE) + layer * 512;
    __syncthreads();
    if (TIDX == 0) {
        int a = 0;
        for (int e = 0; e < 32; e++) {
            sst[e] = a;
            const int nt = (cnt[e] + 255) / 256;
            if (blockIdx.x == 0) for (int q = 0; q < nt; q++) tile_e[a / 256 + q] = e;
            a += nt * 256;
        }
        sst[32] = a;
    }
    __syncthreads();
    if (blockIdx.x == 0 && TIDX < 33) wsp<int>(p, OFF_STARTS)[layer * 64 + TIDX] = sst[TIDX];
    const int* te = wsp<int>(p, OFF_TOPE);
    const int* tp = wsp<int>(p, OFF_TOPP);
    const bf16_t* HB = wsp<bf16_t>(p, OFF_HB);
    bf16_t* XG = wsp<bf16_t>(p, OFF_XG);
    const int lane = TIDX & 63, wave = TIDX >> 6;
    for (int it = blockIdx.x * NWAVE + wave; it < ntok * 4; it += gridDim.x * NWAVE) {
        const int row = sst[te[it]] + tp[it];
        const pg8::u32x4* src = (const pg8::u32x4*)(HB + (size_t)(it >> 2) * D);
        pg8::u32x4* dst = (pg8::u32x4*)(XG + (size_t)row * D);
        dst[lane] = src[lane];
        dst[lane + 64] = src[lane + 64];
    }
    __syncthreads();
}
__device__ __forceinline__ void ph_moe_gemm1(const Params& p, PG8_LAS unsigned char* lds, int layer) {
    const int total = wsp<int>(p, OFF_STARTS)[layer * 64 + 32];
    pg8::MoeOrder S{wsp<int>(p, OFF_TILEE) + layer * 512, total / 256, 8, (int)gridDim.x, (int)blockIdx.x};
    pg8::Gemm g{wsp<bf16_t>(p, OFF_XG), wsp<bf16_t>(p, OFF_WGU) + (size_t)layer * 32 * 2048 * 1024, 1024};
    pg8::EpiMoe1 E{wsp<bf16_t>(p, OFF_ACTB), p.in[I_BGU] + (size_t)layer * 32 * 2048};
    pg8::gemm_phase(lds, g, S, E);
}
__device__ __forceinline__ void ph_moe_gemm2(const Params& p, PG8_LAS unsigned char* lds, int layer) {
    const int total = wsp<int>(p, OFF_STARTS)[layer * 64 + 32];
    pg8::MoeOrder S{wsp<int>(p, OFF_TILEE) + layer * 512, total / 256, 4, (int)gridDim.x, (int)blockIdx.x};
    pg8::Gemm g{wsp<bf16_t>(p, OFF_ACTB), wsp<bf16_t>(p, OFF_WDN) + (size_t)layer * 32 * 1024 * 1024, 1024};
    pg8::EpiMoe2 E{wsp<float>(p, OFF_YR), p.in[I_BDN] + (size_t)layer * 32 * 1024};
    pg8::gemm_phase(lds, g, S, E);
}
template <bool NEXTPREP>
__device__ __forceinline__ void ph_moe_combine(const Params& p, int layer, int nrows, const float* xi, float* xo, int nlayer) {
    const int TIDX = tid_opaque();
    const int lane = TIDX & 63, wave = TIDX >> 6;
    const int* starts = wsp<int>(p, OFF_STARTS) + layer * 64;
    const int* te = wsp<int>(p, OFF_TOPE);
    const int* tp = wsp<int>(p, OFF_TOPP);
    const float* tg = wsp<float>(p, OFF_TOPG);
    const float* YR = wsp<float>(p, OFF_YR);
    float* H = wsp<float>(p, OFF_H);
    for (int r = blockIdx.x * NWAVE + wave; r < nrows; r += gridDim.x * NWAVE) {
        const float* gt = modp(p, layer, r < L ? 0 : 1, 1) + 2048;
        float v[16];
#pragma unroll
        for (int i = 0; i < 16; i++) v[i] = 0.f;
#pragma unroll
        for (int k = 0; k < 4; k++) {
            const int row = starts[te[r * 4 + k]] + tp[r * 4 + k];
            const float g = tg[r * 4 + k];
#pragma unroll
            for (int i = 0; i < 16; i++) v[i] = fmaf(g, YR[(size_t)row * 1024 + lane + 64 * i], v[i]);
        }
        float ss = 0.f;
#pragma unroll
        for (int i = 0; i < 16; i++) {
            const int c = lane + 64 * i;
            v[i] = xi[(size_t)r * D + c] + gt[c] * v[i];
            xo[(size_t)r * D + c] = v[i];
            ss = fmaf(v[i], v[i], ss);
        }
        if (NEXTPREP) {
            ss = wave_sum(ss);
            const float rinv = rsqrtf(ss * (1.f / 1024.f) + EPS);
            const float* md = modp(p, nlayer, r < L ? 0 : 1, 0);
            const float* g = p.in[I_NORMG] + (nlayer * 2 + 0) * 1024;
#pragma unroll
            for (int i = 0; i < 16; i++) {
                const int c = lane + 64 * i;
                const float hv = v[i] * rinv * g[c] * (1.f + md[1024 + c]) + md[c];
                H[(size_t)r * D + c] = hv;
                wsp<bf16_t>(p, OFF_HB)[(size_t)r * D + c] = f2bf(hv);
            }
        }
    }
}

__device__ __forceinline__ void ph_streams(const Params& p) {
    const int TIDX = tid_opaque();
    const float* P1 = wsp<float>(p, OFF_P);
    float* XBC = wsp<float>(p, OFF_XBC);
    float* DT = wsp<float>(p, OFF_DT);
    float* F = wsp<float>(p, OFF_F);
    float* Q1 = wsp<float>(p, OFF_Q1);
    const float* cw = p.in[I_SSDCW];
    const float* cb = p.in[I_SSDCB];
    const float* lb = wsp<float>(p, OFF_LB);
    const size_t gsz = (size_t)gridDim.x * NT, g0 = (size_t)blockIdx.x * NT + TIDX;
    for (size_t it = g0; it < (size_t)R * 1024; it += gsz) {
        const int r = (int)(it >> 10), c = (int)(it & 1023);
        const int lo = r < L ? 0 : L, hi = r < L ? L : R;
        float a = cb[c];
#pragma unroll
        for (int j = 0; j < 3; j++) {
            const int rr = r + j - 1;
            if (rr >= lo && rr < hi) a = fmaf(cw[j * 1024 + c], P1[(size_t)rr * ODD_IN + c], a);
        }
        XBC[it] = silu_f(a);
        if (c < 512) {
            F[(size_t)r * 512 + c] = lb[c] + (1.f - lb[c]) * sigmoid_f(P1[(size_t)r * ODD_IN + 1040 + c]);
            F[(size_t)R * 512 + (size_t)r * 512 + c] = lb[c] + (1.f - lb[c]) * sigmoid_f(P1[(size_t)r * ODD_IN + 1040 + 512 + c]);
            Q1[(size_t)r * 512 + c] = silu_f(P1[(size_t)r * ODD_IN + 3088 + c]);
        }
        if (c < 16) {
            const int d = c >> 3, h = c & 7;
            DT[(size_t)d * R * 8 + (size_t)r * 8 + h] = softplus_f(P1[(size_t)r * ODD_IN + 1024 + c] + p.in[I_DTB][d * 8 + h]);
        }
    }
}
typedef short bf16x8_t __attribute__((ext_vector_type(8)));
typedef float f32x16 __attribute__((ext_vector_type(16)));
constexpr int LDP = 136;
template <int KSTEPS>
__device__ __forceinline__ f32x16 mma32(int lane, const bf16_t* As, int lda, const bf16_t* Bs, int ldb, f32x16 acc) {
    const int r = lane & 31, hh = lane >> 5;
    const bf16_t* ap = As + r * lda + 8 * hh;
    const bf16_t* bp = Bs + r * ldb + 8 * hh;
#pragma unroll 2
    for (int ks = 0; ks < KSTEPS; ks++) {
        const bf16x8_t a = *(const bf16x8_t*)(ap + ks * 16);
        const bf16x8_t b = *(const bf16x8_t*)(bp + ks * 16);
        acc = __builtin_amdgcn_mfma_f32_32x32x16_bf16(a, b, acc, 0, 0, 0);
    }
    return acc;
}
#define CROW(reg, hf) (((reg) & 3) + 8 * ((reg) >> 2) + 4 * (hf))
__device__ __forceinline__ float bf2f(unsigned short b) { return __uint_as_float(((unsigned)b) << 16); }

__device__ __forceinline__ float chunk_cumsum128(float a0, float a1, int lane, int d, float& c0, float& c1) {
    const float s = a0 + a1;
    float incl = s;
#pragma unroll
    for (int o = 1; o < 64; o <<= 1) { const float t = __shfl_up(incl, o); if (lane >= o) incl += t; }
    const float total = __shfl(incl, 63);
    c0 = incl - s + a0; c1 = incl;
    if (d == 1) { c0 = total - (c0 - a0); c1 = total - (c1 - a1); }
    return total;
}

__device__ __forceinline__ void ph_ssd_s1(const Params& p, unsigned char* smem) {
    const int TIDX = tid_opaque();
    bf16_t* Bt = (bf16_t*)smem;
    bf16_t* XW = Bt + 128 * LDP;
    float* csb = (float*)(XW + 64 * LDP);
    const float* XBC = wsp<float>(p, OFF_XBC);
    const float* DT = wsp<float>(p, OFF_DT);
    bf16_t* ST = wsp<bf16_t>(p, OFF_SST);
    float* DEC = wsp<float>(p, OFF_SDEC);
    const int tid = TIDX, lane = tid & 63, wave = tid >> 6;
    for (int it = blockIdx.x; it < 130 * 8; it += gridDim.x) {
        const int c = it >> 3, hh = it & 7, g = hh >> 2, r0 = c * 128;
        __syncthreads();
#pragma unroll 4
        for (int i = 0; i < 32; i++) { const int idx = tid + 512 * i, s = idx >> 7, n = idx & 127;
            Bt[n * LDP + s] = f2bf(XBC[(size_t)(r0 + s) * 1024 + 512 + g * 128 + n]); }
#pragma unroll 1
        for (int d = 0; d < 2; d++) {
            if (wave == 0) {
                const float a = -expf(p.in[I_ALOG][d * 8 + hh]);
                const float dt0 = DT[(size_t)d * R * 8 + (size_t)(r0 + 2 * lane) * 8 + hh], dt1 = DT[(size_t)d * R * 8 + (size_t)(r0 + 2 * lane + 1) * 8 + hh];
                float c0, c1;
                const float total = chunk_cumsum128(dt0 * a, dt1 * a, lane, d, c0, c1);
                csb[2 * lane] = expf(total - c0) * dt0;
                csb[2 * lane + 1] = expf(total - c1) * dt1;
                if (lane == 0) csb[128] = total;
            }
            __syncthreads();
#pragma unroll 4
            for (int i = 0; i < 16; i++) { const int idx = tid + 512 * i, s = idx >> 6, pp = idx & 63;
                XW[pp * LDP + s] = f2bf(XBC[(size_t)(r0 + s) * 1024 + hh * 64 + pp] * csb[s]); }
            __syncthreads();
            {
                const int mt = wave >> 2, nt = wave & 3, hf = lane >> 5;
                f32x16 acc;
#pragma unroll
                for (int q = 0; q < 16; q++) acc[q] = 0.f;
                acc = mma32<8>(lane, XW + mt * 32 * LDP, LDP, Bt + nt * 32 * LDP, LDP, acc);
                int rb = mt * 32 + 4 * hf;
                asm volatile("" : "+v"(rb));
                bf16_t* dst = ST + ((((size_t)d * 130 + c) * 8 + hh) * 64 + rb) * 128 + nt * 32 + (lane & 31);
#pragma unroll
                for (int q = 0; q < 16; q++) dst[((q & 3) + 8 * (q >> 2)) * 128] = f2bf(acc[q]);
                if (tid == 0) DEC[(d * 130 + c) * 8 + hh] = expf(csb[128]);
            }
            __syncthreads();
        }
    }
}
__device__ __forceinline__ void ph_ssd_s2(const Params& p) {
    const int TIDX = tid_opaque();
    const bf16_t* __restrict__ ST = wsp<bf16_t>(p, OFF_SST);
    bf16_t* __restrict__ SIN = wsp<bf16_t>(p, OFF_SSIN);
    const float* __restrict__ DEC = wsp<float>(p, OFF_SDEC);
    for (int it = blockIdx.x * NT + TIDX; it < 65536; it += gridDim.x * NT) {
        const int n2 = it & 63, pp = (it >> 6) & 63, hh = (it >> 12) & 7, d = it >> 15;
        float s0 = 0.f, s1 = 0.f;
#pragma unroll 8
        for (int step = 0; step < 130; step++) {
            const int c = d == 0 ? (step < 2 ? 128 + step : step - 2) : 129 - step;
            const size_t off = ((((size_t)d * 130 + c) * 8 + hh) * 64 + pp) * 128 + 2 * n2;
            const unsigned st = *(const unsigned*)(ST + off);
            const float dec = DEC[(d * 130 + c) * 8 + hh];
            *(unsigned*)(SIN + off) = pack_bf16(s0, s1);
            s0 = fmaf(s0, dec, bf2f((unsigned short)(st & 0xffff)));
            s1 = fmaf(s1, dec, bf2f((unsigned short)(st >> 16)));
        }
    }
}
__device__ __forceinline__ void ph_ssd_s3(const Params& p, unsigned char* smem) {
    const int TIDX = tid_opaque();
    bf16_t* Cm = (bf16_t*)smem;
    bf16_t* Bm = Cm + 128 * LDP;
    bf16_t* Wm = Bm + 128 * LDP;
    bf16_t* Xt = Wm + 128 * LDP;
    bf16_t* Sn = Xt + 64 * LDP;
    float* csb = (float*)(Sn + 64 * LDP);
    const float* XBC = wsp<float>(p, OFF_XBC);
    const float* DT = wsp<float>(p, OFF_DT);
    const bf16_t* SIN = wsp<bf16_t>(p, OFF_SSIN);
    float* Y = wsp<float>(p, OFF_Y);
    const int tid = TIDX, lane = tid & 63, wave = tid >> 6, hf = lane >> 5;
    for (int it = blockIdx.x; it < 256; it += gridDim.x) {
        const int c = it >> 1, g = it & 1, r0 = c * 128;
        __syncthreads();
#pragma unroll 4
        for (int i = 0; i < 32; i++) { const int idx = tid + 512 * i, s = idx >> 7, n = idx & 127;
            const float* xr = XBC + (size_t)(r0 + s) * 1024 + g * 128 + n;
            Bm[s * LDP + n] = f2bf(xr[512]); Cm[s * LDP + n] = f2bf(xr[768]); }
        __syncthreads();
        const int gmt = wave >> 1, gnt0 = (wave & 1) * 2;
        f32x16 G0, G1;
#pragma unroll
        for (int q = 0; q < 16; q++) { G0[q] = 0.f; G1[q] = 0.f; }
        G0 = mma32<8>(lane, Cm + gmt * 32 * LDP, LDP, Bm + gnt0 * 32 * LDP, LDP, G0);
        G1 = mma32<8>(lane, Cm + gmt * 32 * LDP, LDP, Bm + (gnt0 + 1) * 32 * LDP, LDP, G1);
#pragma unroll 1
        for (int h = 0; h < 4; h++) {
            const int hh = g * 4 + h;
            const int ymt = wave >> 1, ynt = wave & 1;
            f32x16 ytot;
#pragma unroll
            for (int q = 0; q < 16; q++) ytot[q] = 0.f;
#pragma unroll 1
            for (int d = 0; d < 2; d++) {
                __syncthreads();
                if (d == 0) {
#pragma unroll 4
                    for (int i = 0; i < 16; i++) { const int idx = tid + 512 * i, s = idx >> 6, pp = idx & 63;
                        Xt[pp * LDP + s] = f2bf(XBC[(size_t)(r0 + s) * 1024 + hh * 64 + pp]); }
                }
                {
                    const bf16_t* src = SIN + ((((size_t)d * 130 + c) * 8 + hh) * 64) * 128;
#pragma unroll
                    for (int i = 0; i < 2; i++) { const int v = tid + 512 * i, row = v >> 4, col8 = (v & 15) * 8;
                        *(pg8::u32x4*)(Sn + row * LDP + col8) = *(const pg8::u32x4*)(src + row * 128 + col8); }
                }
                if (wave == 0) {
                    const float a = -expf(p.in[I_ALOG][d * 8 + hh]);
                    const float dt0 = DT[(size_t)d * R * 8 + (size_t)(r0 + 2 * lane) * 8 + hh], dt1 = DT[(size_t)d * R * 8 + (size_t)(r0 + 2 * lane + 1) * 8 + hh];
                    float c0, c1;
                    chunk_cumsum128(dt0 * a, dt1 * a, lane, d, c0, c1);
                    csb[2 * lane] = c0; csb[2 * lane + 1] = c1;
                    csb[128 + 2 * lane] = dt0; csb[128 + 2 * lane + 1] = dt1;
                }
                __syncthreads();
#pragma unroll
                for (int t2 = 0; t2 < 2; t2++) {
                    const int s = (gnt0 + t2) * 32 + (lane & 31);
                    const float css = csb[s], dts = csb[128 + s];
#pragma unroll
                    for (int q = 0; q < 16; q++) {
                        const int l = gmt * 32 + CROW(q, hf);
                        const bool ok = d == 0 ? (s <= l) : (s >= l);
                        const float gv = t2 == 0 ? G0[q] : G1[q];
                        const float w = ok ? gv * __expf(csb[l] - css) * dts : 0.f;
                        Wm[l * LDP + s] = f2bf(w);
                    }
                }
                __syncthreads();
                f32x16 a2;
#pragma unroll
                for (int q = 0; q < 16; q++) a2[q] = 0.f;
                a2 = mma32<8>(lane, Cm + ymt * 32 * LDP, LDP, Sn + ynt * 32 * LDP, LDP, a2);
#pragma unroll
                for (int q = 0; q < 16; q++) ytot[q] += __expf(csb[ymt * 32 + CROW(q, hf)]) * a2[q];
                ytot = mma32<8>(lane, Wm + ymt * 32 * LDP, LDP, Xt + ynt * 32 * LDP, LDP, ytot);
            }
            const float Dsum = p.in[I_SSDD][hh] + p.in[I_SSDD][8 + hh];
            {
                int lbase = r0 + ymt * 32 + 4 * hf;
                asm volatile("" : "+v"(lbase));
                const int cbase = hh * 64 + ynt * 32 + (lane & 31);
                float* yb = Y + (size_t)lbase * 512 + cbase;
                const float* xb = XBC + (size_t)lbase * 1024 + cbase;
#pragma unroll
                for (int q = 0; q < 16; q++) {
                    const int lo = (q & 3) + 8 * (q >> 2);
                    yb[lo * 512] = ytot[q] + Dsum * xb[lo * 1024];
                }
            }
        }
    }
}

constexpr int LDQ = 72;
__device__ __forceinline__ void ph_hg_s1(const Params& p, unsigned char* smem) {
    const int TIDX = tid_opaque();
    bf16_t* KbT = (bf16_t*)smem;
    bf16_t* Vt = KbT + 2 * 128 * LDQ;
    const float* P1 = wsp<float>(p, OFF_P);
    const float* F = wsp<float>(p, OFF_F);
    bf16_t* ST = wsp<bf16_t>(p, OFF_HST);
    float* DEC = wsp<float>(p, OFF_HDEC);
    const int tid = TIDX, lane = tid & 63, wave = tid >> 6, hf = lane >> 5;
    for (int it = blockIdx.x; it < 260 * 4; it += gridDim.x) {
        const int c = it >> 2, h = it & 3, r0 = c * 64;
        __syncthreads();
        if (tid < 256) {
            const int d = tid >> 7, k = tid & 127;
            const float* fp = F + (size_t)d * R * 512 + (size_t)r0 * 512 + h * 128 + k;
            float total = 0.f;
#pragma unroll 8
            for (int i = 0; i < 64; i++) total += logf(fp[(size_t)i * 512]);
            float cum = 0.f;
            bf16_t* dst = KbT + (d * 128 + k) * LDQ;
#pragma unroll 8
            for (int i = 0; i < 64; i++) {
                const int row = d == 0 ? i : 63 - i;
                const float f = fp[(size_t)row * 512];
                cum += logf(f);
                dst[row] = f2bf((1.f - f) * __expf(total - cum));
            }
            DEC[(((size_t)d * 260 + c) * 4 + h) * 128 + k] = __expf(total);
        } else {
            const int t2 = tid - 256;
#pragma unroll 8
            for (int i = 0; i < 32; i++) { const int idx = t2 + 256 * i, s2 = idx >> 7, v = idx & 127;
                Vt[v * LDQ + s2] = f2bf(P1[(size_t)(r0 + s2) * ODD_IN + 2064 + h * 128 + v]); }
        }
        __syncthreads();
#pragma unroll 1
        for (int q4 = 0; q4 < 4; q4++) {
            const int tix = wave * 4 + q4, d = tix >> 4, vt = (tix >> 2) & 3, kt = tix & 3;
            f32x16 acc;
#pragma unroll
            for (int q = 0; q < 16; q++) acc[q] = 0.f;
            acc = mma32<4>(lane, Vt + vt * 32 * LDQ, LDQ, KbT + (d * 128 + kt * 32) * LDQ, LDQ, acc);
            int rb = vt * 32 + 4 * hf;
            asm volatile("" : "+v"(rb));
            bf16_t* dst = ST + ((((size_t)d * 260 + c) * 4 + h) * 128 + rb) * 128 + kt * 32 + (lane & 31);
#pragma unroll
            for (int q = 0; q < 16; q++) dst[((q & 3) + 8 * (q >> 2)) * 128] = f2bf(acc[q]);
        }
    }
}
__device__ __forceinline__ void ph_hg_s2(const Params& p) {
    const int TIDX = tid_opaque();
    const bf16_t* __restrict__ ST = wsp<bf16_t>(p, OFF_HST);
    bf16_t* __restrict__ SIN = wsp<bf16_t>(p, OFF_HSIN);
    const float* __restrict__ DEC = wsp<float>(p, OFF_HDEC);
    for (int it = blockIdx.x * NT + TIDX; it < 65536; it += gridDim.x * NT) {
        const int k2 = it & 63, v = (it >> 6) & 127, h = (it >> 13) & 3, d = it >> 15;
        float s0 = 0.f, s1 = 0.f;
#pragma unroll 8
        for (int step = 0; step < 260; step++) {
            const int c = d == 0 ? (step < 4 ? 256 + step : step - 4) : 259 - step;
            const size_t blk = ((size_t)d * 260 + c) * 4 + h;
            const size_t off = (blk * 128 + v) * 128 + 2 * k2;
            const unsigned st = *(const unsigned*)(ST + off);
            const float2 dec = *(const float2*)(DEC + blk * 128 + 2 * k2);
            *(unsigned*)(SIN + off) = pack_bf16(s0, s1);
            s0 = fmaf(s0, dec.x, bf2f((unsigned short)(st & 0xffff)));
            s1 = fmaf(s1, dec.y, bf2f((unsigned short)(st >> 16)));
        }
    }
}
__device__ __forceinline__ void ph_hg_s3(const Params& p, unsigned char* smem) {
    const int TIDX = tid_opaque();
    bf16_t* Qb = (bf16_t*)smem;
    bf16_t* Kh = Qb + 2 * 64 * LDP;
    bf16_t* Vt = Kh + 2 * 64 * LDP;
    bf16_t* Am = Vt + 128 * LDQ;
    bf16_t* Sn = Am + 64 * LDQ;
    const float* P1 = wsp<float>(p, OFF_P);
    const float* F = wsp<float>(p, OFF_F);
    const float* Q1 = wsp<float>(p, OFF_Q1);
    const bf16_t* SIN = wsp<bf16_t>(p, OFF_HSIN);
    float* O = wsp<float>(p, OFF_O);
    const int tid = TIDX, lane = tid & 63, wave = tid >> 6, hf = lane >> 5;
    for (int it = blockIdx.x; it < 256 * 4; it += gridDim.x) {
        const int c = it >> 2, h = it & 3, r0 = c * 64;
        __syncthreads();
        if (tid < 256) {
            const int d = tid >> 7, k = tid & 127;
            const float* fp = F + (size_t)d * R * 512 + (size_t)r0 * 512 + h * 128 + k;
            const float* qp = Q1 + (size_t)r0 * 512 + h * 128 + k;
            float cum = 0.f;
#pragma unroll 8
            for (int i = 0; i < 64; i++) {
                const int row = d == 0 ? i : 63 - i;
                const float f = fp[(size_t)row * 512];
                cum += logf(f);
                Qb[(d * 64 + row) * LDP + k] = f2bf(qp[(size_t)row * 512] * __expf(cum));
                Kh[(d * 64 + row) * LDP + k] = f2bf((1.f - f) * __expf(fminf(-cum, 80.f)));
            }
        } else {
            const int t2 = tid - 256;
#pragma unroll 8
            for (int i = 0; i < 32; i++) { const int idx = t2 + 256 * i, s2 = idx >> 7, v = idx & 127;
                Vt[v * LDQ + s2] = f2bf(P1[(size_t)(r0 + s2) * ODD_IN + 2064 + h * 128 + v]); }
        }
        const int omt = wave >> 2, ont = wave & 3;
        f32x16 otot;
#pragma unroll
        for (int q = 0; q < 16; q++) otot[q] = 0.f;
#pragma unroll 1
        for (int d = 0; d < 2; d++) {
            __syncthreads();
            {
                const bf16_t* src = SIN + ((((size_t)d * 260 + c) * 4 + h) * 128) * 128;
#pragma unroll
                for (int i = 0; i < 4; i++) { const int v = tid + 512 * i, row = v >> 4, col8 = (v & 15) * 8;
                    *(pg8::u32x4*)(Sn + row * LDP + col8) = *(const pg8::u32x4*)(src + row * 128 + col8); }
            }
            if (wave < 4) {
                const int amt = wave >> 1, ant = wave & 1;
                f32x16 a;
#pragma unroll
                for (int q = 0; q < 16; q++) a[q] = 0.f;
                a = mma32<8>(lane, Qb + (d * 64 + amt * 32) * LDP, LDP, Kh + (d * 64 + ant * 32) * LDP, LDP, a);
                const int s2 = ant * 32 + (lane & 31);
#pragma unroll
                for (int q = 0; q < 16; q++) {
                    const int t = amt * 32 + CROW(q, hf);
                    const bool ok = d == 0 ? (s2 <= t) : (s2 >= t);
                    Am[t * LDQ + s2] = f2bf(ok ? a[q] : 0.f);
                }
            }
            __syncthreads();
            otot = mma32<8>(lane, Qb + (d * 64 + omt * 32) * LDP, LDP, Sn + ont * 32 * LDP, LDP, otot);
            otot = mma32<4>(lane, Am + omt * 32 * LDQ, LDQ, Vt + ont * 32 * LDQ, LDQ, otot);
        }
        {
            int lbase = r0 + omt * 32 + 4 * hf;
            asm volatile("" : "+v"(lbase));
            float* ob = O + (size_t)lbase * 512 + h * 128 + ont * 32 + (lane & 31);
#pragma unroll
            for (int q = 0; q < 16; q++) ob[((q & 3) + 8 * (q >> 2)) * 512] = otot[q];
        }
    }
}

__device__ __forceinline__ void ph_merge(const Params& p) {
    const int TIDX = tid_opaque();
    const int lane = TIDX & 63, wave = TIDX >> 6;
    const float* P1 = wsp<float>(p, OFF_P);
    const float* Y = wsp<float>(p, OFF_Y);
    const float* O = wsp<float>(p, OFF_O);
    for (int r = blockIdx.x * NWAVE + wave; r < L; r += gridDim.x * NWAVE) {
        float ys[8], os[8];
        float sy0 = 0.f, sy1 = 0.f, so[4] = {0.f, 0.f, 0.f, 0.f};
#pragma unroll
        for (int i = 0; i < 8; i++) {
            const int c = lane + 64 * i;
            const float y = Y[(size_t)r * 512 + c];
            ys[i] = y * silu_f(P1[(size_t)r * ODD_IN + 2576 + c]);
            if (i < 4) sy0 = fmaf(ys[i], ys[i], sy0); else sy1 = fmaf(ys[i], ys[i], sy1);
            os[i] = O[(size_t)r * 512 + c];
            so[i >> 1] = fmaf(os[i], os[i], so[i >> 1]);
        }
        sy0 = rsqrtf(wave_sum(sy0) * (1.f / 256.f) + EPS);
        sy1 = rsqrtf(wave_sum(sy1) * (1.f / 256.f) + EPS);
#pragma unroll
        for (int k = 0; k < 4; k++) so[k] = rsqrtf(wave_sum(so[k]) * (1.f / 128.f) + EPS);
#pragma unroll
        for (int i = 0; i < 8; i++) {
            const int c = lane + 64 * i;
            const float mv0 = ys[i] * (i < 4 ? sy0 : sy1) * p.in[I_SSDN][c];
            const float mv1 = os[i] * so[i >> 1] * p.in[I_HGN][c] * silu_f(P1[(size_t)r * ODD_IN + 3600 + c]);
            wsp<bf16_t>(p, OFF_MB)[(size_t)r * D + c] = f2bf(mv0);
            wsp<bf16_t>(p, OFF_MB)[(size_t)r * D + 512 + c] = f2bf(mv1);
        }
    }
}

constexpr int N_PHASES = 22;
__global__ void __launch_bounds__(NT, 2) mega(KArgs ka) {
    extern __shared__ __attribute__((aligned(16))) unsigned char smem[];
    float* lds = (float*)smem;
    PG8_LAS unsigned char* glds = (PG8_LAS unsigned char*)smem;
    cg::grid_group grid = cg::this_grid();
    Params p;
    p.in = (const float* const*)(ka.ws + OFF_TAB); p.out = ka.out; p.ws = ka.ws;
    float* XA = wsp<float>(p, OFF_XA);
    float* XB = wsp<float>(p, OFF_XB);
    float* XC = wsp<float>(p, OFF_XC);
    float* H = wsp<float>(p, OFF_H);
    float* PP = wsp<float>(p, OFF_P);
    const int G = gridDim.x, bid = blockIdx.x;
#ifndef ONLY
#define ONLY -1
#endif
#ifndef PHMASK
#define PHMASK 0xFFFFFFFFull
#endif
#define IN(k) ((ONLY < 0 || ONLY == (k)) && ((PHMASK >> (k)) & 1ull))
#define SEAM(k) grid.sync()
    if (blockIdx.x == 0 && threadIdx.x == 0) {
#pragma unroll
        for (int i = 0; i < N_IN; i++) ((const float**)(ka.ws + OFF_TAB))[i] = ka.in[i];
    }
    if (IN(0)) { ph_prologue(ka, lds); __syncthreads(); ph_convert_weights(ka, lds);
    }
    SEAM(0);
    if (IN(1)) {
            prep_rows<false>(p, p.in[I_X], p.in[I_CTX], R, p.in[I_NORMG] + 0, 0, 0, H);
            ph_filter_gemm_lat(p, smem); ph_filter_gemm_ctx(p, lds);
    }
    SEAM(1);
    if (IN(2)) {
            { pg8::StaticOrder S; S.init(R, EVEN_IN, G, bid);
              pg8::gemm_phase(glds, pg8::Gemm{wsp<bf16_t>(p, OFF_HB), wsp<bf16_t>(p, OFF_WINE), D}, S, pg8::EpiStoreF32{PP, EVEN_IN, EVEN_IN}); }
            ph_filter_fft(p, smem); ph_filter_abs_ctx(p);
    }
    SEAM(2);
    if (IN(3)) { ph_qk_dwconv(p); ph_dwconv_t(p, lds);
    }
    SEAM(3);
    if (IN(4)) { ph_hyena_fft(p, smem); ph_attention(p, lds); ph_hyena_conv(p, 0);
    }
    SEAM(4);
    if (IN(5)) { ph_hy_transpose(p, smem); ph_hyena_conv(p, 1);
    }
    SEAM(5);
    if (IN(6)) {
            { pg8::StaticOrder S; S.init(R, D, G, bid);
              pg8::gemm_phase(glds, pg8::Gemm{wsp<bf16_t>(p, OFF_MB), wsp<bf16_t>(p, OFF_WOUT), D}, S,
                              pg8::EpiResid{p.in[I_X], p.in[I_CTX], modp(p, 0, 0, 0) + 2048, modp(p, 0, 1, 0) + 2048, XA}); }
    }
    SEAM(6);
    if (IN(7)) { prep_rows<true>(p, XA, XA + (size_t)L * D, R, p.in[I_NORMG] + 1024, 0, 1, H);
    }
    SEAM(7);
    if (IN(8)) { ph_moe_scatter(p, lds, 0, R);
    }
    SEAM(8);
    if (IN(9)) { ph_moe_gemm1(p, glds, 0);
    }
    SEAM(9);
    if (IN(10)) { ph_moe_gemm2(p, glds, 0);
    }
    SEAM(10);
    if (IN(11)) { ph_moe_combine<true>(p, 0, R, XA, XB, 1);
    }
    SEAM(11);
    if (IN(12)) {
            { pg8::StaticOrder S; S.init(R, ODD_PAD, G, bid);
              pg8::gemm_phase(glds, pg8::Gemm{wsp<bf16_t>(p, OFF_HB), wsp<bf16_t>(p, OFF_WINO), D}, S, pg8::EpiStoreF32{PP, ODD_IN, ODD_IN}); }
    }
    SEAM(12);
    if (IN(13)) { ph_streams(p);
    }
    SEAM(13);
    if (IN(14)) { ph_ssd_s1(p, smem); ph_hg_s1(p, smem);
    }
    SEAM(14);
    if (IN(22)) { ph_ssd_s2(p); ph_hg_s2(p);
    }
    SEAM(22);
    if (IN(23)) { ph_ssd_s3(p, smem); ph_hg_s3(p, smem);
    }
    SEAM(23);
    if (IN(15)) { ph_merge(p);
    }
    SEAM(15);
    if (IN(16)) {
            { pg8::StaticOrder S; S.init(L, D, G, bid);
              pg8::gemm_phase(glds, pg8::Gemm{wsp<bf16_t>(p, OFF_MB), wsp<bf16_t>(p, OFF_WOUT) + (size_t)D * D, D}, S,
                              pg8::EpiResid{XB, XB, modp(p, 1, 0, 0) + 2048, modp(p, 1, 0, 0) + 2048, XC}); }
    }
    SEAM(16);
    if (IN(17)) { prep_rows<true>(p, XC, XC, L, p.in[I_NORMG] + 3 * 1024, 1, 1, H);
    }
    SEAM(17);
    if (IN(18)) { ph_moe_scatter(p, lds, 1, L);
    }
    SEAM(18);
    if (IN(19)) { ph_moe_gemm1(p, glds, 1);
    }
    SEAM(19);
    if (IN(20)) { ph_moe_gemm2(p, glds, 1);
    }
    SEAM(20);
    if (IN(21)) { ph_moe_combine<false>(p, 1, L, XC, p.out, 0);
    }
#undef IN
#undef SEAM
}

extern "C" void kernel_launch(void* const* d_in, const int* in_sizes, int n_in, void* d_out, int out_size, void* d_ws, size_t ws_size,
                              hipStream_t stream) {
    static int grid_blocks = 0;
    if (!grid_blocks) {
        int dev = 0, cus = 0, per_cu = 0;
        hipGetDevice(&dev);
        hipDeviceGetAttribute(&cus, hipDeviceAttributeMultiprocessorCount, dev);
        hipFuncSetAttribute((const void*)mega, hipFuncAttributeMaxDynamicSharedMemorySize, LDS_BYTES);
        hipOccupancyMaxActiveBlocksPerMultiprocessor(&per_cu, mega, NT, LDS_BYTES);
        if (per_cu < 1) per_cu = 1;
        grid_blocks = cus;
        if (ws_size < WS_END) fprintf(stderr, "kernel_launch: workspace too small: %zu < %zu\n", ws_size, (size_t)WS_END);
    }
    hipMemsetAsync((char*)d_ws + OFF_CTL, 0, 65536, stream);
    KArgs p{};
    for (int i = 0; i < N_IN; i++) p.in[i] = (const float*)d_in[i];
    p.out = (float*)d_out;
    p.ws = (unsigned char*)d_ws;
    void* args[] = {&p};
    hipError_t e = hipLaunchCooperativeKernel((void*)mega, dim3(grid_blocks), dim3(NT), args, LDS_BYTES, stream);
    if (e != hipSuccess) fprintf(stderr, "cooperative launch failed: %s (grid %d)\n", hipGetErrorString(e), grid_blocks);
}
```

```cpp
#include <hip/hip_runtime.h>
#include <cstdio>
#include <cstdint>

constexpr int L = 16384, NCX = 256, R = L + NCX, D = 1024;
constexpr int EVEN_IN = 2304, ODD_IN = 4112;
constexpr int NT = 512, NWAVE = 8;
constexpr int NEXP = 32;
constexpr int NROWS = 74752;
constexpr int ODD_PAD = 4352;
constexpr int LDS_BYTES = 147456;
typedef unsigned short bf16_t;
constexpr float EPS = 1e-6f;

enum { I_X = 0, I_C, I_CTX, I_CCTX, I_NORMG, I_ADAW, I_ADAB, I_WOUT, I_WINE, I_HYCW, I_HYCB, I_HYW1, I_HYB1, I_HYW2, I_HYB2,
       I_HYW3, I_HYB3, I_HYW4, I_HYFREQ, I_HYFB, I_QNORM, I_KNORM, I_SINK, I_WINO, I_SSDCW, I_SSDCB, I_DTB, I_ALOG, I_SSDD,
       I_SSDN, I_HGLB, I_HGN, I_RW, I_RB, I_WGU, I_BGU, I_WDN, I_BDN, N_IN };

constexpr size_t al256(size_t x) { return (x + 255) & ~(size_t)255; }
constexpr size_t OFF_CTL = 0;
constexpr size_t OFF_BAR = 1024;
constexpr size_t OFF_TAB = 32768;
constexpr size_t OFF_MOD = 65536;
constexpr size_t OFF_LB = OFF_MOD + al256(4 * 24576);
constexpr size_t OFF_STARTS = OFF_LB + 4096;
constexpr size_t OFF_ROPE = OFF_STARTS + 4096;
constexpr size_t OFF_HNP = OFF_ROPE + 32768;
constexpr size_t OFF_HD3 = OFF_HNP + al256(4 * 130 * 1024);
constexpr size_t OFF_HH = OFF_HD3 + al256(4ull * R * 64);
constexpr size_t OFF_HHC = OFF_HH + al256(4ull * 2 * L * 1024);
constexpr size_t OFF_XA = OFF_HHC + al256(4ull * 512 * 1024);
constexpr size_t OFF_XB = OFF_XA + al256(4ull * R * D);
constexpr size_t OFF_XC = OFF_XA;
constexpr size_t OFF_H = OFF_XB + al256(4ull * R * D);
constexpr size_t OFF_P = OFF_H + al256(4ull * R * D);
constexpr size_t OFF_QN = OFF_P + al256(4ull * R * ODD_IN);
constexpr size_t OFF_KN = OFF_QN + al256(4ull * R * 512);
constexpr size_t OFF_U = OFF_KN + al256(4ull * R * 128);
constexpr size_t OFF_Z1 = OFF_U + al256(4ull * R * 1536);
constexpr size_t OFF_TOPE = OFF_Z1 + al256(4ull * R * 512);
constexpr size_t OFF_TOPG = OFF_TOPE + al256(4ull * R * 4);
constexpr size_t OFF_TOPP = OFF_TOPG + al256(4ull * R * 4);
constexpr size_t OFF_ROWTOK = OFF_TOPP + al256(4ull * R * 4);
constexpr size_t OFF_YR = OFF_ROWTOK + al256(4ull * 2 * NROWS);
constexpr size_t OFF_XBC = OFF_U;
constexpr size_t OFF_DT = OFF_YR + al256(4ull * NROWS * 1024);
constexpr size_t OFF_F = OFF_HH;
constexpr size_t OFF_Q1 = OFF_F + al256(4ull * 2 * R * 512);
constexpr size_t OFF_Y = OFF_DT + al256(4ull * 2 * R * 8);
constexpr size_t OFF_O = OFF_Y + al256(4ull * 2 * R * 512);
constexpr size_t OFF_TILEE = OFF_O + al256(4ull * 2 * R * 512);
constexpr size_t OFF_SDEC = OFF_TILEE + 4096;
constexpr size_t OFF_BC = OFF_SDEC + 16384;
constexpr size_t OFF_HDEC = OFF_BC + 2 * 512 * 32 * 4;
constexpr size_t OFF_HB = OFF_HDEC + al256(4ull * 2 * 260 * 4 * 128);
constexpr size_t OFF_MB = OFF_HB + al256(2ull * R * D);
constexpr size_t OFF_XG = OFF_MB + al256(2ull * R * D);
constexpr size_t OFF_ACTB = OFF_XG + al256(2ull * NROWS * D);
constexpr size_t OFF_SST = OFF_XG;
constexpr size_t OFF_SSIN = OFF_SST + al256(2ull * 2 * 130 * 8 * 64 * 128);
constexpr size_t OFF_HST = OFF_SSIN + al256(2ull * 2 * 130 * 8 * 64 * 128);
constexpr size_t OFF_HSIN = OFF_ACTB;
constexpr size_t OFF_VB = OFF_KN + 2ull * R * 128;
constexpr size_t OFF_HT = OFF_ACTB;
constexpr size_t OFF_HF = OFF_XG;
constexpr size_t OFF_UC = OFF_U + 4ull * 1536 * L;
constexpr size_t OFF_HYT = OFF_Z1;
constexpr size_t OFF_WINE = OFF_ACTB + al256(2ull * NROWS * D);
constexpr size_t OFF_WINO = OFF_WINE + al256(2ull * EVEN_IN * D);
constexpr size_t OFF_WOUT = OFF_WINO + al256(2ull * ODD_PAD * D);
constexpr size_t OFF_WGU = OFF_WOUT + al256(2ull * 2 * D * D);
constexpr size_t OFF_WDN = OFF_WGU + al256(2ull * 2 * 32 * 2048 * D);
constexpr size_t WS_END = OFF_WDN + al256(2ull * 2 * 32 * 1024 * D);

struct KArgs {
    const float* in[N_IN];
    float* out;
    unsigned char* ws;
};
struct Params {
    const float* const* in;
    float* out;
    unsigned char* ws;
    int wave_id;
};

__device__ __forceinline__ int tid_opaque() { int t = threadIdx.x; asm volatile("" : "+v"(t)); return t; }
__device__ __forceinline__ int tid_of_wave(int wave_id) { unsigned m = ~0u; asm volatile("" : "+s"(m));
    int t = wave_id * 64 + (int)__builtin_amdgcn_mbcnt_hi(m, __builtin_amdgcn_mbcnt_lo(m, 0u)); asm volatile("" : "+v"(t)); return t; }

#define XB_TMO      128
#define XB_XCNT(j)  (256  + 64 * (j))
#define XB_XSUB(j)  (1280 + 64 * (j))
#define XB_XGEN(j)  (2304 + 64 * (j))
#define XB_TOP      3328
#define XB_TOPGEN   3392
#define XCD_BAR_WORDS 3456
#define XB_SPIN_CAP (1u << 22)
#define LAS3 __attribute__((address_space(3)))
__device__ __forceinline__ unsigned xb_ld(unsigned* p) { return __hip_atomic_load(p, __ATOMIC_RELAXED, __HIP_MEMORY_SCOPE_AGENT); }
__device__ __forceinline__ unsigned xb_add(unsigned* p, unsigned v) { return __hip_atomic_fetch_add(p, v, __ATOMIC_RELAXED, __HIP_MEMORY_SCOPE_AGENT); }
__device__ __forceinline__ unsigned xb_xcc_id() { return (unsigned)__builtin_amdgcn_s_getreg((3 << 11) | 20) & 0xFu; }
#define XB_SPIN(cond, bar) do { unsigned _sp = 0; while (cond) { __builtin_amdgcn_s_sleep(1); \
    if ((++_sp & 255u) == 0u) { if (xb_ld(&(bar)[XB_TMO])) break; if (_sp > XB_SPIN_CAP) { atomicAdd(&(bar)[XB_TMO], 1u); break; } } } } while (0)
struct XcdBarrier { unsigned* bar; unsigned x; volatile LAS3 unsigned* st; };
__device__ __forceinline__ XcdBarrier xcd_barrier_post(unsigned* bar, volatile LAS3 unsigned* st) {
    XcdBarrier b; b.bar = bar; b.x = xb_xcc_id(); b.st = st;
    if (threadIdx.x == 0) (void)xb_add(&bar[XB_XCNT(b.x)], 1u);
    return b;
}
__device__ __forceinline__ void xcd_barrier_complete(unsigned* bar, unsigned x, unsigned& nloc, unsigned& nx) {
    const unsigned G = gridDim.x * gridDim.y * gridDim.z;
    unsigned sum, cnt, mine, sp = 0u;
    for (;;) {
        sum = 0u; cnt = 0u; mine = 0u;
#pragma unroll
        for (unsigned j = 0; j < 16; ++j) { const unsigned c = xb_ld(&bar[XB_XCNT(j)]); sum += c; cnt += (c > 0u) ? 1u : 0u; mine = (j == x) ? c : mine; }
        if (sum == G) break;
        __builtin_amdgcn_s_sleep(1);
        if ((++sp & 255u) == 0u) { if (xb_ld(&bar[XB_TMO])) break; if (sp > XB_SPIN_CAP) { atomicAdd(&bar[XB_TMO], 1u); break; } }
    }
    nloc = mine > 0u ? mine : 1u; nx = cnt > 0u ? cnt : 1u;
}
__device__ __forceinline__ void xcd_barrier(const XcdBarrier& b, int wave_id) {
    asm volatile("s_waitcnt vmcnt(0)" ::: "memory");
    __syncthreads();
    if (tid_of_wave(wave_id) == 0) {
        unsigned* bar = b.bar;
        __builtin_amdgcn_s_waitcnt(0);
        unsigned nloc = b.st[0], nx = b.st[1];
        if (nloc == 0u) { xcd_barrier_complete(bar, b.x, nloc, nx); b.st[0] = nloc; b.st[1] = nx; }
        const unsigned old = xb_add(&bar[XB_XSUB(b.x)], 1u);
        const unsigned gen = old / nloc;
        if (old + 1u == (gen + 1u) * nloc) {
            __builtin_amdgcn_fence(__ATOMIC_RELEASE, "agent");
            asm volatile("s_waitcnt vmcnt(0)" ::: "memory");
            const unsigned og = xb_add(&bar[XB_TOP], 1u);
            const unsigned tg = og / nx;
            if (og + 1u == (tg + 1u) * nx) xb_add(&bar[XB_TOPGEN], 1u);
            else XB_SPIN(xb_ld(&bar[XB_TOPGEN]) == tg, bar);
            __builtin_amdgcn_fence(__ATOMIC_ACQUIRE, "agent");
            xb_add(&bar[XB_XGEN(b.x)], 1u);
            asm volatile("s_waitcnt vmcnt(0)" ::: "memory");
        } else {
            XB_SPIN(xb_ld(&bar[XB_XGEN(b.x)]) == gen, bar);
            __builtin_amdgcn_fence(__ATOMIC_ACQUIRE, "agent");
            asm volatile("s_waitcnt vmcnt(0)" ::: "memory");
        }
    }
    __syncthreads();
}
__device__ __forceinline__ float silu_f(float x) { return x / (1.f + expf(-x)); }
__device__ __forceinline__ float sigmoid_f(float x) { return 1.f / (1.f + expf(-x)); }
__device__ __forceinline__ float sigmoid_fast(float x) { return __builtin_amdgcn_rcpf(1.f + __expf(-x)); }
__device__ __forceinline__ float silu_fast(float x) { return x * __builtin_amdgcn_rcpf(1.f + __expf(-x)); }
__device__ __forceinline__ float softplus_f(float x) { return x > 20.f ? x : log1pf(expf(x)); }
__device__ __forceinline__ float lane_xor(int lane, float v, int mask) { return __int_as_float(__builtin_amdgcn_ds_bpermute((lane ^ mask) << 2, __float_as_int(v))); }
__device__ __forceinline__ float lane_get(float v, int src) { return __int_as_float(__builtin_amdgcn_ds_bpermute(src << 2, __float_as_int(v))); }
template <int CTRL> __device__ __forceinline__ float dpp_f(float v) { return __int_as_float(__builtin_amdgcn_update_dpp(0, __float_as_int(v), CTRL, 0xF, 0xF, false)); }
__device__ __forceinline__ float wave_sum(int lane, float v) {
    v += dpp_f<0xB1>(v);
    v += dpp_f<0x4E>(v);
    v += dpp_f<0x141>(v);
    v += dpp_f<0x140>(v);
    v += lane_xor(lane, v, 16);
    v += lane_xor(lane, v, 32);
    return v;
}
__device__ __forceinline__ float wave_max(int lane, float v) {
    v = fmaxf(v, dpp_f<0xB1>(v));
    v = fmaxf(v, dpp_f<0x4E>(v));
    v = fmaxf(v, dpp_f<0x141>(v));
    v = fmaxf(v, dpp_f<0x140>(v));
    v = fmaxf(v, lane_xor(lane, v, 16));
    v = fmaxf(v, lane_xor(lane, v, 32));
    return v;
}
template <class T, class PT> __device__ __forceinline__ T* wsp(const PT& p, size_t off) { return (T*)(p.ws + off); }
__device__ __forceinline__ const float* modp(const Params& p, int layer, int cond, int j) {
    return wsp<float>(p, OFF_MOD) + (layer * 2 + cond) * 6144 + j * 3072;
}

__device__ __forceinline__ bf16_t f2bf(float f) { unsigned u = __float_as_uint(f); u += 0x7FFFu + ((u >> 16) & 1u); return (bf16_t)(u >> 16); }
__device__ __forceinline__ unsigned pack_bf16(float lo, float hi) { return (unsigned)f2bf(lo) | ((unsigned)f2bf(hi) << 16); }

namespace pg8 {
#define PG8_LAS __attribute__((address_space(3)))
typedef short bf16x8 __attribute__((ext_vector_type(8)));
typedef float f32x4 __attribute__((ext_vector_type(4)));
typedef unsigned u32x4 __attribute__((ext_vector_type(4)));
constexpr int BM = 256, BK = 64, HALF = 128, HTB = HALF * BK * 2, STAGE_BYTES = 8 * HTB, NXCD = 8, WGM = 8;
__device__ __forceinline__ int lds_byte(int r, int c) { const int st = (r >> 4) * 2 + (c >> 5), rr = r & 15, cc = c & 31, ob = rr * 64 + cc * 2; return st * 1024 + (ob ^ (((ob >> 9) & 1) << 5)); }
__device__ __forceinline__ void stage_rc(int b, int& Rr, int& C) { const int st = b / 1024, sb = b % 1024, swz = sb ^ (((sb >> 9) & 1) << 5); Rr = (st >> 1) * 16 + swz / 64; C = (st & 1) * 32 + (swz % 64) / 2; }
__device__ __forceinline__ int perm32(int rho) { const int n = rho >> 4, i = rho & 15; return 8 * (i >> 2) + 4 * n + (i & 3); }
struct Unit { int pm, pn, pb, e; };
struct Gemm { const bf16_t* A; const bf16_t* Bt; int K; };
struct StaticOrder {
    int nM, nN, nwg, G, c;
    __device__ void init(int M, int N, int G_, int c_) { nM = M / BM; nN = N / BM; nwg = nM * nN; G = G_; c = c_; }
    __device__ bool next(int i, Unit& u) const {
        const long Lx = (long)i * G + c; if (Lx >= nwg) return false;
        int wgid = (int)Lx; { const int q = nwg / NXCD, r = nwg % NXCD, xcd = wgid % NXCD, off = wgid / NXCD; wgid = (xcd < r ? xcd * (q + 1) : r * (q + 1) + (xcd - r) * q) + off; }
        const int nig = WGM * nN, gid = wgid / nig, fm = gid * WGM, gsz = (nM - fm) < WGM ? (nM - fm) : WGM;
        u.pm = fm + ((wgid % nig) % gsz); u.pn = (wgid % nig) / gsz; u.pb = u.pn; u.e = 0; return true;
    }
};
struct MoeOrder {
    const int* tile_e; int ntile, nN, G, c;
    __device__ bool next(int i, Unit& u) const {
        const long Lx = (long)i * G + c; if (Lx >= (long)ntile * nN) return false;
        u.pm = (int)(Lx / nN); u.pn = (int)(Lx % nN); u.e = tile_e[u.pm]; u.pb = u.e * nN + u.pn; return true;
    }
};
struct EpiStoreF32 {
    static constexpr bool PERM = false;
    float* C; int ldc; int nvalid;
    __device__ __forceinline__ void operator()(const f32x4 (&acc)[2][2][4][2], const Unit& u, int wr, int wc, int fr, int fq) const {
        const int row0 = u.pm * BM + wr * 64 + fr, col0 = u.pn * BM + wc * 32 + 4 * fq;
#pragma unroll
        for (int ai = 0; ai < 2; ++ai)
#pragma unroll
            for (int m = 0; m < 4; ++m) { float* rowp = C + (size_t)(row0 + ai * HALF + m * 16) * ldc + col0;
#pragma unroll
                for (int bj = 0; bj < 2; ++bj)
#pragma unroll
                    for (int n = 0; n < 2; ++n) if (col0 + bj * HALF + n * 16 < nvalid) *(f32x4*)(rowp + bj * HALF + n * 16) = acc[ai][bj][m][n]; }
    }
};
struct EpiStoreBf16 {
    static constexpr bool PERM = true;
    bf16_t* C; int ldc; int nvalid;
    __device__ __forceinline__ void operator()(const f32x4 (&acc)[2][2][4][2], const Unit& u, int wr, int wc, int fr, int fq) const {
        const int row0 = u.pm * BM + wr * 64 + fr, col0 = u.pn * BM + wc * 32 + 8 * fq;
#pragma unroll
        for (int ai = 0; ai < 2; ++ai)
#pragma unroll
            for (int m = 0; m < 4; ++m) { bf16_t* rowp = C + (size_t)(row0 + ai * HALF + m * 16) * ldc + col0;
#pragma unroll
                for (int bj = 0; bj < 2; ++bj) if (col0 + bj * HALF < nvalid) {
                    const f32x4 v0 = acc[ai][bj][m][0], v1 = acc[ai][bj][m][1];
                    u32x4 w; w.x = pack_bf16(v0[0], v0[1]); w.y = pack_bf16(v0[2], v0[3]); w.z = pack_bf16(v1[0], v1[1]); w.w = pack_bf16(v1[2], v1[3]);
                    *(u32x4*)(rowp + bj * HALF) = w; } }
    }
};
struct EpiResid {
    static constexpr bool PERM = false;
    const float* res_lat; const float* res_ctx; const float* gt_lat; const float* gt_ctx; float* out;
    __device__ __forceinline__ void operator()(const f32x4 (&acc)[2][2][4][2], const Unit& u, int wr, int wc, int fr, int fq) const {
        const int row0 = u.pm * BM + wr * 64 + fr, col0 = u.pn * BM + wc * 32 + 4 * fq;
        const bool ctx = (u.pm * BM) >= L;
        const float* gt = ctx ? gt_ctx : gt_lat;
        f32x4 gv[2][2];
#pragma unroll
        for (int bj = 0; bj < 2; ++bj)
#pragma unroll
            for (int n = 0; n < 2; ++n) gv[bj][n] = *(const f32x4*)(gt + col0 + bj * HALF + n * 16);
#pragma unroll
        for (int ai = 0; ai < 2; ++ai)
#pragma unroll
            for (int m = 0; m < 4; ++m) { const int row = row0 + ai * HALF + m * 16;
                const float* rp = (ctx ? res_ctx + (size_t)(row - L) * D : res_lat + (size_t)row * D) + col0;
                float* op = out + (size_t)row * D + col0;
#pragma unroll
                for (int bj = 0; bj < 2; ++bj)
#pragma unroll
                    for (int n = 0; n < 2; ++n) *(f32x4*)(op + bj * HALF + n * 16) = *(const f32x4*)(rp + bj * HALF + n * 16) + gv[bj][n] * acc[ai][bj][m][n];
                asm volatile("" ::: "memory"); }
    }
};
struct EpiMoe1 {
    static constexpr bool PERM = true;
    bf16_t* ACT; const float* bgu;
    __device__ __forceinline__ void operator()(const f32x4 (&acc)[2][2][4][2], const Unit& u, int wr, int wc, int fr, int fq) const {
        const int row0 = u.pm * BM + wr * 64 + fr, col0 = u.pn * HALF + wc * 32 + 8 * fq;
        const float* bg = bgu + (size_t)u.e * 2048 + col0;
        f32x4 bgv[2], buv[2];
#pragma unroll
        for (int n = 0; n < 2; ++n) { bgv[n] = *(const f32x4*)(bg + 4 * n); buv[n] = *(const f32x4*)(bg + 1024 + 4 * n); }
#pragma unroll
        for (int ai = 0; ai < 2; ++ai)
#pragma unroll
            for (int m = 0; m < 4; ++m) {
                float a[8];
#pragma unroll
                for (int n = 0; n < 2; ++n) { const f32x4 g4 = acc[ai][0][m][n] + bgv[n], u4 = acc[ai][1][m][n] + buv[n];
#pragma unroll
                    for (int j = 0; j < 4; ++j) { const float gate = fminf(g4[j], 7.f), up = fminf(fmaxf(u4[j], -7.f), 7.f);
                        a[n * 4 + j] = (up + 1.f) * gate * __builtin_amdgcn_rcpf(1.f + __expf(-1.702f * gate)); } }
                u32x4 w; w.x = pack_bf16(a[0], a[1]); w.y = pack_bf16(a[2], a[3]); w.z = pack_bf16(a[4], a[5]); w.w = pack_bf16(a[6], a[7]);
                *(u32x4*)(ACT + (size_t)(row0 + ai * HALF + m * 16) * 1024 + col0) = w;
                asm volatile("" ::: "memory"); }
    }
};
struct EpiMoe2 {
    static constexpr bool PERM = true;
    bf16_t* YR; const float* bdn;
    __device__ __forceinline__ void operator()(const f32x4 (&acc)[2][2][4][2], const Unit& u, int wr, int wc, int fr, int fq) const {
        const int row0 = u.pm * BM + wr * 64 + fr, col0 = u.pn * BM + wc * 32 + 8 * fq;
        const float* bd = bdn + (size_t)u.e * 1024 + col0;
        f32x4 bv[2][2];
#pragma unroll
        for (int bj = 0; bj < 2; ++bj)
#pragma unroll
            for (int n = 0; n < 2; ++n) bv[bj][n] = *(const f32x4*)(bd + bj * HALF + 4 * n);
#pragma unroll
        for (int ai = 0; ai < 2; ++ai)
#pragma unroll
            for (int m = 0; m < 4; ++m) { bf16_t* rowp = YR + (size_t)(row0 + ai * HALF + m * 16) * 1024 + col0;
#pragma unroll
                for (int bj = 0; bj < 2; ++bj) {
                    const f32x4 v0 = acc[ai][bj][m][0] + bv[bj][0], v1 = acc[ai][bj][m][1] + bv[bj][1];
                    u32x4 w; w.x = pack_bf16(v0[0], v0[1]); w.y = pack_bf16(v0[2], v0[3]); w.z = pack_bf16(v1[0], v1[1]); w.w = pack_bf16(v1[2], v1[3]);
                    *(u32x4*)(rowp + bj * HALF) = w; }
                asm volatile("" ::: "memory"); }
    }
};
template <class Epi, class Sched>
__device__ __forceinline__ void gemm_phase(int wave_id, PG8_LAS unsigned char* lds, const Gemm g, const Sched& S, const Epi& E) {
    const int TIDX = tid_of_wave(wave_id);
    const int tid = TIDX, wid = __builtin_amdgcn_readfirstlane(tid >> 6), lane = tid & 63, wr = wid >> 2, wc = wid & 3, fr = lane & 15, fq = lane >> 4;
    const int K = g.K, nt = K / BK;
    unsigned voffA[2], voffB[2];
#pragma unroll
    for (int i = 0; i < 2; ++i) { int Rr, C; stage_rc(tid * 16 + i * 8192, Rr, C); const int Rb = Epi::PERM ? ((Rr & ~31) + perm32(Rr & 31)) : Rr;
        voffA[i] = (unsigned)(Rr * K + C) * 2u; voffB[i] = (unsigned)(Rb * K + C) * 2u; }
    const size_t kstep = (size_t)(BK * 2);
    const size_t hstep = (size_t)HALF * K * 2;
    const size_t tstep = 2 * hstep;
    const unsigned ldsw = (unsigned)wid * 1024u;
    const int aoff = lds_byte(wr * 64 + fr, fq * 8), boff = lds_byte(wc * 32 + fr, fq * 8);
#define PG8_SA(b, h) (((b) * 2 + (h)) * HTB)
#define PG8_SB(b, h) ((4 + (b) * 2 + (h)) * HTB)
#define PG8_STAGE(bufoff, gbase, voff) do { _Pragma("unroll") for (int _i = 0; _i < 2; ++_i) \
        __builtin_amdgcn_global_load_lds((const unsigned*)((const char*)(gbase) + (voff)[_i]), (PG8_LAS unsigned*)(lds + (bufoff) + ldsw + _i * 8192), 16, 0, 0); } while (0)
#define PG8_LDA(dst, b, h) do { _Pragma("unroll") for (int m = 0; m < 4; ++m) _Pragma("unroll") for (int k = 0; k < 2; ++k) dst[m][k] = *(const PG8_LAS bf16x8*)(lds + PG8_SA(b, h) + aoff + m * 2048 + k * 1024); } while (0)
#define PG8_LDB(dst, b, h) do { _Pragma("unroll") for (int n = 0; n < 2; ++n) _Pragma("unroll") for (int k = 0; k < 2; ++k) dst[n][k] = *(const PG8_LAS bf16x8*)(lds + PG8_SB(b, h) + boff + n * 2048 + k * 1024); } while (0)
#define PG8_MMA(ai, bj, At, Bt) do { __builtin_amdgcn_s_setprio(1); _Pragma("unroll") for (int m = 0; m < 4; ++m) _Pragma("unroll") for (int n = 0; n < 2; ++n) _Pragma("unroll") for (int k = 0; k < 2; ++k) \
        acc[ai][bj][m][n] = __builtin_amdgcn_mfma_f32_16x16x32_bf16(Bt[n][k], At[m][k], acc[ai][bj][m][n], 0, 0, 0); __builtin_amdgcn_s_setprio(0); } while (0)
#define PG8_WAIT_V(n) asm volatile("s_waitcnt vmcnt(" #n ")" ::: "memory")
#define PG8_WAIT_L(n) asm volatile("s_waitcnt lgkmcnt(" #n ")" ::: "memory")
#define PG8_BAR __builtin_amdgcn_s_barrier()
#define PG8_SCHED __builtin_amdgcn_sched_barrier(0)
    Unit cur, nxt; int ui = 0;
    if (!S.next(0, cur)) return;
    f32x4 acc[2][2][4][2];
#pragma unroll
    for (int a = 0; a < 2; ++a)
#pragma unroll
        for (int b = 0; b < 2; ++b)
#pragma unroll
            for (int m = 0; m < 4; ++m)
#pragma unroll
                for (int n = 0; n < 2; ++n) acc[a][b][m][n] = (f32x4){0.f, 0.f, 0.f, 0.f};
    bf16x8 At[4][2], B0[2][2], B1[2][2];
    const char* cA = (const char*)g.A + (size_t)cur.pm * tstep; const char* cB = (const char*)g.Bt + (size_t)cur.pb * tstep;
    PG8_STAGE(PG8_SB(0, 0), cB, voffB); PG8_STAGE(PG8_SA(0, 0), cA, voffA); PG8_STAGE(PG8_SB(0, 1), cB + hstep, voffB); PG8_STAGE(PG8_SA(0, 1), cA + hstep, voffA);
    if (wr == 1) PG8_BAR;
    PG8_WAIT_V(4); PG8_BAR;
    PG8_STAGE(PG8_SB(1, 0), cB + kstep, voffB); PG8_STAGE(PG8_SA(1, 0), cA + kstep, voffA); PG8_STAGE(PG8_SB(1, 1), cB + hstep + kstep, voffB);
    PG8_WAIT_V(6); PG8_BAR;
    for (;;) {
        const bool has_next = S.next(ui + 1, nxt);
        const char* nA = has_next ? (const char*)g.A + (size_t)nxt.pm * tstep : cA; const char* nB = has_next ? (const char*)g.Bt + (size_t)nxt.pb * tstep : cB;
        for (int t = 0; t < nt; t += 2) {
            const bool last = (t == nt - 2);
            const char* a1 = cA + (size_t)(t + 1) * kstep;
            const char* a2 = last ? nA : cA + (size_t)(t + 2) * kstep; const char* b2 = last ? nB : cB + (size_t)(t + 2) * kstep;
            const char* a3 = a2 + kstep; const char* b3 = b2 + kstep;
            PG8_LDB(B0, 0, 0); PG8_SCHED; PG8_LDA(At, 0, 0); PG8_STAGE(PG8_SA(1, 1), a1 + hstep, voffA);
            PG8_WAIT_L(8); PG8_BAR; PG8_WAIT_L(0); PG8_MMA(0, 0, At, B0); PG8_BAR; PG8_SCHED;
            PG8_LDB(B1, 0, 1); PG8_STAGE(PG8_SB(0, 0), b2, voffB);
            PG8_BAR; PG8_WAIT_L(0); PG8_MMA(0, 1, At, B1); PG8_BAR;
            PG8_LDA(At, 0, 1); PG8_STAGE(PG8_SA(0, 0), a2, voffA);
            PG8_BAR; PG8_WAIT_L(0); PG8_MMA(1, 0, At, B0); PG8_BAR; PG8_SCHED;
            PG8_STAGE(PG8_SB(0, 1), b2 + hstep, voffB);
            PG8_WAIT_V(6); PG8_BAR; PG8_MMA(1, 1, At, B1); PG8_BAR;
            PG8_LDB(B0, 1, 0); PG8_SCHED; PG8_LDA(At, 1, 0); PG8_STAGE(PG8_SA(0, 1), a2 + hstep, voffA);
            PG8_WAIT_L(8); PG8_BAR; PG8_WAIT_L(0); PG8_MMA(0, 0, At, B0); PG8_BAR; PG8_SCHED;
            PG8_LDB(B1, 1, 1); PG8_STAGE(PG8_SB(1, 0), b3, voffB);
            PG8_BAR; PG8_WAIT_L(0); PG8_MMA(0, 1, At, B1); PG8_BAR;
            PG8_LDA(At, 1, 1); PG8_STAGE(PG8_SA(1, 0), a3, voffA);
            PG8_BAR; PG8_WAIT_L(0); PG8_MMA(1, 0, At, B0); PG8_BAR; PG8_SCHED;
            PG8_STAGE(PG8_SB(1, 1), b3 + hstep, voffB);
            PG8_WAIT_V(6); PG8_BAR; PG8_MMA(1, 1, At, B1); PG8_BAR;
        }
        E(acc, cur, wr, wc, fr, fq);
        if (!has_next) break;
#pragma unroll
        for (int a = 0; a < 2; ++a)
#pragma unroll
            for (int b = 0; b < 2; ++b)
#pragma unroll
                for (int m = 0; m < 4; ++m)
#pragma unroll
                    for (int n = 0; n < 2; ++n) acc[a][b][m][n] = (f32x4){0.f, 0.f, 0.f, 0.f};
        cur = nxt; cA = nA; cB = nB; ++ui;
    }
    PG8_WAIT_V(0);
    if (wr == 0) PG8_BAR;
    PG8_BAR;
#undef PG8_SA
#undef PG8_SB
#undef PG8_STAGE
#undef PG8_LDA
#undef PG8_LDB
#undef PG8_MMA
#undef PG8_WAIT_V
#undef PG8_WAIT_L
#undef PG8_BAR
#undef PG8_SCHED
}
}

typedef unsigned u32x2_t __attribute__((ext_vector_type(2)));
typedef short bf16x8_t __attribute__((ext_vector_type(8)));
typedef float f32x16 __attribute__((ext_vector_type(16)));
typedef float f32x16f __attribute__((ext_vector_type(16)));
constexpr int LDP = 136;
template <int KSTEPS>
__device__ __forceinline__ f32x16 mma32(int lane, const bf16_t* As, int lda, const bf16_t* Bs, int ldb, f32x16 acc) {
    const int r = lane & 31, hh = lane >> 5;
    const bf16_t* ap = As + r * lda + 8 * hh;
    const bf16_t* bp = Bs + r * ldb + 8 * hh;
#pragma unroll 2
    for (int ks = 0; ks < KSTEPS; ks++) {
        const bf16x8_t a = *(const bf16x8_t*)(ap + ks * 16);
        const bf16x8_t b = *(const bf16x8_t*)(bp + ks * 16);
        acc = __builtin_amdgcn_mfma_f32_32x32x16_bf16(a, b, acc, 0, 0, 0);
    }
    return acc;
}
#define CROW(reg, hf) (((reg) & 3) + 8 * ((reg) >> 2) + 4 * (hf))
__device__ __forceinline__ float bf2f(unsigned short b) { return __uint_as_float(((unsigned)b) << 16); }

template <class PT>
__device__ __forceinline__ void ph_convert_weights(const PT& p) {
    const int TIDX = tid_opaque();
    const int lane = TIDX & 63, wave = TIDX >> 6, nl = lane & 31, kh = lane >> 5;
    constexpr int G_INE = EVEN_IN / 32, G_INO = ODD_PAD / 32, G_OUT = 2 * D / 32, G_GU = 64 * 2048 / 32, G_DN = 64 * 1024 / 32;
    constexpr int GT = G_INE + G_INO + G_OUT + G_GU + G_DN;
    for (int it = blockIdx.x * NWAVE + wave; it < GT * 16; it += gridDim.x * NWAVE) {
        const int item = __builtin_amdgcn_readfirstlane(it);
        int g = item % GT; const int kg = item / GT;
        const float* src; bf16_t* dst; int N, col0, nvalid;
        if (g < G_INE) { src = p.in[I_WINE]; N = EVEN_IN; col0 = g * 32; nvalid = EVEN_IN; dst = wsp<bf16_t>(p, OFF_WINE) + (size_t)g * 32 * 1024; }
        else if ((g -= G_INE) < G_INO) { src = p.in[I_WINO]; N = ODD_IN; col0 = g * 32; nvalid = ODD_IN; dst = wsp<bf16_t>(p, OFF_WINO) + (size_t)g * 32 * 1024; }
        else if ((g -= G_INO) < G_OUT) { const int l = g / 32, gg = g % 32; src = p.in[I_WOUT] + (size_t)l * D * D; N = D; col0 = gg * 32; nvalid = D; dst = wsp<bf16_t>(p, OFF_WOUT) + ((size_t)l * 1024 + gg * 32) * 1024; }
        else if ((g -= G_OUT) < G_GU) { const int le = g / 64, gg = g % 64, drow = gg * 32, T = drow >> 8, within = drow & 255;
            src = p.in[I_WGU] + (size_t)le * 1024 * 2048; N = 2048; nvalid = 2048;
            col0 = within < 128 ? 128 * T + within : 1024 + 128 * T + (within - 128);
            dst = wsp<bf16_t>(p, OFF_WGU) + ((size_t)le * 2048 + drow) * 1024; }
        else { g -= G_GU; const int le = g / 32, gg = g % 32; src = p.in[I_WDN] + (size_t)le * 1024 * 1024; N = 1024; col0 = gg * 32; nvalid = 1024; dst = wsp<bf16_t>(p, OFF_WDN) + ((size_t)le * 1024 + gg * 32) * 1024; }
        const bool ok = col0 + nl < nvalid;
        const float* sp = src + (size_t)(kg * 64 + kh * 8) * N + col0 + nl;
        float a[4][8];
#pragma unroll
        for (int ch = 0; ch < 4; ch++)
#pragma unroll
            for (int q = 0; q < 8; q++) a[ch][q] = ok ? sp[(size_t)(16 * ch + q) * N] : 0.f;
#pragma unroll
        for (int ch = 0; ch < 4; ch++) {
            pg8::u32x4 w; w.x = pack_bf16(a[ch][0], a[ch][1]); w.y = pack_bf16(a[ch][2], a[ch][3]); w.z = pack_bf16(a[ch][4], a[ch][5]); w.w = pack_bf16(a[ch][6], a[ch][7]);
            *(pg8::u32x4*)(dst + (size_t)nl * 1024 + kg * 64 + 16 * ch + kh * 8) = w;
        }
    }
}

template <class AL, class BL, class EP>
__device__ __forceinline__ void gemm_tile_f32(int wave_id, float* lds, int K, AL aload, BL bload, EP epi) {
    const int TIDX = tid_of_wave(wave_id);
    float(*As)[132] = (float(*)[132])lds;
    float(*Bs)[132] = (float(*)[132])(lds + 16 * 132);
    const int tid = TIDX, tx = tid & 15, ty = tid >> 4;
    float acc[4][8];
#pragma unroll
    for (int i = 0; i < 4; i++)
#pragma unroll
        for (int j = 0; j < 8; j++) acc[i][j] = 0.f;
    for (int k0 = 0; k0 < K; k0 += 16) {
        float av[4], bv[4];
#pragma unroll
        for (int i = 0; i < 4; i++) av[i] = aload((tid >> 4) + 32 * i, k0 + (tid & 15));
#pragma unroll
        for (int i = 0; i < 4; i++) bv[i] = bload(k0 + (tid >> 7) + 4 * i, tid & 127);
        __syncthreads();
#pragma unroll
        for (int i = 0; i < 4; i++) As[tid & 15][(tid >> 4) + 32 * i] = av[i];
#pragma unroll
        for (int i = 0; i < 4; i++) Bs[(tid >> 7) + 4 * i][tid & 127] = bv[i];
        __syncthreads();
#pragma unroll
        for (int k = 0; k < 16; k++) {
            const float4 a = *(const float4*)&As[k][ty * 4];
            const float4 b0 = *(const float4*)&Bs[k][tx * 4];
            const float4 b1 = *(const float4*)&Bs[k][64 + tx * 4];
            const float aa[4] = {a.x, a.y, a.z, a.w};
            const float bb[8] = {b0.x, b0.y, b0.z, b0.w, b1.x, b1.y, b1.z, b1.w};
#pragma unroll
            for (int i = 0; i < 4; i++)
#pragma unroll
                for (int j = 0; j < 8; j++) acc[i][j] = fmaf(aa[i], bb[j], acc[i][j]);
        }
    }
    __syncthreads();
#pragma unroll
    for (int i = 0; i < 4; i++) epi(ty * 4 + i, tx, acc[i]);
}
__device__ __forceinline__ int lcol(int tx, int jc) { return tx * 4 + (jc & 3) + 64 * (jc >> 2); }

template <class EP>
__device__ __forceinline__ void gemm_dense(int wave_id, float* lds, const float* A, int lda, const float* B, int N, int M, int K, EP epi) {
    const int tm = M / 128, tn = (N + 127) / 128;
    for (int t = blockIdx.x; t < tm * tn; t += gridDim.x) {
        const int m0 = (t / tn) * 128, n0 = (t % tn) * 128;
        gemm_tile_f32(
            wave_id, lds, K, [&](int r, int k) { return A[(size_t)(m0 + r) * lda + k]; },
            [&](int k, int c) { return (n0 + c < N) ? B[(size_t)k * N + n0 + c] : 0.f; },
            [&](int r, int tx, const float(&a)[8]) {
#pragma unroll
                for (int jc = 0; jc < 8; jc++) {
                    const int c = n0 + lcol(tx, jc);
                    if (c < N) epi(m0 + r, c, a[jc]);
                }
            });
    }
}

template <class PT>
__device__ __forceinline__ void ph_prologue(const PT& p, float* lds) {
    const int TIDX = tid_opaque();
    const int tid = TIDX, lane = tid & 63, wave = tid >> 6;
    const int gthreads = gridDim.x * NT, gtid = blockIdx.x * NT + tid;
    float* mod = wsp<float>(p, OFF_MOD);
    {
        float* sc = lds + 1024;
        float* red = lds + 3072;
        for (int k = tid; k < 1024; k += NT) { sc[k] = silu_f(p.in[I_C][k]); sc[1024 + k] = silu_f(p.in[I_CCTX][k]); }
        __syncthreads();
        for (int it = blockIdx.x; it < 2 * 96; it += gridDim.x) {
            const int layer = it / 96, n = (it % 96) * 64 + lane;
            const float* w = p.in[I_ADAW] + (size_t)layer * 1024 * 6144 + (size_t)wave * 128 * 6144 + n;
            float a0 = 0.f, a1 = 0.f;
#pragma unroll 8
            for (int k = 0; k < 128; k++) {
                const float wv = w[(size_t)k * 6144];
                a0 = fmaf(sc[wave * 128 + k], wv, a0);
                a1 = fmaf(sc[1024 + wave * 128 + k], wv, a1);
            }
            red[(wave * 2 + 0) * 64 + lane] = a0;
            red[(wave * 2 + 1) * 64 + lane] = a1;
            __syncthreads();
            if (wave < 2) {
                float a = p.in[I_ADAB][layer * 6144 + n];
#pragma unroll
                for (int w8 = 0; w8 < 8; w8++) a += red[(w8 * 2 + wave) * 64 + lane];
                mod[(layer * 2 + wave) * 6144 + n] = a;
            }
            __syncthreads();
        }
    }
    for (int it = gtid; it < 4096; it += gthreads) {
        const int pos = it >> 4, i = it & 15;
        const float ang = (float)pos * powf(10000.f, -(float)i / 16.f);
        wsp<float2>(p, OFF_ROPE)[it] = make_float2(cosf(ang), sinf(ang));
    }
    for (int it = gtid; it < 512; it += gthreads) {
        const float b0 = p.in[I_HGLB][it], b1 = p.in[I_HGLB][512 + it];
        wsp<float>(p, OFF_LB)[it] = 1.f / (1.f + expf(b0 - b1));
    }
    float* zb = lds + wave * 64;
    float* hd3 = wsp<float>(p, OFF_HD3);
    const float fq = p.in[I_HYFREQ][lane];
    float w1r[33], w2r[64], w3r[64];
#pragma unroll
    for (int i = 0; i < 33; i++) w1r[i] = p.in[I_HYW1][i * 64 + lane];
#pragma unroll
    for (int i = 0; i < 64; i++) { w2r[i] = p.in[I_HYW2][i * 64 + lane]; w3r[i] = p.in[I_HYW3][i * 64 + lane]; }
    const float b1 = p.in[I_HYB1][lane], b2 = p.in[I_HYB2][lane], b3 = p.in[I_HYB3][lane];
    for (int row = blockIdx.x * NWAVE + wave; row < R; row += gridDim.x * NWAVE) {
        const int Ls = row < L ? L : NCX, t = row < L ? row : row - L;
        const float tn = (float)t / (float)(Ls - 1);
        const float wang = 6.283185307179586f * (float)t / (float)Ls;
        if (lane < 33) {
            float z;
            if (lane == 0) z = tn;
            else {
                const int b = (lane - 1) & 15;
                const float fr = 1e-4f + (float)b * ((15.f - 1e-4f) / 15.f);
                z = (lane <= 16) ? cosf(fr * wang) : -sinf(fr * wang);
            }
            zb[lane] = z;
        }
        __builtin_amdgcn_wave_barrier();
        float a = b1;
#pragma unroll
        for (int i = 0; i < 33; i++) a = fmaf(zb[i], w1r[i], a);
        float h = sinf(fq * a);
        __builtin_amdgcn_wave_barrier();
        zb[lane] = h;
        __builtin_amdgcn_wave_barrier();
        a = b2;
#pragma unroll
        for (int i = 0; i < 64; i++) a = fmaf(zb[i], w2r[i], a);
        h = sinf(fq * a);
        __builtin_amdgcn_wave_barrier();
        zb[lane] = h;
        __builtin_amdgcn_wave_barrier();
        a = b3;
#pragma unroll
        for (int i = 0; i < 64; i++) a = fmaf(zb[i], w3r[i], a);
        h = sinf(fq * a);
        hd3[(size_t)row * 64 + lane] = h;
        __builtin_amdgcn_wave_barrier();
    }
}

template <bool ROUTER>
__device__ __forceinline__ void prep_rows(const Params& p, float* lds, const float* xl, const float* xc, int nrows, const float* g, int layer, int j) {
    const int TIDX = tid_of_wave(p.wave_id);
    const int lane = TIDX & 63, wave = TIDX >> 6;
    float* rwT = lds;
    int* lcnt = (int*)(lds + 32 * 1024);
    if (ROUTER) {
        __syncthreads();
        if (TIDX < 32) lcnt[TIDX] = 0;
        const float* rw = p.in[I_RW] + (size_t)layer * 1024 * 32;
#pragma unroll 4
        for (int idx = TIDX; idx < 1024 * 8; idx += NT) {
            const int c = idx >> 3, e4 = (idx & 7) * 4;
            const float4 w = *(const float4*)(rw + (size_t)c * 32 + e4);
            rwT[(e4 + 0) * 1024 + c] = w.x; rwT[(e4 + 1) * 1024 + c] = w.y; rwT[(e4 + 2) * 1024 + c] = w.z; rwT[(e4 + 3) * 1024 + c] = w.w;
        }
        __syncthreads();
    }
    bf16_t* HB = wsp<bf16_t>(p, OFF_HB);
    for (int r = blockIdx.x * NWAVE + wave; r < nrows; r += gridDim.x * NWAVE) {
        const float* src = r < L ? xl + (size_t)r * D : xc + (size_t)(r - L) * D;
        const float* md = modp(p, layer, r < L ? 0 : 1, j);
        float4 v[4];
        float ss = 0.f;
#pragma unroll
        for (int i = 0; i < 4; i++) { v[i] = *(const float4*)(src + 256 * i + 4 * lane); ss += v[i].x * v[i].x + v[i].y * v[i].y + v[i].z * v[i].z + v[i].w * v[i].w; }
        ss = wave_sum(lane, ss);
        const float rinv = rsqrtf(ss * (1.f / 1024.f) + EPS);
#pragma unroll
        for (int i = 0; i < 4; i++) {
            const int c = 256 * i + 4 * lane;
            const float4 g4 = *(const float4*)(g + c), sc4 = *(const float4*)(md + 1024 + c), sh4 = *(const float4*)(md + c);
            v[i].x = v[i].x * rinv * g4.x * (1.f + sc4.x) + sh4.x; v[i].y = v[i].y * rinv * g4.y * (1.f + sc4.y) + sh4.y;
            v[i].z = v[i].z * rinv * g4.z * (1.f + sc4.z) + sh4.z; v[i].w = v[i].w * rinv * g4.w * (1.f + sc4.w) + sh4.w;
            u32x2_t o; o.x = pack_bf16(v[i].x, v[i].y); o.y = pack_bf16(v[i].z, v[i].w);
            *(u32x2_t*)(HB + (size_t)r * D + c) = o;
        }
        if (ROUTER) {
            float lg[32];
#pragma unroll
            for (int e = 0; e < 32; e++) {
                float a = 0.f;
#pragma unroll
                for (int i = 0; i < 4; i++) {
                    const float4 w = *(const float4*)(rwT + e * 1024 + 256 * i + 4 * lane);
                    a = fmaf(v[i].x, w.x, a); a = fmaf(v[i].y, w.y, a); a = fmaf(v[i].z, w.z, a); a = fmaf(v[i].w, w.w, a);
                }
                lg[e] = a;
                if ((e & 3) == 3) asm volatile("" ::: "memory");
            }
#pragma unroll
            for (int e = 0; e < 32; e++) lg[e] = wave_sum(lane, lg[e]) + p.in[I_RB][layer * 32 + e];
            unsigned used = 0u;
            float tv[4];
            int ti[4];
#pragma unroll
            for (int k = 0; k < 4; k++) {
                float best = -INFINITY;
                int bi = 0;
#pragma unroll
                for (int e = 0; e < 32; e++) {
                    const bool ok = !((used >> e) & 1u) && (lg[e] > best);
                    best = ok ? lg[e] : best;
                    bi = ok ? e : bi;
                }
                used |= 1u << bi;
                tv[k] = best;
                ti[k] = bi;
            }
            float es[4], den = 0.f;
#pragma unroll
            for (int k = 0; k < 4; k++) { es[k] = expf(tv[k] - tv[0]); den += es[k]; }
            if (lane < 4) {
                int e = ti[0];
                float gg = es[0];
#pragma unroll
                for (int k = 1; k < 4; k++) { e = (lane == k) ? ti[k] : e; gg = (lane == k) ? es[k] : gg; }
                const int pos = atomicAdd(&lcnt[e], 1);
                wsp<int>(p, OFF_TOPE)[r * 4 + lane] = e;
                wsp<float>(p, OFF_TOPG)[r * 4 + lane] = gg / den;
                wsp<int>(p, OFF_TOPP)[r * 4 + lane] = pos;
            }
        }
    }
    if (ROUTER) {
        __syncthreads();
        if (TIDX < 32) wsp<int>(p, OFF_BC)[((size_t)layer * 512 + blockIdx.x) * 32 + TIDX] = lcnt[TIDX];
    }
}

__device__ __forceinline__ void prep_router(const Params& p, unsigned char* smem, const float* xl, const float* xc, int nrows, const float* g, int layer, int j) {
    const int TIDX = tid_of_wave(p.wave_id);
    const int tid = TIDX, lane = tid & 63, wave = tid >> 6, hf = lane >> 5;
    float* HTl = (float*)smem;
    int* lcnt = (int*)(smem + 32 * 1028 * 4);
    float* LGT = (float*)(smem + 32 * 1028 * 4 + 128);
    const float* rw = p.in[I_RW] + (size_t)layer * 1024 * 32;
    const float* rb = p.in[I_RB] + layer * 32;
    bf16_t* HB = wsp<bf16_t>(p, OFF_HB);
    if (tid < 32) lcnt[tid] = 0;
    for (int grp = blockIdx.x; grp < nrows / 32; grp += gridDim.x) {
        __syncthreads();
#pragma unroll
        for (int q = 0; q < 4; q++) {
            const int rl = wave * 4 + q, r = grp * 32 + rl;
            const float* src = r < L ? xl + (size_t)r * D : xc + (size_t)(r - L) * D;
            const float* md = modp(p, layer, r < L ? 0 : 1, j);
            float4 v[4];
            float ss = 0.f;
#pragma unroll
            for (int i = 0; i < 4; i++) { v[i] = *(const float4*)(src + 256 * i + 4 * lane); ss += v[i].x * v[i].x + v[i].y * v[i].y + v[i].z * v[i].z + v[i].w * v[i].w; }
            ss = wave_sum(lane, ss);
            const float rinv = rsqrtf(ss * (1.f / 1024.f) + EPS);
#pragma unroll
            for (int i = 0; i < 4; i++) {
                const int c = 256 * i + 4 * lane;
                const float4 g4 = *(const float4*)(g + c), sc4 = *(const float4*)(md + 1024 + c), sh4 = *(const float4*)(md + c);
                v[i].x = v[i].x * rinv * g4.x * (1.f + sc4.x) + sh4.x; v[i].y = v[i].y * rinv * g4.y * (1.f + sc4.y) + sh4.y;
                v[i].z = v[i].z * rinv * g4.z * (1.f + sc4.z) + sh4.z; v[i].w = v[i].w * rinv * g4.w * (1.f + sc4.w) + sh4.w;
                u32x2_t o; o.x = pack_bf16(v[i].x, v[i].y); o.y = pack_bf16(v[i].z, v[i].w);
                *(u32x2_t*)(HB + (size_t)r * D + c) = o;
                *(float4*)(HTl + rl * 1028 + c) = v[i];
            }
        }
        __syncthreads();
        f32x16f acc;
#pragma unroll
        for (int q = 0; q < 16; q++) acc[q] = 0.f;
        {
            const float* ap = HTl + (lane & 31) * 1028 + wave * 128 + hf;
            const float* bp = rw + (size_t)(wave * 128 + hf) * 32 + (lane & 31);
#pragma unroll 16
            for (int kk = 0; kk < 64; kk++) acc = __builtin_amdgcn_mfma_f32_32x32x2f32(ap[2 * kk], bp[(size_t)kk * 64], acc, 0, 0, 0);
        }
        __syncthreads();
        {
            float* part = HTl + wave * 1024 + (lane & 31);
#pragma unroll
            for (int q = 0; q < 16; q++) part[CROW(q, hf) * 32] = acc[q];
        }
        __syncthreads();
#pragma unroll
        for (int q = 0; q < 2; q++) {
            const int o = tid + 512 * q;
            float a = rb[o & 31];
#pragma unroll
            for (int w8 = 0; w8 < 8; w8++) a += HTl[w8 * 1024 + o];
            LGT[(o >> 5) * 33 + (o & 31)] = a;
        }
        __syncthreads();
        if (tid < 32) {
            const int r = grp * 32 + tid;
            float lg[32];
#pragma unroll
            for (int e = 0; e < 32; e++) lg[e] = LGT[tid * 33 + e];
            unsigned used = 0u;
            float tv[4];
            int ti[4];
#pragma unroll
            for (int k = 0; k < 4; k++) {
                float best = -INFINITY;
                int bi = 0;
#pragma unroll
                for (int e = 0; e < 32; e++) {
                    const bool ok = !((used >> e) & 1u) && (lg[e] > best);
                    best = ok ? lg[e] : best;
                    bi = ok ? e : bi;
                }
                used |= 1u << bi;
                tv[k] = best;
                ti[k] = bi;
            }
            float es[4], den = 0.f;
#pragma unroll
            for (int k = 0; k < 4; k++) { es[k] = expf(tv[k] - tv[0]); den += es[k]; }
            const float rden = 1.f / den;
            int pos[4];
#pragma unroll
            for (int k = 0; k < 4; k++) pos[k] = atomicAdd(&lcnt[ti[k]], 1);
            *(int4*)(wsp<int>(p, OFF_TOPE) + r * 4) = make_int4(ti[0], ti[1], ti[2], ti[3]);
            *(float4*)(wsp<float>(p, OFF_TOPG) + r * 4) = make_float4(es[0] * rden, es[1] * rden, es[2] * rden, es[3] * rden);
            *(int4*)(wsp<int>(p, OFF_TOPP) + r * 4) = make_int4(pos[0], pos[1], pos[2], pos[3]);
        }
    }
    __syncthreads();
    if (tid < 32) wsp<int>(p, OFF_BC)[((size_t)layer * 512 + blockIdx.x) * 32 + tid] = lcnt[tid];
}

__device__ __forceinline__ void ph_filter_gemm_ctx(const Params& p, float* lds) {
    const float* hd3 = wsp<float>(p, OFF_HD3) + (size_t)L * 64;
    float* hhc = wsp<float>(p, OFF_HHC);
    const float mind = logf(1e-2f) / 1.5f, maxd = logf(1e-2f) / 0.3f;
    gemm_dense(p.wave_id, lds, hd3, 64, p.in[I_HYW4], 2048, NCX, 64, [&](int t, int col, float v) {
        const int o = col >> 10, side = (col >> 9) & 1, ch = col & 511;
        const float delta = fabsf(mind + (float)ch * ((maxd - mind) / 511.f));
        const float tn = (float)t / (float)(NCX - 1);
        const float val = v * expf(-tn * delta);
        if (side == 0) hhc[(size_t)(NCX + t) * 1024 + o * 512 + ch] = val;
        else if (t > 0) hhc[(size_t)(NCX - t) * 1024 + o * 512 + ch] = val;
        else hhc[o * 512 + ch] = 0.f;
    });
}
__device__ __forceinline__ void ph_filter_abs_ctx(const Params& p) {
    const int TIDX = tid_of_wave(p.wave_id);
    const float* hhc = wsp<float>(p, OFF_HHC);
    float* hnp = wsp<float>(p, OFF_HNP);
    for (int it = blockIdx.x; it < 4; it += gridDim.x) {
        const int chunk = it >> 1, col = (it & 1) * 512 + TIDX;
        const float* src = hhc + (size_t)chunk * 256 * 1024;
        float s = 0.f;
        for (int i = 0; i < 256; i++) s += fabsf(src[(size_t)i * 1024 + col]);
        hnp[(128 + chunk) * 1024 + col] = s;
    }
}
__device__ __forceinline__ void ph_filter_gemm_lat(const Params& p, unsigned char* smem) {
    const int TIDX = tid_of_wave(p.wave_id);
    float* As = (float*)smem;
    float* Bs = As + 64 * 132;
    const float* hd3 = wsp<float>(p, OFF_HD3);
    const float* w4 = p.in[I_HYW4];
    float* HT = wsp<float>(p, OFF_HT);
    const float mind = logf(1e-2f) / 1.5f, maxd = logf(1e-2f) / 0.3f;
    const int tid = TIDX, lane = tid & 63, wave = tid >> 6, hf = lane >> 5;
    for (int it = blockIdx.x; it < 16 * 128; it += gridDim.x) {
        const int c0 = (it & 15) * 128, t0 = (it >> 4) * 128;
        float av[16], bv[16];
#pragma unroll
        for (int q = 0; q < 16; q++) { const int idx = tid + 512 * q; av[q] = w4[(size_t)(idx >> 7) * 2048 + c0 + (idx & 127)]; bv[q] = hd3[(size_t)(t0 + (idx >> 6)) * 64 + (idx & 63)]; }
        __syncthreads();
#pragma unroll
        for (int q = 0; q < 16; q++) { const int idx = tid + 512 * q; As[(idx >> 7) * 132 + (idx & 127)] = av[q]; Bs[(idx & 63) * 132 + (idx >> 6)] = bv[q]; }
        __syncthreads();
        const int mt = wave >> 1, nt0 = (wave & 1) * 2;
        f32x16f acc0, acc1;
#pragma unroll
        for (int q = 0; q < 16; q++) { acc0[q] = 0.f; acc1[q] = 0.f; }
        const float* ap = As + hf * 132 + mt * 32 + (lane & 31);
        const float* bp = Bs + hf * 132 + nt0 * 32 + (lane & 31);
#pragma unroll 4
        for (int k0 = 0; k0 < 64; k0 += 2) {
            const float a = ap[k0 * 132], b0 = bp[k0 * 132], b1 = bp[k0 * 132 + 32];
            acc0 = __builtin_amdgcn_mfma_f32_32x32x2f32(a, b0, acc0, 0, 0, 0);
            acc1 = __builtin_amdgcn_mfma_f32_32x32x2f32(a, b1, acc1, 0, 0, 0);
        }
#pragma unroll
        for (int t2 = 0; t2 < 2; t2++) {
            const int t = t0 + (nt0 + t2) * 32 + (lane & 31);
            const float tn = (float)t / (float)(L - 1);
            int cb = c0 + mt * 32 + 4 * hf;
            asm volatile("" : "+v"(cb));
#pragma unroll
            for (int q = 0; q < 16; q++) {
                const int col = cb + (q & 3) + 8 * (q >> 2), ch = col & 511;
                const float delta = fabsf(mind + (float)ch * ((maxd - mind) / 511.f));
                HT[(size_t)col * L + t] = (t2 == 0 ? acc0[q] : acc1[q]) * __expf(-tn * delta);
            }
        }
    }
}

__device__ __forceinline__ float2 cmul(float2 a, float2 b) { return make_float2(a.x * b.x - a.y * b.y, a.x * b.y + a.y * b.x); }
__device__ __forceinline__ float2 cadd(float2 a, float2 b) { return make_float2(a.x + b.x, a.y + b.y); }
__device__ __forceinline__ float2 csub(float2 a, float2 b) { return make_float2(a.x - b.x, a.y - b.y); }
__device__ __forceinline__ float2 cconj(float2 a) { return make_float2(a.x, -a.y); }
__device__ __forceinline__ float2 twid(float frac) { return make_float2(__builtin_amdgcn_cosf(frac), -__builtin_amdgcn_sinf(frac)); }
constexpr int FM = 16384;
__device__ __forceinline__ int fphys(int j) { return j + (j >> 4); }
constexpr int FX_BYTES = (FM + FM / 16) * 8;
__device__ __forceinline__ void dft4(float2& x0, float2& x1, float2& x2, float2& x3) {
    const float2 y0 = cadd(x0, x2), y1 = csub(x0, x2), y2 = cadd(x1, x3), t = csub(x1, x3), y3 = make_float2(t.y, -t.x);
    x0 = cadd(y0, y2); x1 = cadd(y1, y3); x2 = csub(y0, y2); x3 = csub(y1, y3);
}
template <int LP>
__device__ __forceinline__ void fft_pass8(float2* X, int tid) {
    constexpr int pp = 1 << LP;
    float2 u[4][8];
    float2* xb0 = X + fphys(tid);
    float2* xb1 = xb0 + 6144;
    float2* xb2 = xb0 + 12288;
    asm volatile("" : "+v"(xb1), "+v"(xb2));
#define XR(off) ((off) < 6144 ? xb0[(off)] : ((off) < 12288 ? xb1[(off) - 6144] : xb2[(off) - 12288]))
#pragma unroll
    for (int b = 0; b < 4; b++)
#pragma unroll
        for (int r = 0; r < 8; r++) u[b][r] = XR(544 * b + 2176 * r);
    __syncthreads();
#pragma unroll
    for (int b = 0; b < 4; b++) {
        const int i = tid + 512 * b, k = i & (pp - 1), j = ((i - k) << 3) + k;
        const float2 w1 = twid(ldexpf((float)k, -(LP + 3)));
        const float2 w2 = cmul(w1, w1), w3 = cmul(w2, w1), w4 = cmul(w2, w2), w5 = cmul(w4, w1), w6 = cmul(w4, w2), w7 = cmul(w4, w3);
        const float2 u0 = u[b][0], u1 = cmul(u[b][1], w1), u2 = cmul(u[b][2], w2), u3 = cmul(u[b][3], w3);
        const float2 u4 = cmul(u[b][4], w4), u5 = cmul(u[b][5], w5), u6 = cmul(u[b][6], w6), u7 = cmul(u[b][7], w7);
        float2 a0 = cadd(u0, u4), a1 = cadd(u1, u5), a2 = cadd(u2, u6), a3 = cadd(u3, u7);
        float2 b0 = csub(u0, u4), t1 = csub(u1, u5), t2 = csub(u2, u6), t3 = csub(u3, u7);
        const float sq = 0.70710678118654752f;
        float2 b1 = make_float2(sq * (t1.x + t1.y), sq * (t1.y - t1.x));
        float2 b2 = make_float2(t2.y, -t2.x);
        float2 b3 = make_float2(sq * (t3.y - t3.x), -sq * (t3.x + t3.y));
        dft4(a0, a1, a2, a3);
        dft4(b0, b1, b2, b3);
        float2* yb = X + fphys(j);
#define FWO(r) ((r) * pp + (pp == 1 ? 0 : (pp == 8 ? ((r) >> 1) : (r) * pp / 16)))
        yb[FWO(0)] = a0; yb[FWO(1)] = b0; yb[FWO(2)] = a1; yb[FWO(3)] = b1; yb[FWO(4)] = a2; yb[FWO(5)] = b2; yb[FWO(6)] = a3; yb[FWO(7)] = b3;
#undef FWO
        __builtin_amdgcn_sched_barrier(0);
    }
    __syncthreads();
}
__device__ __forceinline__ void fft16k(float2* X, int tid) {
    asm volatile("" : "+v"(tid));
    fft_pass8<0>(X, tid); fft_pass8<3>(X, tid); fft_pass8<6>(X, tid); fft_pass8<9>(X, tid);
    float2* xb0 = X + fphys(tid);
    float2* xb1 = xb0 + 6144;
    float2* xb2 = xb0 + 12288;
    asm volatile("" : "+v"(xb1), "+v"(xb2));
#pragma unroll
    for (int b = 0; b < 8; b++) {
        const int i = tid + 512 * b;
        const float2 w1 = twid(ldexpf((float)i, -14));
        const float2 w2 = cmul(w1, w1), w3 = cmul(w2, w1);
        float2 x0 = XR(544 * b), x1 = cmul(XR(544 * b + 4352), w1), x2 = cmul(XR(544 * b + 8704), w2), x3 = cmul(XR(544 * b + 13056), w3);
        dft4(x0, x1, x2, x3);
        XR(544 * b) = x0; XR(544 * b + 4352) = x1; XR(544 * b + 8704) = x2; XR(544 * b + 13056) = x3;
        __builtin_amdgcn_sched_barrier(0);
    }
    __syncthreads();
#undef XR
}
__device__ __forceinline__ void ph_filter_fft(const Params& p, unsigned char* smem) {
    const int TIDX = tid_of_wave(p.wave_id);
    float2* X = (float2*)smem;
    float* red = (float*)(smem + FX_BYTES);
    const float* HT = wsp<float>(p, OFF_HT);
    float2* HF = wsp<float2>(p, OFF_HF);
    const int tid = TIDX, lane = tid & 63, wave = tid >> 6;
    constexpr int N2 = 2 * L;
    for (int it = blockIdx.x; it < 1024; it += gridDim.x) {
        const int o = it >> 9, ch = it & 511;
        const float* s0 = HT + ((size_t)(o * 2 + 0) * 512 + ch) * L;
        const float* s1 = HT + ((size_t)(o * 2 + 1) * 512 + ch) * L;
        __syncthreads();
        float sa = 0.f;
#pragma unroll 8
        for (int j = 0; j < 16; j++) {
            const int m = tid + 512 * j;
            const float2 v = *(const float2*)(s0 + 2 * m);
            sa += fabsf(v.x) + fabsf(v.y);
            X[fphys(m)] = v;
        }
#pragma unroll 8
        for (int j = 16; j < 32; j++) {
            const int m = tid + 512 * j;
            float2 v = make_float2(s1[N2 - 2 * m], s1[N2 - 2 * m - 1]);
            if (m == L / 2) v.x = 0.f;
            sa += fabsf(v.x) + fabsf(v.y);
            X[fphys(m)] = v;
        }
        sa = wave_sum(lane, sa);
        if (lane == 0) red[wave] = sa;
        __syncthreads();
        float nrm = 0.f;
#pragma unroll
        for (int w = 0; w < 8; w++) nrm += red[w];
        const float scale = 1.f / (nrm * (float)FM);
        fft16k(X, tid);
        float2* dst = HF + (size_t)it * FM;
#pragma unroll 1
        for (int k = tid; k <= FM / 2; k += 512) {
            if (k == 0) { const float2 b0 = X[0]; dst[0] = make_float2((b0.x + b0.y) * scale, (b0.x - b0.y) * scale); }
            else if (k == FM / 2) { const float2 b = X[fphys(k)]; dst[k] = make_float2(b.x * scale, -b.y * scale); }
            else {
                const float2 ak = X[fphys(k)], am = cconj(X[fphys(FM - k)]);
                const float2 e = make_float2(0.5f * (ak.x + am.x), 0.5f * (ak.y + am.y));
                const float2 od = make_float2(0.5f * (ak.x - am.x), 0.5f * (ak.y - am.y));
                const float2 oo = make_float2(od.y, -od.x);
                const float2 wo = cmul(twid(ldexpf((float)k, -15)), oo);
                const float2 hk = cadd(e, wo), hm = cconj(csub(e, wo));
                dst[k] = make_float2(hk.x * scale, hk.y * scale);
                dst[FM - k] = make_float2(hm.x * scale, hm.y * scale);
            }
        }
    }
}
__device__ __forceinline__ void hy_pw_pair(float2* X, const float2* __restrict__ HFc, int k) {
    const float2 hk = HFc[k], hm = HFc[FM - k];
    const float2 ak = X[fphys(k)], am = cconj(X[fphys(FM - k)]);
    const float2 e = make_float2(0.5f * (ak.x + am.x), 0.5f * (ak.y + am.y));
    const float2 od = make_float2(0.5f * (ak.x - am.x), 0.5f * (ak.y - am.y));
    const float2 oo = make_float2(od.y, -od.x);
    const float2 w = twid(ldexpf((float)k, -15));
    const float2 wo = cmul(w, oo);
    const float2 yk = cmul(cadd(e, wo), hk), ym = cmul(cconj(csub(e, wo)), hm);
    const float2 ymc = cconj(ym);
    const float2 P = make_float2(0.5f * (yk.x + ymc.x), 0.5f * (yk.y + ymc.y));
    const float2 Q = make_float2(0.5f * (yk.x - ymc.x), 0.5f * (yk.y - ymc.y));
    const float2 qw = cmul(Q, cconj(w));
    const float2 ck = make_float2(P.x - qw.y, P.y + qw.x);
    const float2 qcw = cmul(cconj(Q), w);
    const float2 cm = make_float2(P.x - qcw.y, -P.y + qcw.x);
    X[fphys(k)] = cconj(ck); X[fphys(FM - k)] = cconj(cm);
}
__device__ __forceinline__ void hy_pointwise(float2* X, const float2* __restrict__ HFc, int tid) {
    asm volatile("" : "+v"(tid));
#pragma unroll 5
    for (int j = 1; j < 16; j++) hy_pw_pair(X, HFc, tid + 512 * j);
    if (tid != 0) hy_pw_pair(X, HFc, tid);
    else {
        const float2 a0 = X[0], h = HFc[0];
        const float y0 = (a0.x + a0.y) * h.x, ym = (a0.x - a0.y) * h.y;
        X[0] = make_float2(0.5f * (y0 + ym), -0.5f * (y0 - ym));
        X[fphys(FM / 2)] = cmul(cconj(X[fphys(FM / 2)]), HFc[FM / 2]);
    }
}
__device__ __forceinline__ void ph_hyena_fft(const Params& p, unsigned char* smem) {
    const int TIDX = tid_of_wave(p.wave_id);
    float2* X = (float2*)smem;
    const float* UT = wsp<float>(p, OFF_U);
    const float2* HF = wsp<float2>(p, OFF_HF);
    unsigned* HYT = wsp<unsigned>(p, OFF_HYT);
    const int tid = TIDX;
    for (int ch = blockIdx.x; ch < 512; ch += gridDim.x) {
        float2 z[16];
#pragma unroll
        for (int j = 0; j < 16; j++) z[j] = ((const float2*)(UT + (size_t)ch * L))[tid + 512 * j];
#pragma unroll 1
        for (int o = 0; o < 2; o++) {
            __syncthreads();
#pragma unroll
            for (int j = 0; j < 16; j++) { X[fphys(tid + 512 * j)] = z[j]; X[fphys(8192 + tid + 512 * j)] = make_float2(0.f, 0.f); }
            __syncthreads();
            fft16k(X, tid);
            hy_pointwise(X, HF + (size_t)(o * 512 + ch) * FM, tid);
            __syncthreads();
            fft16k(X, tid);
            const float bias = p.in[I_HYFB][o * 512 + ch];
            const float2* gate = (const float2*)(UT + (size_t)(512 * (o + 1) + ch) * L);
#pragma unroll
            for (int j = 0; j < 16; j++) {
                const int m = tid + 512 * j;
                const float2 r = X[fphys(m)], g = gate[m];
                z[j] = make_float2(g.x * (r.x + z[j].x * bias), g.y * (-r.y + z[j].y * bias));
            }
        }
#pragma unroll
        for (int j = 0; j < 16; j++) HYT[(size_t)ch * (L / 2) + tid + 512 * j] = pack_bf16(z[j].x, z[j].y);
    }
}
__device__ __forceinline__ void ph_hy_transpose(const Params& p, unsigned char* smem) {
    const int TIDX = tid_of_wave(p.wave_id);
    bf16_t* T = (bf16_t*)smem;
    const bf16_t* HYT = wsp<bf16_t>(p, OFF_HYT);
    bf16_t* MB = wsp<bf16_t>(p, OFF_MB);
    const int tid = TIDX;
    for (int it = blockIdx.x; it < 8 * 256; it += gridDim.x) {
        const int c0 = (it & 7) * 64, t0 = (it >> 3) * 64;
        __syncthreads();
#pragma unroll
        for (int q = 0; q < 8; q++) { const int c = (tid >> 6) + 8 * q, t = tid & 63; T[c * 66 + t] = HYT[(size_t)(c0 + c) * L + t0 + t]; }
        __syncthreads();
#pragma unroll
        for (int q = 0; q < 8; q++) { const int t = (tid >> 6) + 8 * q, c = tid & 63; MB[(size_t)(t0 + t) * D + c0 + c] = T[c * 66 + t]; }
    }
}

__device__ __forceinline__ void ph_qk_dwconv(const Params& p) {
    const int TIDX = tid_of_wave(p.wave_id);
    const int lane = TIDX & 63, wave = TIDX >> 6;
    const bf16_t* P0 = wsp<bf16_t>(p, OFF_P);
    bf16_t* qn = wsp<bf16_t>(p, OFF_QN);
    bf16_t* kn = wsp<bf16_t>(p, OFF_KN);
    const float2* rope = wsp<float2>(p, OFF_ROPE);
    const float gk = p.in[I_KNORM][lane], gq = p.in[I_QNORM][lane];
    for (int r = blockIdx.x * NWAVE + wave; r < R; r += gridDim.x * NWAVE) {
        const bf16_t* pr = P0 + (size_t)r * EVEN_IN;
        float v[10];
#pragma unroll
        for (int s2 = 0; s2 < 10; s2++) v[s2] = bf2f(pr[(s2 < 2 ? s2 * 64 : 256 + (s2 - 2) * 64) + lane]);
        float2 cs = make_float2(1.f, 0.f);
        if (r < L) cs = rope[(lane < 32 ? (r >> 6) : (r & 63)) * 16 + (lane & 15)];
#pragma unroll
        for (int s2 = 0; s2 < 10; s2++) {
            const float ss = wave_sum(lane, v[s2] * v[s2]);
            float n = v[s2] * rsqrtf(ss * (1.f / 64.f) + EPS) * (s2 < 2 ? gk : gq);
            if (r < L) {
                const float partner = lane_xor(lane, n, 16);
                n = ((lane & 16) == 0) ? n * cs.x - partner * cs.y : partner * cs.y + n * cs.x;
            }
            if (s2 < 2) kn[(size_t)r * 128 + s2 * 64 + lane] = f2bf(n);
            else qn[(size_t)r * 512 + (s2 - 2) * 64 + lane] = f2bf(n * 0.125f);
        }
    }
    float* UC = wsp<float>(p, OFF_UC);
    const float* cw = p.in[I_HYCW];
    const float* cb = p.in[I_HYCB];
    for (int it = blockIdx.x * NT + TIDX; it < NCX * 1536; it += gridDim.x * NT) {
        const int r = L + it / 1536, c = it % 1536;
        float a = cb[c];
#pragma unroll
        for (int j = 0; j < 3; j++) {
            const int rr = r + j - 1;
            if (rr >= L && rr < R) a = fmaf(cw[j * 1536 + c], bf2f(P0[(size_t)rr * EVEN_IN + 768 + c]), a);
        }
        UC[it] = a;
    }
}
__device__ __forceinline__ void ph_dwconv_t(const Params& p, float* lds) {
    const int TIDX = tid_of_wave(p.wave_id);
    const bf16_t* P0 = wsp<bf16_t>(p, OFF_P);
    float* UT = wsp<float>(p, OFF_U);
    const float* cw = p.in[I_HYCW];
    const float* cb = p.in[I_HYCB];
    bf16_t* T = (bf16_t*)lds;
    const int tid = TIDX;
    for (int it = blockIdx.x; it < 24 * 128; it += gridDim.x) {
        const int c0 = (it % 24) * 64, t0 = (it / 24) * 128;
        __syncthreads();
        for (int v = tid; v < 130 * 8; v += NT) {
            const int row = v >> 3, c8 = (v & 7) * 8, t = t0 - 1 + row;
            pg8::u32x4 x = {0u, 0u, 0u, 0u};
            if (t >= 0 && t < L) x = *(const pg8::u32x4*)(P0 + (size_t)t * EVEN_IN + 768 + c0 + c8);
            *(pg8::u32x4*)(T + row * 72 + c8) = x;
        }
        __syncthreads();
#pragma unroll
        for (int ps = 0; ps < 4; ps++) {
            const int t4 = tid & 31, c = (tid >> 5) + 16 * ps;
            const float w0 = cw[c0 + c], w1 = cw[1536 + c0 + c], w2 = cw[3072 + c0 + c], bb = cb[c0 + c];
            const bf16_t* tp = T + (t4 * 4) * 72 + c;
            float x[6];
#pragma unroll
            for (int q = 0; q < 6; q++) x[q] = bf2f(tp[q * 72]);
            float4 o;
            o.x = fmaf(w0, x[0], fmaf(w1, x[1], fmaf(w2, x[2], bb)));
            o.y = fmaf(w0, x[1], fmaf(w1, x[2], fmaf(w2, x[3], bb)));
            o.z = fmaf(w0, x[2], fmaf(w1, x[3], fmaf(w2, x[4], bb)));
            o.w = fmaf(w0, x[3], fmaf(w1, x[4], fmaf(w2, x[5], bb)));
            *(float4*)(UT + (size_t)(c0 + c) * L + t0 + t4 * 4) = o;
        }
    }
}

__device__ __forceinline__ void ph_attention_mfma(const Params& p, unsigned char* smem) {
    const int TIDX = tid_of_wave(p.wave_id);
    bf16_t* Ks = (bf16_t*)smem;
    bf16_t* Vts = Ks + 64 * 72;
    const bf16_t* QN = wsp<bf16_t>(p, OFF_QN);
    const bf16_t* KN = wsp<bf16_t>(p, OFF_KN);
    const bf16_t* VB = wsp<bf16_t>(p, OFF_P) + 128;
    bf16_t* MB = wsp<bf16_t>(p, OFF_MB);
    const int tid = TIDX, lane = tid & 63, wave = tid >> 6, hf = lane >> 5, r = lane & 31;
    for (int it = blockIdx.x; it < 260; it += gridDim.x) {
        const bool isctx = it >= 256;
        const int qb = isctx ? (it - 256) >> 1 : it >> 1, kvh = it & 1;
        const int qrow0 = (isctx ? L : 0) + qb * 128;
        const int hq = kvh * 4 + (wave >> 1), qoff = (wave & 1) * 64;
        bf16x8_t qf[2][4];
#pragma unroll
        for (int b = 0; b < 2; b++)
#pragma unroll
            for (int ks = 0; ks < 4; ks++) qf[b][ks] = *(const bf16x8_t*)(QN + (size_t)(qrow0 + qoff + b * 32 + r) * 512 + hq * 64 + ks * 16 + 8 * hf);
        float mrun[2], lrun[2];
        mrun[0] = mrun[1] = p.in[I_SINK][hq];
        lrun[0] = lrun[1] = 1.f;
        f32x16 o[2][2];
#pragma unroll
        for (int dt = 0; dt < 2; dt++)
#pragma unroll
            for (int b = 0; b < 2; b++)
#pragma unroll
                for (int q = 0; q < 16; q++) o[dt][b][q] = 0.f;
        const int tlo = (!isctx && qb == 0) ? 6 : 4, thi = isctx ? 4 : ((qb == L / 128 - 1) ? 8 : 10);
        const int ntiles = 4 + (thi - tlo);
        const int kkey = tid >> 3, kd8 = (tid & 7) * 8, vkey = tid & 63, vd8 = (tid >> 6) * 8;
        pg8::u32x4 kreg, vreg;
        {
            const int krow0 = L;
            kreg = *(const pg8::u32x4*)(KN + (size_t)(krow0 + kkey) * 128 + kvh * 64 + kd8);
            vreg = *(const pg8::u32x4*)(VB + (size_t)(krow0 + vkey) * EVEN_IN + kvh * 64 + vd8);
        }
#pragma unroll 1
        for (int n = 0; n < ntiles; n++) {
            const int tix = n < 4 ? n : tlo + (n - 4);
            const bool local = tix >= 4;
            const int krow0 = local ? qb * 128 - 128 + (tix - 4) * 64 : L + tix * 64;
            __syncthreads();
            *(pg8::u32x4*)(Ks + kkey * 72 + kd8) = kreg;
            {
                bf16_t* dst = Vts + vd8 * 72 + vkey;
                dst[0] = (bf16_t)(vreg.x & 0xffff); dst[72] = (bf16_t)(vreg.x >> 16);
                dst[144] = (bf16_t)(vreg.y & 0xffff); dst[216] = (bf16_t)(vreg.y >> 16);
                dst[288] = (bf16_t)(vreg.z & 0xffff); dst[360] = (bf16_t)(vreg.z >> 16);
                dst[432] = (bf16_t)(vreg.w & 0xffff); dst[504] = (bf16_t)(vreg.w >> 16);
            }
            if (n + 1 < ntiles) {
                const int t2 = (n + 1) < 4 ? (n + 1) : tlo + (n + 1 - 4);
                const int kr2 = t2 >= 4 ? qb * 128 - 128 + (t2 - 4) * 64 : L + t2 * 64;
                kreg = *(const pg8::u32x4*)(KN + (size_t)(kr2 + kkey) * 128 + kvh * 64 + kd8);
                vreg = *(const pg8::u32x4*)(VB + (size_t)(kr2 + vkey) * EVEN_IN + kvh * 64 + vd8);
            }
            __syncthreads();
            f32x16 sc[2][2];
#pragma unroll
            for (int a = 0; a < 2; a++)
#pragma unroll
                for (int b = 0; b < 2; b++) {
#pragma unroll
                    for (int q = 0; q < 16; q++) sc[a][b][q] = 0.f;
#pragma unroll
                    for (int ks = 0; ks < 4; ks++) {
                        const bf16x8_t kf = *(const bf16x8_t*)(Ks + (a * 32 + r) * 72 + ks * 16 + 8 * hf);
                        sc[a][b] = __builtin_amdgcn_mfma_f32_32x32x16_bf16(kf, qf[b][ks], sc[a][b], 0, 0, 0);
                    }
                }
#pragma unroll
            for (int b = 0; b < 2; b++) {
                const int qpos = qb * 128 + qoff + b * 32 + r;
                float mx = mrun[b];
#pragma unroll
                for (int a = 0; a < 2; a++)
#pragma unroll
                    for (int q = 0; q < 16; q++) {
                        if (local) {
                            const int kpos = krow0 + a * 32 + CROW(q, hf);
                            const int dd = kpos - qpos;
                            const bool ok = kpos >= 0 && kpos < L && dd <= 128 && dd >= -128;
                            sc[a][b][q] = ok ? sc[a][b][q] : -INFINITY;
                        }
                        mx = fmaxf(mx, sc[a][b][q]);
                    }
                mx = fmaxf(mx, lane_xor(lane, mx, 32));
                const float corr = __expf(mrun[b] - mx);
                mrun[b] = mx;
                float sum = 0.f;
#pragma unroll
                for (int a = 0; a < 2; a++)
#pragma unroll
                    for (int q = 0; q < 16; q++) { const float pv = __expf(sc[a][b][q] - mx); sc[a][b][q] = pv; sum += pv; }
                sum += lane_xor(lane, sum, 32);
                lrun[b] = lrun[b] * corr + sum;
#pragma unroll
                for (int dt = 0; dt < 2; dt++)
#pragma unroll
                    for (int q = 0; q < 16; q++) o[dt][b][q] *= corr;
            }
#pragma unroll
            for (int a = 0; a < 2; a++)
#pragma unroll
                for (int si = 0; si < 2; si++) {
                    bf16x8_t pf[2];
#pragma unroll
                    for (int b = 0; b < 2; b++) {
                        pg8::u32x4 w;
                        w.x = pack_bf16(sc[a][b][8 * si + 0], sc[a][b][8 * si + 1]); w.y = pack_bf16(sc[a][b][8 * si + 2], sc[a][b][8 * si + 3]);
                        w.z = pack_bf16(sc[a][b][8 * si + 4], sc[a][b][8 * si + 5]); w.w = pack_bf16(sc[a][b][8 * si + 6], sc[a][b][8 * si + 7]);
                        pf[b] = __builtin_bit_cast(bf16x8_t, w);
                    }
#pragma unroll
                    for (int dt = 0; dt < 2; dt++) {
                        const bf16_t* vp = Vts + (dt * 32 + r) * 72 + a * 32 + 16 * si + 4 * hf;
                        const u32x2_t lo = *(const u32x2_t*)vp, hi = *(const u32x2_t*)(vp + 8);
                        pg8::u32x4 w; w.x = lo.x; w.y = lo.y; w.z = hi.x; w.w = hi.y;
                        const bf16x8_t vf = __builtin_bit_cast(bf16x8_t, w);
#pragma unroll
                        for (int b = 0; b < 2; b++) o[dt][b] = __builtin_amdgcn_mfma_f32_32x32x16_bf16(vf, pf[b], o[dt][b], 0, 0, 0);
                    }
                }
        }
#pragma unroll
        for (int b = 0; b < 2; b++) {
            const float rl = 1.f / lrun[b];
            bf16_t* dst = MB + (size_t)(qrow0 + qoff + b * 32 + r) * D + 512 + hq * 64 + 4 * hf;
#pragma unroll
            for (int dt = 0; dt < 2; dt++)
#pragma unroll
                for (int q4 = 0; q4 < 4; q4++) {
                    u32x2_t w;
                    w.x = pack_bf16(o[dt][b][4 * q4 + 0] * rl, o[dt][b][4 * q4 + 1] * rl);
                    w.y = pack_bf16(o[dt][b][4 * q4 + 2] * rl, o[dt][b][4 * q4 + 3] * rl);
                    *(u32x2_t*)(dst + dt * 32 + 8 * q4) = w;
                }
        }
    }
}

__device__ __forceinline__ void ph_hyena_conv(const Params& p, int o) {
    const int TIDX = tid_of_wave(p.wave_id);
    const int lane = TIDX & 63, wave = TIDX >> 6;
    const float* U = wsp<float>(p, OFF_UC) - (size_t)L * 1536;
    const float* hnp = wsp<float>(p, OFF_HNP);
    float* Z1 = wsp<float>(p, OFF_Z1);
    const float* zin = o == 0 ? U : Z1;
    const int zld = o == 0 ? 1536 : 512;
    const int nlat = 8 * (L / 64), nctx = 8 * (NCX / 64);
    for (int it = nlat + blockIdx.x; it < nlat + nctx; it += gridDim.x) {
        const bool lat = it < nlat;
        const int ii = lat ? it : it - nlat;
        const int Ls = lat ? L : NCX, base = lat ? 0 : L;
        const int ch = (ii & 7) * 64 + lane, t0 = (ii >> 3) * 64 + wave * 8;
        const float* hf = (lat ? wsp<float>(p, OFF_HH) : wsp<float>(p, OFF_HHC)) + o * 512 + ch;
        float nrm = 0.f;
        if (lat) { for (int c = 0; c < 128; c++) nrm += hnp[c * 1024 + o * 512 + ch]; }
        else { nrm = hnp[128 * 1024 + o * 512 + ch] + hnp[129 * 1024 + o * 512 + ch]; }
        float acc[8];
#pragma unroll
        for (int i = 0; i < 8; i++) acc[i] = 0.f;
#pragma unroll 4
        for (int s0 = 0; s0 < Ls; s0 += 8) {
            float zv[8], hv[15];
#pragma unroll
            for (int j = 0; j < 8; j++) zv[j] = zin[(size_t)(base + s0 + j) * zld + ch];
#pragma unroll
            for (int e = 0; e < 15; e++) hv[e] = hf[(size_t)(t0 - s0 + e - 7 + Ls) * 1024];
#pragma unroll
            for (int i = 0; i < 8; i++)
#pragma unroll
                for (int j = 0; j < 8; j++) acc[i] = fmaf(hv[i - j + 7], zv[j], acc[i]);
        }
        const float inv = 1.f / nrm;
        const float bias = p.in[I_HYFB][o * 512 + ch];
#pragma unroll
        for (int i = 0; i < 8; i++) {
            const int r = base + t0 + i;
            const float zc = acc[i] * inv;
            const float z = zin[(size_t)r * zld + ch];
            const float gate = U[(size_t)r * 1536 + 512 * (o + 1) + ch];
            const float res = gate * (zc + z * bias);
            if (o == 0) Z1[(size_t)r * 512 + ch] = res;
            else wsp<bf16_t>(p, OFF_MB)[(size_t)r * D + ch] = f2bf(res);
        }
    }
}

__device__ __forceinline__ void ph_moe_scatter(const Params& p, float* lds, int layer, int ntok) {
    const int TIDX = tid_of_wave(p.wave_id);
    int* sst = (int*)lds;
    int* pre = sst + 128;
    const int G = gridDim.x;
    const int* bc = wsp<int>(p, OFF_BC) + (size_t)layer * 512 * 32;
    int* tile_e = wsp<int>(p, OFF_TILEE) + layer * 512;
    __syncthreads();
    for (int i = TIDX; i < G * 32; i += NT) pre[i] = bc[i];
    __syncthreads();
    if (TIDX < 32) {
        int a = 0;
        for (int b = 0; b < G; b++) { const int c = pre[b * 32 + TIDX]; pre[b * 32 + TIDX] = a; a += c; }
        sst[64 + TIDX] = a;
    }
    __syncthreads();
    if (TIDX == 0) {
        int a = 0;
        for (int e = 0; e < 32; e++) {
            const int nt = (sst[64 + e] + 255) / 256;
            if (blockIdx.x == 0) for (int q = 0; q < nt; q++) tile_e[a / 256 + q] = e;
            const int st = a;
            a += nt * 256;
            sst[e] = st;
        }
        sst[32] = a;
    }
    __syncthreads();
    if (blockIdx.x == 0 && TIDX < 33) wsp<int>(p, OFF_STARTS)[layer * 64 + TIDX] = sst[TIDX];
    const int* te = wsp<int>(p, OFF_TOPE);
    int* tp = wsp<int>(p, OFF_TOPP);
    const bf16_t* HB = wsp<bf16_t>(p, OFF_HB);
    bf16_t* XG = wsp<bf16_t>(p, OFF_XG);
    const int lane = TIDX & 63, wave = TIDX >> 6;
    for (int it = blockIdx.x * NWAVE + wave; it < ntok * 4; it += gridDim.x * NWAVE) {
        const int tok = it >> 2, e = te[it];
        const int row = sst[e] + pre[((tok >> 5) % G) * 32 + e] + tp[it];
        if (lane == 0) tp[it] = row;
        const pg8::u32x4* src = (const pg8::u32x4*)(HB + (size_t)tok * D);
        pg8::u32x4* dst = (pg8::u32x4*)(XG + (size_t)row * D);
        dst[lane] = src[lane];
        dst[lane + 64] = src[lane + 64];
    }
    __syncthreads();
}
__device__ __forceinline__ void ph_moe_gemm1(const Params& p, PG8_LAS unsigned char* lds, int layer) {
    const int total = wsp<int>(p, OFF_STARTS)[layer * 64 + 32];
    pg8::MoeOrder S{wsp<int>(p, OFF_TILEE) + layer * 512, total / 256, 8, (int)gridDim.x, (int)blockIdx.x};
    pg8::Gemm g{wsp<bf16_t>(p, OFF_XG), wsp<bf16_t>(p, OFF_WGU) + (size_t)layer * 32 * 2048 * 1024, 1024};
    pg8::EpiMoe1 E{wsp<bf16_t>(p, OFF_ACTB), p.in[I_BGU] + (size_t)layer * 32 * 2048};
    pg8::gemm_phase(p.wave_id, lds, g, S, E);
}
__device__ __forceinline__ void ph_moe_gemm2(const Params& p, PG8_LAS unsigned char* lds, int layer) {
    const int total = wsp<int>(p, OFF_STARTS)[layer * 64 + 32];
    pg8::MoeOrder S{wsp<int>(p, OFF_TILEE) + layer * 512, total / 256, 4, (int)gridDim.x, (int)blockIdx.x};
    pg8::Gemm g{wsp<bf16_t>(p, OFF_ACTB), wsp<bf16_t>(p, OFF_WDN) + (size_t)layer * 32 * 1024 * 1024, 1024};
    pg8::EpiMoe2 E{wsp<bf16_t>(p, OFF_YR), p.in[I_BDN] + (size_t)layer * 32 * 1024};
    pg8::gemm_phase(p.wave_id, lds, g, S, E);
}
template <bool NEXTPREP>
__device__ __forceinline__ void ph_moe_combine(const Params& p, int layer, int nrows, const float* xi, float* xo, int nlayer) {
    const int TIDX = tid_of_wave(p.wave_id);
    const int lane = TIDX & 63, wave = TIDX >> 6;
    const int* tp = wsp<int>(p, OFF_TOPP);
    const float* tg = wsp<float>(p, OFF_TOPG);
    const bf16_t* YR = wsp<bf16_t>(p, OFF_YR);
    for (int r = blockIdx.x * NWAVE + wave; r < nrows; r += gridDim.x * NWAVE) {
        const float* gt = modp(p, layer, r < L ? 0 : 1, 1) + 2048;
        float v[16];
#pragma unroll
        for (int i = 0; i < 16; i++) v[i] = 0.f;
        const int4 rows = *(const int4*)(tp + r * 4);
        const float4 gs = *(const float4*)(tg + r * 4);
        const int rw[4] = {rows.x, rows.y, rows.z, rows.w};
        const float gw[4] = {gs.x, gs.y, gs.z, gs.w};
#pragma unroll
        for (int k = 0; k < 4; k++)
#pragma unroll
            for (int i = 0; i < 2; i++) {
                const pg8::u32x4 y = *(const pg8::u32x4*)(YR + (size_t)rw[k] * 1024 + 512 * i + 8 * lane);
                const unsigned w[4] = {y.x, y.y, y.z, y.w};
#pragma unroll
                for (int q = 0; q < 4; q++) {
                    v[8 * i + 2 * q] = fmaf(gw[k], bf2f((unsigned short)(w[q] & 0xffff)), v[8 * i + 2 * q]);
                    v[8 * i + 2 * q + 1] = fmaf(gw[k], bf2f((unsigned short)(w[q] >> 16)), v[8 * i + 2 * q + 1]);
                }
            }
        float ss = 0.f;
#pragma unroll
        for (int i = 0; i < 2; i++)
#pragma unroll
            for (int h4 = 0; h4 < 2; h4++) {
                const int c = 512 * i + 8 * lane + 4 * h4;
                const float4 x4 = *(const float4*)(xi + (size_t)r * D + c), g4 = *(const float4*)(gt + c);
                float* vv = v + 8 * i + 4 * h4;
                vv[0] = x4.x + g4.x * vv[0]; vv[1] = x4.y + g4.y * vv[1]; vv[2] = x4.z + g4.z * vv[2]; vv[3] = x4.w + g4.w * vv[3];
                *(float4*)(xo + (size_t)r * D + c) = make_float4(vv[0], vv[1], vv[2], vv[3]);
                ss += vv[0] * vv[0] + vv[1] * vv[1] + vv[2] * vv[2] + vv[3] * vv[3];
            }
        if (NEXTPREP) {
            ss = wave_sum(lane, ss);
            const float rinv = rsqrtf(ss * (1.f / 1024.f) + EPS);
            const float* md = modp(p, nlayer, r < L ? 0 : 1, 0);
            const float* g = p.in[I_NORMG] + (nlayer * 2 + 0) * 1024;
#pragma unroll
            for (int i = 0; i < 2; i++) {
                const int c = 512 * i + 8 * lane;
                float hv[8];
#pragma unroll
                for (int h4 = 0; h4 < 2; h4++) {
                    const float4 g4 = *(const float4*)(g + c + 4 * h4), sc4 = *(const float4*)(md + 1024 + c + 4 * h4), sh4 = *(const float4*)(md + c + 4 * h4);
                    const float* vv = v + 8 * i + 4 * h4;
                    hv[4 * h4 + 0] = vv[0] * rinv * g4.x * (1.f + sc4.x) + sh4.x; hv[4 * h4 + 1] = vv[1] * rinv * g4.y * (1.f + sc4.y) + sh4.y;
                    hv[4 * h4 + 2] = vv[2] * rinv * g4.z * (1.f + sc4.z) + sh4.z; hv[4 * h4 + 3] = vv[3] * rinv * g4.w * (1.f + sc4.w) + sh4.w;
                }
                pg8::u32x4 o; o.x = pack_bf16(hv[0], hv[1]); o.y = pack_bf16(hv[2], hv[3]); o.z = pack_bf16(hv[4], hv[5]); o.w = pack_bf16(hv[6], hv[7]);
                *(pg8::u32x4*)(wsp<bf16_t>(p, OFF_HB) + (size_t)r * D + c) = o;
            }
        }
    }
}

__device__ __forceinline__ void ph_streams(const Params& p) {
    const int TIDX = tid_of_wave(p.wave_id);
    const bf16_t* P1 = wsp<bf16_t>(p, OFF_P);
    bf16_t* XBC = wsp<bf16_t>(p, OFF_XBC);
    float* DT = wsp<float>(p, OFF_DT);
    const float* cw = p.in[I_SSDCW];
    const float* cb = p.in[I_SSDCB];
    const int gsz = gridDim.x * NT, g0 = blockIdx.x * NT + TIDX;
    for (int it = g0; it < R * 128; it += gsz) {
        const int r = it >> 7, c = (it & 127) * 8;
        const int lo = r < L ? 0 : L, hi = r < L ? L : R;
        float a[8];
#pragma unroll
        for (int q = 0; q < 8; q++) a[q] = cb[c + q];
#pragma unroll
        for (int j = 0; j < 3; j++) {
            const int rr = r + j - 1;
            if (rr >= lo && rr < hi) {
                const pg8::u32x4 v = *(const pg8::u32x4*)(P1 + (size_t)rr * ODD_IN + c);
                const unsigned w[4] = {v.x, v.y, v.z, v.w};
#pragma unroll
                for (int q = 0; q < 4; q++) {
                    a[2 * q] = fmaf(cw[j * 1024 + c + 2 * q], bf2f((unsigned short)(w[q] & 0xffff)), a[2 * q]);
                    a[2 * q + 1] = fmaf(cw[j * 1024 + c + 2 * q + 1], bf2f((unsigned short)(w[q] >> 16)), a[2 * q + 1]);
                }
            }
        }
        pg8::u32x4 o;
        o.x = pack_bf16(silu_fast(a[0]), silu_fast(a[1])); o.y = pack_bf16(silu_fast(a[2]), silu_fast(a[3]));
        o.z = pack_bf16(silu_fast(a[4]), silu_fast(a[5])); o.w = pack_bf16(silu_fast(a[6]), silu_fast(a[7]));
        *(pg8::u32x4*)(XBC + (size_t)r * 1024 + c) = o;
    }
    for (int it = g0; it < R * 16; it += gsz) {
        const int r = it >> 4, c = it & 15, d = c >> 3, h = c & 7;
        DT[(size_t)d * R * 8 + (size_t)r * 8 + h] = softplus_f(bf2f(P1[(size_t)r * ODD_IN + 1024 + c]) + p.in[I_DTB][d * 8 + h]);
    }
}
__device__ __forceinline__ float chunk_cumsum128(float a0, float a1, int lane, int d, float& c0, float& c1) {
    const float s = a0 + a1;
    float incl = s;
#pragma unroll
    for (int o = 1; o < 64; o <<= 1) { const float t = lane_get(incl, lane >= o ? lane - o : lane); if (lane >= o) incl += t; }
    const float total = lane_get(incl, 63);
    c0 = incl - s + a0; c1 = incl;
    if (d == 1) { c0 = total - (c0 - a0); c1 = total - (c1 - a1); }
    return total;
}

__device__ __forceinline__ void ph_ssd_s1(const Params& p, unsigned char* smem) {
    const int TIDX = tid_of_wave(p.wave_id);
    bf16_t* Bt = (bf16_t*)smem;
    bf16_t* XW = Bt + 128 * LDP;
    float* csb = (float*)(XW + 2 * 64 * LDP);
    const bf16_t* XBC = wsp<bf16_t>(p, OFF_XBC);
    const float* DT = wsp<float>(p, OFF_DT);
    bf16_t* ST = wsp<bf16_t>(p, OFF_SST);
    float* DEC = wsp<float>(p, OFF_SDEC);
    const int tid = TIDX, lane = tid & 63, wave = tid >> 6, hf = lane >> 5;
    for (int it = blockIdx.x; it < 130 * 8; it += gridDim.x) {
        const int c = it >> 3, hh = it & 7, g = hh >> 2, r0 = c * 128;
        const int s = tid >> 2, q4 = tid & 3;
        const bf16_t* xr = XBC + (size_t)(r0 + s) * 1024;
        pg8::u32x4 bv[4], xv[2];
#pragma unroll
        for (int j = 0; j < 4; j++) bv[j] = *(const pg8::u32x4*)(xr + 512 + g * 128 + q4 * 32 + 8 * j);
#pragma unroll
        for (int j = 0; j < 2; j++) xv[j] = *(const pg8::u32x4*)(xr + hh * 64 + q4 * 16 + 8 * j);
        __syncthreads();
        if (wave < 2) {
            const int d = wave;
            const float a = -expf(p.in[I_ALOG][d * 8 + hh]);
            const float dt0 = DT[(size_t)d * R * 8 + (size_t)(r0 + 2 * lane) * 8 + hh], dt1 = DT[(size_t)d * R * 8 + (size_t)(r0 + 2 * lane + 1) * 8 + hh];
            float c0, c1;
            const float total = chunk_cumsum128(dt0 * a, dt1 * a, lane, d, c0, c1);
            csb[d * 128 + 2 * lane] = __expf(total - c0) * dt0;
            csb[d * 128 + 2 * lane + 1] = __expf(total - c1) * dt1;
            if (lane == 0) DEC[(d * 130 + c) * 8 + hh] = __expf(total);
        }
#pragma unroll
        for (int j = 0; j < 4; j++) {
            const unsigned w[4] = {bv[j].x, bv[j].y, bv[j].z, bv[j].w};
            bf16_t* dst = Bt + (q4 * 32 + 8 * j) * LDP + s;
#pragma unroll
            for (int q = 0; q < 4; q++) { dst[(2 * q) * LDP] = (bf16_t)(w[q] & 0xffff); dst[(2 * q + 1) * LDP] = (bf16_t)(w[q] >> 16); }
        }
        __syncthreads();
        {
            const float w0 = csb[s], w1 = csb[128 + s];
#pragma unroll
            for (int j = 0; j < 2; j++) {
                const unsigned w[4] = {xv[j].x, xv[j].y, xv[j].z, xv[j].w};
                bf16_t* dst = XW + (q4 * 16 + 8 * j) * LDP + s;
#pragma unroll
                for (int q = 0; q < 4; q++) {
                    const float x0 = bf2f((unsigned short)(w[q] & 0xffff)), x1 = bf2f((unsigned short)(w[q] >> 16));
                    dst[(2 * q) * LDP] = f2bf(x0 * w0); dst[(2 * q + 1) * LDP] = f2bf(x1 * w0);
                    dst[64 * LDP + (2 * q) * LDP] = f2bf(x0 * w1); dst[64 * LDP + (2 * q + 1) * LDP] = f2bf(x1 * w1);
                }
            }
        }
        __syncthreads();
#pragma unroll 1
        for (int t2 = 0; t2 < 2; t2++) {
            const int tix = wave * 2 + t2, d = tix >> 3, mt = (tix >> 2) & 1, nt = tix & 3;
            f32x16 acc;
#pragma unroll
            for (int q = 0; q < 16; q++) acc[q] = 0.f;
            acc = mma32<8>(lane, XW + (d * 64 + mt * 32) * LDP, LDP, Bt + nt * 32 * LDP, LDP, acc);
            int rb = mt * 32 + 4 * hf;
            asm volatile("" : "+v"(rb));
            bf16_t* dst = ST + ((((size_t)d * 130 + c) * 8 + hh) * 64 + rb) * 128 + nt * 32 + (lane & 31);
#pragma unroll
            for (int q = 0; q < 16; q++) dst[((q & 3) + 8 * (q >> 2)) * 128] = f2bf(acc[q]);
        }
    }
}
__device__ __forceinline__ void ph_ssd_s2(const Params& p) {
    const int TIDX = tid_of_wave(p.wave_id);
    const bf16_t* __restrict__ ST = wsp<bf16_t>(p, OFF_SST);
    bf16_t* __restrict__ SIN = wsp<bf16_t>(p, OFF_SSIN);
    const float* __restrict__ DEC = wsp<float>(p, OFF_SDEC);
    for (int it = blockIdx.x * NT + TIDX; it < 65536; it += gridDim.x * NT) {
        const int n2 = it & 63, pp = (it >> 6) & 63, hh = (it >> 12) & 7, d = it >> 15;
        float s0 = 0.f, s1 = 0.f;
#pragma unroll 26
        for (int step = 0; step < 130; step++) {
            const int c = d == 0 ? (step < 2 ? 128 + step : step - 2) : 129 - step;
            const size_t off = ((((size_t)d * 130 + c) * 8 + hh) * 64 + pp) * 128 + 2 * n2;
            const unsigned st = *(const unsigned*)(ST + off);
            const float dec = DEC[(d * 130 + c) * 8 + hh];
            *(unsigned*)(SIN + off) = pack_bf16(s0, s1);
            s0 = fmaf(s0, dec, bf2f((unsigned short)(st & 0xffff)));
            s1 = fmaf(s1, dec, bf2f((unsigned short)(st >> 16)));
        }
    }
}
__device__ __forceinline__ void ph_ssd_s3(const Params& p, unsigned char* smem) {
    const int TIDX = tid_of_wave(p.wave_id);
    bf16_t* Cm = (bf16_t*)smem;
    bf16_t* Bm = Cm + 128 * LDP;
    bf16_t* Wm = Bm;
    bf16_t* Xt = Bm + 128 * LDP;
    bf16_t* Sn = Xt + 64 * LDP;
    float* csA = (float*)(Sn + 2 * 64 * LDP);
    float* dtA = csA + 8 * 128;
    const bf16_t* XBC = wsp<bf16_t>(p, OFF_XBC);
    const float* DT = wsp<float>(p, OFF_DT);
    const bf16_t* SIN = wsp<bf16_t>(p, OFF_SSIN);
    float* Y = wsp<float>(p, OFF_Y);
    const int tid = TIDX, lane = tid & 63, wave = tid >> 6, hf = lane >> 5;
    for (int it = blockIdx.x; it < 256; it += gridDim.x) {
        const int c = it >> 1, g = it & 1, r0 = c * 128;
        const int s = tid >> 2, q4 = tid & 3;
        const bf16_t* xr = XBC + (size_t)(r0 + s) * 1024;
        __syncthreads();
        {
            pg8::u32x4 bv[4], cv[4];
#pragma unroll
            for (int j = 0; j < 4; j++) { bv[j] = *(const pg8::u32x4*)(xr + 512 + g * 128 + q4 * 32 + 8 * j); cv[j] = *(const pg8::u32x4*)(xr + 768 + g * 128 + q4 * 32 + 8 * j); }
            {
                const int hh = g * 4 + (wave >> 1), d = wave & 1;
                const float a = -expf(p.in[I_ALOG][d * 8 + hh]);
                const float dt0 = DT[(size_t)d * R * 8 + (size_t)(r0 + 2 * lane) * 8 + hh], dt1 = DT[(size_t)d * R * 8 + (size_t)(r0 + 2 * lane + 1) * 8 + hh];
                float c0, c1;
                chunk_cumsum128(dt0 * a, dt1 * a, lane, d, c0, c1);
                csA[wave * 128 + 2 * lane] = c0; csA[wave * 128 + 2 * lane + 1] = c1;
                dtA[wave * 128 + 2 * lane] = dt0; dtA[wave * 128 + 2 * lane + 1] = dt1;
            }
#pragma unroll
            for (int j = 0; j < 4; j++) { *(pg8::u32x4*)(Bm + s * LDP + q4 * 32 + 8 * j) = bv[j]; *(pg8::u32x4*)(Cm + s * LDP + q4 * 32 + 8 * j) = cv[j]; }
        }
        __syncthreads();
        const int gmt = wave >> 1, gnt0 = (wave & 1) * 2;
        f32x16 G0, G1;
#pragma unroll
        for (int q = 0; q < 16; q++) { G0[q] = 0.f; G1[q] = 0.f; }
        G0 = mma32<8>(lane, Cm + gmt * 32 * LDP, LDP, Bm + gnt0 * 32 * LDP, LDP, G0);
        G1 = mma32<8>(lane, Cm + gmt * 32 * LDP, LDP, Bm + (gnt0 + 1) * 32 * LDP, LDP, G1);
#pragma unroll 1
        for (int h = 0; h < 4; h++) {
            const int hh = g * 4 + h;
            const int ymt = wave >> 1, ynt = wave & 1;
            f32x16 ytot;
#pragma unroll
            for (int q = 0; q < 16; q++) ytot[q] = 0.f;
            pg8::u32x4 xv[2], sv[2][2];
            {
                int tb = tid;
                asm volatile("" : "+v"(tb));
                const int s2 = tb >> 2, q42 = tb & 3;
#pragma unroll
                for (int j = 0; j < 2; j++) xv[j] = *(const pg8::u32x4*)(XBC + (size_t)(r0 + s2) * 1024 + hh * 64 + q42 * 16 + 8 * j);
#pragma unroll
                for (int d = 0; d < 2; d++) {
                    const bf16_t* src = SIN + ((((size_t)d * 130 + c) * 8 + hh) * 64) * 128;
#pragma unroll
                    for (int i = 0; i < 2; i++) { const int v = tb + 512 * i; sv[d][i] = *(const pg8::u32x4*)(src + (v >> 4) * 128 + (v & 15) * 8); }
                }
            }
#pragma unroll 1
            for (int d = 0; d < 2; d++) {
                __syncthreads();
                if (d == 0) {
                    int tb = tid;
                    asm volatile("" : "+v"(tb));
                    const int s2 = tb >> 2, q42 = tb & 3;
#pragma unroll
                    for (int j = 0; j < 2; j++) {
                        const unsigned w[4] = {xv[j].x, xv[j].y, xv[j].z, xv[j].w};
                        bf16_t* dst = Xt + (q42 * 16 + 8 * j) * LDP + s2;
#pragma unroll
                        for (int q = 0; q < 4; q++) { dst[(2 * q) * LDP] = (bf16_t)(w[q] & 0xffff); dst[(2 * q + 1) * LDP] = (bf16_t)(w[q] >> 16); }
                    }
#pragma unroll
                    for (int dd = 0; dd < 2; dd++)
#pragma unroll
                        for (int i = 0; i < 2; i++) { const int v = tb + 512 * i; *(pg8::u32x4*)(Sn + (dd * 64 + (v >> 4)) * LDP + (v & 15) * 8) = sv[dd][i]; }
                }
                const float* csb = csA + (h * 2 + d) * 128;
                const float* dtb = dtA + (h * 2 + d) * 128;
#pragma unroll
                for (int t2 = 0; t2 < 2; t2++) {
                    const int s3 = (gnt0 + t2) * 32 + (lane & 31);
                    const float css = csb[s3], dts = dtb[s3];
#pragma unroll
                    for (int q = 0; q < 16; q++) {
                        const int l = gmt * 32 + CROW(q, hf);
                        const bool ok = d == 0 ? (s3 <= l) : (s3 >= l);
                        const float gv = t2 == 0 ? G0[q] : G1[q];
                        const float w = ok ? gv * __expf(csb[l] - css) * dts : 0.f;
                        Wm[l * LDP + s3] = f2bf(w);
                    }
                }
                __syncthreads();
                f32x16 a2;
#pragma unroll
                for (int q = 0; q < 16; q++) a2[q] = 0.f;
                a2 = mma32<8>(lane, Cm + ymt * 32 * LDP, LDP, Sn + (d * 64 + ynt * 32) * LDP, LDP, a2);
#pragma unroll
                for (int q = 0; q < 16; q++) ytot[q] += __expf(csb[ymt * 32 + CROW(q, hf)]) * a2[q];
                ytot = mma32<8>(lane, Wm + ymt * 32 * LDP, LDP, Xt + ynt * 32 * LDP, LDP, ytot);
            }
            const float Dsum = p.in[I_SSDD][hh] + p.in[I_SSDD][8 + hh];
            {
                int lbase = r0 + ymt * 32 + 4 * hf;
                asm volatile("" : "+v"(lbase));
                const int cbase = hh * 64 + ynt * 32 + (lane & 31);
                float* yb = Y + (size_t)lbase * 512 + cbase;
                const bf16_t* xb = XBC + (size_t)lbase * 1024 + cbase;
#pragma unroll
                for (int q = 0; q < 16; q++) {
                    const int lo = (q & 3) + 8 * (q >> 2);
                    yb[lo * 512] = ytot[q] + Dsum * bf2f(xb[lo * 1024]);
                }
            }
        }
    }
}

constexpr int LDQ = 72;
__device__ __forceinline__ void ph_hg_s1(const Params& p, unsigned char* smem) {
    const int TIDX = tid_of_wave(p.wave_id);
    float* LG = (float*)smem;
    bf16_t* KbT = (bf16_t*)(smem + 65536);
    bf16_t* Vt = KbT + 2 * 128 * LDQ;
    const bf16_t* P1 = wsp<bf16_t>(p, OFF_P);
    const float* lbp = wsp<float>(p, OFF_LB);
    bf16_t* ST = wsp<bf16_t>(p, OFF_HST);
    float* DEC = wsp<float>(p, OFF_HDEC);
    const int tid = TIDX, lane = tid & 63, wave = tid >> 6, hf = lane >> 5;
    for (int it = blockIdx.x; it < 260 * 4; it += gridDim.x) {
        const int c = it >> 2, h = it & 3, r0 = c * 64;
        __syncthreads();
        float fv[32];
#pragma unroll
        for (int i = 0; i < 32; i++) {
            const int d = i >> 4, e = tid + 512 * (i & 15), row = e >> 7, k = e & 127;
            fv[i] = bf2f(P1[(size_t)(r0 + row) * ODD_IN + 1040 + d * 512 + h * 128 + k]);
        }
        {
            const float lbk = lbp[h * 128 + (tid & 127)];
#pragma unroll
            for (int i = 0; i < 32; i++) fv[i] = lbk + (1.f - lbk) * sigmoid_fast(fv[i]);
        }
#pragma unroll
        for (int q = 0; q < 2; q++) {
            const int vec = tid + 512 * q, s2 = vec >> 4, v0 = (vec & 15) * 8;
            const pg8::u32x4 x = *(const pg8::u32x4*)(P1 + (size_t)(r0 + s2) * ODD_IN + 2064 + h * 128 + v0);
            bf16_t* dst = Vt + v0 * LDQ + s2;
            dst[0] = (bf16_t)(x.x & 0xffff); dst[LDQ] = (bf16_t)(x.x >> 16); dst[2 * LDQ] = (bf16_t)(x.y & 0xffff); dst[3 * LDQ] = (bf16_t)(x.y >> 16);
            dst[4 * LDQ] = (bf16_t)(x.z & 0xffff); dst[5 * LDQ] = (bf16_t)(x.z >> 16); dst[6 * LDQ] = (bf16_t)(x.w & 0xffff); dst[7 * LDQ] = (bf16_t)(x.w >> 16);
        }
#pragma unroll
        for (int i = 0; i < 32; i++) LG[(i >> 4) * 8192 + tid + 512 * (i & 15)] = __logf(fv[i]);
        __syncthreads();
        if (tid < 256) {
            const int d = tid >> 7, k = tid & 127;
            float* col = LG + d * 8192 + k;
            float cum = 0.f;
#pragma unroll 8
            for (int i = 0; i < 64; i++) { const int row = d == 0 ? i : 63 - i; cum += col[row * 128]; col[row * 128] = cum; }
            DEC[(((size_t)d * 260 + c) * 4 + h) * 128 + k] = __expf(cum);
        }
        __syncthreads();
#pragma unroll
        for (int i = 0; i < 32; i++) {
            const int d = i >> 4, e = tid + 512 * (i & 15), row = e >> 7, k = e & 127;
            const float total = LG[d * 8192 + (d == 0 ? 63 : 0) * 128 + k], cum = LG[d * 8192 + e];
            KbT[(d * 128 + k) * LDQ + row] = f2bf((1.f - fv[i]) * __expf(total - cum));
        }
        __syncthreads();
#pragma unroll 1
        for (int q4 = 0; q4 < 4; q4++) {
            const int tix = wave * 4 + q4, d = tix >> 4, vt = (tix >> 2) & 3, kt = tix & 3;
            f32x16 acc;
#pragma unroll
            for (int q = 0; q < 16; q++) acc[q] = 0.f;
            acc = mma32<4>(lane, Vt + vt * 32 * LDQ, LDQ, KbT + (d * 128 + kt * 32) * LDQ, LDQ, acc);
            int rb = vt * 32 + 4 * hf;
            asm volatile("" : "+v"(rb));
            bf16_t* dst = ST + ((((size_t)d * 260 + c) * 4 + h) * 128 + rb) * 128 + kt * 32 + (lane & 31);
#pragma unroll
            for (int q = 0; q < 16; q++) dst[((q & 3) + 8 * (q >> 2)) * 128] = f2bf(acc[q]);
        }
    }
}
__device__ __forceinline__ void ph_hg_s2(const Params& p) {
    const int TIDX = tid_of_wave(p.wave_id);
    const bf16_t* __restrict__ ST = wsp<bf16_t>(p, OFF_HST);
    bf16_t* __restrict__ SIN = wsp<bf16_t>(p, OFF_HSIN);
    const float* __restrict__ DEC = wsp<float>(p, OFF_HDEC);
    const int gb = gridDim.x >= 256 ? (int)blockIdx.x - 128 : (int)blockIdx.x, gs = gridDim.x >= 256 ? 128 : (int)gridDim.x;
    for (int it = gb * NT + TIDX; it >= 0 && it < 65536; it += gs * NT) {
        const int k2 = it & 63, v = (it >> 6) & 127, h = (it >> 13) & 3, d = it >> 15;
        float s0 = 0.f, s1 = 0.f;
#pragma unroll 26
        for (int step = 0; step < 260; step++) {
            const int c = d == 0 ? (step < 4 ? 256 + step : step - 4) : 259 - step;
            const size_t blk = ((size_t)d * 260 + c) * 4 + h;
            const size_t off = (blk * 128 + v) * 128 + 2 * k2;
            const unsigned st = *(const unsigned*)(ST + off);
            const float2 dec = *(const float2*)(DEC + blk * 128 + 2 * k2);
            *(unsigned*)(SIN + off) = pack_bf16(s0, s1);
            s0 = fmaf(s0, dec.x, bf2f((unsigned short)(st & 0xffff)));
            s1 = fmaf(s1, dec.y, bf2f((unsigned short)(st >> 16)));
        }
    }
}
__device__ __forceinline__ void ph_hg_s3(const Params& p, unsigned char* smem) {
    const int TIDX = tid_of_wave(p.wave_id);
    float* LG = (float*)smem;
    bf16_t* Qb = (bf16_t*)(smem + 32768);
    bf16_t* Kh = Qb + 64 * LDP;
    bf16_t* Vt = Kh + 64 * LDP;
    bf16_t* Am = Vt + 128 * LDQ;
    bf16_t* Sn = Am + 64 * LDQ;
    const bf16_t* P1 = wsp<bf16_t>(p, OFF_P);
    const float* lbp = wsp<float>(p, OFF_LB);
    const bf16_t* SIN = wsp<bf16_t>(p, OFF_HSIN);
    float* O = wsp<float>(p, OFF_O);
    const int tid = TIDX, lane = tid & 63, wave = tid >> 6, hf = lane >> 5;
    for (int it = blockIdx.x; it < 256 * 4; it += gridDim.x) {
        const int c = it >> 2, h = it & 3, r0 = c * 64;
        const int omt = wave >> 2, ont = wave & 3;
        f32x16 otot;
#pragma unroll
        for (int q = 0; q < 16; q++) otot[q] = 0.f;
#pragma unroll 1
        for (int d = 0; d < 2; d++) {
            __syncthreads();
            float fv[16], qv[16];
#pragma unroll
            for (int i = 0; i < 16; i++) {
                const int e = tid + 512 * i, row = e >> 7, k = e & 127;
                fv[i] = bf2f(P1[(size_t)(r0 + row) * ODD_IN + 1040 + d * 512 + h * 128 + k]);
                qv[i] = bf2f(P1[(size_t)(r0 + row) * ODD_IN + 3088 + h * 128 + k]);
            }
            {
                const float lbk = lbp[h * 128 + (tid & 127)];
#pragma unroll
                for (int i = 0; i < 16; i++) { fv[i] = lbk + (1.f - lbk) * sigmoid_fast(fv[i]); qv[i] = silu_fast(qv[i]); }
            }
            {
                const bf16_t* src = SIN + ((((size_t)d * 260 + c) * 4 + h) * 128) * 128;
#pragma unroll
                for (int i = 0; i < 4; i++) { const int v = tid + 512 * i, row = v >> 4, col8 = (v & 15) * 8;
                    *(pg8::u32x4*)(Sn + row * LDP + col8) = *(const pg8::u32x4*)(src + row * 128 + col8); }
            }
            if (d == 0) {
#pragma unroll
                for (int q = 0; q < 2; q++) {
                    const int vec = tid + 512 * q, s2 = vec >> 4, v0 = (vec & 15) * 8;
                    const pg8::u32x4 x = *(const pg8::u32x4*)(P1 + (size_t)(r0 + s2) * ODD_IN + 2064 + h * 128 + v0);
                    bf16_t* dst = Vt + v0 * LDQ + s2;
                    dst[0] = (bf16_t)(x.x & 0xffff); dst[LDQ] = (bf16_t)(x.x >> 16); dst[2 * LDQ] = (bf16_t)(x.y & 0xffff); dst[3 * LDQ] = (bf16_t)(x.y >> 16);
                    dst[4 * LDQ] = (bf16_t)(x.z & 0xffff); dst[5 * LDQ] = (bf16_t)(x.z >> 16); dst[6 * LDQ] = (bf16_t)(x.w & 0xffff); dst[7 * LDQ] = (bf16_t)(x.w >> 16);
                }
            }
#pragma unroll
            for (int i = 0; i < 16; i++) LG[tid + 512 * i] = __logf(fv[i]);
            __syncthreads();
            if (tid < 128) {
                float* col = LG + tid;
                float cum = 0.f;
#pragma unroll 8
                for (int i = 0; i < 64; i++) { const int row = d == 0 ? i : 63 - i; cum += col[row * 128]; col[row * 128] = cum; }
            }
            __syncthreads();
#pragma unroll
            for (int i = 0; i < 16; i++) {
                const int e = tid + 512 * i, row = e >> 7, k = e & 127;
                const float cum = LG[e];
                Qb[row * LDP + k] = f2bf(qv[i] * __expf(cum));
                Kh[row * LDP + k] = f2bf((1.f - fv[i]) * __expf(fminf(-cum, 80.f)));
            }
            __syncthreads();
            if (wave < 4) {
                const int amt = wave >> 1, ant = wave & 1;
                f32x16 a;
#pragma unroll
                for (int q = 0; q < 16; q++) a[q] = 0.f;
                a = mma32<8>(lane, Qb + amt * 32 * LDP, LDP, Kh + ant * 32 * LDP, LDP, a);
                const int s2 = ant * 32 + (lane & 31);
#pragma unroll
                for (int q = 0; q < 16; q++) {
                    const int t = amt * 32 + CROW(q, hf);
                    const bool ok = d == 0 ? (s2 <= t) : (s2 >= t);
                    Am[t * LDQ + s2] = f2bf(ok ? a[q] : 0.f);
                }
            }
            otot = mma32<8>(lane, Qb + omt * 32 * LDP, LDP, Sn + ont * 32 * LDP, LDP, otot);
            __syncthreads();
            otot = mma32<4>(lane, Am + omt * 32 * LDQ, LDQ, Vt + ont * 32 * LDQ, LDQ, otot);
        }
        {
            int lbase = r0 + omt * 32 + 4 * hf;
            asm volatile("" : "+v"(lbase));
            float* ob = O + (size_t)lbase * 512 + h * 128 + ont * 32 + (lane & 31);
#pragma unroll
            for (int q = 0; q < 16; q++) ob[((q & 3) + 8 * (q >> 2)) * 512] = otot[q];
        }
    }
}

__device__ __forceinline__ void ph_merge(const Params& p) {
    const int TIDX = tid_of_wave(p.wave_id);
    const int lane = TIDX & 63, wave = TIDX >> 6;
    const bf16_t* P1 = wsp<bf16_t>(p, OFF_P);
    const float* Y = wsp<float>(p, OFF_Y);
    const float* O = wsp<float>(p, OFF_O);
    bf16_t* MB = wsp<bf16_t>(p, OFF_MB);
    const int c = 8 * lane;
    for (int r = blockIdx.x * NWAVE + wave; r < L; r += gridDim.x * NWAVE) {
        const float4 y0 = *(const float4*)(Y + (size_t)r * 512 + c), y1 = *(const float4*)(Y + (size_t)r * 512 + c + 4);
        const float4 o0 = *(const float4*)(O + (size_t)r * 512 + c), o1 = *(const float4*)(O + (size_t)r * 512 + c + 4);
        const pg8::u32x4 zz = *(const pg8::u32x4*)(P1 + (size_t)r * ODD_IN + 2576 + c), gg = *(const pg8::u32x4*)(P1 + (size_t)r * ODD_IN + 3600 + c);
        const float yv[8] = {y0.x, y0.y, y0.z, y0.w, y1.x, y1.y, y1.z, y1.w};
        const float ov[8] = {o0.x, o0.y, o0.z, o0.w, o1.x, o1.y, o1.z, o1.w};
        const unsigned zw[4] = {zz.x, zz.y, zz.z, zz.w}, gw[4] = {gg.x, gg.y, gg.z, gg.w};
        float ys[8], gs[8], sy = 0.f, so = 0.f;
#pragma unroll
        for (int q = 0; q < 4; q++) {
            ys[2 * q] = yv[2 * q] * silu_fast(bf2f((unsigned short)(zw[q] & 0xffff)));
            ys[2 * q + 1] = yv[2 * q + 1] * silu_fast(bf2f((unsigned short)(zw[q] >> 16)));
            gs[2 * q] = silu_fast(bf2f((unsigned short)(gw[q] & 0xffff)));
            gs[2 * q + 1] = silu_fast(bf2f((unsigned short)(gw[q] >> 16)));
        }
#pragma unroll
        for (int q = 0; q < 8; q++) { sy = fmaf(ys[q], ys[q], sy); so = fmaf(ov[q], ov[q], so); }
        sy += dpp_f<0xB1>(sy); sy += dpp_f<0x4E>(sy); sy += dpp_f<0x141>(sy); sy += dpp_f<0x140>(sy);
        so += dpp_f<0xB1>(so); so += dpp_f<0x4E>(so); so += dpp_f<0x141>(so); so += dpp_f<0x140>(so);
        sy += lane_xor(lane, sy, 16);
        const float ry = rsqrtf(sy * (1.f / 256.f) + EPS), ro = rsqrtf(so * (1.f / 128.f) + EPS);
        const float4 n0 = *(const float4*)(p.in[I_SSDN] + c), n1 = *(const float4*)(p.in[I_SSDN] + c + 4);
        const float4 h0 = *(const float4*)(p.in[I_HGN] + c), h1 = *(const float4*)(p.in[I_HGN] + c + 4);
        const float nv[8] = {n0.x, n0.y, n0.z, n0.w, n1.x, n1.y, n1.z, n1.w}, hv[8] = {h0.x, h0.y, h0.z, h0.w, h1.x, h1.y, h1.z, h1.w};
        float m0[8], m1[8];
#pragma unroll
        for (int q = 0; q < 8; q++) { m0[q] = ys[q] * ry * nv[q]; m1[q] = ov[q] * ro * hv[q] * gs[q]; }
        pg8::u32x4 w0, w1;
        w0.x = pack_bf16(m0[0], m0[1]); w0.y = pack_bf16(m0[2], m0[3]); w0.z = pack_bf16(m0[4], m0[5]); w0.w = pack_bf16(m0[6], m0[7]);
        w1.x = pack_bf16(m1[0], m1[1]); w1.y = pack_bf16(m1[2], m1[3]); w1.z = pack_bf16(m1[4], m1[5]); w1.w = pack_bf16(m1[6], m1[7]);
        *(pg8::u32x4*)(MB + (size_t)r * D + c) = w0;
        *(pg8::u32x4*)(MB + (size_t)r * D + 512 + c) = w1;
    }
}

constexpr int N_PHASES = 22;
__global__ void __launch_bounds__(NT, 2) mega(KArgs ka) {
    extern __shared__ __attribute__((aligned(16))) unsigned char smem[];
    float* lds = (float*)smem;
    PG8_LAS unsigned char* glds = (PG8_LAS unsigned char*)smem;
    if (threadIdx.x < 4) ((unsigned*)(smem + LDS_BYTES - 16))[threadIdx.x] = 0u;
    __syncthreads();
    XcdBarrier gbar = xcd_barrier_post((unsigned*)(ka.ws + OFF_BAR), (volatile LAS3 unsigned*)(smem + LDS_BYTES - 16));
    Params p;
    p.in = (const float* const*)(ka.ws + OFF_TAB); p.out = ka.out; p.ws = ka.ws;
    p.wave_id = __builtin_amdgcn_readfirstlane(threadIdx.x >> 6);
    float* XA = wsp<float>(p, OFF_XA);
    float* XB = wsp<float>(p, OFF_XB);
    float* XC = wsp<float>(p, OFF_XC);
    bf16_t* PB = wsp<bf16_t>(p, OFF_P);
    const int G = gridDim.x, bid = blockIdx.x;
#ifndef ONLY
#define ONLY -1
#endif
#ifndef PHMASK
#define PHMASK 0xFFFFFFFFull
#endif
#define IN(k) ((ONLY < 0 || ONLY == (k)) && ((PHMASK >> (k)) & 1ull))
#ifndef REPMASK
#define REPMASK 0ull
#endif
#define NREP(k) (IN(k) ? ((((REPMASK) >> (k)) & 1ull) ? 2 : 1) : 0)
#ifndef PROBE_LO
#define PROBE_LO -1
#define PROBE_HI -1
#define PROBE_AMP 4
#endif
    volatile unsigned long long* tsl = (volatile unsigned long long*)(smem + LDS_BYTES - 512);
    int nstamp = 0;
#define STAMP() do { if (PROBE_LO >= 0) { if (tid_of_wave(p.wave_id) == 0) tsl[nstamp] = __builtin_amdgcn_s_memrealtime(); ++nstamp; } } while (0)
    STAMP();
#define SEAM(k) do { xcd_barrier(gbar, p.wave_id); STAMP(); } while (0)
#define SUBSTAMP() do { if (PROBE_LO >= 0) { __syncthreads(); STAMP(); } } while (0)
    if (blockIdx.x == 0 && threadIdx.x == 0) {
#pragma unroll
        for (int i = 0; i < N_IN; i++) ((const float**)(ka.ws + OFF_TAB))[i] = ka.in[i];
    }
    for (int _r = 0; _r < NREP(0); _r++) { if (_r) SEAM(0); ph_prologue(ka, lds); ph_convert_weights(ka);
    }
    SEAM(0);
    for (int _r = 0; _r < NREP(1); _r++) { if (_r) SEAM(1);
            prep_rows<false>(p, lds, p.in[I_X], p.in[I_CTX], R, p.in[I_NORMG] + 0, 0, 0); SUBSTAMP();
            ph_filter_gemm_lat(p, smem); ph_filter_gemm_ctx(p, lds);
    }
    SEAM(1);
    for (int _r = 0; _r < NREP(2); _r++) { if (_r) SEAM(2);
            { pg8::StaticOrder S; S.init(R, EVEN_IN, G, bid);
              pg8::gemm_phase(p.wave_id, glds, pg8::Gemm{wsp<bf16_t>(p, OFF_HB), wsp<bf16_t>(p, OFF_WINE), D}, S, pg8::EpiStoreBf16{PB, EVEN_IN, EVEN_IN}); } SUBSTAMP();
            ph_filter_fft(p, smem); ph_filter_abs_ctx(p);
    }
    SEAM(2);
    for (int _r = 0; _r < NREP(3); _r++) { if (_r) SEAM(3); ph_qk_dwconv(p); SUBSTAMP(); ph_dwconv_t(p, lds);
    }
    SEAM(3);
    for (int _r = 0; _r < NREP(4); _r++) { if (_r) SEAM(4); ph_hyena_fft(p, smem); SUBSTAMP(); ph_attention_mfma(p, smem); SUBSTAMP(); ph_hyena_conv(p, 0);
    }
    SEAM(4);
    for (int _r = 0; _r < NREP(5); _r++) { if (_r) SEAM(5); ph_hy_transpose(p, smem); ph_hyena_conv(p, 1);
    }
    SEAM(5);
    for (int _r = 0; _r < NREP(6); _r++) { if (_r) SEAM(6);
            { pg8::StaticOrder S; S.init(R, D, G, bid);
              pg8::gemm_phase(p.wave_id, glds, pg8::Gemm{wsp<bf16_t>(p, OFF_MB), wsp<bf16_t>(p, OFF_WOUT), D}, S,
                              pg8::EpiResid{p.in[I_X], p.in[I_CTX], modp(p, 0, 0, 0) + 2048, modp(p, 0, 1, 0) + 2048, XA}); }
    }
    SEAM(6);
    for (int _r = 0; _r < NREP(7); _r++) { if (_r) SEAM(7); prep_router(p, smem, XA, XA + (size_t)L * D, R, p.in[I_NORMG] + 1024, 0, 1);
    }
    SEAM(7);
    for (int _r = 0; _r < NREP(8); _r++) { if (_r) SEAM(8); ph_moe_scatter(p, lds, 0, R);
    }
    SEAM(8);
    for (int _r = 0; _r < NREP(9); _r++) { if (_r) SEAM(9); ph_moe_gemm1(p, glds, 0);
    }
    SEAM(9);
    for (int _r = 0; _r < NREP(10); _r++) { if (_r) SEAM(10); ph_moe_gemm2(p, glds, 0);
    }
    SEAM(10);
    for (int _r = 0; _r < NREP(11); _r++) { if (_r) SEAM(11); ph_moe_combine<true>(p, 0, R, XA, XB, 1);
    }
    SEAM(11);
    for (int _r = 0; _r < NREP(12); _r++) { if (_r) SEAM(12);
            { pg8::StaticOrder S; S.init(R, ODD_PAD, G, bid);
              pg8::gemm_phase(p.wave_id, glds, pg8::Gemm{wsp<bf16_t>(p, OFF_HB), wsp<bf16_t>(p, OFF_WINO), D}, S, pg8::EpiStoreBf16{PB, ODD_IN, ODD_IN}); }
    }
    SEAM(12);
    for (int _r = 0; _r < NREP(13); _r++) { if (_r) SEAM(13); ph_streams(p);
    }
    SEAM(13);
    for (int _r = 0; _r < NREP(14); _r++) { if (_r) SEAM(14); ph_ssd_s1(p, smem); SUBSTAMP(); ph_hg_s1(p, smem);
    }
    SEAM(14);
    for (int _r = 0; _r < NREP(22); _r++) { if (_r) SEAM(22); ph_ssd_s2(p); ph_hg_s2(p);
    }
    SEAM(22);
    for (int _r = 0; _r < NREP(23); _r++) { if (_r) SEAM(23); ph_ssd_s3(p, smem); SUBSTAMP(); ph_hg_s3(p, smem);
    }
    SEAM(23);
    for (int _r = 0; _r < NREP(15); _r++) { if (_r) SEAM(15); ph_merge(p);
    }
    SEAM(15);
    for (int _r = 0; _r < NREP(16); _r++) { if (_r) SEAM(16);
            { pg8::StaticOrder S; S.init(L, D, G, bid);
              pg8::gemm_phase(p.wave_id, glds, pg8::Gemm{wsp<bf16_t>(p, OFF_MB), wsp<bf16_t>(p, OFF_WOUT) + (size_t)D * D, D}, S,
                              pg8::EpiResid{XB, XB, modp(p, 1, 0, 0) + 2048, modp(p, 1, 0, 0) + 2048, XC}); }
    }
    SEAM(16);
    for (int _r = 0; _r < NREP(17); _r++) { if (_r) SEAM(17); prep_router(p, smem, XC, XC, L, p.in[I_NORMG] + 3 * 1024, 1, 1);
    }
    SEAM(17);
    for (int _r = 0; _r < NREP(18); _r++) { if (_r) SEAM(18); ph_moe_scatter(p, lds, 1, L);
    }
    SEAM(18);
    for (int _r = 0; _r < NREP(19); _r++) { if (_r) SEAM(19); ph_moe_gemm1(p, glds, 1);
    }
    SEAM(19);
    for (int _r = 0; _r < NREP(20); _r++) { if (_r) SEAM(20); ph_moe_gemm2(p, glds, 1);
    }
    SEAM(20);
    for (int _r = 0; _r < NREP(21); _r++) { if (_r) SEAM(21); ph_moe_combine<false>(p, 1, L, XC, p.out, 0);
    }
    if (PROBE_LO >= 0) {
        STAMP();
        __syncthreads();
        const unsigned long long dtk = tsl[PROBE_HI] - tsl[PROBE_LO];
        const unsigned long long t0 = __builtin_amdgcn_s_memrealtime();
        while (__builtin_amdgcn_s_memrealtime() - t0 < (unsigned long long)PROBE_AMP * dtk) __builtin_amdgcn_s_sleep(8);
    }
#undef IN
#undef SEAM
}

extern "C" void kernel_launch(void* const* d_in, const int* in_sizes, int n_in, void* d_out, int out_size, void* d_ws, size_t ws_size,
                              hipStream_t stream) {
    static int grid_blocks = 0;
    if (!grid_blocks) {
        int dev = 0, cus = 0, per_cu = 0;
        hipGetDevice(&dev);
        hipDeviceGetAttribute(&cus, hipDeviceAttributeMultiprocessorCount, dev);
        hipFuncSetAttribute((const void*)mega, hipFuncAttributeMaxDynamicSharedMemorySize, LDS_BYTES);
        hipOccupancyMaxActiveBlocksPerMultiprocessor(&per_cu, mega, NT, LDS_BYTES);
        if (per_cu < 1) per_cu = 1;
        grid_blocks = cus;
        if (ws_size < WS_END) fprintf(stderr, "kernel_launch: workspace too small: %zu < %zu\n", ws_size, (size_t)WS_END);
    }
    hipMemsetAsync((char*)d_ws + OFF_CTL, 0, 65536, stream);
    KArgs p{};
    for (int i = 0; i < N_IN; i++) p.in[i] = (const float*)d_in[i];
    p.out = (float*)d_out;
    p.ws = (unsigned char*)d_ws;
    hipLaunchKernelGGL(mega, dim3(grid_blocks), dim3(NT), LDS_BYTES, stream, p);
}
```

```cpp
#include <hip/hip_runtime.h>
#include <cstdio>
#include <cstdint>

constexpr int L = 16384, NCX = 256, R = L + NCX, D = 1024;
constexpr int EVEN_IN = 2304, ODD_IN = 4112;
constexpr int NT = 512, NWAVE = 8;
constexpr int NEXP = 32;
constexpr int NROWS = 74752;
constexpr int ODD_PAD = 4352;
constexpr int LDS_BYTES = 147456;
typedef unsigned short bf16_t;
constexpr float EPS = 1e-6f;

enum { I_X = 0, I_C, I_CTX, I_CCTX, I_NORMG, I_ADAW, I_ADAB, I_WOUT, I_WINE, I_HYCW, I_HYCB, I_HYW1, I_HYB1, I_HYW2, I_HYB2,
       I_HYW3, I_HYB3, I_HYW4, I_HYFREQ, I_HYFB, I_QNORM, I_KNORM, I_SINK, I_WINO, I_SSDCW, I_SSDCB, I_DTB, I_ALOG, I_SSDD,
       I_SSDN, I_HGLB, I_HGN, I_RW, I_RB, I_WGU, I_BGU, I_WDN, I_BDN, N_IN };

constexpr size_t al256(size_t x) { return (x + 255) & ~(size_t)255; }
constexpr size_t OFF_CTL = 0;
constexpr size_t OFF_BAR = 1024;
constexpr size_t OFF_TAB = 32768;
constexpr size_t OFF_MOD = 65536;
constexpr size_t OFF_LB = OFF_MOD + al256(4 * 24576);
constexpr size_t OFF_STARTS = OFF_LB + 4096;
constexpr size_t OFF_ROPE = OFF_STARTS + 4096;
constexpr size_t OFF_HNP = OFF_ROPE + 32768;
constexpr size_t OFF_HD3 = OFF_HNP + al256(4 * 130 * 1024);
constexpr size_t OFF_HH = OFF_HD3 + al256(4ull * R * 64);
constexpr size_t OFF_HHC = OFF_HH + al256(4ull * 2 * L * 1024);
constexpr size_t OFF_XA = OFF_HHC + al256(4ull * 512 * 1024);
constexpr size_t OFF_XB = OFF_XA + al256(4ull * R * D);
constexpr size_t OFF_XC = OFF_XA;
constexpr size_t OFF_H = OFF_XB + al256(4ull * R * D);
constexpr size_t OFF_P = OFF_H + al256(4ull * R * D);
constexpr size_t OFF_QN = OFF_P + al256(4ull * R * ODD_IN);
constexpr size_t OFF_KN = OFF_QN + al256(4ull * R * 512);
constexpr size_t OFF_U = OFF_KN + al256(4ull * R * 128);
constexpr size_t OFF_Z1 = OFF_U + al256(4ull * R * 1536);
constexpr size_t OFF_TOPE = OFF_Z1 + al256(4ull * R * 512);
constexpr size_t OFF_TOPG = OFF_TOPE + al256(4ull * R * 4);
constexpr size_t OFF_TOPP = OFF_TOPG + al256(4ull * R * 4);
constexpr size_t OFF_ROWTOK = OFF_TOPP + al256(4ull * R * 4);
constexpr size_t OFF_YR = OFF_ROWTOK + al256(4ull * 2 * NROWS);
constexpr size_t OFF_XBC = OFF_U;
constexpr size_t OFF_DT = OFF_YR + al256(4ull * NROWS * 1024);
constexpr size_t OFF_F = OFF_HH;
constexpr size_t OFF_Q1 = OFF_F + al256(4ull * 2 * R * 512);
constexpr size_t OFF_Y = OFF_DT + al256(4ull * 2 * R * 8);
constexpr size_t OFF_O = OFF_Y + al256(4ull * 2 * R * 512);
constexpr size_t OFF_TILEE = OFF_O + al256(4ull * 2 * R * 512);
constexpr size_t OFF_SDEC = OFF_TILEE + 4096;
constexpr size_t OFF_BC = OFF_SDEC + 16384;
constexpr size_t OFF_HDEC = OFF_BC + 2 * 512 * 32 * 4;
constexpr size_t OFF_HB = OFF_HDEC + al256(4ull * 2 * 260 * 4 * 128);
constexpr size_t OFF_MB = OFF_HB + al256(2ull * R * D);
constexpr size_t OFF_XG = OFF_MB + al256(2ull * R * D);
constexpr size_t OFF_ACTB = OFF_XG + al256(2ull * NROWS * D);
constexpr size_t OFF_SST = OFF_XG;
constexpr size_t OFF_SSIN = OFF_SST + al256(2ull * 2 * 130 * 8 * 64 * 128);
constexpr size_t OFF_HST = OFF_SSIN + al256(2ull * 2 * 130 * 8 * 64 * 128);
constexpr size_t OFF_HSIN = OFF_ACTB;
constexpr size_t OFF_VB = OFF_KN + 2ull * R * 128;
constexpr size_t OFF_HT = OFF_ACTB;
constexpr size_t OFF_HF = OFF_XG;
constexpr size_t OFF_UC = OFF_U + 4ull * 1536 * L;
constexpr size_t OFF_HYT = OFF_Z1;
constexpr size_t OFF_WINE = OFF_ACTB + al256(2ull * NROWS * D);
constexpr size_t OFF_WINO = OFF_WINE + al256(2ull * EVEN_IN * D);
constexpr size_t OFF_WOUT = OFF_WINO + al256(2ull * ODD_PAD * D);
constexpr size_t OFF_WGU = OFF_WOUT + al256(2ull * 2 * D * D);
constexpr size_t OFF_WDN = OFF_WGU + al256(2ull * 2 * 32 * 2048 * D);
constexpr size_t WS_END = OFF_WDN + al256(2ull * 2 * 32 * 1024 * D);

struct KArgs {
    const float* in[N_IN];
    float* out;
    unsigned char* ws;
};
struct Params {
    const float* const* in;
    float* out;
    unsigned char* ws;
    int wave_id;
};

__device__ __forceinline__ int tid_opaque() { int t = threadIdx.x; asm volatile("" : "+v"(t)); return t; }
__device__ __forceinline__ int tid_of_wave(int wave_id) { unsigned m = ~0u; asm volatile("" : "+s"(m));
    int t = wave_id * 64 + (int)__builtin_amdgcn_mbcnt_hi(m, __builtin_amdgcn_mbcnt_lo(m, 0u)); asm volatile("" : "+v"(t)); return t; }

#define XB_TMO      128
#define XB_XCNT(j)  (256  + 64 * (j))
#define XB_XSUB(j)  (1280 + 64 * (j))
#define XB_XGEN(j)  (2304 + 64 * (j))
#define XB_TOP      3328
#define XB_TOPGEN   3392
#define XCD_BAR_WORDS 3456
#define XB_SPIN_CAP (1u << 22)
#define LAS3 __attribute__((address_space(3)))
__device__ __forceinline__ unsigned xb_ld(unsigned* p) { return __hip_atomic_load(p, __ATOMIC_RELAXED, __HIP_MEMORY_SCOPE_AGENT); }
__device__ __forceinline__ unsigned xb_add(unsigned* p, unsigned v) { return __hip_atomic_fetch_add(p, v, __ATOMIC_RELAXED, __HIP_MEMORY_SCOPE_AGENT); }
__device__ __forceinline__ unsigned xb_xcc_id() { return (unsigned)__builtin_amdgcn_s_getreg((3 << 11) | 20) & 0xFu; }
#define XB_SPIN(cond, bar) do { unsigned _sp = 0; while (cond) { __builtin_amdgcn_s_sleep(1); \
    if ((++_sp & 255u) == 0u) { if (xb_ld(&(bar)[XB_TMO])) break; if (_sp > XB_SPIN_CAP) { atomicAdd(&(bar)[XB_TMO], 1u); break; } } } } while (0)
struct XcdBarrier { unsigned* bar; unsigned x; volatile LAS3 unsigned* st; };
__device__ __forceinline__ XcdBarrier xcd_barrier_post(unsigned* bar, volatile LAS3 unsigned* st) {
    XcdBarrier b; b.bar = bar; b.x = xb_xcc_id(); b.st = st;
    if (threadIdx.x == 0) (void)xb_add(&bar[XB_XCNT(b.x)], 1u);
    return b;
}
__device__ __forceinline__ void xcd_barrier_complete(unsigned* bar, unsigned x, unsigned& nloc, unsigned& nx) {
    const unsigned G = gridDim.x * gridDim.y * gridDim.z;
    unsigned sum, cnt, mine, sp = 0u;
    for (;;) {
        sum = 0u; cnt = 0u; mine = 0u;
#pragma unroll
        for (unsigned j = 0; j < 16; ++j) { const unsigned c = xb_ld(&bar[XB_XCNT(j)]); sum += c; cnt += (c > 0u) ? 1u : 0u; mine = (j == x) ? c : mine; }
        if (sum == G) break;
        __builtin_amdgcn_s_sleep(1);
        if ((++sp & 255u) == 0u) { if (xb_ld(&bar[XB_TMO])) break; if (sp > XB_SPIN_CAP) { atomicAdd(&bar[XB_TMO], 1u); break; } }
    }
    nloc = mine > 0u ? mine : 1u; nx = cnt > 0u ? cnt : 1u;
}
__device__ __forceinline__ void xcd_barrier(const XcdBarrier& b, int wave_id) {
    asm volatile("s_waitcnt vmcnt(0)" ::: "memory");
    __syncthreads();
    if (tid_of_wave(wave_id) == 0) {
        unsigned* bar = b.bar;
        __builtin_amdgcn_s_waitcnt(0);
        unsigned nloc = b.st[0], nx = b.st[1];
        if (nloc == 0u) { xcd_barrier_complete(bar, b.x, nloc, nx); b.st[0] = nloc; b.st[1] = nx; }
        const unsigned old = xb_add(&bar[XB_XSUB(b.x)], 1u);
        const unsigned gen = old / nloc;
        if (old + 1u == (gen + 1u) * nloc) {
            __builtin_amdgcn_fence(__ATOMIC_RELEASE, "agent");
            asm volatile("s_waitcnt vmcnt(0)" ::: "memory");
            const unsigned og = xb_add(&bar[XB_TOP], 1u);
            const unsigned tg = og / nx;
            if (og + 1u == (tg + 1u) * nx) xb_add(&bar[XB_TOPGEN], 1u);
            else XB_SPIN(xb_ld(&bar[XB_TOPGEN]) == tg, bar);
            __builtin_amdgcn_fence(__ATOMIC_ACQUIRE, "agent");
            xb_add(&bar[XB_XGEN(b.x)], 1u);
            asm volatile("s_waitcnt vmcnt(0)" ::: "memory");
        } else {
            XB_SPIN(xb_ld(&bar[XB_XGEN(b.x)]) == gen, bar);
            __builtin_amdgcn_fence(__ATOMIC_ACQUIRE, "agent");
            asm volatile("s_waitcnt vmcnt(0)" ::: "memory");
        }
    }
    __syncthreads();
}
__device__ __forceinline__ float silu_f(float x) { return x / (1.f + expf(-x)); }
__device__ __forceinline__ float sigmoid_f(float x) { return 1.f / (1.f + expf(-x)); }
__device__ __forceinline__ float sigmoid_fast(float x) { return __builtin_amdgcn_rcpf(1.f + __expf(-x)); }
__device__ __forceinline__ float silu_fast(float x) { return x * __builtin_amdgcn_rcpf(1.f + __expf(-x)); }
__device__ __forceinline__ float softplus_f(float x) { return x > 20.f ? x : log1pf(expf(x)); }
__device__ __forceinline__ float lane_xor(int lane, float v, int mask) { return __int_as_float(__builtin_amdgcn_ds_bpermute((lane ^ mask) << 2, __float_as_int(v))); }
__device__ __forceinline__ float lane_get(float v, int src) { return __int_as_float(__builtin_amdgcn_ds_bpermute(src << 2, __float_as_int(v))); }
template <int CTRL> __device__ __forceinline__ float dpp_f(float v) { return __int_as_float(__builtin_amdgcn_update_dpp(0, __float_as_int(v), CTRL, 0xF, 0xF, false)); }
__device__ __forceinline__ float wave_sum(int lane, float v) {
    v += dpp_f<0xB1>(v);
    v += dpp_f<0x4E>(v);
    v += dpp_f<0x141>(v);
    v += dpp_f<0x140>(v);
    v += lane_xor(lane, v, 16);
    v += lane_xor(lane, v, 32);
    return v;
}
__device__ __forceinline__ float wave_max(int lane, float v) {
    v = fmaxf(v, dpp_f<0xB1>(v));
    v = fmaxf(v, dpp_f<0x4E>(v));
    v = fmaxf(v, dpp_f<0x141>(v));
    v = fmaxf(v, dpp_f<0x140>(v));
    v = fmaxf(v, lane_xor(lane, v, 16));
    v = fmaxf(v, lane_xor(lane, v, 32));
    return v;
}
template <class T, class PT> __device__ __forceinline__ T* wsp(const PT& p, size_t off) { return (T*)(p.ws + off); }
__device__ __forceinline__ const float* modp(const Params& p, int layer, int cond, int j) {
    return wsp<float>(p, OFF_MOD) + (layer * 2 + cond) * 6144 + j * 3072;
}

__device__ __forceinline__ bf16_t f2bf(float f) { unsigned u = __float_as_uint(f); u += 0x7FFFu + ((u >> 16) & 1u); return (bf16_t)(u >> 16); }
__device__ __forceinline__ unsigned pack_bf16(float lo, float hi) { return (unsigned)f2bf(lo) | ((unsigned)f2bf(hi) << 16); }

namespace pg8 {
#define PG8_LAS __attribute__((address_space(3)))
typedef short bf16x8 __attribute__((ext_vector_type(8)));
typedef float f32x4 __attribute__((ext_vector_type(4)));
typedef unsigned u32x4 __attribute__((ext_vector_type(4)));
constexpr int BM = 256, BK = 64, HALF = 128, HTB = HALF * BK * 2, STAGE_BYTES = 8 * HTB, NXCD = 8, WGM = 8;
__device__ __forceinline__ int lds_byte(int r, int c) { const int st = (r >> 4) * 2 + (c >> 5), rr = r & 15, cc = c & 31, ob = rr * 64 + cc * 2; return st * 1024 + (ob ^ (((ob >> 9) & 1) << 5)); }
__device__ __forceinline__ void stage_rc(int b, int& Rr, int& C) { const int st = b / 1024, sb = b % 1024, swz = sb ^ (((sb >> 9) & 1) << 5); Rr = (st >> 1) * 16 + swz / 64; C = (st & 1) * 32 + (swz % 64) / 2; }
__device__ __forceinline__ int perm32(int rho) { const int n = rho >> 4, i = rho & 15; return 8 * (i >> 2) + 4 * n + (i & 3); }
struct Unit { int pm, pn, pb, e; };
struct Gemm { const bf16_t* A; const bf16_t* Bt; int K; };
struct StaticOrder {
    int nM, nN, nwg, G, c;
    __device__ void init(int M, int N, int G_, int c_) { nM = M / BM; nN = N / BM; nwg = nM * nN; G = G_; c = c_; }
    __device__ bool next(int i, Unit& u) const {
        const long Lx = (long)i * G + c; if (Lx >= nwg) return false;
        int wgid = (int)Lx; { const int q = nwg / NXCD, r = nwg % NXCD, xcd = wgid % NXCD, off = wgid / NXCD; wgid = (xcd < r ? xcd * (q + 1) : r * (q + 1) + (xcd - r) * q) + off; }
        const int nig = WGM * nN, gid = wgid / nig, fm = gid * WGM, gsz = (nM - fm) < WGM ? (nM - fm) : WGM;
        u.pm = fm + ((wgid % nig) % gsz); u.pn = (wgid % nig) / gsz; u.pb = u.pn; u.e = 0; return true;
    }
};
struct MoeOrder {
    const int* tile_e; int ntile, nN, G, c;
    __device__ bool next(int i, Unit& u) const {
        const long Lx = (long)i * G + c; if (Lx >= (long)ntile * nN) return false;
        u.pm = (int)(Lx / nN); u.pn = (int)(Lx % nN); u.e = tile_e[u.pm]; u.pb = u.e * nN + u.pn; return true;
    }
};
struct EpiStoreF32 {
    static constexpr bool PERM = false;
    float* C; int ldc; int nvalid;
    __device__ __forceinline__ void operator()(const f32x4 (&acc)[2][2][4][2], const Unit& u, int wr, int wc, int fr, int fq) const {
        const int row0 = u.pm * BM + wr * 64 + fr, col0 = u.pn * BM + wc * 32 + 4 * fq;
#pragma unroll
        for (int ai = 0; ai < 2; ++ai)
#pragma unroll
            for (int m = 0; m < 4; ++m) { float* rowp = C + (size_t)(row0 + ai * HALF + m * 16) * ldc + col0;
#pragma unroll
                for (int bj = 0; bj < 2; ++bj)
#pragma unroll
                    for (int n = 0; n < 2; ++n) if (col0 + bj * HALF + n * 16 < nvalid) *(f32x4*)(rowp + bj * HALF + n * 16) = acc[ai][bj][m][n]; }
    }
};
struct EpiStoreBf16 {
    static constexpr bool PERM = true;
    bf16_t* C; int ldc; int nvalid;
    __device__ __forceinline__ void operator()(const f32x4 (&acc)[2][2][4][2], const Unit& u, int wr, int wc, int fr, int fq) const {
        const int row0 = u.pm * BM + wr * 64 + fr, col0 = u.pn * BM + wc * 32 + 8 * fq;
#pragma unroll
        for (int ai = 0; ai < 2; ++ai)
#pragma unroll
            for (int m = 0; m < 4; ++m) { bf16_t* rowp = C + (size_t)(row0 + ai * HALF + m * 16) * ldc + col0;
#pragma unroll
                for (int bj = 0; bj < 2; ++bj) if (col0 + bj * HALF < nvalid) {
                    const f32x4 v0 = acc[ai][bj][m][0], v1 = acc[ai][bj][m][1];
                    u32x4 w; w.x = pack_bf16(v0[0], v0[1]); w.y = pack_bf16(v0[2], v0[3]); w.z = pack_bf16(v1[0], v1[1]); w.w = pack_bf16(v1[2], v1[3]);
                    *(u32x4*)(rowp + bj * HALF) = w; } }
    }
};
struct EpiResid {
    static constexpr bool PERM = false;
    const float* res_lat; const float* res_ctx; const float* gt_lat; const float* gt_ctx; float* out;
    __device__ __forceinline__ void operator()(const f32x4 (&acc)[2][2][4][2], const Unit& u, int wr, int wc, int fr, int fq) const {
        const int row0 = u.pm * BM + wr * 64 + fr, col0 = u.pn * BM + wc * 32 + 4 * fq;
        const bool ctx = (u.pm * BM) >= L;
        const float* gt = ctx ? gt_ctx : gt_lat;
        f32x4 gv[2][2];
#pragma unroll
        for (int bj = 0; bj < 2; ++bj)
#pragma unroll
            for (int n = 0; n < 2; ++n) gv[bj][n] = *(const f32x4*)(gt + col0 + bj * HALF + n * 16);
#pragma unroll
        for (int ai = 0; ai < 2; ++ai)
#pragma unroll
            for (int m = 0; m < 4; ++m) { const int row = row0 + ai * HALF + m * 16;
                const float* rp = (ctx ? res_ctx + (size_t)(row - L) * D : res_lat + (size_t)row * D) + col0;
                float* op = out + (size_t)row * D + col0;
#pragma unroll
                for (int bj = 0; bj < 2; ++bj)
#pragma unroll
                    for (int n = 0; n < 2; ++n) *(f32x4*)(op + bj * HALF + n * 16) = *(const f32x4*)(rp + bj * HALF + n * 16) + gv[bj][n] * acc[ai][bj][m][n];
                asm volatile("" ::: "memory"); }
    }
};
struct EpiMoe1 {
    static constexpr bool PERM = true;
    bf16_t* ACT; const float* bgu;
    __device__ __forceinline__ void operator()(const f32x4 (&acc)[2][2][4][2], const Unit& u, int wr, int wc, int fr, int fq) const {
        const int row0 = u.pm * BM + wr * 64 + fr, col0 = u.pn * HALF + wc * 32 + 8 * fq;
        const float* bg = bgu + (size_t)u.e * 2048 + col0;
        f32x4 bgv[2], buv[2];
#pragma unroll
        for (int n = 0; n < 2; ++n) { bgv[n] = *(const f32x4*)(bg + 4 * n); buv[n] = *(const f32x4*)(bg + 1024 + 4 * n); }
#pragma unroll
        for (int ai = 0; ai < 2; ++ai)
#pragma unroll
            for (int m = 0; m < 4; ++m) {
                float a[8];
#pragma unroll
                for (int n = 0; n < 2; ++n) { const f32x4 g4 = acc[ai][0][m][n] + bgv[n], u4 = acc[ai][1][m][n] + buv[n];
#pragma unroll
                    for (int j = 0; j < 4; ++j) { const float gate = fminf(g4[j], 7.f), up = fminf(fmaxf(u4[j], -7.f), 7.f);
                        a[n * 4 + j] = (up + 1.f) * gate * __builtin_amdgcn_rcpf(1.f + __expf(-1.702f * gate)); } }
                u32x4 w; w.x = pack_bf16(a[0], a[1]); w.y = pack_bf16(a[2], a[3]); w.z = pack_bf16(a[4], a[5]); w.w = pack_bf16(a[6], a[7]);
                *(u32x4*)(ACT + (size_t)(row0 + ai * HALF + m * 16) * 1024 + col0) = w;
                asm volatile("" ::: "memory"); }
    }
};
struct EpiMoe2 {
    static constexpr bool PERM = true;
    bf16_t* YR; const float* bdn;
    __device__ __forceinline__ void operator()(const f32x4 (&acc)[2][2][4][2], const Unit& u, int wr, int wc, int fr, int fq) const {
        const int row0 = u.pm * BM + wr * 64 + fr, col0 = u.pn * BM + wc * 32 + 8 * fq;
        const float* bd = bdn + (size_t)u.e * 1024 + col0;
        f32x4 bv[2][2];
#pragma unroll
        for (int bj = 0; bj < 2; ++bj)
#pragma unroll
            for (int n = 0; n < 2; ++n) bv[bj][n] = *(const f32x4*)(bd + bj * HALF + 4 * n);
#pragma unroll
        for (int ai = 0; ai < 2; ++ai)
#pragma unroll
            for (int m = 0; m < 4; ++m) { bf16_t* rowp = YR + (size_t)(row0 + ai * HALF + m * 16) * 1024 + col0;
#pragma unroll
                for (int bj = 0; bj < 2; ++bj) {
                    const f32x4 v0 = acc[ai][bj][m][0] + bv[bj][0], v1 = acc[ai][bj][m][1] + bv[bj][1];
                    u32x4 w; w.x = pack_bf16(v0[0], v0[1]); w.y = pack_bf16(v0[2], v0[3]); w.z = pack_bf16(v1[0], v1[1]); w.w = pack_bf16(v1[2], v1[3]);
                    *(u32x4*)(rowp + bj * HALF) = w; }
                asm volatile("" ::: "memory"); }
    }
};
template <class Epi, class Sched>
__device__ __forceinline__ void gemm_phase(int wave_id, PG8_LAS unsigned char* lds, const Gemm g, const Sched& S, const Epi& E) {
    const int TIDX = tid_of_wave(wave_id);
    const int tid = TIDX, wid = __builtin_amdgcn_readfirstlane(tid >> 6), lane = tid & 63, wr = wid >> 2, wc = wid & 3, fr = lane & 15, fq = lane >> 4;
    const int K = g.K, nt = K / BK;
    unsigned voffA[2], voffB[2];
#pragma unroll
    for (int i = 0; i < 2; ++i) { int Rr, C; stage_rc(tid * 16 + i * 8192, Rr, C); const int Rb = Epi::PERM ? ((Rr & ~31) + perm32(Rr & 31)) : Rr;
        voffA[i] = (unsigned)(Rr * K + C) * 2u; voffB[i] = (unsigned)(Rb * K + C) * 2u; }
    const size_t kstep = (size_t)(BK * 2);
    const size_t hstep = (size_t)HALF * K * 2;
    const size_t tstep = 2 * hstep;
    const unsigned ldsw = (unsigned)wid * 1024u;
    const int aoff = lds_byte(wr * 64 + fr, fq * 8), boff = lds_byte(wc * 32 + fr, fq * 8);
#define PG8_SA(b, h) (((b) * 2 + (h)) * HTB)
#define PG8_SB(b, h) ((4 + (b) * 2 + (h)) * HTB)
#define PG8_STAGE(bufoff, gbase, voff) do { _Pragma("unroll") for (int _i = 0; _i < 2; ++_i) \
        __builtin_amdgcn_global_load_lds((const unsigned*)((const char*)(gbase) + (voff)[_i]), (PG8_LAS unsigned*)(lds + (bufoff) + ldsw + _i * 8192), 16, 0, 0); } while (0)
#define PG8_LDA(dst, b, h) do { _Pragma("unroll") for (int m = 0; m < 4; ++m) _Pragma("unroll") for (int k = 0; k < 2; ++k) dst[m][k] = *(const PG8_LAS bf16x8*)(lds + PG8_SA(b, h) + aoff + m * 2048 + k * 1024); } while (0)
#define PG8_LDB(dst, b, h) do { _Pragma("unroll") for (int n = 0; n < 2; ++n) _Pragma("unroll") for (int k = 0; k < 2; ++k) dst[n][k] = *(const PG8_LAS bf16x8*)(lds + PG8_SB(b, h) + boff + n * 2048 + k * 1024); } while (0)
#define PG8_MMA(ai, bj, At, Bt) do { __builtin_amdgcn_s_setprio(1); _Pragma("unroll") for (int m = 0; m < 4; ++m) _Pragma("unroll") for (int n = 0; n < 2; ++n) _Pragma("unroll") for (int k = 0; k < 2; ++k) \
        acc[ai][bj][m][n] = __builtin_amdgcn_mfma_f32_16x16x32_bf16(Bt[n][k], At[m][k], acc[ai][bj][m][n], 0, 0, 0); __builtin_amdgcn_s_setprio(0); } while (0)
#define PG8_WAIT_V(n) asm volatile("s_waitcnt vmcnt(" #n ")" ::: "memory")
#define PG8_WAIT_L(n) asm volatile("s_waitcnt lgkmcnt(" #n ")" ::: "memory")
#define PG8_BAR __builtin_amdgcn_s_barrier()
#define PG8_SCHED __builtin_amdgcn_sched_barrier(0)
    Unit cur, nxt; int ui = 0;
    if (!S.next(0, cur)) return;
    f32x4 acc[2][2][4][2];
#pragma unroll
    for (int a = 0; a < 2; ++a)
#pragma unroll
        for (int b = 0; b < 2; ++b)
#pragma unroll
            for (int m = 0; m < 4; ++m)
#pragma unroll
                for (int n = 0; n < 2; ++n) acc[a][b][m][n] = (f32x4){0.f, 0.f, 0.f, 0.f};
    bf16x8 At[4][2], B0[2][2], B1[2][2];
    const char* cA = (const char*)g.A + (size_t)cur.pm * tstep; const char* cB = (const char*)g.Bt + (size_t)cur.pb * tstep;
    PG8_STAGE(PG8_SB(0, 0), cB, voffB); PG8_STAGE(PG8_SA(0, 0), cA, voffA); PG8_STAGE(PG8_SB(0, 1), cB + hstep, voffB); PG8_STAGE(PG8_SA(0, 1), cA + hstep, voffA);
    if (wr == 1) PG8_BAR;
    PG8_WAIT_V(4); PG8_BAR;
    PG8_STAGE(PG8_SB(1, 0), cB + kstep, voffB); PG8_STAGE(PG8_SA(1, 0), cA + kstep, voffA); PG8_STAGE(PG8_SB(1, 1), cB + hstep + kstep, voffB);
    PG8_WAIT_V(6); PG8_BAR;
    for (;;) {
        const bool has_next = S.next(ui + 1, nxt);
        const char* nA = has_next ? (const char*)g.A + (size_t)nxt.pm * tstep : cA; const char* nB = has_next ? (const char*)g.Bt + (size_t)nxt.pb * tstep : cB;
        for (int t = 0; t < nt; t += 2) {
            const bool last = (t == nt - 2);
            const char* a1 = cA + (size_t)(t + 1) * kstep;
            const char* a2 = last ? nA : cA + (size_t)(t + 2) * kstep; const char* b2 = last ? nB : cB + (size_t)(t + 2) * kstep;
            const char* a3 = a2 + kstep; const char* b3 = b2 + kstep;
            PG8_LDB(B0, 0, 0); PG8_SCHED; PG8_LDA(At, 0, 0); PG8_STAGE(PG8_SA(1, 1), a1 + hstep, voffA);
            PG8_WAIT_L(8); PG8_BAR; PG8_WAIT_L(0); PG8_MMA(0, 0, At, B0); PG8_BAR; PG8_SCHED;
            PG8_LDB(B1, 0, 1); PG8_STAGE(PG8_SB(0, 0), b2, voffB);
            PG8_BAR; PG8_WAIT_L(0); PG8_MMA(0, 1, At, B1); PG8_BAR;
            PG8_LDA(At, 0, 1); PG8_STAGE(PG8_SA(0, 0), a2, voffA);
            PG8_BAR; PG8_WAIT_L(0); PG8_MMA(1, 0, At, B0); PG8_BAR; PG8_SCHED;
            PG8_STAGE(PG8_SB(0, 1), b2 + hstep, voffB);
            PG8_WAIT_V(6); PG8_BAR; PG8_MMA(1, 1, At, B1); PG8_BAR;
            PG8_LDB(B0, 1, 0); PG8_SCHED; PG8_LDA(At, 1, 0); PG8_STAGE(PG8_SA(0, 1), a2 + hstep, voffA);
            PG8_WAIT_L(8); PG8_BAR; PG8_WAIT_L(0); PG8_MMA(0, 0, At, B0); PG8_BAR; PG8_SCHED;
            PG8_LDB(B1, 1, 1); PG8_STAGE(PG8_SB(1, 0), b3, voffB);
            PG8_BAR; PG8_WAIT_L(0); PG8_MMA(0, 1, At, B1); PG8_BAR;
            PG8_LDA(At, 1, 1); PG8_STAGE(PG8_SA(1, 0), a3, voffA);
            PG8_BAR; PG8_WAIT_L(0); PG8_MMA(1, 0, At, B0); PG8_BAR; PG8_SCHED;
            PG8_STAGE(PG8_SB(1, 1), b3 + hstep, voffB);
            PG8_WAIT_V(6); PG8_BAR; PG8_MMA(1, 1, At, B1); PG8_BAR;
        }
        E(acc, cur, wr, wc, fr, fq);
        if (!has_next) break;
#pragma unroll
        for (int a = 0; a < 2; ++a)
#pragma unroll
            for (int b = 0; b < 2; ++b)
#pragma unroll
                for (int m = 0; m < 4; ++m)
#pragma unroll
                    for (int n = 0; n < 2; ++n) acc[a][b][m][n] = (f32x4){0.f, 0.f, 0.f, 0.f};
        cur = nxt; cA = nA; cB = nB; ++ui;
    }
    PG8_WAIT_V(0);
    if (wr == 0) PG8_BAR;
    PG8_BAR;
#undef PG8_SA
#undef PG8_SB
#undef PG8_STAGE
#undef PG8_LDA
#undef PG8_LDB
#undef PG8_MMA
#undef PG8_WAIT_V
#undef PG8_WAIT_L
#undef PG8_BAR
#undef PG8_SCHED
}
}

typedef unsigned u32x2_t __attribute__((ext_vector_type(2)));
typedef short bf16x8_t __attribute__((ext_vector_type(8)));
typedef float f32x16 __attribute__((ext_vector_type(16)));
typedef float f32x16f __attribute__((ext_vector_type(16)));
constexpr int LDP = 136;
template <int KSTEPS>
__device__ __forceinline__ f32x16 mma32(int lane, const bf16_t* As, int lda, const bf16_t* Bs, int ldb, f32x16 acc) {
    const int r = lane & 31, hh = lane >> 5;
    const bf16_t* ap = As + r * lda + 8 * hh;
    const bf16_t* bp = Bs + r * ldb + 8 * hh;
#pragma unroll 2
    for (int ks = 0; ks < KSTEPS; ks++) {
        const bf16x8_t a = *(const bf16x8_t*)(ap + ks * 16);
        const bf16x8_t b = *(const bf16x8_t*)(bp + ks * 16);
        acc = __builtin_amdgcn_mfma_f32_32x32x16_bf16(a, b, acc, 0, 0, 0);
    }
    return acc;
}
#define CROW(reg, hf) (((reg) & 3) + 8 * ((reg) >> 2) + 4 * (hf))
__device__ __forceinline__ float bf2f(unsigned short b) { return __uint_as_float(((unsigned)b) << 16); }

template <class PT>
__device__ __forceinline__ void ph_convert_weights(const PT& p) {
    const int TIDX = tid_opaque();
    const int lane = TIDX & 63, wave = TIDX >> 6, nl = lane & 31, kh = lane >> 5;
    constexpr int G_INE = EVEN_IN / 32, G_INO = ODD_PAD / 32, G_OUT = 2 * D / 32, G_GU = 64 * 2048 / 32, G_DN = 64 * 1024 / 32;
    constexpr int GT = G_INE + G_INO + G_OUT + G_GU + G_DN;
    for (int it = blockIdx.x * NWAVE + wave; it < GT * 16; it += gridDim.x * NWAVE) {
        const int item = __builtin_amdgcn_readfirstlane(it);
        int g = item % GT; const int kg = item / GT;
        const float* src; bf16_t* dst; int N, col0, nvalid;
        if (g < G_INE) { src = p.in[I_WINE]; N = EVEN_IN; col0 = g * 32; nvalid = EVEN_IN; dst = wsp<bf16_t>(p, OFF_WINE) + (size_t)g * 32 * 1024; }
        else if ((g -= G_INE) < G_INO) { src = p.in[I_WINO]; N = ODD_IN; col0 = g * 32; nvalid = ODD_IN; dst = wsp<bf16_t>(p, OFF_WINO) + (size_t)g * 32 * 1024; }
        else if ((g -= G_INO) < G_OUT) { const int l = g / 32, gg = g % 32; src = p.in[I_WOUT] + (size_t)l * D * D; N = D; col0 = gg * 32; nvalid = D; dst = wsp<bf16_t>(p, OFF_WOUT) + ((size_t)l * 1024 + gg * 32) * 1024; }
        else if ((g -= G_OUT) < G_GU) { const int le = g / 64, gg = g % 64, drow = gg * 32, T = drow >> 8, within = drow & 255;
            src = p.in[I_WGU] + (size_t)le * 1024 * 2048; N = 2048; nvalid = 2048;
            col0 = within < 128 ? 128 * T + within : 1024 + 128 * T + (within - 128);
            dst = wsp<bf16_t>(p, OFF_WGU) + ((size_t)le * 2048 + drow) * 1024; }
        else { g -= G_GU; const int le = g / 32, gg = g % 32; src = p.in[I_WDN] + (size_t)le * 1024 * 1024; N = 1024; col0 = gg * 32; nvalid = 1024; dst = wsp<bf16_t>(p, OFF_WDN) + ((size_t)le * 1024 + gg * 32) * 1024; }
        const bool ok = col0 + nl < nvalid;
        const float* sp = src + (size_t)(kg * 64 + kh * 8) * N + col0 + nl;
        float a[4][8];
#pragma unroll
        for (int ch = 0; ch < 4; ch++)
#pragma unroll
            for (int q = 0; q < 8; q++) a[ch][q] = ok ? sp[(size_t)(16 * ch + q) * N] : 0.f;
#pragma unroll
        for (int ch = 0; ch < 4; ch++) {
            pg8::u32x4 w; w.x = pack_bf16(a[ch][0], a[ch][1]); w.y = pack_bf16(a[ch][2], a[ch][3]); w.z = pack_bf16(a[ch][4], a[ch][5]); w.w = pack_bf16(a[ch][6], a[ch][7]);
            *(pg8::u32x4*)(dst + (size_t)nl * 1024 + kg * 64 + 16 * ch + kh * 8) = w;
        }
    }
}

template <class AL, class BL, class EP>
__device__ __forceinline__ void gemm_tile_f32(int wave_id, float* lds, int K, AL aload, BL bload, EP epi) {
    const int TIDX = tid_of_wave(wave_id);
    float(*As)[132] = (float(*)[132])lds;
    float(*Bs)[132] = (float(*)[132])(lds + 16 * 132);
    const int tid = TIDX, tx = tid & 15, ty = tid >> 4;
    float acc[4][8];
#pragma unroll
    for (int i = 0; i < 4; i++)
#pragma unroll
        for (int j = 0; j < 8; j++) acc[i][j] = 0.f;
    for (int k0 = 0; k0 < K; k0 += 16) {
        float av[4], bv[4];
#pragma unroll
        for (int i = 0; i < 4; i++) av[i] = aload((tid >> 4) + 32 * i, k0 + (tid & 15));
#pragma unroll
        for (int i = 0; i < 4; i++) bv[i] = bload(k0 + (tid >> 7) + 4 * i, tid & 127);
        __syncthreads();
#pragma unroll
        for (int i = 0; i < 4; i++) As[tid & 15][(tid >> 4) + 32 * i] = av[i];
#pragma unroll
        for (int i = 0; i < 4; i++) Bs[(tid >> 7) + 4 * i][tid & 127] = bv[i];
        __syncthreads();
#pragma unroll
        for (int k = 0; k < 16; k++) {
            const float4 a = *(const float4*)&As[k][ty * 4];
            const float4 b0 = *(const float4*)&Bs[k][tx * 4];
            const float4 b1 = *(const float4*)&Bs[k][64 + tx * 4];
            const float aa[4] = {a.x, a.y, a.z, a.w};
            const float bb[8] = {b0.x, b0.y, b0.z, b0.w, b1.x, b1.y, b1.z, b1.w};
#pragma unroll
            for (int i = 0; i < 4; i++)
#pragma unroll
                for (int j = 0; j < 8; j++) acc[i][j] = fmaf(aa[i], bb[j], acc[i][j]);
        }
    }
    __syncthreads();
#pragma unroll
    for (int i = 0; i < 4; i++) epi(ty * 4 + i, tx, acc[i]);
}
__device__ __forceinline__ int lcol(int tx, int jc) { return tx * 4 + (jc & 3) + 64 * (jc >> 2); }

template <class EP>
__device__ __forceinline__ void gemm_dense(int wave_id, float* lds, const float* A, int lda, const float* B, int N, int M, int K, EP epi) {
    const int tm = M / 128, tn = (N + 127) / 128;
    for (int t = blockIdx.x; t < tm * tn; t += gridDim.x) {
        const int m0 = (t / tn) * 128, n0 = (t % tn) * 128;
        gemm_tile_f32(
            wave_id, lds, K, [&](int r, int k) { return A[(size_t)(m0 + r) * lda + k]; },
            [&](int k, int c) { return (n0 + c < N) ? B[(size_t)k * N + n0 + c] : 0.f; },
            [&](int r, int tx, const float(&a)[8]) {
#pragma unroll
                for (int jc = 0; jc < 8; jc++) {
                    const int c = n0 + lcol(tx, jc);
                    if (c < N) epi(m0 + r, c, a[jc]);
                }
            });
    }
}

template <class PT>
__device__ __forceinline__ void ph_prologue(const PT& p, float* lds) {
    const int TIDX = tid_opaque();
    const int tid = TIDX, lane = tid & 63, wave = tid >> 6;
    const int gthreads = gridDim.x * NT, gtid = blockIdx.x * NT + tid;
    float* mod = wsp<float>(p, OFF_MOD);
    {
        float* sc = lds + 1024;
        float* red = lds + 3072;
        for (int k = tid; k < 1024; k += NT) { sc[k] = silu_f(p.in[I_C][k]); sc[1024 + k] = silu_f(p.in[I_CCTX][k]); }
        __syncthreads();
        for (int it = blockIdx.x; it < 2 * 96; it += gridDim.x) {
            const int layer = it / 96, n = (it % 96) * 64 + lane;
            const float* w = p.in[I_ADAW] + (size_t)layer * 1024 * 6144 + (size_t)wave * 128 * 6144 + n;
            float a0 = 0.f, a1 = 0.f;
#pragma unroll 8
            for (int k = 0; k < 128; k++) {
                const float wv = w[(size_t)k * 6144];
                a0 = fmaf(sc[wave * 128 + k], wv, a0);
                a1 = fmaf(sc[1024 + wave * 128 + k], wv, a1);
            }
            red[(wave * 2 + 0) * 64 + lane] = a0;
            red[(wave * 2 + 1) * 64 + lane] = a1;
            __syncthreads();
            if (wave < 2) {
                float a = p.in[I_ADAB][layer * 6144 + n];
#pragma unroll
                for (int w8 = 0; w8 < 8; w8++) a += red[(w8 * 2 + wave) * 64 + lane];
                mod[(layer * 2 + wave) * 6144 + n] = a;
            }
            __syncthreads();
        }
    }
    for (int it = gtid; it < 4096; it += gthreads) {
        const int pos = it >> 4, i = it & 15;
        const float ang = (float)pos * powf(10000.f, -(float)i / 16.f);
        wsp<float2>(p, OFF_ROPE)[it] = make_float2(cosf(ang), sinf(ang));
    }
    for (int it = gtid; it < 512; it += gthreads) {
        const float b0 = p.in[I_HGLB][it], b1 = p.in[I_HGLB][512 + it];
        wsp<float>(p, OFF_LB)[it] = 1.f / (1.f + expf(b0 - b1));
    }
    float* zb = lds + wave * 64;
    float* hd3 = wsp<float>(p, OFF_HD3);
    const float fq = p.in[I_HYFREQ][lane];
    float w1r[33], w2r[64], w3r[64];
#pragma unroll
    for (int i = 0; i < 33; i++) w1r[i] = p.in[I_HYW1][i * 64 + lane];
#pragma unroll
    for (int i = 0; i < 64; i++) { w2r[i] = p.in[I_HYW2][i * 64 + lane]; w3r[i] = p.in[I_HYW3][i * 64 + lane]; }
    const float b1 = p.in[I_HYB1][lane], b2 = p.in[I_HYB2][lane], b3 = p.in[I_HYB3][lane];
    for (int row = blockIdx.x * NWAVE + wave; row < R; row += gridDim.x * NWAVE) {
        const int Ls = row < L ? L : NCX, t = row < L ? row : row - L;
        const float tn = (float)t / (float)(Ls - 1);
        const float wang = 6.283185307179586f * (float)t / (float)Ls;
        if (lane < 33) {
            float z;
            if (lane == 0) z = tn;
            else {
                const int b = (lane - 1) & 15;
                const float fr = 1e-4f + (float)b * ((15.f - 1e-4f) / 15.f);
                z = (lane <= 16) ? cosf(fr * wang) : -sinf(fr * wang);
            }
            zb[lane] = z;
        }
        __builtin_amdgcn_wave_barrier();
        float a = b1;
#pragma unroll
        for (int i = 0; i < 33; i++) a = fmaf(zb[i], w1r[i], a);
        float h = sinf(fq * a);
        __builtin_amdgcn_wave_barrier();
        zb[lane] = h;
        __builtin_amdgcn_wave_barrier();
        a = b2;
#pragma unroll
        for (int i = 0; i < 64; i++) a = fmaf(zb[i], w2r[i], a);
        h = sinf(fq * a);
        __builtin_amdgcn_wave_barrier();
        zb[lane] = h;
        __builtin_amdgcn_wave_barrier();
        a = b3;
#pragma unroll
        for (int i = 0; i < 64; i++) a = fmaf(zb[i], w3r[i], a);
        h = sinf(fq * a);
        hd3[(size_t)row * 64 + lane] = h;
        __builtin_amdgcn_wave_barrier();
    }
}

template <bool ROUTER>
__device__ __forceinline__ void prep_rows(const Params& p, float* lds, const float* xl, const float* xc, int nrows, const float* g, int layer, int j) {
    const int TIDX = tid_of_wave(p.wave_id);
    const int lane = TIDX & 63, wave = TIDX >> 6;
    float* rwT = lds;
    int* lcnt = (int*)(lds + 32 * 1024);
    if (ROUTER) {
        __syncthreads();
        if (TIDX < 32) lcnt[TIDX] = 0;
        const float* rw = p.in[I_RW] + (size_t)layer * 1024 * 32;
#pragma unroll 4
        for (int idx = TIDX; idx < 1024 * 8; idx += NT) {
            const int c = idx >> 3, e4 = (idx & 7) * 4;
            const float4 w = *(const float4*)(rw + (size_t)c * 32 + e4);
            rwT[(e4 + 0) * 1024 + c] = w.x; rwT[(e4 + 1) * 1024 + c] = w.y; rwT[(e4 + 2) * 1024 + c] = w.z; rwT[(e4 + 3) * 1024 + c] = w.w;
        }
        __syncthreads();
    }
    bf16_t* HB = wsp<bf16_t>(p, OFF_HB);
    for (int r = blockIdx.x * NWAVE + wave; r < nrows; r += gridDim.x * NWAVE) {
        const float* src = r < L ? xl + (size_t)r * D : xc + (size_t)(r - L) * D;
        const float* md = modp(p, layer, r < L ? 0 : 1, j);
        float4 v[4];
        float ss = 0.f;
#pragma unroll
        for (int i = 0; i < 4; i++) { v[i] = *(const float4*)(src + 256 * i + 4 * lane); ss += v[i].x * v[i].x + v[i].y * v[i].y + v[i].z * v[i].z + v[i].w * v[i].w; }
        ss = wave_sum(lane, ss);
        const float rinv = rsqrtf(ss * (1.f / 1024.f) + EPS);
#pragma unroll
        for (int i = 0; i < 4; i++) {
            const int c = 256 * i + 4 * lane;
            const float4 g4 = *(const float4*)(g + c), sc4 = *(const float4*)(md + 1024 + c), sh4 = *(const float4*)(md + c);
            v[i].x = v[i].x * rinv * g4.x * (1.f + sc4.x) + sh4.x; v[i].y = v[i].y * rinv * g4.y * (1.f + sc4.y) + sh4.y;
            v[i].z = v[i].z * rinv * g4.z * (1.f + sc4.z) + sh4.z; v[i].w = v[i].w * rinv * g4.w * (1.f + sc4.w) + sh4.w;
            u32x2_t o; o.x = pack_bf16(v[i].x, v[i].y); o.y = pack_bf16(v[i].z, v[i].w);
            *(u32x2_t*)(HB + (size_t)r * D + c) = o;
        }
        if (ROUTER) {
            float lg[32];
#pragma unroll
            for (int e = 0; e < 32; e++) {
                float a = 0.f;
#pragma unroll
                for (int i = 0; i < 4; i++) {
                    const float4 w = *(const float4*)(rwT + e * 1024 + 256 * i + 4 * lane);
                    a = fmaf(v[i].x, w.x, a); a = fmaf(v[i].y, w.y, a); a = fmaf(v[i].z, w.z, a); a = fmaf(v[i].w, w.w, a);
                }
                lg[e] = a;
                if ((e & 3) == 3) asm volatile("" ::: "memory");
            }
#pragma unroll
            for (int e = 0; e < 32; e++) lg[e] = wave_sum(lane, lg[e]) + p.in[I_RB][layer * 32 + e];
            unsigned used = 0u;
            float tv[4];
            int ti[4];
#pragma unroll
            for (int k = 0; k < 4; k++) {
                float best = -INFINITY;
                int bi = 0;
#pragma unroll
                for (int e = 0; e < 32; e++) {
                    const bool ok = !((used >> e) & 1u) && (lg[e] > best);
                    best = ok ? lg[e] : best;
                    bi = ok ? e : bi;
                }
                used |= 1u << bi;
                tv[k] = best;
                ti[k] = bi;
            }
            float es[4], den = 0.f;
#pragma unroll
            for (int k = 0; k < 4; k++) { es[k] = expf(tv[k] - tv[0]); den += es[k]; }
            if (lane < 4) {
                int e = ti[0];
                float gg = es[0];
#pragma unroll
                for (int k = 1; k < 4; k++) { e = (lane == k) ? ti[k] : e; gg = (lane == k) ? es[k] : gg; }
                const int pos = atomicAdd(&lcnt[e], 1);
                wsp<int>(p, OFF_TOPE)[r * 4 + lane] = e;
                wsp<float>(p, OFF_TOPG)[r * 4 + lane] = gg / den;
                wsp<int>(p, OFF_TOPP)[r * 4 + lane] = pos;
            }
        }
    }
    if (ROUTER) {
        __syncthreads();
        if (TIDX < 32) wsp<int>(p, OFF_BC)[((size_t)layer * 512 + blockIdx.x) * 32 + TIDX] = lcnt[TIDX];
    }
}

__device__ __forceinline__ void prep_router(const Params& p, unsigned char* smem, const float* xl, const float* xc, int nrows, const float* g, int layer, int j) {
    const int TIDX = tid_of_wave(p.wave_id);
    const int tid = TIDX, lane = tid & 63, wave = tid >> 6, hf = lane >> 5;
    float* HTl = (float*)smem;
    int* lcnt = (int*)(smem + 32 * 1028 * 4);
    float* LGT = (float*)(smem + 32 * 1028 * 4 + 128);
    const float* rw = p.in[I_RW] + (size_t)layer * 1024 * 32;
    const float* rb = p.in[I_RB] + layer * 32;
    bf16_t* HB = wsp<bf16_t>(p, OFF_HB);
    if (tid < 32) lcnt[tid] = 0;
    for (int grp = blockIdx.x; grp < nrows / 32; grp += gridDim.x) {
        __syncthreads();
        float4 xv[4][4];
#pragma unroll
        for (int q = 0; q < 4; q++) {
            const int r = grp * 32 + wave * 4 + q;
            const float* src = r < L ? xl + (size_t)r * D : xc + (size_t)(r - L) * D;
#pragma unroll
            for (int i = 0; i < 4; i++) xv[q][i] = *(const float4*)(src + 256 * i + 4 * lane);
        }
#pragma unroll
        for (int q = 0; q < 4; q++) {
            const int rl = wave * 4 + q, r = grp * 32 + rl;
            const float* md = modp(p, layer, r < L ? 0 : 1, j);
            float4 v[4];
            float ss = 0.f;
#pragma unroll
            for (int i = 0; i < 4; i++) { v[i] = xv[q][i]; ss += v[i].x * v[i].x + v[i].y * v[i].y + v[i].z * v[i].z + v[i].w * v[i].w; }
            ss = wave_sum(lane, ss);
            const float rinv = rsqrtf(ss * (1.f / 1024.f) + EPS);
#pragma unroll
            for (int i = 0; i < 4; i++) {
                const int c = 256 * i + 4 * lane;
                const float4 g4 = *(const float4*)(g + c), sc4 = *(const float4*)(md + 1024 + c), sh4 = *(const float4*)(md + c);
                v[i].x = v[i].x * rinv * g4.x * (1.f + sc4.x) + sh4.x; v[i].y = v[i].y * rinv * g4.y * (1.f + sc4.y) + sh4.y;
                v[i].z = v[i].z * rinv * g4.z * (1.f + sc4.z) + sh4.z; v[i].w = v[i].w * rinv * g4.w * (1.f + sc4.w) + sh4.w;
                u32x2_t o; o.x = pack_bf16(v[i].x, v[i].y); o.y = pack_bf16(v[i].z, v[i].w);
                *(u32x2_t*)(HB + (size_t)r * D + c) = o;
                *(float4*)(HTl + rl * 1028 + c) = v[i];
            }
        }
        __syncthreads();
        f32x16f acc;
#pragma unroll
        for (int q = 0; q < 16; q++) acc[q] = 0.f;
        {
            const float* ap = HTl + (lane & 31) * 1028 + wave * 128 + hf;
            const float* bp = rw + (size_t)(wave * 128 + hf) * 32 + (lane & 31);
#pragma unroll 16
            for (int kk = 0; kk < 64; kk++) acc = __builtin_amdgcn_mfma_f32_32x32x2f32(ap[2 * kk], bp[(size_t)kk * 64], acc, 0, 0, 0);
        }
        __syncthreads();
        {
            float* part = HTl + wave * 1024 + (lane & 31);
#pragma unroll
            for (int q = 0; q < 16; q++) part[CROW(q, hf) * 32] = acc[q];
        }
        __syncthreads();
#pragma unroll
        for (int q = 0; q < 2; q++) {
            const int o = tid + 512 * q;
            float a = rb[o & 31];
#pragma unroll
            for (int w8 = 0; w8 < 8; w8++) a += HTl[w8 * 1024 + o];
            LGT[(o >> 5) * 33 + (o & 31)] = a;
        }
        __syncthreads();
        if (tid < 32) {
            const int r = grp * 32 + tid;
            float lg[32];
#pragma unroll
            for (int e = 0; e < 32; e++) lg[e] = LGT[tid * 33 + e];
            unsigned used = 0u;
            float tv[4];
            int ti[4];
#pragma unroll
            for (int k = 0; k < 4; k++) {
                float best = -INFINITY;
                int bi = 0;
#pragma unroll
                for (int e = 0; e < 32; e++) {
                    const bool ok = !((used >> e) & 1u) && (lg[e] > best);
                    best = ok ? lg[e] : best;
                    bi = ok ? e : bi;
                }
                used |= 1u << bi;
                tv[k] = best;
                ti[k] = bi;
            }
            float es[4], den = 0.f;
#pragma unroll
            for (int k = 0; k < 4; k++) { es[k] = expf(tv[k] - tv[0]); den += es[k]; }
            const float rden = 1.f / den;
            int pos[4];
#pragma unroll
            for (int k = 0; k < 4; k++) pos[k] = atomicAdd(&lcnt[ti[k]], 1);
            *(int4*)(wsp<int>(p, OFF_TOPE) + r * 4) = make_int4(ti[0], ti[1], ti[2], ti[3]);
            *(float4*)(wsp<float>(p, OFF_TOPG) + r * 4) = make_float4(es[0] * rden, es[1] * rden, es[2] * rden, es[3] * rden);
            *(int4*)(wsp<int>(p, OFF_TOPP) + r * 4) = make_int4(pos[0], pos[1], pos[2], pos[3]);
        }
    }
    __syncthreads();
    if (tid < 32) wsp<int>(p, OFF_BC)[((size_t)layer * 512 + blockIdx.x) * 32 + tid] = lcnt[tid];
}

__device__ __forceinline__ void ph_filter_gemm_ctx(const Params& p, float* lds) {
    const float* hd3 = wsp<float>(p, OFF_HD3) + (size_t)L * 64;
    float* hhc = wsp<float>(p, OFF_HHC);
    const float mind = logf(1e-2f) / 1.5f, maxd = logf(1e-2f) / 0.3f;
    gemm_dense(p.wave_id, lds, hd3, 64, p.in[I_HYW4], 2048, NCX, 64, [&](int t, int col, float v) {
        const int o = col >> 10, side = (col >> 9) & 1, ch = col & 511;
        const float delta = fabsf(mind + (float)ch * ((maxd - mind) / 511.f));
        const float tn = (float)t / (float)(NCX - 1);
        const float val = v * expf(-tn * delta);
        if (side == 0) hhc[(size_t)(NCX + t) * 1024 + o * 512 + ch] = val;
        else if (t > 0) hhc[(size_t)(NCX - t) * 1024 + o * 512 + ch] = val;
        else hhc[o * 512 + ch] = 0.f;
    });
}
__device__ __forceinline__ void ph_filter_abs_ctx(const Params& p) {
    const int TIDX = tid_of_wave(p.wave_id);
    const float* hhc = wsp<float>(p, OFF_HHC);
    float* hnp = wsp<float>(p, OFF_HNP);
    for (int it = blockIdx.x; it < 4; it += gridDim.x) {
        const int chunk = it >> 1, col = (it & 1) * 512 + TIDX;
        const float* src = hhc + (size_t)chunk * 256 * 1024;
        float s = 0.f;
        for (int i = 0; i < 256; i++) s += fabsf(src[(size_t)i * 1024 + col]);
        hnp[(128 + chunk) * 1024 + col] = s;
    }
}
__device__ __forceinline__ void ph_filter_gemm_lat(const Params& p, unsigned char* smem) {
    const int TIDX = tid_of_wave(p.wave_id);
    float* As = (float*)smem;
    float* Bs = As + 64 * 132;
    const float* hd3 = wsp<float>(p, OFF_HD3);
    const float* w4 = p.in[I_HYW4];
    float* HT = wsp<float>(p, OFF_HT);
    const float mind = logf(1e-2f) / 1.5f, maxd = logf(1e-2f) / 0.3f;
    const int tid = TIDX, lane = tid & 63, wave = tid >> 6, hf = lane >> 5;
    for (int it = blockIdx.x; it < 16 * 128; it += gridDim.x) {
        const int c0 = (it & 15) * 128, t0 = (it >> 4) * 128;
        float av[16], bv[16];
#pragma unroll
        for (int q = 0; q < 16; q++) { const int idx = tid + 512 * q; av[q] = w4[(size_t)(idx >> 7) * 2048 + c0 + (idx & 127)]; bv[q] = hd3[(size_t)(t0 + (idx >> 6)) * 64 + (idx & 63)]; }
        __syncthreads();
#pragma unroll
        for (int q = 0; q < 16; q++) { const int idx = tid + 512 * q; As[(idx >> 7) * 132 + (idx & 127)] = av[q]; Bs[(idx & 63) * 132 + (idx >> 6)] = bv[q]; }
        __syncthreads();
        const int mt = wave >> 1, nt0 = (wave & 1) * 2;
        f32x16f acc0, acc1;
#pragma unroll
        for (int q = 0; q < 16; q++) { acc0[q] = 0.f; acc1[q] = 0.f; }
        const float* ap = As + hf * 132 + mt * 32 + (lane & 31);
        const float* bp = Bs + hf * 132 + nt0 * 32 + (lane & 31);
#pragma unroll 4
        for (int k0 = 0; k0 < 64; k0 += 2) {
            const float a = ap[k0 * 132], b0 = bp[k0 * 132], b1 = bp[k0 * 132 + 32];
            acc0 = __builtin_amdgcn_mfma_f32_32x32x2f32(a, b0, acc0, 0, 0, 0);
            acc1 = __builtin_amdgcn_mfma_f32_32x32x2f32(a, b1, acc1, 0, 0, 0);
        }
#pragma unroll
        for (int t2 = 0; t2 < 2; t2++) {
            const int t = t0 + (nt0 + t2) * 32 + (lane & 31);
            const float tn = (float)t / (float)(L - 1);
            int cb = c0 + mt * 32 + 4 * hf;
            asm volatile("" : "+v"(cb));
#pragma unroll
            for (int q = 0; q < 16; q++) {
                const int col = cb + (q & 3) + 8 * (q >> 2), ch = col & 511;
                const float delta = fabsf(mind + (float)ch * ((maxd - mind) / 511.f));
                HT[(size_t)col * L + t] = (t2 == 0 ? acc0[q] : acc1[q]) * __expf(-tn * delta);
            }
        }
    }
}

__device__ __forceinline__ float2 cmul(float2 a, float2 b) { return make_float2(a.x * b.x - a.y * b.y, a.x * b.y + a.y * b.x); }
__device__ __forceinline__ float2 cadd(float2 a, float2 b) { return make_float2(a.x + b.x, a.y + b.y); }
__device__ __forceinline__ float2 csub(float2 a, float2 b) { return make_float2(a.x - b.x, a.y - b.y); }
__device__ __forceinline__ float2 cconj(float2 a) { return make_float2(a.x, -a.y); }
__device__ __forceinline__ float2 twid(float frac) { return make_float2(__builtin_amdgcn_cosf(frac), -__builtin_amdgcn_sinf(frac)); }
constexpr int FM = 16384;
__device__ __forceinline__ int fphys(int j) { return j + (j >> 4); }
constexpr int FX_BYTES = (FM + FM / 16) * 8;
__device__ __forceinline__ void dft4(float2& x0, float2& x1, float2& x2, float2& x3) {
    const float2 y0 = cadd(x0, x2), y1 = csub(x0, x2), y2 = cadd(x1, x3), t = csub(x1, x3), y3 = make_float2(t.y, -t.x);
    x0 = cadd(y0, y2); x1 = cadd(y1, y3); x2 = csub(y0, y2); x3 = csub(y1, y3);
}
template <int LP>
__device__ __forceinline__ void fft_pass8(float2* X, int tid) {
    constexpr int pp = 1 << LP;
    float2 u[4][8];
    float2* xb0 = X + fphys(tid);
    float2* xb1 = xb0 + 6144;
    float2* xb2 = xb0 + 12288;
    asm volatile("" : "+v"(xb1), "+v"(xb2));
#define XR(off) ((off) < 6144 ? xb0[(off)] : ((off) < 12288 ? xb1[(off) - 6144] : xb2[(off) - 12288]))
#pragma unroll
    for (int b = 0; b < 4; b++)
#pragma unroll
        for (int r = 0; r < 8; r++) u[b][r] = XR(544 * b + 2176 * r);
    __syncthreads();
#pragma unroll
    for (int b = 0; b < 4; b++) {
        const int i = tid + 512 * b, k = i & (pp - 1), j = ((i - k) << 3) + k;
        const float2 w1 = twid(ldexpf((float)k, -(LP + 3)));
        const float2 w2 = cmul(w1, w1), w3 = cmul(w2, w1), w4 = cmul(w2, w2), w5 = cmul(w4, w1), w6 = cmul(w4, w2), w7 = cmul(w4, w3);
        const float2 u0 = u[b][0], u1 = cmul(u[b][1], w1), u2 = cmul(u[b][2], w2), u3 = cmul(u[b][3], w3);
        const float2 u4 = cmul(u[b][4], w4), u5 = cmul(u[b][5], w5), u6 = cmul(u[b][6], w6), u7 = cmul(u[b][7], w7);
        float2 a0 = cadd(u0, u4), a1 = cadd(u1, u5), a2 = cadd(u2, u6), a3 = cadd(u3, u7);
        float2 b0 = csub(u0, u4), t1 = csub(u1, u5), t2 = csub(u2, u6), t3 = csub(u3, u7);
        const float sq = 0.70710678118654752f;
        float2 b1 = make_float2(sq * (t1.x + t1.y), sq * (t1.y - t1.x));
        float2 b2 = make_float2(t2.y, -t2.x);
        float2 b3 = make_float2(sq * (t3.y - t3.x), -sq * (t3.x + t3.y));
        dft4(a0, a1, a2, a3);
        dft4(b0, b1, b2, b3);
        float2* yb = X + fphys(j);
#define FWO(r) ((r) * pp + (pp == 1 ? 0 : (pp == 8 ? ((r) >> 1) : (r) * pp / 16)))
        yb[FWO(0)] = a0; yb[FWO(1)] = b0; yb[FWO(2)] = a1; yb[FWO(3)] = b1; yb[FWO(4)] = a2; yb[FWO(5)] = b2; yb[FWO(6)] = a3; yb[FWO(7)] = b3;
#undef FWO
        __builtin_amdgcn_sched_barrier(0);
    }
    __syncthreads();
}
__device__ __forceinline__ void fft16k(float2* X, int tid) {
    asm volatile("" : "+v"(tid));
    fft_pass8<0>(X, tid); fft_pass8<3>(X, tid); fft_pass8<6>(X, tid); fft_pass8<9>(X, tid);
    float2* xb0 = X + fphys(tid);
    float2* xb1 = xb0 + 6144;
    float2* xb2 = xb0 + 12288;
    asm volatile("" : "+v"(xb1), "+v"(xb2));
#pragma unroll
    for (int b = 0; b < 8; b++) {
        const int i = tid + 512 * b;
        const float2 w1 = twid(ldexpf((float)i, -14));
        const float2 w2 = cmul(w1, w1), w3 = cmul(w2, w1);
        float2 x0 = XR(544 * b), x1 = cmul(XR(544 * b + 4352), w1), x2 = cmul(XR(544 * b + 8704), w2), x3 = cmul(XR(544 * b + 13056), w3);
        dft4(x0, x1, x2, x3);
        XR(544 * b) = x0; XR(544 * b + 4352) = x1; XR(544 * b + 8704) = x2; XR(544 * b + 13056) = x3;
        __builtin_amdgcn_sched_barrier(0);
    }
    __syncthreads();
#undef XR
}
__device__ __forceinline__ void ph_filter_fft(const Params& p, unsigned char* smem) {
    const int TIDX = tid_of_wave(p.wave_id);
    float2* X = (float2*)smem;
    float* red = (float*)(smem + FX_BYTES);
    const float* HT = wsp<float>(p, OFF_HT);
    float2* HF = wsp<float2>(p, OFF_HF);
    const int tid = TIDX, lane = tid & 63, wave = tid >> 6;
    constexpr int N2 = 2 * L;
    for (int it = blockIdx.x; it < 1024; it += gridDim.x) {
        const int o = it >> 9, ch = it & 511;
        const float* s0 = HT + ((size_t)(o * 2 + 0) * 512 + ch) * L;
        const float* s1 = HT + ((size_t)(o * 2 + 1) * 512 + ch) * L;
        __syncthreads();
        float sa = 0.f;
#pragma unroll 8
        for (int j = 0; j < 16; j++) {
            const int m = tid + 512 * j;
            const float2 v = *(const float2*)(s0 + 2 * m);
            sa += fabsf(v.x) + fabsf(v.y);
            X[fphys(m)] = v;
        }
#pragma unroll 8
        for (int j = 16; j < 32; j++) {
            const int m = tid + 512 * j;
            float2 v = make_float2(s1[N2 - 2 * m], s1[N2 - 2 * m - 1]);
            if (m == L / 2) v.x = 0.f;
            sa += fabsf(v.x) + fabsf(v.y);
            X[fphys(m)] = v;
        }
        sa = wave_sum(lane, sa);
        if (lane == 0) red[wave] = sa;
        __syncthreads();
        float nrm = 0.f;
#pragma unroll
        for (int w = 0; w < 8; w++) nrm += red[w];
        const float scale = 1.f / (nrm * (float)FM);
        fft16k(X, tid);
        float2* dst = HF + (size_t)it * FM;
#pragma unroll 1
        for (int k = tid; k <= FM / 2; k += 512) {
            if (k == 0) { const float2 b0 = X[0]; dst[0] = make_float2((b0.x + b0.y) * scale, (b0.x - b0.y) * scale); }
            else if (k == FM / 2) { const float2 b = X[fphys(k)]; dst[k] = make_float2(b.x * scale, -b.y * scale); }
            else {
                const float2 ak = X[fphys(k)], am = cconj(X[fphys(FM - k)]);
                const float2 e = make_float2(0.5f * (ak.x + am.x), 0.5f * (ak.y + am.y));
                const float2 od = make_float2(0.5f * (ak.x - am.x), 0.5f * (ak.y - am.y));
                const float2 oo = make_float2(od.y, -od.x);
                const float2 wo = cmul(twid(ldexpf((float)k, -15)), oo);
                const float2 hk = cadd(e, wo), hm = cconj(csub(e, wo));
                dst[k] = make_float2(hk.x * scale, hk.y * scale);
                dst[FM - k] = make_float2(hm.x * scale, hm.y * scale);
            }
        }
    }
}
__device__ __forceinline__ void hy_pw_pair(float2* X, const float2* __restrict__ HFc, int k) {
    const float2 hk = HFc[k], hm = HFc[FM - k];
    const float2 ak = X[fphys(k)], am = cconj(X[fphys(FM - k)]);
    const float2 e = make_float2(0.5f * (ak.x + am.x), 0.5f * (ak.y + am.y));
    const float2 od = make_float2(0.5f * (ak.x - am.x), 0.5f * (ak.y - am.y));
    const float2 oo = make_float2(od.y, -od.x);
    const float2 w = twid(ldexpf((float)k, -15));
    const float2 wo = cmul(w, oo);
    const float2 yk = cmul(cadd(e, wo), hk), ym = cmul(cconj(csub(e, wo)), hm);
    const float2 ymc = cconj(ym);
    const float2 P = make_float2(0.5f * (yk.x + ymc.x), 0.5f * (yk.y + ymc.y));
    const float2 Q = make_float2(0.5f * (yk.x - ymc.x), 0.5f * (yk.y - ymc.y));
    const float2 qw = cmul(Q, cconj(w));
    const float2 ck = make_float2(P.x - qw.y, P.y + qw.x);
    const float2 qcw = cmul(cconj(Q), w);
    const float2 cm = make_float2(P.x - qcw.y, -P.y + qcw.x);
    X[fphys(k)] = cconj(ck); X[fphys(FM - k)] = cconj(cm);
}
__device__ __forceinline__ void hy_pointwise(float2* X, const float2* __restrict__ HFc, int tid) {
    asm volatile("" : "+v"(tid));
#pragma unroll 5
    for (int j = 1; j < 16; j++) hy_pw_pair(X, HFc, tid + 512 * j);
    if (tid != 0) hy_pw_pair(X, HFc, tid);
    else {
        const float2 a0 = X[0], h = HFc[0];
        const float y0 = (a0.x + a0.y) * h.x, ym = (a0.x - a0.y) * h.y;
        X[0] = make_float2(0.5f * (y0 + ym), -0.5f * (y0 - ym));
        X[fphys(FM / 2)] = cmul(cconj(X[fphys(FM / 2)]), HFc[FM / 2]);
    }
}
__device__ __forceinline__ void ph_hyena_fft(const Params& p, unsigned char* smem) {
    const int TIDX = tid_of_wave(p.wave_id);
    float2* X = (float2*)smem;
    const float* UT = wsp<float>(p, OFF_U);
    const float2* HF = wsp<float2>(p, OFF_HF);
    unsigned* HYT = wsp<unsigned>(p, OFF_HYT);
    const int tid = TIDX;
    for (int ch = blockIdx.x; ch < 512; ch += gridDim.x) {
        float2 z[16];
#pragma unroll
        for (int j = 0; j < 16; j++) z[j] = ((const float2*)(UT + (size_t)ch * L))[tid + 512 * j];
#pragma unroll 1
        for (int o = 0; o < 2; o++) {
            __syncthreads();
#pragma unroll
            for (int j = 0; j < 16; j++) { X[fphys(tid + 512 * j)] = z[j]; X[fphys(8192 + tid + 512 * j)] = make_float2(0.f, 0.f); }
            __syncthreads();
            fft16k(X, tid);
            hy_pointwise(X, HF + (size_t)(o * 512 + ch) * FM, tid);
            __syncthreads();
            fft16k(X, tid);
            const float bias = p.in[I_HYFB][o * 512 + ch];
            const float2* gate = (const float2*)(UT + (size_t)(512 * (o + 1) + ch) * L);
#pragma unroll
            for (int j = 0; j < 16; j++) {
                const int m = tid + 512 * j;
                const float2 r = X[fphys(m)], g = gate[m];
                z[j] = make_float2(g.x * (r.x + z[j].x * bias), g.y * (-r.y + z[j].y * bias));
            }
        }
#pragma unroll
        for (int j = 0; j < 16; j++) HYT[(size_t)ch * (L / 2) + tid + 512 * j] = pack_bf16(z[j].x, z[j].y);
    }
}
__device__ __forceinline__ void ph_hy_transpose(const Params& p, unsigned char* smem) {
    const int TIDX = tid_of_wave(p.wave_id);
    bf16_t* T = (bf16_t*)smem;
    const bf16_t* HYT = wsp<bf16_t>(p, OFF_HYT);
    bf16_t* MB = wsp<bf16_t>(p, OFF_MB);
    const int tid = TIDX;
    for (int it = blockIdx.x; it < 8 * 256; it += gridDim.x) {
        const int c0 = (it & 7) * 64, t0 = (it >> 3) * 64;
        __syncthreads();
#pragma unroll
        for (int q = 0; q < 8; q++) { const int c = (tid >> 6) + 8 * q, t = tid & 63; T[c * 66 + t] = HYT[(size_t)(c0 + c) * L + t0 + t]; }
        __syncthreads();
#pragma unroll
        for (int q = 0; q < 8; q++) { const int t = (tid >> 6) + 8 * q, c = tid & 63; MB[(size_t)(t0 + t) * D + c0 + c] = T[c * 66 + t]; }
    }
}

__device__ __forceinline__ void ph_qk_dwconv(const Params& p) {
    const int TIDX = tid_of_wave(p.wave_id);
    const int lane = TIDX & 63, wave = TIDX >> 6;
    const bf16_t* P0 = wsp<bf16_t>(p, OFF_P);
    bf16_t* qn = wsp<bf16_t>(p, OFF_QN);
    bf16_t* kn = wsp<bf16_t>(p, OFF_KN);
    const float2* rope = wsp<float2>(p, OFF_ROPE);
    const float gk = p.in[I_KNORM][lane], gq = p.in[I_QNORM][lane];
    for (int r = blockIdx.x * NWAVE + wave; r < R; r += gridDim.x * NWAVE) {
        const bf16_t* pr = P0 + (size_t)r * EVEN_IN;
        float v[10];
#pragma unroll
        for (int s2 = 0; s2 < 10; s2++) v[s2] = bf2f(pr[(s2 < 2 ? s2 * 64 : 256 + (s2 - 2) * 64) + lane]);
        float2 cs = make_float2(1.f, 0.f);
        if (r < L) cs = rope[(lane < 32 ? (r >> 6) : (r & 63)) * 16 + (lane & 15)];
#pragma unroll
        for (int s2 = 0; s2 < 10; s2++) {
            const float ss = wave_sum(lane, v[s2] * v[s2]);
            float n = v[s2] * rsqrtf(ss * (1.f / 64.f) + EPS) * (s2 < 2 ? gk : gq);
            if (r < L) {
                const float partner = lane_xor(lane, n, 16);
                n = ((lane & 16) == 0) ? n * cs.x - partner * cs.y : partner * cs.y + n * cs.x;
            }
            if (s2 < 2) kn[(size_t)r * 128 + s2 * 64 + lane] = f2bf(n);
            else qn[(size_t)r * 512 + (s2 - 2) * 64 + lane] = f2bf(n * 0.125f);
        }
    }
    float* UC = wsp<float>(p, OFF_UC);
    const float* cw = p.in[I_HYCW];
    const float* cb = p.in[I_HYCB];
    for (int it = blockIdx.x * NT + TIDX; it < NCX * 1536; it += gridDim.x * NT) {
        const int r = L + it / 1536, c = it % 1536;
        float a = cb[c];
#pragma unroll
        for (int j = 0; j < 3; j++) {
            const int rr = r + j - 1;
            if (rr >= L && rr < R) a = fmaf(cw[j * 1536 + c], bf2f(P0[(size_t)rr * EVEN_IN + 768 + c]), a);
        }
        UC[it] = a;
    }
}
__device__ __forceinline__ void ph_dwconv_t(const Params& p, float* lds) {
    const int TIDX = tid_of_wave(p.wave_id);
    const bf16_t* P0 = wsp<bf16_t>(p, OFF_P);
    float* UT = wsp<float>(p, OFF_U);
    const float* cw = p.in[I_HYCW];
    const float* cb = p.in[I_HYCB];
    bf16_t* T = (bf16_t*)lds;
    const int tid = TIDX;
    for (int it = blockIdx.x; it < 24 * 128; it += gridDim.x) {
        const int c0 = (it % 24) * 64, t0 = (it / 24) * 128;
        __syncthreads();
        for (int v = tid; v < 130 * 8; v += NT) {
            const int row = v >> 3, c8 = (v & 7) * 8, t = t0 - 1 + row;
            pg8::u32x4 x = {0u, 0u, 0u, 0u};
            if (t >= 0 && t < L) x = *(const pg8::u32x4*)(P0 + (size_t)t * EVEN_IN + 768 + c0 + c8);
            *(pg8::u32x4*)(T + row * 72 + c8) = x;
        }
        __syncthreads();
#pragma unroll
        for (int ps = 0; ps < 4; ps++) {
            const int t4 = tid & 31, c = (tid >> 5) + 16 * ps;
            const float w0 = cw[c0 + c], w1 = cw[1536 + c0 + c], w2 = cw[3072 + c0 + c], bb = cb[c0 + c];
            const bf16_t* tp = T + (t4 * 4) * 72 + c;
            float x[6];
#pragma unroll
            for (int q = 0; q < 6; q++) x[q] = bf2f(tp[q * 72]);
            float4 o;
            o.x = fmaf(w0, x[0], fmaf(w1, x[1], fmaf(w2, x[2], bb)));
            o.y = fmaf(w0, x[1], fmaf(w1, x[2], fmaf(w2, x[3], bb)));
            o.z = fmaf(w0, x[2], fmaf(w1, x[3], fmaf(w2, x[4], bb)));
            o.w = fmaf(w0, x[3], fmaf(w1, x[4], fmaf(w2, x[5], bb)));
            *(float4*)(UT + (size_t)(c0 + c) * L + t0 + t4 * 4) = o;
        }
    }
}

__device__ __forceinline__ void ph_attention_mfma(const Params& p, unsigned char* smem) {
    const int TIDX = tid_of_wave(p.wave_id);
    bf16_t* Ks = (bf16_t*)smem;
    bf16_t* Vts = Ks + 64 * 72;
    const bf16_t* QN = wsp<bf16_t>(p, OFF_QN);
    const bf16_t* KN = wsp<bf16_t>(p, OFF_KN);
    const bf16_t* VB = wsp<bf16_t>(p, OFF_P) + 128;
    bf16_t* MB = wsp<bf16_t>(p, OFF_MB);
    const int tid = TIDX, lane = tid & 63, wave = tid >> 6, hf = lane >> 5, r = lane & 31;
    for (int it = blockIdx.x; it < 260; it += gridDim.x) {
        const bool isctx = it >= 256;
        const int qb = isctx ? (it - 256) >> 1 : it >> 1, kvh = it & 1;
        const int qrow0 = (isctx ? L : 0) + qb * 128;
        const int hq = kvh * 4 + (wave >> 1), qoff = (wave & 1) * 64;
        bf16x8_t qf[2][4];
#pragma unroll
        for (int b = 0; b < 2; b++)
#pragma unroll
            for (int ks = 0; ks < 4; ks++) qf[b][ks] = *(const bf16x8_t*)(QN + (size_t)(qrow0 + qoff + b * 32 + r) * 512 + hq * 64 + ks * 16 + 8 * hf);
        float mrun[2], lrun[2];
        mrun[0] = mrun[1] = p.in[I_SINK][hq];
        lrun[0] = lrun[1] = 1.f;
        f32x16 o[2][2];
#pragma unroll
        for (int dt = 0; dt < 2; dt++)
#pragma unroll
            for (int b = 0; b < 2; b++)
#pragma unroll
                for (int q = 0; q < 16; q++) o[dt][b][q] = 0.f;
        const int tlo = (!isctx && qb == 0) ? 6 : 4, thi = isctx ? 4 : ((qb == L / 128 - 1) ? 8 : 10);
        const int ntiles = 4 + (thi - tlo);
        const int kkey = tid >> 3, kd8 = (tid & 7) * 8, vkey = tid & 63, vd8 = (tid >> 6) * 8;
        pg8::u32x4 kreg, vreg;
        {
            const int krow0 = L;
            kreg = *(const pg8::u32x4*)(KN + (size_t)(krow0 + kkey) * 128 + kvh * 64 + kd8);
            vreg = *(const pg8::u32x4*)(VB + (size_t)(krow0 + vkey) * EVEN_IN + kvh * 64 + vd8);
        }
#pragma unroll 1
        for (int n = 0; n < ntiles; n++) {
            const int tix = n < 4 ? n : tlo + (n - 4);
            const bool local = tix >= 4;
            const int krow0 = local ? qb * 128 - 128 + (tix - 4) * 64 : L + tix * 64;
            __syncthreads();
            *(pg8::u32x4*)(Ks + kkey * 72 + kd8) = kreg;
            {
                bf16_t* dst = Vts + vd8 * 72 + vkey;
                dst[0] = (bf16_t)(vreg.x & 0xffff); dst[72] = (bf16_t)(vreg.x >> 16);
                dst[144] = (bf16_t)(vreg.y & 0xffff); dst[216] = (bf16_t)(vreg.y >> 16);
                dst[288] = (bf16_t)(vreg.z & 0xffff); dst[360] = (bf16_t)(vreg.z >> 16);
                dst[432] = (bf16_t)(vreg.w & 0xffff); dst[504] = (bf16_t)(vreg.w >> 16);
            }
            if (n + 1 < ntiles) {
                const int t2 = (n + 1) < 4 ? (n + 1) : tlo + (n + 1 - 4);
                const int kr2 = t2 >= 4 ? qb * 128 - 128 + (t2 - 4) * 64 : L + t2 * 64;
                kreg = *(const pg8::u32x4*)(KN + (size_t)(kr2 + kkey) * 128 + kvh * 64 + kd8);
                vreg = *(const pg8::u32x4*)(VB + (size_t)(kr2 + vkey) * EVEN_IN + kvh * 64 + vd8);
            }
            __syncthreads();
            f32x16 sc[2][2];
#pragma unroll
            for (int a = 0; a < 2; a++)
#pragma unroll
                for (int b = 0; b < 2; b++) {
#pragma unroll
                    for (int q = 0; q < 16; q++) sc[a][b][q] = 0.f;
#pragma unroll
                    for (int ks = 0; ks < 4; ks++) {
                        const bf16x8_t kf = *(const bf16x8_t*)(Ks + (a * 32 + r) * 72 + ks * 16 + 8 * hf);
                        sc[a][b] = __builtin_amdgcn_mfma_f32_32x32x16_bf16(kf, qf[b][ks], sc[a][b], 0, 0, 0);
                    }
                }
#pragma unroll
            for (int b = 0; b < 2; b++) {
                const int qpos = qb * 128 + qoff + b * 32 + r;
                float mx = mrun[b];
#pragma unroll
                for (int a = 0; a < 2; a++)
#pragma unroll
                    for (int q = 0; q < 16; q++) {
                        if (local) {
                            const int kpos = krow0 + a * 32 + CROW(q, hf);
                            const int dd = kpos - qpos;
                            const bool ok = kpos >= 0 && kpos < L && dd <= 128 && dd >= -128;
                            sc[a][b][q] = ok ? sc[a][b][q] : -INFINITY;
                        }
                        mx = fmaxf(mx, sc[a][b][q]);
                    }
                mx = fmaxf(mx, lane_xor(lane, mx, 32));
                const float corr = __expf(mrun[b] - mx);
                mrun[b] = mx;
                float sum = 0.f;
#pragma unroll
                for (int a = 0; a < 2; a++)
#pragma unroll
                    for (int q = 0; q < 16; q++) { const float pv = __expf(sc[a][b][q] - mx); sc[a][b][q] = pv; sum += pv; }
                sum += lane_xor(lane, sum, 32);
                lrun[b] = lrun[b] * corr + sum;
#pragma unroll
                for (int dt = 0; dt < 2; dt++)
#pragma unroll
                    for (int q = 0; q < 16; q++) o[dt][b][q] *= corr;
            }
#pragma unroll
            for (int a = 0; a < 2; a++)
#pragma unroll
                for (int si = 0; si < 2; si++) {
                    bf16x8_t pf[2];
#pragma unroll
                    for (int b = 0; b < 2; b++) {
                        pg8::u32x4 w;
                        w.x = pack_bf16(sc[a][b][8 * si + 0], sc[a][b][8 * si + 1]); w.y = pack_bf16(sc[a][b][8 * si + 2], sc[a][b][8 * si + 3]);
                        w.z = pack_bf16(sc[a][b][8 * si + 4], sc[a][b][8 * si + 5]); w.w = pack_bf16(sc[a][b][8 * si + 6], sc[a][b][8 * si + 7]);
                        pf[b] = __builtin_bit_cast(bf16x8_t, w);
                    }
#pragma unroll
                    for (int dt = 0; dt < 2; dt++) {
                        const bf16_t* vp = Vts + (dt * 32 + r) * 72 + a * 32 + 16 * si + 4 * hf;
                        const u32x2_t lo = *(const u32x2_t*)vp, hi = *(const u32x2_t*)(vp + 8);
                        pg8::u32x4 w; w.x = lo.x; w.y = lo.y; w.z = hi.x; w.w = hi.y;
                        const bf16x8_t vf = __builtin_bit_cast(bf16x8_t, w);
#pragma unroll
                        for (int b = 0; b < 2; b++) o[dt][b] = __builtin_amdgcn_mfma_f32_32x32x16_bf16(vf, pf[b], o[dt][b], 0, 0, 0);
                    }
                }
        }
#pragma unroll
        for (int b = 0; b < 2; b++) {
            const float rl = 1.f / lrun[b];
            bf16_t* dst = MB + (size_t)(qrow0 + qoff + b * 32 + r) * D + 512 + hq * 64 + 4 * hf;
#pragma unroll
            for (int dt = 0; dt < 2; dt++)
#pragma unroll
                for (int q4 = 0; q4 < 4; q4++) {
                    u32x2_t w;
                    w.x = pack_bf16(o[dt][b][4 * q4 + 0] * rl, o[dt][b][4 * q4 + 1] * rl);
                    w.y = pack_bf16(o[dt][b][4 * q4 + 2] * rl, o[dt][b][4 * q4 + 3] * rl);
                    *(u32x2_t*)(dst + dt * 32 + 8 * q4) = w;
                }
        }
    }
}

__device__ __forceinline__ void ph_hyena_conv(const Params& p, int o) {
    const int TIDX = tid_of_wave(p.wave_id);
    const int lane = TIDX & 63, wave = TIDX >> 6;
    const float* U = wsp<float>(p, OFF_UC) - (size_t)L * 1536;
    const float* hnp = wsp<float>(p, OFF_HNP);
    float* Z1 = wsp<float>(p, OFF_Z1);
    const float* zin = o == 0 ? U : Z1;
    const int zld = o == 0 ? 1536 : 512;
    const int nlat = 8 * (L / 64), nctx = 8 * (NCX / 64);
    for (int it = nlat + blockIdx.x; it < nlat + nctx; it += gridDim.x) {
        const bool lat = it < nlat;
        const int ii = lat ? it : it - nlat;
        const int Ls = lat ? L : NCX, base = lat ? 0 : L;
        const int ch = (ii & 7) * 64 + lane, t0 = (ii >> 3) * 64 + wave * 8;
        const float* hf = (lat ? wsp<float>(p, OFF_HH) : wsp<float>(p, OFF_HHC)) + o * 512 + ch;
        float nrm = 0.f;
        if (lat) { for (int c = 0; c < 128; c++) nrm += hnp[c * 1024 + o * 512 + ch]; }
        else { nrm = hnp[128 * 1024 + o * 512 + ch] + hnp[129 * 1024 + o * 512 + ch]; }
        float acc[8];
#pragma unroll
        for (int i = 0; i < 8; i++) acc[i] = 0.f;
#pragma unroll 4
        for (int s0 = 0; s0 < Ls; s0 += 8) {
            float zv[8], hv[15];
#pragma unroll
            for (int j = 0; j < 8; j++) zv[j] = zin[(size_t)(base + s0 + j) * zld + ch];
#pragma unroll
            for (int e = 0; e < 15; e++) hv[e] = hf[(size_t)(t0 - s0 + e - 7 + Ls) * 1024];
#pragma unroll
            for (int i = 0; i < 8; i++)
#pragma unroll
                for (int j = 0; j < 8; j++) acc[i] = fmaf(hv[i - j + 7], zv[j], acc[i]);
        }
        const float inv = 1.f / nrm;
        const float bias = p.in[I_HYFB][o * 512 + ch];
#pragma unroll
        for (int i = 0; i < 8; i++) {
            const int r = base + t0 + i;
            const float zc = acc[i] * inv;
            const float z = zin[(size_t)r * zld + ch];
            const float gate = U[(size_t)r * 1536 + 512 * (o + 1) + ch];
            const float res = gate * (zc + z * bias);
            if (o == 0) Z1[(size_t)r * 512 + ch] = res;
            else wsp<bf16_t>(p, OFF_MB)[(size_t)r * D + ch] = f2bf(res);
        }
    }
}

__device__ __forceinline__ void ph_moe_scatter(const Params& p, float* lds, int layer, int ntok) {
    const int TIDX = tid_of_wave(p.wave_id);
    int* sst = (int*)lds;
    int* pre = sst + 128;
    const int G = gridDim.x;
    const int* bc = wsp<int>(p, OFF_BC) + (size_t)layer * 512 * 32;
    int* tile_e = wsp<int>(p, OFF_TILEE) + layer * 512;
    __syncthreads();
    for (int i = TIDX; i < G * 32; i += NT) pre[i] = bc[i];
    __syncthreads();
    if (TIDX < 32) {
        int a = 0;
        for (int b = 0; b < G; b++) { const int c = pre[b * 32 + TIDX]; pre[b * 32 + TIDX] = a; a += c; }
        sst[64 + TIDX] = a;
    }
    __syncthreads();
    if (TIDX == 0) {
        int a = 0;
        for (int e = 0; e < 32; e++) {
            const int nt = (sst[64 + e] + 255) / 256;
            if (blockIdx.x == 0) for (int q = 0; q < nt; q++) tile_e[a / 256 + q] = e;
            const int st = a;
            a += nt * 256;
            sst[e] = st;
        }
        sst[32] = a;
    }
    __syncthreads();
    if (blockIdx.x == 0 && TIDX < 33) wsp<int>(p, OFF_STARTS)[layer * 64 + TIDX] = sst[TIDX];
    const int* te = wsp<int>(p, OFF_TOPE);
    int* tp = wsp<int>(p, OFF_TOPP);
    const bf16_t* HB = wsp<bf16_t>(p, OFF_HB);
    bf16_t* XG = wsp<bf16_t>(p, OFF_XG);
    const int lane = TIDX & 63, wave = TIDX >> 6;
    for (int it = blockIdx.x * NWAVE + wave; it < ntok * 4; it += gridDim.x * NWAVE) {
        const int tok = it >> 2, e = te[it];
        const int row = sst[e] + pre[((tok >> 5) % G) * 32 + e] + tp[it];
        if (lane == 0) tp[it] = row;
        const pg8::u32x4* src = (const pg8::u32x4*)(HB + (size_t)tok * D);
        pg8::u32x4* dst = (pg8::u32x4*)(XG + (size_t)row * D);
        dst[lane] = src[lane];
        dst[lane + 64] = src[lane + 64];
    }
    __syncthreads();
}
__device__ __forceinline__ void ph_moe_gemm1(const Params& p, PG8_LAS unsigned char* lds, int layer) {
    const int total = wsp<int>(p, OFF_STARTS)[layer * 64 + 32];
    pg8::MoeOrder S{wsp<int>(p, OFF_TILEE) + layer * 512, total / 256, 8, (int)gridDim.x, (int)blockIdx.x};
    pg8::Gemm g{wsp<bf16_t>(p, OFF_XG), wsp<bf16_t>(p, OFF_WGU) + (size_t)layer * 32 * 2048 * 1024, 1024};
    pg8::EpiMoe1 E{wsp<bf16_t>(p, OFF_ACTB), p.in[I_BGU] + (size_t)layer * 32 * 2048};
    pg8::gemm_phase(p.wave_id, lds, g, S, E);
}
__device__ __forceinline__ void ph_moe_gemm2(const Params& p, PG8_LAS unsigned char* lds, int layer) {
    const int total = wsp<int>(p, OFF_STARTS)[layer * 64 + 32];
    pg8::MoeOrder S{wsp<int>(p, OFF_TILEE) + layer * 512, total / 256, 4, (int)gridDim.x, (int)blockIdx.x};
    pg8::Gemm g{wsp<bf16_t>(p, OFF_ACTB), wsp<bf16_t>(p, OFF_WDN) + (size_t)layer * 32 * 1024 * 1024, 1024};
    pg8::EpiMoe2 E{wsp<bf16_t>(p, OFF_YR), p.in[I_BDN] + (size_t)layer * 32 * 1024};
    pg8::gemm_phase(p.wave_id, lds, g, S, E);
}
template <bool NEXTPREP>
__device__ __forceinline__ void ph_moe_combine(const Params& p, int layer, int nrows, const float* xi, float* xo, int nlayer) {
    const int TIDX = tid_of_wave(p.wave_id);
    const int lane = TIDX & 63, wave = TIDX >> 6;
    const int* tp = wsp<int>(p, OFF_TOPP);
    const float* tg = wsp<float>(p, OFF_TOPG);
    const bf16_t* YR = wsp<bf16_t>(p, OFF_YR);
    for (int r0 = blockIdx.x * NWAVE + wave; r0 < nrows; r0 += 2 * gridDim.x * NWAVE) {
      const int r1 = r0 + gridDim.x * NWAVE;
      const bool ok1 = r1 < nrows;
      const int rr[2] = {r0, ok1 ? r1 : r0};
      int4 rows2[2]; float4 gs2[2];
#pragma unroll
      for (int u = 0; u < 2; u++) { rows2[u] = *(const int4*)(tp + rr[u] * 4); gs2[u] = *(const float4*)(tg + rr[u] * 4); }
      pg8::u32x4 yv[2][4][2]; float4 xv[2][4];
#pragma unroll
      for (int u = 0; u < 2; u++) {
          const int rw[4] = {rows2[u].x, rows2[u].y, rows2[u].z, rows2[u].w};
#pragma unroll
          for (int k = 0; k < 4; k++)
#pragma unroll
              for (int i = 0; i < 2; i++) yv[u][k][i] = *(const pg8::u32x4*)(YR + (size_t)rw[k] * 1024 + 512 * i + 8 * lane);
#pragma unroll
          for (int i = 0; i < 4; i++) xv[u][i] = *(const float4*)(xi + (size_t)rr[u] * D + 512 * (i >> 1) + 8 * lane + 4 * (i & 1));
      }
#pragma unroll
      for (int u = 0; u < 2; u++) {
        if (u == 1 && !ok1) continue;
        const int r = rr[u];
        const float* gt = modp(p, layer, r < L ? 0 : 1, 1) + 2048;
        float v[16];
#pragma unroll
        for (int i = 0; i < 16; i++) v[i] = 0.f;
        const float gw[4] = {gs2[u].x, gs2[u].y, gs2[u].z, gs2[u].w};
#pragma unroll
        for (int k = 0; k < 4; k++)
#pragma unroll
            for (int i = 0; i < 2; i++) {
                const pg8::u32x4 y = yv[u][k][i];
                const unsigned w[4] = {y.x, y.y, y.z, y.w};
#pragma unroll
                for (int q = 0; q < 4; q++) {
                    v[8 * i + 2 * q] = fmaf(gw[k], bf2f((unsigned short)(w[q] & 0xffff)), v[8 * i + 2 * q]);
                    v[8 * i + 2 * q + 1] = fmaf(gw[k], bf2f((unsigned short)(w[q] >> 16)), v[8 * i + 2 * q + 1]);
                }
            }
        float ss = 0.f;
#pragma unroll
        for (int i = 0; i < 2; i++)
#pragma unroll
            for (int h4 = 0; h4 < 2; h4++) {
                const int c = 512 * i + 8 * lane + 4 * h4;
                const float4 x4 = xv[u][2 * i + h4], g4 = *(const float4*)(gt + c);
                float* vv = v + 8 * i + 4 * h4;
                vv[0] = x4.x + g4.x * vv[0]; vv[1] = x4.y + g4.y * vv[1]; vv[2] = x4.z + g4.z * vv[2]; vv[3] = x4.w + g4.w * vv[3];
                *(float4*)(xo + (size_t)r * D + c) = make_float4(vv[0], vv[1], vv[2], vv[3]);
                ss += vv[0] * vv[0] + vv[1] * vv[1] + vv[2] * vv[2] + vv[3] * vv[3];
            }
        if (NEXTPREP) {
            ss = wave_sum(lane, ss);
            const float rinv = rsqrtf(ss * (1.f / 1024.f) + EPS);
            const float* md = modp(p, nlayer, r < L ? 0 : 1, 0);
            const float* g = p.in[I_NORMG] + (nlayer * 2 + 0) * 1024;
#pragma unroll
            for (int i = 0; i < 2; i++) {
                const int c = 512 * i + 8 * lane;
                float hv[8];
#pragma unroll
                for (int h4 = 0; h4 < 2; h4++) {
                    const float4 g4 = *(const float4*)(g + c + 4 * h4), sc4 = *(const float4*)(md + 1024 + c + 4 * h4), sh4 = *(const float4*)(md + c + 4 * h4);
                    const float* vv = v + 8 * i + 4 * h4;
                    hv[4 * h4 + 0] = vv[0] * rinv * g4.x * (1.f + sc4.x) + sh4.x; hv[4 * h4 + 1] = vv[1] * rinv * g4.y * (1.f + sc4.y) + sh4.y;
                    hv[4 * h4 + 2] = vv[2] * rinv * g4.z * (1.f + sc4.z) + sh4.z; hv[4 * h4 + 3] = vv[3] * rinv * g4.w * (1.f + sc4.w) + sh4.w;
                }
                pg8::u32x4 o; o.x = pack_bf16(hv[0], hv[1]); o.y = pack_bf16(hv[2], hv[3]); o.z = pack_bf16(hv[4], hv[5]); o.w = pack_bf16(hv[6], hv[7]);
                *(pg8::u32x4*)(wsp<bf16_t>(p, OFF_HB) + (size_t)r * D + c) = o;
            }
        }
      }
    }
}

__device__ __forceinline__ void ph_streams(const Params& p) {
    const int TIDX = tid_of_wave(p.wave_id);
    const bf16_t* P1 = wsp<bf16_t>(p, OFF_P);
    bf16_t* XBC = wsp<bf16_t>(p, OFF_XBC);
    float* DT = wsp<float>(p, OFF_DT);
    const float* cw = p.in[I_SSDCW];
    const float* cb = p.in[I_SSDCB];
    const int gsz = gridDim.x * NT, g0 = blockIdx.x * NT + TIDX;
    for (int base = g0; base < R * 128; base += 4 * gsz) {
        pg8::u32x4 v[4][3];
#pragma unroll
        for (int u = 0; u < 4; u++) {
            const int it = base + u * gsz, r = it >> 7, c = (it & 127) * 8;
            const int lo = r < L ? 0 : L, hi = r < L ? L : R;
#pragma unroll
            for (int j = 0; j < 3; j++) {
                const int rr = r + j - 1;
                v[u][j] = pg8::u32x4{0u, 0u, 0u, 0u};
                if (it < R * 128 && rr >= lo && rr < hi) v[u][j] = *(const pg8::u32x4*)(P1 + (size_t)rr * ODD_IN + c);
            }
        }
#pragma unroll
        for (int u = 0; u < 4; u++) {
            const int it = base + u * gsz, r = it >> 7, c = (it & 127) * 8;
            if (it >= R * 128) continue;
            float a[8];
#pragma unroll
            for (int q = 0; q < 8; q++) a[q] = cb[c + q];
#pragma unroll
            for (int j = 0; j < 3; j++) {
                const unsigned w[4] = {v[u][j].x, v[u][j].y, v[u][j].z, v[u][j].w};
#pragma unroll
                for (int q = 0; q < 4; q++) {
                    a[2 * q] = fmaf(cw[j * 1024 + c + 2 * q], bf2f((unsigned short)(w[q] & 0xffff)), a[2 * q]);
                    a[2 * q + 1] = fmaf(cw[j * 1024 + c + 2 * q + 1], bf2f((unsigned short)(w[q] >> 16)), a[2 * q + 1]);
                }
            }
            pg8::u32x4 o;
            o.x = pack_bf16(silu_fast(a[0]), silu_fast(a[1])); o.y = pack_bf16(silu_fast(a[2]), silu_fast(a[3]));
            o.z = pack_bf16(silu_fast(a[4]), silu_fast(a[5])); o.w = pack_bf16(silu_fast(a[6]), silu_fast(a[7]));
            *(pg8::u32x4*)(XBC + (size_t)r * 1024 + c) = o;
        }
    }
    for (int it = g0; it < R * 16; it += gsz) {
        const int r = it >> 4, c = it & 15, d = c >> 3, h = c & 7;
        DT[(size_t)d * R * 8 + (size_t)r * 8 + h] = softplus_f(bf2f(P1[(size_t)r * ODD_IN + 1024 + c]) + p.in[I_DTB][d * 8 + h]);
    }
}
__device__ __forceinline__ float chunk_cumsum128(float a0, float a1, int lane, int d, float& c0, float& c1) {
    const float s = a0 + a1;
    float incl = s;
#pragma unroll
    for (int o = 1; o < 64; o <<= 1) { const float t = lane_get(incl, lane >= o ? lane - o : lane); if (lane >= o) incl += t; }
    const float total = lane_get(incl, 63);
    c0 = incl - s + a0; c1 = incl;
    if (d == 1) { c0 = total - (c0 - a0); c1 = total - (c1 - a1); }
    return total;
}

__device__ __forceinline__ void ph_ssd_s1(const Params& p, unsigned char* smem) {
    const int TIDX = tid_of_wave(p.wave_id);
    bf16_t* Bt = (bf16_t*)smem;
    bf16_t* XW = Bt + 128 * LDP;
    float* csb = (float*)(XW + 2 * 64 * LDP);
    const bf16_t* XBC = wsp<bf16_t>(p, OFF_XBC);
    const float* DT = wsp<float>(p, OFF_DT);
    bf16_t* ST = wsp<bf16_t>(p, OFF_SST);
    float* DEC = wsp<float>(p, OFF_SDEC);
    const int tid = TIDX, lane = tid & 63, wave = tid >> 6, hf = lane >> 5;
    for (int it = blockIdx.x; it < 130 * 8; it += gridDim.x) {
        const int c = it >> 3, hh = it & 7, g = hh >> 2, r0 = c * 128;
        const int s = tid >> 2, q4 = tid & 3;
        const bf16_t* xr = XBC + (size_t)(r0 + s) * 1024;
        pg8::u32x4 bv[4], xv[2];
#pragma unroll
        for (int j = 0; j < 4; j++) bv[j] = *(const pg8::u32x4*)(xr + 512 + g * 128 + q4 * 32 + 8 * j);
#pragma unroll
        for (int j = 0; j < 2; j++) xv[j] = *(const pg8::u32x4*)(xr + hh * 64 + q4 * 16 + 8 * j);
        __syncthreads();
        if (wave < 2) {
            const int d = wave;
            const float a = -expf(p.in[I_ALOG][d * 8 + hh]);
            const float dt0 = DT[(size_t)d * R * 8 + (size_t)(r0 + 2 * lane) * 8 + hh], dt1 = DT[(size_t)d * R * 8 + (size_t)(r0 + 2 * lane + 1) * 8 + hh];
            float c0, c1;
            const float total = chunk_cumsum128(dt0 * a, dt1 * a, lane, d, c0, c1);
            csb[d * 128 + 2 * lane] = __expf(total - c0) * dt0;
            csb[d * 128 + 2 * lane + 1] = __expf(total - c1) * dt1;
            if (lane == 0) DEC[(d * 130 + c) * 8 + hh] = __expf(total);
        }
#pragma unroll
        for (int j = 0; j < 4; j++) {
            const unsigned w[4] = {bv[j].x, bv[j].y, bv[j].z, bv[j].w};
            bf16_t* dst = Bt + (q4 * 32 + 8 * j) * LDP + s;
#pragma unroll
            for (int q = 0; q < 4; q++) { dst[(2 * q) * LDP] = (bf16_t)(w[q] & 0xffff); dst[(2 * q + 1) * LDP] = (bf16_t)(w[q] >> 16); }
        }
        __syncthreads();
        {
            const float w0 = csb[s], w1 = csb[128 + s];
#pragma unroll
            for (int j = 0; j < 2; j++) {
                const unsigned w[4] = {xv[j].x, xv[j].y, xv[j].z, xv[j].w};
                bf16_t* dst = XW + (q4 * 16 + 8 * j) * LDP + s;
#pragma unroll
                for (int q = 0; q < 4; q++) {
                    const float x0 = bf2f((unsigned short)(w[q] & 0xffff)), x1 = bf2f((unsigned short)(w[q] >> 16));
                    dst[(2 * q) * LDP] = f2bf(x0 * w0); dst[(2 * q + 1) * LDP] = f2bf(x1 * w0);
                    dst[64 * LDP + (2 * q) * LDP] = f2bf(x0 * w1); dst[64 * LDP + (2 * q + 1) * LDP] = f2bf(x1 * w1);
                }
            }
        }
        __syncthreads();
#pragma unroll 1
        for (int t2 = 0; t2 < 2; t2++) {
            const int tix = wave * 2 + t2, d = tix >> 3, mt = (tix >> 2) & 1, nt = tix & 3;
            f32x16 acc;
#pragma unroll
            for (int q = 0; q < 16; q++) acc[q] = 0.f;
            acc = mma32<8>(lane, XW + (d * 64 + mt * 32) * LDP, LDP, Bt + nt * 32 * LDP, LDP, acc);
            int rb = mt * 32 + 4 * hf;
            asm volatile("" : "+v"(rb));
            bf16_t* dst = ST + ((((size_t)d * 130 + c) * 8 + hh) * 64 + rb) * 128 + nt * 32 + (lane & 31);
#pragma unroll
            for (int q = 0; q < 16; q++) dst[((q & 3) + 8 * (q >> 2)) * 128] = f2bf(acc[q]);
        }
    }
}
__device__ __forceinline__ void ph_ssd_s2(const Params& p) {
    const int TIDX = tid_of_wave(p.wave_id);
    const bf16_t* __restrict__ ST = wsp<bf16_t>(p, OFF_SST);
    bf16_t* __restrict__ SIN = wsp<bf16_t>(p, OFF_SSIN);
    const float* __restrict__ DEC = wsp<float>(p, OFF_SDEC);
    for (int it = blockIdx.x * NT + TIDX; it < 65536; it += gridDim.x * NT) {
        const int n2 = it & 63, pp = (it >> 6) & 63, hh = (it >> 12) & 7, d = it >> 15;
        float s0 = 0.f, s1 = 0.f;
#pragma unroll 1
        for (int g0 = 0; g0 < 130; g0 += 26) {
            unsigned stv[26]; float dv[26];
#pragma unroll
            for (int j = 0; j < 26; j++) {
                const int step = g0 + j, c = d == 0 ? (step < 2 ? 128 + step : step - 2) : 129 - step;
                stv[j] = *(const unsigned*)(ST + ((((size_t)d * 130 + c) * 8 + hh) * 64 + pp) * 128 + 2 * n2);
                dv[j] = DEC[(d * 130 + c) * 8 + hh];
            }
#pragma unroll
            for (int j = 0; j < 26; j++) {
                const int step = g0 + j, c = d == 0 ? (step < 2 ? 128 + step : step - 2) : 129 - step;
                *(unsigned*)(SIN + ((((size_t)d * 130 + c) * 8 + hh) * 64 + pp) * 128 + 2 * n2) = pack_bf16(s0, s1);
                s0 = fmaf(s0, dv[j], bf2f((unsigned short)(stv[j] & 0xffff)));
                s1 = fmaf(s1, dv[j], bf2f((unsigned short)(stv[j] >> 16)));
            }
        }
    }
}
__device__ __forceinline__ void ph_ssd_s3(const Params& p, unsigned char* smem) {
    const int TIDX = tid_of_wave(p.wave_id);
    bf16_t* Cm = (bf16_t*)smem;
    bf16_t* Bm = Cm + 128 * LDP;
    bf16_t* Wm = Bm;
    bf16_t* Xt = Bm + 128 * LDP;
    bf16_t* Sn = Xt + 64 * LDP;
    float* csA = (float*)(Sn + 2 * 64 * LDP);
    float* dtA = csA + 8 * 128;
    const bf16_t* XBC = wsp<bf16_t>(p, OFF_XBC);
    const float* DT = wsp<float>(p, OFF_DT);
    const bf16_t* SIN = wsp<bf16_t>(p, OFF_SSIN);
    float* Y = wsp<float>(p, OFF_Y);
    const int tid = TIDX, lane = tid & 63, wave = tid >> 6, hf = lane >> 5;
    for (int it = blockIdx.x; it < 256; it += gridDim.x) {
        const int c = it >> 1, g = it & 1, r0 = c * 128;
        const int s = tid >> 2, q4 = tid & 3;
        const bf16_t* xr = XBC + (size_t)(r0 + s) * 1024;
        __syncthreads();
        {
            pg8::u32x4 bv[4], cv[4];
#pragma unroll
            for (int j = 0; j < 4; j++) { bv[j] = *(const pg8::u32x4*)(xr + 512 + g * 128 + q4 * 32 + 8 * j); cv[j] = *(const pg8::u32x4*)(xr + 768 + g * 128 + q4 * 32 + 8 * j); }
            {
                const int hh = g * 4 + (wave >> 1), d = wave & 1;
                const float a = -expf(p.in[I_ALOG][d * 8 + hh]);
                const float dt0 = DT[(size_t)d * R * 8 + (size_t)(r0 + 2 * lane) * 8 + hh], dt1 = DT[(size_t)d * R * 8 + (size_t)(r0 + 2 * lane + 1) * 8 + hh];
                float c0, c1;
                chunk_cumsum128(dt0 * a, dt1 * a, lane, d, c0, c1);
                csA[wave * 128 + 2 * lane] = c0; csA[wave * 128 + 2 * lane + 1] = c1;
                dtA[wave * 128 + 2 * lane] = dt0; dtA[wave * 128 + 2 * lane + 1] = dt1;
            }
#pragma unroll
            for (int j = 0; j < 4; j++) { *(pg8::u32x4*)(Bm + s * LDP + q4 * 32 + 8 * j) = bv[j]; *(pg8::u32x4*)(Cm + s * LDP + q4 * 32 + 8 * j) = cv[j]; }
        }
        __syncthreads();
        const int gmt = wave >> 1, gnt0 = (wave & 1) * 2;
        f32x16 G0, G1;
#pragma unroll
        for (int q = 0; q < 16; q++) { G0[q] = 0.f; G1[q] = 0.f; }
        G0 = mma32<8>(lane, Cm + gmt * 32 * LDP, LDP, Bm + gnt0 * 32 * LDP, LDP, G0);
        G1 = mma32<8>(lane, Cm + gmt * 32 * LDP, LDP, Bm + (gnt0 + 1) * 32 * LDP, LDP, G1);
#pragma unroll 1
        for (int h = 0; h < 4; h++) {
            const int hh = g * 4 + h;
            const int ymt = wave >> 1, ynt = wave & 1;
            f32x16 ytot;
#pragma unroll
            for (int q = 0; q < 16; q++) ytot[q] = 0.f;
            pg8::u32x4 xv[2], sv[2][2];
            {
                int tb = tid;
                asm volatile("" : "+v"(tb));
                const int s2 = tb >> 2, q42 = tb & 3;
#pragma unroll
                for (int j = 0; j < 2; j++) xv[j] = *(const pg8::u32x4*)(XBC + (size_t)(r0 + s2) * 1024 + hh * 64 + q42 * 16 + 8 * j);
#pragma unroll
                for (int d = 0; d < 2; d++) {
                    const bf16_t* src = SIN + ((((size_t)d * 130 + c) * 8 + hh) * 64) * 128;
#pragma unroll
                    for (int i = 0; i < 2; i++) { const int v = tb + 512 * i; sv[d][i] = *(const pg8::u32x4*)(src + (v >> 4) * 128 + (v & 15) * 8); }
                }
            }
#pragma unroll 1
            for (int d = 0; d < 2; d++) {
                __syncthreads();
                if (d == 0) {
                    int tb = tid;
                    asm volatile("" : "+v"(tb));
                    const int s2 = tb >> 2, q42 = tb & 3;
#pragma unroll
                    for (int j = 0; j < 2; j++) {
                        const unsigned w[4] = {xv[j].x, xv[j].y, xv[j].z, xv[j].w};
                        bf16_t* dst = Xt + (q42 * 16 + 8 * j) * LDP + s2;
#pragma unroll
                        for (int q = 0; q < 4; q++) { dst[(2 * q) * LDP] = (bf16_t)(w[q] & 0xffff); dst[(2 * q + 1) * LDP] = (bf16_t)(w[q] >> 16); }
                    }
#pragma unroll
                    for (int dd = 0; dd < 2; dd++)
#pragma unroll
                        for (int i = 0; i < 2; i++) { const int v = tb + 512 * i; *(pg8::u32x4*)(Sn + (dd * 64 + (v >> 4)) * LDP + (v & 15) * 8) = sv[dd][i]; }
                }
                const float* csb = csA + (h * 2 + d) * 128;
                const float* dtb = dtA + (h * 2 + d) * 128;
#pragma unroll
                for (int t2 = 0; t2 < 2; t2++) {
                    const int s3 = (gnt0 + t2) * 32 + (lane & 31);
                    const float css = csb[s3], dts = dtb[s3];
#pragma unroll
                    for (int q = 0; q < 16; q++) {
                        const int l = gmt * 32 + CROW(q, hf);
                        const bool ok = d == 0 ? (s3 <= l) : (s3 >= l);
                        const float gv = t2 == 0 ? G0[q] : G1[q];
                        const float w = ok ? gv * __expf(csb[l] - css) * dts : 0.f;
                        Wm[l * LDP + s3] = f2bf(w);
                    }
                }
                __syncthreads();
                f32x16 a2;
#pragma unroll
                for (int q = 0; q < 16; q++) a2[q] = 0.f;
                a2 = mma32<8>(lane, Cm + ymt * 32 * LDP, LDP, Sn + (d * 64 + ynt * 32) * LDP, LDP, a2);
#pragma unroll
                for (int q = 0; q < 16; q++) ytot[q] += __expf(csb[ymt * 32 + CROW(q, hf)]) * a2[q];
                ytot = mma32<8>(lane, Wm + ymt * 32 * LDP, LDP, Xt + ynt * 32 * LDP, LDP, ytot);
            }
            const float Dsum = p.in[I_SSDD][hh] + p.in[I_SSDD][8 + hh];
            {
                int lbase = r0 + ymt * 32 + 4 * hf;
                asm volatile("" : "+v"(lbase));
                const int cbase = hh * 64 + ynt * 32 + (lane & 31);
                float* yb = Y + (size_t)lbase * 512 + cbase;
                const bf16_t* xb = XBC + (size_t)lbase * 1024 + cbase;
#pragma unroll
                for (int q = 0; q < 16; q++) {
                    const int lo = (q & 3) + 8 * (q >> 2);
                    yb[lo * 512] = ytot[q] + Dsum * bf2f(xb[lo * 1024]);
                }
            }
        }
    }
}

constexpr int LDQ = 72;
__device__ __forceinline__ void ph_hg_s1(const Params& p, unsigned char* smem) {
    const int TIDX = tid_of_wave(p.wave_id);
    float* LG = (float*)smem;
    bf16_t* KbT = (bf16_t*)(smem + 65536);
    bf16_t* Vt = KbT + 2 * 128 * LDQ;
    const bf16_t* P1 = wsp<bf16_t>(p, OFF_P);
    const float* lbp = wsp<float>(p, OFF_LB);
    bf16_t* ST = wsp<bf16_t>(p, OFF_HST);
    float* DEC = wsp<float>(p, OFF_HDEC);
    const int tid = TIDX, lane = tid & 63, wave = tid >> 6, hf = lane >> 5;
    for (int it = blockIdx.x; it < 260 * 4; it += gridDim.x) {
        const int c = it >> 2, h = it & 3, r0 = c * 64;
        __syncthreads();
        float fv[32];
#pragma unroll
        for (int i = 0; i < 32; i++) {
            const int d = i >> 4, e = tid + 512 * (i & 15), row = e >> 7, k = e & 127;
            fv[i] = bf2f(P1[(size_t)(r0 + row) * ODD_IN + 1040 + d * 512 + h * 128 + k]);
        }
        {
            const float lbk = lbp[h * 128 + (tid & 127)];
#pragma unroll
            for (int i = 0; i < 32; i++) fv[i] = lbk + (1.f - lbk) * sigmoid_fast(fv[i]);
        }
#pragma unroll
        for (int q = 0; q < 2; q++) {
            const int vec = tid + 512 * q, s2 = vec >> 4, v0 = (vec & 15) * 8;
            const pg8::u32x4 x = *(const pg8::u32x4*)(P1 + (size_t)(r0 + s2) * ODD_IN + 2064 + h * 128 + v0);
            bf16_t* dst = Vt + v0 * LDQ + s2;
            dst[0] = (bf16_t)(x.x & 0xffff); dst[LDQ] = (bf16_t)(x.x >> 16); dst[2 * LDQ] = (bf16_t)(x.y & 0xffff); dst[3 * LDQ] = (bf16_t)(x.y >> 16);
            dst[4 * LDQ] = (bf16_t)(x.z & 0xffff); dst[5 * LDQ] = (bf16_t)(x.z >> 16); dst[6 * LDQ] = (bf16_t)(x.w & 0xffff); dst[7 * LDQ] = (bf16_t)(x.w >> 16);
        }
#pragma unroll
        for (int i = 0; i < 32; i++) LG[(i >> 4) * 8192 + tid + 512 * (i & 15)] = __logf(fv[i]);
        __syncthreads();
        if (tid < 256) {
            const int d = tid >> 7, k = tid & 127;
            float* col = LG + d * 8192 + k;
            float cum = 0.f;
#pragma unroll 8
            for (int i = 0; i < 64; i++) { const int row = d == 0 ? i : 63 - i; cum += col[row * 128]; col[row * 128] = cum; }
            DEC[(((size_t)d * 260 + c) * 4 + h) * 128 + k] = __expf(cum);
        }
        __syncthreads();
#pragma unroll
        for (int i = 0; i < 32; i++) {
            const int d = i >> 4, e = tid + 512 * (i & 15), row = e >> 7, k = e & 127;
            const float total = LG[d * 8192 + (d == 0 ? 63 : 0) * 128 + k], cum = LG[d * 8192 + e];
            KbT[(d * 128 + k) * LDQ + row] = f2bf((1.f - fv[i]) * __expf(total - cum));
        }
        __syncthreads();
#pragma unroll 1
        for (int q4 = 0; q4 < 4; q4++) {
            const int tix = wave * 4 + q4, d = tix >> 4, vt = (tix >> 2) & 3, kt = tix & 3;
            f32x16 acc;
#pragma unroll
            for (int q = 0; q < 16; q++) acc[q] = 0.f;
            acc = mma32<4>(lane, Vt + vt * 32 * LDQ, LDQ, KbT + (d * 128 + kt * 32) * LDQ, LDQ, acc);
            int rb = vt * 32 + 4 * hf;
            asm volatile("" : "+v"(rb));
            bf16_t* dst = ST + ((((size_t)d * 260 + c) * 4 + h) * 128 + rb) * 128 + kt * 32 + (lane & 31);
#pragma unroll
            for (int q = 0; q < 16; q++) dst[((q & 3) + 8 * (q >> 2)) * 128] = f2bf(acc[q]);
        }
    }
}
__device__ __forceinline__ void ph_hg_s2(const Params& p) {
    const int TIDX = tid_of_wave(p.wave_id);
    const bf16_t* __restrict__ ST = wsp<bf16_t>(p, OFF_HST);
    bf16_t* __restrict__ SIN = wsp<bf16_t>(p, OFF_HSIN);
    const float* __restrict__ DEC = wsp<float>(p, OFF_HDEC);
    const int gb = gridDim.x >= 256 ? (int)blockIdx.x - 128 : (int)blockIdx.x, gs = gridDim.x >= 256 ? 128 : (int)gridDim.x;
    for (int it = gb * NT + TIDX; it >= 0 && it < 65536; it += gs * NT) {
        const int k2 = it & 63, v = (it >> 6) & 127, h = (it >> 13) & 3, d = it >> 15;
        float s0 = 0.f, s1 = 0.f;
#pragma unroll 1
        for (int g0 = 0; g0 < 260; g0 += 26) {
            unsigned stv[26]; float2 dv[26];
#pragma unroll
            for (int j = 0; j < 26; j++) {
                const int step = g0 + j, c = d == 0 ? (step < 4 ? 256 + step : step - 4) : 259 - step;
                const size_t blk = ((size_t)d * 260 + c) * 4 + h;
                stv[j] = *(const unsigned*)(ST + (blk * 128 + v) * 128 + 2 * k2);
                dv[j] = *(const float2*)(DEC + blk * 128 + 2 * k2);
            }
#pragma unroll
            for (int j = 0; j < 26; j++) {
                const int step = g0 + j, c = d == 0 ? (step < 4 ? 256 + step : step - 4) : 259 - step;
                const size_t blk = ((size_t)d * 260 + c) * 4 + h;
                *(unsigned*)(SIN + (blk * 128 + v) * 128 + 2 * k2) = pack_bf16(s0, s1);
                s0 = fmaf(s0, dv[j].x, bf2f((unsigned short)(stv[j] & 0xffff)));
                s1 = fmaf(s1, dv[j].y, bf2f((unsigned short)(stv[j] >> 16)));
            }
        }
    }
}
__device__ __forceinline__ void ph_hg_s3(const Params& p, unsigned char* smem) {
    const int TIDX = tid_of_wave(p.wave_id);
    float* LG = (float*)smem;
    bf16_t* Qb = (bf16_t*)(smem + 32768);
    bf16_t* Kh = Qb + 64 * LDP;
    bf16_t* Vt = Kh + 64 * LDP;
    bf16_t* Am = Vt + 128 * LDQ;
    bf16_t* Sn = Am + 64 * LDQ;
    const bf16_t* P1 = wsp<bf16_t>(p, OFF_P);
    const float* lbp = wsp<float>(p, OFF_LB);
    const bf16_t* SIN = wsp<bf16_t>(p, OFF_HSIN);
    float* O = wsp<float>(p, OFF_O);
    const int tid = TIDX, lane = tid & 63, wave = tid >> 6, hf = lane >> 5;
    for (int it = blockIdx.x; it < 256 * 4; it += gridDim.x) {
        const int c = it >> 2, h = it & 3, r0 = c * 64;
        const int omt = wave >> 2, ont = wave & 3;
        f32x16 otot;
#pragma unroll
        for (int q = 0; q < 16; q++) otot[q] = 0.f;
#pragma unroll 1
        for (int d = 0; d < 2; d++) {
            __syncthreads();
            float fv[16], qv[16];
#pragma unroll
            for (int i = 0; i < 16; i++) {
                const int e = tid + 512 * i, row = e >> 7, k = e & 127;
                fv[i] = bf2f(P1[(size_t)(r0 + row) * ODD_IN + 1040 + d * 512 + h * 128 + k]);
                qv[i] = bf2f(P1[(size_t)(r0 + row) * ODD_IN + 3088 + h * 128 + k]);
            }
            {
                const float lbk = lbp[h * 128 + (tid & 127)];
#pragma unroll
                for (int i = 0; i < 16; i++) { fv[i] = lbk + (1.f - lbk) * sigmoid_fast(fv[i]); qv[i] = silu_fast(qv[i]); }
            }
            {
                const bf16_t* src = SIN + ((((size_t)d * 260 + c) * 4 + h) * 128) * 128;
#pragma unroll
                for (int i = 0; i < 4; i++) { const int v = tid + 512 * i, row = v >> 4, col8 = (v & 15) * 8;
                    *(pg8::u32x4*)(Sn + row * LDP + col8) = *(const pg8::u32x4*)(src + row * 128 + col8); }
            }
            if (d == 0) {
#pragma unroll
                for (int q = 0; q < 2; q++) {
                    const int vec = tid + 512 * q, s2 = vec >> 4, v0 = (vec & 15) * 8;
                    const pg8::u32x4 x = *(const pg8::u32x4*)(P1 + (size_t)(r0 + s2) * ODD_IN + 2064 + h * 128 + v0);
                    bf16_t* dst = Vt + v0 * LDQ + s2;
                    dst[0] = (bf16_t)(x.x & 0xffff); dst[LDQ] = (bf16_t)(x.x >> 16); dst[2 * LDQ] = (bf16_t)(x.y & 0xffff); dst[3 * LDQ] = (bf16_t)(x.y >> 16);
                    dst[4 * LDQ] = (bf16_t)(x.z & 0xffff); dst[5 * LDQ] = (bf16_t)(x.z >> 16); dst[6 * LDQ] = (bf16_t)(x.w & 0xffff); dst[7 * LDQ] = (bf16_t)(x.w >> 16);
                }
            }
#pragma unroll
            for (int i = 0; i < 16; i++) LG[tid + 512 * i] = __logf(fv[i]);
            __syncthreads();
            if (tid < 128) {
                float* col = LG + tid;
                float cum = 0.f;
#pragma unroll 8
                for (int i = 0; i < 64; i++) { const int row = d == 0 ? i : 63 - i; cum += col[row * 128]; col[row * 128] = cum; }
            }
            __syncthreads();
#pragma unroll
            for (int i = 0; i < 16; i++) {
                const int e = tid + 512 * i, row = e >> 7, k = e & 127;
                const float cum = LG[e];
                Qb[row * LDP + k] = f2bf(qv[i] * __expf(cum));
                Kh[row * LDP + k] = f2bf((1.f - fv[i]) * __expf(fminf(-cum, 80.f)));
            }
            __syncthreads();
            if (wave < 4) {
                const int amt = wave >> 1, ant = wave & 1;
                f32x16 a;
#pragma unroll
                for (int q = 0; q < 16; q++) a[q] = 0.f;
                a = mma32<8>(lane, Qb + amt * 32 * LDP, LDP, Kh + ant * 32 * LDP, LDP, a);
                const int s2 = ant * 32 + (lane & 31);
#pragma unroll
                for (int q = 0; q < 16; q++) {
                    const int t = amt * 32 + CROW(q, hf);
                    const bool ok = d == 0 ? (s2 <= t) : (s2 >= t);
                    Am[t * LDQ + s2] = f2bf(ok ? a[q] : 0.f);
                }
            }
            otot = mma32<8>(lane, Qb + omt * 32 * LDP, LDP, Sn + ont * 32 * LDP, LDP, otot);
            __syncthreads();
            otot = mma32<4>(lane, Am + omt * 32 * LDQ, LDQ, Vt + ont * 32 * LDQ, LDQ, otot);
        }
        {
            int lbase = r0 + omt * 32 + 4 * hf;
            asm volatile("" : "+v"(lbase));
            float* ob = O + (size_t)lbase * 512 + h * 128 + ont * 32 + (lane & 31);
#pragma unroll
            for (int q = 0; q < 16; q++) ob[((q & 3) + 8 * (q >> 2)) * 512] = otot[q];
        }
    }
}

__device__ __forceinline__ void ph_merge(const Params& p) {
    const int TIDX = tid_of_wave(p.wave_id);
    const int lane = TIDX & 63, wave = TIDX >> 6;
    const bf16_t* P1 = wsp<bf16_t>(p, OFF_P);
    const float* Y = wsp<float>(p, OFF_Y);
    const float* O = wsp<float>(p, OFF_O);
    bf16_t* MB = wsp<bf16_t>(p, OFF_MB);
    const int c = 8 * lane;
    for (int r = blockIdx.x * NWAVE + wave; r < L; r += gridDim.x * NWAVE) {
        const float4 y0 = *(const float4*)(Y + (size_t)r * 512 + c), y1 = *(const float4*)(Y + (size_t)r * 512 + c + 4);
        const float4 o0 = *(const float4*)(O + (size_t)r * 512 + c), o1 = *(const float4*)(O + (size_t)r * 512 + c + 4);
        const pg8::u32x4 zz = *(const pg8::u32x4*)(P1 + (size_t)r * ODD_IN + 2576 + c), gg = *(const pg8::u32x4*)(P1 + (size_t)r * ODD_IN + 3600 + c);
        const float yv[8] = {y0.x, y0.y, y0.z, y0.w, y1.x, y1.y, y1.z, y1.w};
        const float ov[8] = {o0.x, o0.y, o0.z, o0.w, o1.x, o1.y, o1.z, o1.w};
        const unsigned zw[4] = {zz.x, zz.y, zz.z, zz.w}, gw[4] = {gg.x, gg.y, gg.z, gg.w};
        float ys[8], gs[8], sy = 0.f, so = 0.f;
#pragma unroll
        for (int q = 0; q < 4; q++) {
            ys[2 * q] = yv[2 * q] * silu_fast(bf2f((unsigned short)(zw[q] & 0xffff)));
            ys[2 * q + 1] = yv[2 * q + 1] * silu_fast(bf2f((unsigned short)(zw[q] >> 16)));
            gs[2 * q] = silu_fast(bf2f((unsigned short)(gw[q] & 0xffff)));
            gs[2 * q + 1] = silu_fast(bf2f((unsigned short)(gw[q] >> 16)));
        }
#pragma unroll
        for (int q = 0; q < 8; q++) { sy = fmaf(ys[q], ys[q], sy); so = fmaf(ov[q], ov[q], so); }
        sy += dpp_f<0xB1>(sy); sy += dpp_f<0x4E>(sy); sy += dpp_f<0x141>(sy); sy += dpp_f<0x140>(sy);
        so += dpp_f<0xB1>(so); so += dpp_f<0x4E>(so); so += dpp_f<0x141>(so); so += dpp_f<0x140>(so);
        sy += lane_xor(lane, sy, 16);
        const float ry = rsqrtf(sy * (1.f / 256.f) + EPS), ro = rsqrtf(so * (1.f / 128.f) + EPS);
        const float4 n0 = *(const float4*)(p.in[I_SSDN] + c), n1 = *(const float4*)(p.in[I_SSDN] + c + 4);
        const float4 h0 = *(const float4*)(p.in[I_HGN] + c), h1 = *(const float4*)(p.in[I_HGN] + c + 4);
        const float nv[8] = {n0.x, n0.y, n0.z, n0.w, n1.x, n1.y, n1.z, n1.w}, hv[8] = {h0.x, h0.y, h0.z, h0.w, h1.x, h1.y, h1.z, h1.w};
        float m0[8], m1[8];
#pragma unroll
        for (int q = 0; q < 8; q++) { m0[q] = ys[q] * ry * nv[q]; m1[q] = ov[q] * ro * hv[q] * gs[q]; }
        pg8::u32x4 w0, w1;
        w0.x = pack_bf16(m0[0], m0[1]); w0.y = pack_bf16(m0[2], m0[3]); w0.z = pack_bf16(m0[4], m0[5]); w0.w = pack_bf16(m0[6], m0[7]);
        w1.x = pack_bf16(m1[0], m1[1]); w1.y = pack_bf16(m1[2], m1[3]); w1.z = pack_bf16(m1[4], m1[5]); w1.w = pack_bf16(m1[6], m1[7]);
        *(pg8::u32x4*)(MB + (size_t)r * D + c) = w0;
        *(pg8::u32x4*)(MB + (size_t)r * D + 512 + c) = w1;
    }
}

constexpr int N_PHASES = 22;
__global__ void __launch_bounds__(NT, 2) mega(KArgs ka) {
    extern __shared__ __attribute__((aligned(16))) unsigned char smem[];
    float* lds = (float*)smem;
    PG8_LAS unsigned char* glds = (PG8_LAS unsigned char*)smem;
    if (threadIdx.x < 4) ((unsigned*)(smem + LDS_BYTES - 16))[threadIdx.x] = 0u;
    __syncthreads();
    XcdBarrier gbar = xcd_barrier_post((unsigned*)(ka.ws + OFF_BAR), (volatile LAS3 unsigned*)(smem + LDS_BYTES - 16));
    Params p;
    p.in = (const float* const*)(ka.ws + OFF_TAB); p.out = ka.out; p.ws = ka.ws;
    p.wave_id = __builtin_amdgcn_readfirstlane(threadIdx.x >> 6);
    float* XA = wsp<float>(p, OFF_XA);
    float* XB = wsp<float>(p, OFF_XB);
    float* XC = wsp<float>(p, OFF_XC);
    bf16_t* PB = wsp<bf16_t>(p, OFF_P);
    const int G = gridDim.x, bid = blockIdx.x;
#ifndef ONLY
#define ONLY -1
#endif
#ifndef PHMASK
#define PHMASK 0xFFFFFFFFull
#endif
#define IN(k) ((ONLY < 0 || ONLY == (k)) && ((PHMASK >> (k)) & 1ull))
#ifndef REPMASK
#define REPMASK 0ull
#endif
#define NREP(k) (IN(k) ? ((((REPMASK) >> (k)) & 1ull) ? 2 : 1) : 0)
#ifndef PROBE_LO
#define PROBE_LO -1
#define PROBE_HI -1
#define PROBE_AMP 4
#endif
    volatile unsigned long long* tsl = (volatile unsigned long long*)(smem + LDS_BYTES - 512);
    int nstamp = 0;
#define STAMP() do { if (PROBE_LO >= 0) { if (tid_of_wave(p.wave_id) == 0) tsl[nstamp] = __builtin_amdgcn_s_memrealtime(); ++nstamp; } } while (0)
    STAMP();
#define SEAM(k) do { xcd_barrier(gbar, p.wave_id); STAMP(); } while (0)
#define SUBSTAMP() do { if (PROBE_LO >= 0) { __syncthreads(); STAMP(); } } while (0)
    if (blockIdx.x == 0 && threadIdx.x == 0) {
#pragma unroll
        for (int i = 0; i < N_IN; i++) ((const float**)(ka.ws + OFF_TAB))[i] = ka.in[i];
    }
    for (int _r = 0; _r < NREP(0); _r++) { if (_r) SEAM(0); ph_prologue(ka, lds); ph_convert_weights(ka);
    }
    SEAM(0);
    for (int _r = 0; _r < NREP(1); _r++) { if (_r) SEAM(1);
            prep_rows<false>(p, lds, p.in[I_X], p.in[I_CTX], R, p.in[I_NORMG] + 0, 0, 0); SUBSTAMP();
            ph_filter_gemm_lat(p, smem); ph_filter_gemm_ctx(p, lds);
    }
    SEAM(1);
    for (int _r = 0; _r < NREP(2); _r++) { if (_r) SEAM(2);
            { pg8::StaticOrder S; S.init(R, EVEN_IN, G, bid);
              pg8::gemm_phase(p.wave_id, glds, pg8::Gemm{wsp<bf16_t>(p, OFF_HB), wsp<bf16_t>(p, OFF_WINE), D}, S, pg8::EpiStoreBf16{PB, EVEN_IN, EVEN_IN}); } SUBSTAMP();
            ph_filter_fft(p, smem); ph_filter_abs_ctx(p);
    }
    SEAM(2);
    for (int _r = 0; _r < NREP(3); _r++) { if (_r) SEAM(3); ph_qk_dwconv(p); SUBSTAMP(); ph_dwconv_t(p, lds);
    }
    SEAM(3);
    for (int _r = 0; _r < NREP(4); _r++) { if (_r) SEAM(4); ph_hyena_fft(p, smem); SUBSTAMP(); ph_attention_mfma(p, smem); SUBSTAMP(); ph_hyena_conv(p, 0);
    }
    SEAM(4);
    for (int _r = 0; _r < NREP(5); _r++) { if (_r) SEAM(5); ph_hy_transpose(p, smem); ph_hyena_conv(p, 1);
    }
    SEAM(5);
    for (int _r = 0; _r < NREP(6); _r++) { if (_r) SEAM(6);
            { pg8::StaticOrder S; S.init(R, D, G, bid);
              pg8::gemm_phase(p.wave_id, glds, pg8::Gemm{wsp<bf16_t>(p, OFF_MB), wsp<bf16_t>(p, OFF_WOUT), D}, S,
                              pg8::EpiResid{p.in[I_X], p.in[I_CTX], modp(p, 0, 0, 0) + 2048, modp(p, 0, 1, 0) + 2048, XA}); }
    }
    SEAM(6);
    for (int _r = 0; _r < NREP(7); _r++) { if (_r) SEAM(7); prep_router(p, smem, XA, XA + (size_t)L * D, R, p.in[I_NORMG] + 1024, 0, 1);
    }
    SEAM(7);
    for (int _r = 0; _r < NREP(8); _r++) { if (_r) SEAM(8); ph_moe_scatter(p, lds, 0, R);
    }
    SEAM(8);
    for (int _r = 0; _r < NREP(9); _r++) { if (_r) SEAM(9); ph_moe_gemm1(p, glds, 0);
    }
    SEAM(9);
    for (int _r = 0; _r < NREP(10); _r++) { if (_r) SEAM(10); ph_moe_gemm2(p, glds, 0);
    }
    SEAM(10);
    for (int _r = 0; _r < NREP(11); _r++) { if (_r) SEAM(11); ph_moe_combine<true>(p, 0, R, XA, XB, 1);
    }
    SEAM(11);
    for (int _r = 0; _r < NREP(12); _r++) { if (_r) SEAM(12);
            { pg8::StaticOrder S; S.init(R, ODD_PAD, G, bid);
              pg8::gemm_phase(p.wave_id, glds, pg8::Gemm{wsp<bf16_t>(p, OFF_HB), wsp<bf16_t>(p, OFF_WINO), D}, S, pg8::EpiStoreBf16{PB, ODD_IN, ODD_IN}); }
    }
    SEAM(12);
    for (int _r = 0; _r < NREP(13); _r++) { if (_r) SEAM(13); ph_streams(p);
    }
    SEAM(13);
    for (int _r = 0; _r < NREP(14); _r++) { if (_r) SEAM(14); ph_ssd_s1(p, smem); SUBSTAMP(); ph_hg_s1(p, smem);
    }
    SEAM(14);
    for (int _r = 0; _r < NREP(22); _r++) { if (_r) SEAM(22); ph_ssd_s2(p); ph_hg_s2(p);
    }
    SEAM(22);
    for (int _r = 0; _r < NREP(23); _r++) { if (_r) SEAM(23); ph_ssd_s3(p, smem); SUBSTAMP(); ph_hg_s3(p, smem);
    }
    SEAM(23);
    for (int _r = 0; _r < NREP(15); _r++) { if (_r) SEAM(15); ph_merge(p);
    }
    SEAM(15);
    for (int _r = 0; _r < NREP(16); _r++) { if (_r) SEAM(16);
            { pg8::StaticOrder S; S.init(L, D, G, bid);
              pg8::gemm_phase(p.wave_id, glds, pg8::Gemm{wsp<bf16_t>(p, OFF_MB), wsp<bf16_t>(p, OFF_WOUT) + (size_t)D * D, D}, S,
                              pg8::EpiResid{XB, XB, modp(p, 1, 0, 0) + 2048, modp(p, 1, 0, 0) + 2048, XC}); }
    }
    SEAM(16);
    for (int _r = 0; _r < NREP(17); _r++) { if (_r) SEAM(17); prep_router(p, smem, XC, XC, L, p.in[I_NORMG] + 3 * 1024, 1, 1);
    }
    SEAM(17);
    for (int _r = 0; _r < NREP(18); _r++) { if (_r) SEAM(18); ph_moe_scatter(p, lds, 1, L);
    }
    SEAM(18);
    for (int _r = 0; _r < NREP(19); _r++) { if (_r) SEAM(19); ph_moe_gemm1(p, glds, 1);
    }
    SEAM(19);
    for (int _r = 0; _r < NREP(20); _r++) { if (_r) SEAM(20); ph_moe_gemm2(p, glds, 1);
    }
    SEAM(20);
    for (int _r = 0; _r < NREP(21); _r++) { if (_r) SEAM(21); ph_moe_combine<false>(p, 1, L, XC, p.out, 0);
    }
    if (PROBE_LO >= 0) {
        STAMP();
        __syncthreads();
        const unsigned long long dtk = tsl[PROBE_HI] - tsl[PROBE_LO];
        const unsigned long long t0 = __builtin_amdgcn_s_memrealtime();
        while (__builtin_amdgcn_s_memrealtime() - t0 < (unsigned long long)PROBE_AMP * dtk) __builtin_amdgcn_s_sleep(8);
    }
#undef IN
#undef SEAM
}

extern "C" void kernel_launch(void* const* d_in, const int* in_sizes, int n_in, void* d_out, int out_size, void* d_ws, size_t ws_size,
                              hipStream_t stream) {
    static int grid_blocks = 0;
    if (!grid_blocks) {
        int dev = 0, cus = 0, per_cu = 0;
        hipGetDevice(&dev);
        hipDeviceGetAttribute(&cus, hipDeviceAttributeMultiprocessorCount, dev);
        hipFuncSetAttribute((const void*)mega, hipFuncAttributeMaxDynamicSharedMemorySize, LDS_BYTES);
        hipOccupancyMaxActiveBlocksPerMultiprocessor(&per_cu, mega, NT, LDS_BYTES);
        if (per_cu < 1) per_cu = 1;
        grid_blocks = cus;
        if (ws_size < WS_END) fprintf(stderr, "kernel_launch: workspace too small: %zu < %zu\n", ws_size, (size_t)WS_END);
    }
    hipMemsetAsync((char*)d_ws + OFF_CTL, 0, 65536, stream);
    KArgs p{};
    for (int i = 0; i < N_IN; i++) p.in[i] = (const float*)d_in[i];
    p.out = (float*)d_out;
    p.ws = (unsigned char*)d_ws;
    hipLaunchKernelGGL(mega, dim3(grid_blocks), dim3(NT), LDS_BYTES, stream, p);
}
```

```cpp
#include <hip/hip_runtime.h>
#include <cstdio>
#include <cstdint>

constexpr int L = 16384, NCX = 256, R = L + NCX, D = 1024;
constexpr int EVEN_IN = 2304, ODD_IN = 4112;
constexpr int NT = 512, NWAVE = 8;
constexpr int NEXP = 32;
constexpr int NROWS = 74752;
constexpr int ODD_PAD = 4352;
constexpr int LDS_BYTES = 147456;
typedef unsigned short bf16_t;
constexpr float EPS = 1e-6f;

enum { I_X = 0, I_C, I_CTX, I_CCTX, I_NORMG, I_ADAW, I_ADAB, I_WOUT, I_WINE, I_HYCW, I_HYCB, I_HYW1, I_HYB1, I_HYW2, I_HYB2,
       I_HYW3, I_HYB3, I_HYW4, I_HYFREQ, I_HYFB, I_QNORM, I_KNORM, I_SINK, I_WINO, I_SSDCW, I_SSDCB, I_DTB, I_ALOG, I_SSDD,
       I_SSDN, I_HGLB, I_HGN, I_RW, I_RB, I_WGU, I_BGU, I_WDN, I_BDN, N_IN };

constexpr size_t al256(size_t x) { return (x + 255) & ~(size_t)255; }
constexpr size_t OFF_CTL = 0;
constexpr size_t OFF_BAR = 1024;
constexpr size_t OFF_TAB = 32768;
constexpr size_t OFF_MOD = 65536;
constexpr size_t OFF_LB = OFF_MOD + al256(4 * 24576);
constexpr size_t OFF_STARTS = OFF_LB + 4096;
constexpr size_t OFF_ROPE = OFF_STARTS + 4096;
constexpr size_t OFF_HNP = OFF_ROPE + 32768;
constexpr size_t OFF_HD3 = OFF_HNP + al256(4 * 130 * 1024);
constexpr size_t OFF_HH = OFF_HD3 + al256(4ull * R * 64);
constexpr size_t OFF_HHC = OFF_HH + al256(4ull * 2 * L * 1024);
constexpr size_t OFF_XA = OFF_HHC + al256(4ull * 512 * 1024);
constexpr size_t OFF_XB = OFF_XA + al256(4ull * R * D);
constexpr size_t OFF_XC = OFF_XA;
constexpr size_t OFF_H = OFF_XB + al256(4ull * R * D);
constexpr size_t OFF_P = OFF_H + al256(4ull * R * D);
constexpr size_t OFF_QN = OFF_P + al256(4ull * R * ODD_IN);
constexpr size_t OFF_KN = OFF_QN + al256(4ull * R * 512);
constexpr size_t OFF_U = OFF_KN + al256(4ull * R * 128);
constexpr size_t OFF_Z1 = OFF_U + al256(4ull * R * 1536);
constexpr size_t OFF_TOPE = OFF_Z1 + al256(4ull * R * 512);
constexpr size_t OFF_TOPG = OFF_TOPE + al256(4ull * R * 4);
constexpr size_t OFF_TOPP = OFF_TOPG + al256(4ull * R * 4);
constexpr size_t OFF_ROWTOK = OFF_TOPP + al256(4ull * R * 4);
constexpr size_t OFF_YR = OFF_ROWTOK + al256(4ull * 2 * NROWS);
constexpr size_t OFF_XBC = OFF_U;
constexpr size_t OFF_DT = OFF_YR + al256(4ull * NROWS * 1024);
constexpr size_t OFF_F = OFF_HH;
constexpr size_t OFF_Q1 = OFF_F + al256(4ull * 2 * R * 512);
constexpr size_t OFF_Y = OFF_DT + al256(4ull * 2 * R * 8);
constexpr size_t OFF_O = OFF_Y + al256(4ull * 2 * R * 512);
constexpr size_t OFF_TILEE = OFF_O + al256(4ull * 2 * R * 512);
constexpr size_t OFF_SDEC = OFF_TILEE + 4096;
constexpr size_t OFF_BC = OFF_SDEC + 16384;
constexpr size_t OFF_HDEC = OFF_BC + 2 * 512 * 32 * 4;
constexpr size_t OFF_HB = OFF_HDEC + al256(4ull * 2 * 260 * 4 * 128);
constexpr size_t OFF_MB = OFF_HB + al256(2ull * R * D);
constexpr size_t OFF_XG = OFF_MB + al256(2ull * R * D);
constexpr size_t OFF_ACTB = OFF_XG + al256(2ull * NROWS * D);
constexpr size_t OFF_SST = OFF_XG;
constexpr size_t OFF_SSIN = OFF_SST + al256(2ull * 2 * 130 * 8 * 64 * 128);
constexpr size_t OFF_HST = OFF_SSIN + al256(2ull * 2 * 130 * 8 * 64 * 128);
constexpr size_t OFF_HSIN = OFF_ACTB;
constexpr size_t OFF_VB = OFF_KN + 2ull * R * 128;
constexpr size_t OFF_HT = OFF_ACTB;
constexpr size_t OFF_HF = OFF_XG;
constexpr size_t OFF_UC = OFF_U + 4ull * 1536 * L;
constexpr size_t OFF_HYT = OFF_Z1;
constexpr size_t OFF_WINE = OFF_ACTB + al256(2ull * NROWS * D);
constexpr size_t OFF_WINO = OFF_WINE + al256(2ull * EVEN_IN * D);
constexpr size_t OFF_WOUT = OFF_WINO + al256(2ull * ODD_PAD * D);
constexpr size_t OFF_WGU = OFF_WOUT + al256(2ull * 2 * D * D);
constexpr size_t OFF_WDN = OFF_WGU + al256(2ull * 2 * 32 * 2048 * D);
constexpr size_t WS_END = OFF_WDN + al256(2ull * 2 * 32 * 1024 * D);

struct KArgs {
    const float* in[N_IN];
    float* out;
    unsigned char* ws;
};
struct Params {
    const float* const* in;
    float* out;
    unsigned char* ws;
    int wave_id;
};

__device__ __forceinline__ int tid_opaque() { int t = threadIdx.x; asm volatile("" : "+v"(t)); return t; }
__device__ __forceinline__ int tid_of_wave(int wave_id) { unsigned m = ~0u; asm volatile("" : "+s"(m));
    int t = wave_id * 64 + (int)__builtin_amdgcn_mbcnt_hi(m, __builtin_amdgcn_mbcnt_lo(m, 0u)); asm volatile("" : "+v"(t)); return t; }

#define XB_TMO      128
#define XB_XCNT(j)  (256  + 64 * (j))
#define XB_XSUB(j)  (1280 + 64 * (j))
#define XB_XGEN(j)  (2304 + 64 * (j))
#define XB_TOP      3328
#define XB_TOPGEN   3392
#define XCD_BAR_WORDS 3456
#define XB_SPIN_CAP (1u << 22)
#define LAS3 __attribute__((address_space(3)))
__device__ __forceinline__ unsigned xb_ld(unsigned* p) { return __hip_atomic_load(p, __ATOMIC_RELAXED, __HIP_MEMORY_SCOPE_AGENT); }
__device__ __forceinline__ unsigned xb_add(unsigned* p, unsigned v) { return __hip_atomic_fetch_add(p, v, __ATOMIC_RELAXED, __HIP_MEMORY_SCOPE_AGENT); }
__device__ __forceinline__ unsigned xb_xcc_id() { return (unsigned)__builtin_amdgcn_s_getreg((3 << 11) | 20) & 0xFu; }
#define XB_SPIN(cond, bar) do { unsigned _sp = 0; while (cond) { __builtin_amdgcn_s_sleep(1); \
    if ((++_sp & 255u) == 0u) { if (xb_ld(&(bar)[XB_TMO])) break; if (_sp > XB_SPIN_CAP) { atomicAdd(&(bar)[XB_TMO], 1u); break; } } } } while (0)
struct XcdBarrier { unsigned* bar; unsigned x; volatile LAS3 unsigned* st; };
__device__ __forceinline__ XcdBarrier xcd_barrier_post(unsigned* bar, volatile LAS3 unsigned* st) {
    XcdBarrier b; b.bar = bar; b.x = xb_xcc_id(); b.st = st;
    if (threadIdx.x == 0) (void)xb_add(&bar[XB_XCNT(b.x)], 1u);
    return b;
}
__device__ __forceinline__ void xcd_barrier_complete(unsigned* bar, unsigned x, unsigned& nloc, unsigned& nx) {
    const unsigned G = gridDim.x * gridDim.y * gridDim.z;
    unsigned sum, cnt, mine, sp = 0u;
    for (;;) {
        sum = 0u; cnt = 0u; mine = 0u;
#pragma unroll
        for (unsigned j = 0; j < 16; ++j) { const unsigned c = xb_ld(&bar[XB_XCNT(j)]); sum += c; cnt += (c > 0u) ? 1u : 0u; mine = (j == x) ? c : mine; }
        if (sum == G) break;
        __builtin_amdgcn_s_sleep(1);
        if ((++sp & 255u) == 0u) { if (xb_ld(&bar[XB_TMO])) break; if (sp > XB_SPIN_CAP) { atomicAdd(&bar[XB_TMO], 1u); break; } }
    }
    nloc = mine > 0u ? mine : 1u; nx = cnt > 0u ? cnt : 1u;
}
__device__ __forceinline__ void xcd_barrier(const XcdBarrier& b, int wave_id) {
    asm volatile("s_waitcnt vmcnt(0)" ::: "memory");
    __syncthreads();
    if (tid_of_wave(wave_id) == 0) {
        unsigned* bar = b.bar;
        __builtin_amdgcn_s_waitcnt(0);
        unsigned nloc = b.st[0], nx = b.st[1];
        if (nloc == 0u) { xcd_barrier_complete(bar, b.x, nloc, nx); b.st[0] = nloc; b.st[1] = nx; }
        const unsigned old = xb_add(&bar[XB_XSUB(b.x)], 1u);
        const unsigned gen = old / nloc;
        if (old + 1u == (gen + 1u) * nloc) {
            __builtin_amdgcn_fence(__ATOMIC_RELEASE, "agent");
            asm volatile("s_waitcnt vmcnt(0)" ::: "memory");
            const unsigned og = xb_add(&bar[XB_TOP], 1u);
            const unsigned tg = og / nx;
            if (og + 1u == (tg + 1u) * nx) xb_add(&bar[XB_TOPGEN], 1u);
            else XB_SPIN(xb_ld(&bar[XB_TOPGEN]) == tg, bar);
            __builtin_amdgcn_fence(__ATOMIC_ACQUIRE, "agent");
            xb_add(&bar[XB_XGEN(b.x)], 1u);
            asm volatile("s_waitcnt vmcnt(0)" ::: "memory");
        } else {
            XB_SPIN(xb_ld(&bar[XB_XGEN(b.x)]) == gen, bar);
            __builtin_amdgcn_fence(__ATOMIC_ACQUIRE, "agent");
            asm volatile("s_waitcnt vmcnt(0)" ::: "memory");
        }
    }
    __syncthreads();
}
__device__ __forceinline__ float silu_f(float x) { return x / (1.f + expf(-x)); }
__device__ __forceinline__ float sigmoid_f(float x) { return 1.f / (1.f + expf(-x)); }
__device__ __forceinline__ float sigmoid_fast(float x) { return __builtin_amdgcn_rcpf(1.f + __expf(-x)); }
__device__ __forceinline__ float silu_fast(float x) { return x * __builtin_amdgcn_rcpf(1.f + __expf(-x)); }
__device__ __forceinline__ float softplus_f(float x) { return x > 20.f ? x : log1pf(expf(x)); }
__device__ __forceinline__ float lane_xor(int lane, float v, int mask) { return __int_as_float(__builtin_amdgcn_ds_bpermute((lane ^ mask) << 2, __float_as_int(v))); }
__device__ __forceinline__ float lane_get(float v, int src) { return __int_as_float(__builtin_amdgcn_ds_bpermute(src << 2, __float_as_int(v))); }
template <int CTRL> __device__ __forceinline__ float dpp_f(float v) { return __int_as_float(__builtin_amdgcn_update_dpp(0, __float_as_int(v), CTRL, 0xF, 0xF, false)); }
__device__ __forceinline__ float wave_sum(int lane, float v) {
    v += dpp_f<0xB1>(v);
    v += dpp_f<0x4E>(v);
    v += dpp_f<0x141>(v);
    v += dpp_f<0x140>(v);
    v += lane_xor(lane, v, 16);
    v += lane_xor(lane, v, 32);
    return v;
}
__device__ __forceinline__ float wave_max(int lane, float v) {
    v = fmaxf(v, dpp_f<0xB1>(v));
    v = fmaxf(v, dpp_f<0x4E>(v));
    v = fmaxf(v, dpp_f<0x141>(v));
    v = fmaxf(v, dpp_f<0x140>(v));
    v = fmaxf(v, lane_xor(lane, v, 16));
    v = fmaxf(v, lane_xor(lane, v, 32));
    return v;
}
template <class T, class PT> __device__ __forceinline__ T* wsp(const PT& p, size_t off) { return (T*)(p.ws + off); }
__device__ __forceinline__ const float* modp(const Params& p, int layer, int cond, int j) {
    return wsp<float>(p, OFF_MOD) + (layer * 2 + cond) * 6144 + j * 3072;
}

__device__ __forceinline__ bf16_t f2bf(float f) { unsigned u = __float_as_uint(f); u += 0x7FFFu + ((u >> 16) & 1u); return (bf16_t)(u >> 16); }
__device__ __forceinline__ unsigned pack_bf16(float lo, float hi) { return (unsigned)f2bf(lo) | ((unsigned)f2bf(hi) << 16); }

namespace pg8 {
#define PG8_LAS __attribute__((address_space(3)))
typedef short bf16x8 __attribute__((ext_vector_type(8)));
typedef float f32x4 __attribute__((ext_vector_type(4)));
typedef unsigned u32x4 __attribute__((ext_vector_type(4)));
constexpr int BM = 256, BK = 64, HALF = 128, HTB = HALF * BK * 2, STAGE_BYTES = 8 * HTB, NXCD = 8, WGM = 8;
__device__ __forceinline__ int lds_byte(int r, int c) { const int st = (r >> 4) * 2 + (c >> 5), rr = r & 15, cc = c & 31, ob = rr * 64 + cc * 2; return st * 1024 + (ob ^ (((ob >> 9) & 1) << 5)); }
__device__ __forceinline__ void stage_rc(int b, int& Rr, int& C) { const int st = b / 1024, sb = b % 1024, swz = sb ^ (((sb >> 9) & 1) << 5); Rr = (st >> 1) * 16 + swz / 64; C = (st & 1) * 32 + (swz % 64) / 2; }
__device__ __forceinline__ int perm32(int rho) { const int n = rho >> 4, i = rho & 15; return 8 * (i >> 2) + 4 * n + (i & 3); }
struct Unit { int pm, pn, pb, e; };
struct Gemm { const bf16_t* A; const bf16_t* Bt; int K; };
struct StaticOrder {
    int nM, nN, nwg, G, c;
    __device__ void init(int M, int N, int G_, int c_) { nM = M / BM; nN = N / BM; nwg = nM * nN; G = G_; c = c_; }
    __device__ bool next(int i, Unit& u) const {
        const long Lx = (long)i * G + c; if (Lx >= nwg) return false;
        int wgid = (int)Lx; { const int q = nwg / NXCD, r = nwg % NXCD, xcd = wgid % NXCD, off = wgid / NXCD; wgid = (xcd < r ? xcd * (q + 1) : r * (q + 1) + (xcd - r) * q) + off; }
        const int nig = WGM * nN, gid = wgid / nig, fm = gid * WGM, gsz = (nM - fm) < WGM ? (nM - fm) : WGM;
        u.pm = fm + ((wgid % nig) % gsz); u.pn = (wgid % nig) / gsz; u.pb = u.pn; u.e = 0; return true;
    }
};
struct MoeOrder {
    const int* tile_e; int ntile, nN, G, c;
    __device__ bool next(int i, Unit& u) const {
        const long Lx = (long)i * G + c; if (Lx >= (long)ntile * nN) return false;
        u.pm = (int)(Lx / nN); u.pn = (int)(Lx % nN); u.e = tile_e[u.pm]; u.pb = u.e * nN + u.pn; return true;
    }
};
struct EpiStoreF32 {
    static constexpr bool PERM = false;
    float* C; int ldc; int nvalid;
    __device__ __forceinline__ void operator()(const f32x4 (&acc)[2][2][4][2], const Unit& u, int wr, int wc, int fr, int fq) const {
        const int row0 = u.pm * BM + wr * 64 + fr, col0 = u.pn * BM + wc * 32 + 4 * fq;
#pragma unroll
        for (int ai = 0; ai < 2; ++ai)
#pragma unroll
            for (int m = 0; m < 4; ++m) { float* rowp = C + (size_t)(row0 + ai * HALF + m * 16) * ldc + col0;
#pragma unroll
                for (int bj = 0; bj < 2; ++bj)
#pragma unroll
                    for (int n = 0; n < 2; ++n) if (col0 + bj * HALF + n * 16 < nvalid) *(f32x4*)(rowp + bj * HALF + n * 16) = acc[ai][bj][m][n]; }
    }
};
struct EpiStoreBf16 {
    static constexpr bool PERM = true;
    bf16_t* C; int ldc; int nvalid;
    __device__ __forceinline__ void operator()(const f32x4 (&acc)[2][2][4][2], const Unit& u, int wr, int wc, int fr, int fq) const {
        const int row0 = u.pm * BM + wr * 64 + fr, col0 = u.pn * BM + wc * 32 + 8 * fq;
#pragma unroll
        for (int ai = 0; ai < 2; ++ai)
#pragma unroll
            for (int m = 0; m < 4; ++m) { bf16_t* rowp = C + (size_t)(row0 + ai * HALF + m * 16) * ldc + col0;
#pragma unroll
                for (int bj = 0; bj < 2; ++bj) if (col0 + bj * HALF < nvalid) {
                    const f32x4 v0 = acc[ai][bj][m][0], v1 = acc[ai][bj][m][1];
                    u32x4 w; w.x = pack_bf16(v0[0], v0[1]); w.y = pack_bf16(v0[2], v0[3]); w.z = pack_bf16(v1[0], v1[1]); w.w = pack_bf16(v1[2], v1[3]);
                    *(u32x4*)(rowp + bj * HALF) = w; } }
    }
};
struct EpiResid {
    static constexpr bool PERM = false;
    const float* res_lat; const float* res_ctx; const float* gt_lat; const float* gt_ctx; float* out;
    __device__ __forceinline__ void operator()(const f32x4 (&acc)[2][2][4][2], const Unit& u, int wr, int wc, int fr, int fq) const {
        const int row0 = u.pm * BM + wr * 64 + fr, col0 = u.pn * BM + wc * 32 + 4 * fq;
        const bool ctx = (u.pm * BM) >= L;
        const float* gt = ctx ? gt_ctx : gt_lat;
        f32x4 gv[2][2];
#pragma unroll
        for (int bj = 0; bj < 2; ++bj)
#pragma unroll
            for (int n = 0; n < 2; ++n) gv[bj][n] = *(const f32x4*)(gt + col0 + bj * HALF + n * 16);
#pragma unroll
        for (int ai = 0; ai < 2; ++ai)
#pragma unroll
            for (int m = 0; m < 4; ++m) { const int row = row0 + ai * HALF + m * 16;
                const float* rp = (ctx ? res_ctx + (size_t)(row - L) * D : res_lat + (size_t)row * D) + col0;
                float* op = out + (size_t)row * D + col0;
#pragma unroll
                for (int bj = 0; bj < 2; ++bj)
#pragma unroll
                    for (int n = 0; n < 2; ++n) *(f32x4*)(op + bj * HALF + n * 16) = *(const f32x4*)(rp + bj * HALF + n * 16) + gv[bj][n] * acc[ai][bj][m][n];
                asm volatile("" ::: "memory"); }
    }
};
struct EpiMoe1 {
    static constexpr bool PERM = true;
    bf16_t* ACT; const float* bgu;
    __device__ __forceinline__ void operator()(const f32x4 (&acc)[2][2][4][2], const Unit& u, int wr, int wc, int fr, int fq) const {
        const int row0 = u.pm * BM + wr * 64 + fr, col0 = u.pn * HALF + wc * 32 + 8 * fq;
        const float* bg = bgu + (size_t)u.e * 2048 + col0;
        f32x4 bgv[2], buv[2];
#pragma unroll
        for (int n = 0; n < 2; ++n) { bgv[n] = *(const f32x4*)(bg + 4 * n); buv[n] = *(const f32x4*)(bg + 1024 + 4 * n); }
#pragma unroll
        for (int ai = 0; ai < 2; ++ai)
#pragma unroll
            for (int m = 0; m < 4; ++m) {
                float a[8];
#pragma unroll
                for (int n = 0; n < 2; ++n) { const f32x4 g4 = acc[ai][0][m][n] + bgv[n], u4 = acc[ai][1][m][n] + buv[n];
#pragma unroll
                    for (int j = 0; j < 4; ++j) { const float gate = fminf(g4[j], 7.f), up = fminf(fmaxf(u4[j], -7.f), 7.f);
                        a[n * 4 + j] = (up + 1.f) * gate * __builtin_amdgcn_rcpf(1.f + __expf(-1.702f * gate)); } }
                u32x4 w; w.x = pack_bf16(a[0], a[1]); w.y = pack_bf16(a[2], a[3]); w.z = pack_bf16(a[4], a[5]); w.w = pack_bf16(a[6], a[7]);
                *(u32x4*)(ACT + (size_t)(row0 + ai * HALF + m * 16) * 1024 + col0) = w;
                asm volatile("" ::: "memory"); }
    }
};
struct EpiMoe2 {
    static constexpr bool PERM = true;
    bf16_t* YR; const float* bdn;
    __device__ __forceinline__ void operator()(const f32x4 (&acc)[2][2][4][2], const Unit& u, int wr, int wc, int fr, int fq) const {
        const int row0 = u.pm * BM + wr * 64 + fr, col0 = u.pn * BM + wc * 32 + 8 * fq;
        const float* bd = bdn + (size_t)u.e * 1024 + col0;
        f32x4 bv[2][2];
#pragma unroll
        for (int bj = 0; bj < 2; ++bj)
#pragma unroll
            for (int n = 0; n < 2; ++n) bv[bj][n] = *(const f32x4*)(bd + bj * HALF + 4 * n);
#pragma unroll
        for (int ai = 0; ai < 2; ++ai)
#pragma unroll
            for (int m = 0; m < 4; ++m) { bf16_t* rowp = YR + (size_t)(row0 + ai * HALF + m * 16) * 1024 + col0;
#pragma unroll
                for (int bj = 0; bj < 2; ++bj) {
                    const f32x4 v0 = acc[ai][bj][m][0] + bv[bj][0], v1 = acc[ai][bj][m][1] + bv[bj][1];
                    u32x4 w; w.x = pack_bf16(v0[0], v0[1]); w.y = pack_bf16(v0[2], v0[3]); w.z = pack_bf16(v1[0], v1[1]); w.w = pack_bf16(v1[2], v1[3]);
                    *(u32x4*)(rowp + bj * HALF) = w; }
                asm volatile("" ::: "memory"); }
    }
};
template <class Epi, class Sched>
__device__ __forceinline__ void gemm_phase(int wave_id, PG8_LAS unsigned char* lds, const Gemm g, const Sched& S, const Epi& E) {
    const int TIDX = tid_of_wave(wave_id);
    const int tid = TIDX, wid = __builtin_amdgcn_readfirstlane(tid >> 6), lane = tid & 63, wr = wid >> 2, wc = wid & 3, fr = lane & 15, fq = lane >> 4;
    const int K = g.K, nt = K / BK;
    unsigned voffA[2], voffB[2];
#pragma unroll
    for (int i = 0; i < 2; ++i) { int Rr, C; stage_rc(tid * 16 + i * 8192, Rr, C); const int Rb = Epi::PERM ? ((Rr & ~31) + perm32(Rr & 31)) : Rr;
        voffA[i] = (unsigned)(Rr * K + C) * 2u; voffB[i] = (unsigned)(Rb * K + C) * 2u; }
    const size_t kstep = (size_t)(BK * 2);
    const size_t hstep = (size_t)HALF * K * 2;
    const size_t tstep = 2 * hstep;
    const unsigned ldsw = (unsigned)wid * 1024u;
    const int aoff = lds_byte(wr * 64 + fr, fq * 8), boff = lds_byte(wc * 32 + fr, fq * 8);
#define PG8_SA(b, h) (((b) * 2 + (h)) * HTB)
#define PG8_SB(b, h) ((4 + (b) * 2 + (h)) * HTB)
#define PG8_STAGE(bufoff, gbase, voff) do { _Pragma("unroll") for (int _i = 0; _i < 2; ++_i) \
        __builtin_amdgcn_global_load_lds((const unsigned*)((const char*)(gbase) + (voff)[_i]), (PG8_LAS unsigned*)(lds + (bufoff) + ldsw + _i * 8192), 16, 0, 0); } while (0)
#define PG8_LDA(dst, b, h) do { _Pragma("unroll") for (int m = 0; m < 4; ++m) _Pragma("unroll") for (int k = 0; k < 2; ++k) dst[m][k] = *(const PG8_LAS bf16x8*)(lds + PG8_SA(b, h) + aoff + m * 2048 + k * 1024); } while (0)
#define PG8_LDB(dst, b, h) do { _Pragma("unroll") for (int n = 0; n < 2; ++n) _Pragma("unroll") for (int k = 0; k < 2; ++k) dst[n][k] = *(const PG8_LAS bf16x8*)(lds + PG8_SB(b, h) + boff + n * 2048 + k * 1024); } while (0)
#define PG8_MMA(ai, bj, At, Bt) do { __builtin_amdgcn_s_setprio(1); _Pragma("unroll") for (int m = 0; m < 4; ++m) _Pragma("unroll") for (int n = 0; n < 2; ++n) _Pragma("unroll") for (int k = 0; k < 2; ++k) \
        acc[ai][bj][m][n] = __builtin_amdgcn_mfma_f32_16x16x32_bf16(Bt[n][k], At[m][k], acc[ai][bj][m][n], 0, 0, 0); __builtin_amdgcn_s_setprio(0); } while (0)
#define PG8_WAIT_V(n) asm volatile("s_waitcnt vmcnt(" #n ")" ::: "memory")
#define PG8_WAIT_L(n) asm volatile("s_waitcnt lgkmcnt(" #n ")" ::: "memory")
#define PG8_BAR __builtin_amdgcn_s_barrier()
#define PG8_SCHED __builtin_amdgcn_sched_barrier(0)
    Unit cur, nxt; int ui = 0;
    if (!S.next(0, cur)) return;
    f32x4 acc[2][2][4][2];
#pragma unroll
    for (int a = 0; a < 2; ++a)
#pragma unroll
        for (int b = 0; b < 2; ++b)
#pragma unroll
            for (int m = 0; m < 4; ++m)
#pragma unroll
                for (int n = 0; n < 2; ++n) acc[a][b][m][n] = (f32x4){0.f, 0.f, 0.f, 0.f};
    bf16x8 At[4][2], B0[2][2], B1[2][2];
    const char* cA = (const char*)g.A + (size_t)cur.pm * tstep; const char* cB = (const char*)g.Bt + (size_t)cur.pb * tstep;
    PG8_STAGE(PG8_SB(0, 0), cB, voffB); PG8_STAGE(PG8_SA(0, 0), cA, voffA); PG8_STAGE(PG8_SB(0, 1), cB + hstep, voffB); PG8_STAGE(PG8_SA(0, 1), cA + hstep, voffA);
    if (wr == 1) PG8_BAR;
    PG8_WAIT_V(4); PG8_BAR;
    PG8_STAGE(PG8_SB(1, 0), cB + kstep, voffB); PG8_STAGE(PG8_SA(1, 0), cA + kstep, voffA); PG8_STAGE(PG8_SB(1, 1), cB + hstep + kstep, voffB);
    PG8_WAIT_V(6); PG8_BAR;
    for (;;) {
        const bool has_next = S.next(ui + 1, nxt);
        const char* nA = has_next ? (const char*)g.A + (size_t)nxt.pm * tstep : cA; const char* nB = has_next ? (const char*)g.Bt + (size_t)nxt.pb * tstep : cB;
        for (int t = 0; t < nt; t += 2) {
            const bool last = (t == nt - 2);
            const char* a1 = cA + (size_t)(t + 1) * kstep;
            const char* a2 = last ? nA : cA + (size_t)(t + 2) * kstep; const char* b2 = last ? nB : cB + (size_t)(t + 2) * kstep;
            const char* a3 = a2 + kstep; const char* b3 = b2 + kstep;
            PG8_LDB(B0, 0, 0); PG8_SCHED; PG8_LDA(At, 0, 0); PG8_STAGE(PG8_SA(1, 1), a1 + hstep, voffA);
            PG8_WAIT_L(8); PG8_BAR; PG8_WAIT_L(0); PG8_MMA(0, 0, At, B0); PG8_BAR; PG8_SCHED;
            PG8_LDB(B1, 0, 1); PG8_STAGE(PG8_SB(0, 0), b2, voffB);
            PG8_BAR; PG8_WAIT_L(0); PG8_MMA(0, 1, At, B1); PG8_BAR;
            PG8_LDA(At, 0, 1); PG8_STAGE(PG8_SA(0, 0), a2, voffA);
            PG8_BAR; PG8_WAIT_L(0); PG8_MMA(1, 0, At, B0); PG8_BAR; PG8_SCHED;
            PG8_STAGE(PG8_SB(0, 1), b2 + hstep, voffB);
            PG8_WAIT_V(6); PG8_BAR; PG8_MMA(1, 1, At, B1); PG8_BAR;
            PG8_LDB(B0, 1, 0); PG8_SCHED; PG8_LDA(At, 1, 0); PG8_STAGE(PG8_SA(0, 1), a2 + hstep, voffA);
            PG8_WAIT_L(8); PG8_BAR; PG8_WAIT_L(0); PG8_MMA(0, 0, At, B0); PG8_BAR; PG8_SCHED;
            PG8_LDB(B1, 1, 1); PG8_STAGE(PG8_SB(1, 0), b3, voffB);
            PG8_BAR; PG8_WAIT_L(0); PG8_MMA(0, 1, At, B1); PG8_BAR;
            PG8_LDA(At, 1, 1); PG8_STAGE(PG8_SA(1, 0), a3, voffA);
            PG8_BAR; PG8_WAIT_L(0); PG8_MMA(1, 0, At, B0); PG8_BAR; PG8_SCHED;
            PG8_STAGE(PG8_SB(1, 1), b3 + hstep, voffB);
            PG8_WAIT_V(6); PG8_BAR; PG8_MMA(1, 1, At, B1); PG8_BAR;
        }
        E(acc, cur, wr, wc, fr, fq);
        if (!has_next) break;
#pragma unroll
        for (int a = 0; a < 2; ++a)
#pragma unroll
            for (int b = 0; b < 2; ++b)
#pragma unroll
                for (int m = 0; m < 4; ++m)
#pragma unroll
                    for (int n = 0; n < 2; ++n) acc[a][b][m][n] = (f32x4){0.f, 0.f, 0.f, 0.f};
        cur = nxt; cA = nA; cB = nB; ++ui;
    }
    PG8_WAIT_V(0);
    if (wr == 0) PG8_BAR;
    PG8_BAR;
#undef PG8_SA
#undef PG8_SB
#undef PG8_STAGE
#undef PG8_LDA
#undef PG8_LDB
#undef PG8_MMA
#undef PG8_WAIT_V
#undef PG8_WAIT_L
#undef PG8_BAR
#undef PG8_SCHED
}
}

typedef unsigned u32x2_t __attribute__((ext_vector_type(2)));
typedef short bf16x8_t __attribute__((ext_vector_type(8)));
typedef float f32x16 __attribute__((ext_vector_type(16)));
typedef float f32x16f __attribute__((ext_vector_type(16)));
constexpr int LDP = 136;
template <int KSTEPS>
__device__ __forceinline__ f32x16 mma32(int lane, const bf16_t* As, int lda, const bf16_t* Bs, int ldb, f32x16 acc) {
    const int r = lane & 31, hh = lane >> 5;
    const bf16_t* ap = As + r * lda + 8 * hh;
    const bf16_t* bp = Bs + r * ldb + 8 * hh;
#pragma unroll 2
    for (int ks = 0; ks < KSTEPS; ks++) {
        const bf16x8_t a = *(const bf16x8_t*)(ap + ks * 16);
        const bf16x8_t b = *(const bf16x8_t*)(bp + ks * 16);
        acc = __builtin_amdgcn_mfma_f32_32x32x16_bf16(a, b, acc, 0, 0, 0);
    }
    return acc;
}
#define CROW(reg, hf) (((reg) & 3) + 8 * ((reg) >> 2) + 4 * (hf))
__device__ __forceinline__ float bf2f(unsigned short b) { return __uint_as_float(((unsigned)b) << 16); }

template <class PT>
__device__ __forceinline__ void ph_convert_weights(const PT& p) {
    const int TIDX = tid_opaque();
    const int lane = TIDX & 63, wave = TIDX >> 6, nl = lane & 31, kh = lane >> 5;
    constexpr int G_INE = EVEN_IN / 32, G_INO = ODD_PAD / 32, G_OUT = 2 * D / 32, G_GU = 64 * 2048 / 32, G_DN = 64 * 1024 / 32;
    constexpr int GT = G_INE + G_INO + G_OUT + G_GU + G_DN;
    for (int it = blockIdx.x * NWAVE + wave; it < GT * 16; it += gridDim.x * NWAVE) {
        const int item = __builtin_amdgcn_readfirstlane(it);
        int g = item % GT; const int kg = item / GT;
        const float* src; bf16_t* dst; int N, col0, nvalid;
        if (g < G_INE) { src = p.in[I_WINE]; N = EVEN_IN; col0 = g * 32; nvalid = EVEN_IN; dst = wsp<bf16_t>(p, OFF_WINE) + (size_t)g * 32 * 1024; }
        else if ((g -= G_INE) < G_INO) { src = p.in[I_WINO]; N = ODD_IN; col0 = g * 32; nvalid = ODD_IN; dst = wsp<bf16_t>(p, OFF_WINO) + (size_t)g * 32 * 1024; }
        else if ((g -= G_INO) < G_OUT) { const int l = g / 32, gg = g % 32; src = p.in[I_WOUT] + (size_t)l * D * D; N = D; col0 = gg * 32; nvalid = D; dst = wsp<bf16_t>(p, OFF_WOUT) + ((size_t)l * 1024 + gg * 32) * 1024; }
        else if ((g -= G_OUT) < G_GU) { const int le = g / 64, gg = g % 64, drow = gg * 32, T = drow >> 8, within = drow & 255;
            src = p.in[I_WGU] + (size_t)le * 1024 * 2048; N = 2048; nvalid = 2048;
            col0 = within < 128 ? 128 * T + within : 1024 + 128 * T + (within - 128);
            dst = wsp<bf16_t>(p, OFF_WGU) + ((size_t)le * 2048 + drow) * 1024; }
        else { g -= G_GU; const int le = g / 32, gg = g % 32; src = p.in[I_WDN] + (size_t)le * 1024 * 1024; N = 1024; col0 = gg * 32; nvalid = 1024; dst = wsp<bf16_t>(p, OFF_WDN) + ((size_t)le * 1024 + gg * 32) * 1024; }
        const bool ok = col0 + nl < nvalid;
        const float* sp = src + (size_t)(kg * 64 + kh * 8) * N + col0 + nl;
        float a[4][8];
#pragma unroll
        for (int ch = 0; ch < 4; ch++)
#pragma unroll
            for (int q = 0; q < 8; q++) a[ch][q] = ok ? sp[(size_t)(16 * ch + q) * N] : 0.f;
#pragma unroll
        for (int ch = 0; ch < 4; ch++) {
            pg8::u32x4 w; w.x = pack_bf16(a[ch][0], a[ch][1]); w.y = pack_bf16(a[ch][2], a[ch][3]); w.z = pack_bf16(a[ch][4], a[ch][5]); w.w = pack_bf16(a[ch][6], a[ch][7]);
            *(pg8::u32x4*)(dst + (size_t)nl * 1024 + kg * 64 + 16 * ch + kh * 8) = w;
        }
    }
}

template <class AL, class BL, class EP>
__device__ __forceinline__ void gemm_tile_f32(int wave_id, float* lds, int K, AL aload, BL bload, EP epi) {
    const int TIDX = tid_of_wave(wave_id);
    float(*As)[132] = (float(*)[132])lds;
    float(*Bs)[132] = (float(*)[132])(lds + 16 * 132);
    const int tid = TIDX, tx = tid & 15, ty = tid >> 4;
    float acc[4][8];
#pragma unroll
    for (int i = 0; i < 4; i++)
#pragma unroll
        for (int j = 0; j < 8; j++) acc[i][j] = 0.f;
    for (int k0 = 0; k0 < K; k0 += 16) {
        float av[4], bv[4];
#pragma unroll
        for (int i = 0; i < 4; i++) av[i] = aload((tid >> 4) + 32 * i, k0 + (tid & 15));
#pragma unroll
        for (int i = 0; i < 4; i++) bv[i] = bload(k0 + (tid >> 7) + 4 * i, tid & 127);
        __syncthreads();
#pragma unroll
        for (int i = 0; i < 4; i++) As[tid & 15][(tid >> 4) + 32 * i] = av[i];
#pragma unroll
        for (int i = 0; i < 4; i++) Bs[(tid >> 7) + 4 * i][tid & 127] = bv[i];
        __syncthreads();
#pragma unroll
        for (int k = 0; k < 16; k++) {
            const float4 a = *(const float4*)&As[k][ty * 4];
            const float4 b0 = *(const float4*)&Bs[k][tx * 4];
            const float4 b1 = *(const float4*)&Bs[k][64 + tx * 4];
            const float aa[4] = {a.x, a.y, a.z, a.w};
            const float bb[8] = {b0.x, b0.y, b0.z, b0.w, b1.x, b1.y, b1.z, b1.w};
#pragma unroll
            for (int i = 0; i < 4; i++)
#pragma unroll
                for (int j = 0; j < 8; j++) acc[i][j] = fmaf(aa[i], bb[j], acc[i][j]);
        }
    }
    __syncthreads();
#pragma unroll
    for (int i = 0; i < 4; i++) epi(ty * 4 + i, tx, acc[i]);
}
__device__ __forceinline__ int lcol(int tx, int jc) { return tx * 4 + (jc & 3) + 64 * (jc >> 2); }

template <class EP>
__device__ __forceinline__ void gemm_dense(int wave_id, float* lds, const float* A, int lda, const float* B, int N, int M, int K, EP epi) {
    const int tm = M / 128, tn = (N + 127) / 128;
    for (int t = blockIdx.x; t < tm * tn; t += gridDim.x) {
        const int m0 = (t / tn) * 128, n0 = (t % tn) * 128;
        gemm_tile_f32(
            wave_id, lds, K, [&](int r, int k) { return A[(size_t)(m0 + r) * lda + k]; },
            [&](int k, int c) { return (n0 + c < N) ? B[(size_t)k * N + n0 + c] : 0.f; },
            [&](int r, int tx, const float(&a)[8]) {
#pragma unroll
                for (int jc = 0; jc < 8; jc++) {
                    const int c = n0 + lcol(tx, jc);
                    if (c < N) epi(m0 + r, c, a[jc]);
                }
            });
    }
}

template <class PT>
__device__ __forceinline__ void ph_prologue(const PT& p, float* lds) {
    const int TIDX = tid_opaque();
    const int tid = TIDX, lane = tid & 63, wave = tid >> 6;
    const int gthreads = gridDim.x * NT, gtid = blockIdx.x * NT + tid;
    float* mod = wsp<float>(p, OFF_MOD);
    {
        float* sc = lds + 1024;
        float* red = lds + 3072;
        for (int k = tid; k < 1024; k += NT) { sc[k] = silu_f(p.in[I_C][k]); sc[1024 + k] = silu_f(p.in[I_CCTX][k]); }
        __syncthreads();
        for (int it = blockIdx.x; it < 2 * 96; it += gridDim.x) {
            const int layer = it / 96, n = (it % 96) * 64 + lane;
            const float* w = p.in[I_ADAW] + (size_t)layer * 1024 * 6144 + (size_t)wave * 128 * 6144 + n;
            float a0 = 0.f, a1 = 0.f;
#pragma unroll 8
            for (int k = 0; k < 128; k++) {
                const float wv = w[(size_t)k * 6144];
                a0 = fmaf(sc[wave * 128 + k], wv, a0);
                a1 = fmaf(sc[1024 + wave * 128 + k], wv, a1);
            }
            red[(wave * 2 + 0) * 64 + lane] = a0;
            red[(wave * 2 + 1) * 64 + lane] = a1;
            __syncthreads();
            if (wave < 2) {
                float a = p.in[I_ADAB][layer * 6144 + n];
#pragma unroll
                for (int w8 = 0; w8 < 8; w8++) a += red[(w8 * 2 + wave) * 64 + lane];
                mod[(layer * 2 + wave) * 6144 + n] = a;
            }
            __syncthreads();
        }
    }
    for (int it = gtid; it < 4096; it += gthreads) {
        const int pos = it >> 4, i = it & 15;
        const float ang = (float)pos * powf(10000.f, -(float)i / 16.f);
        wsp<float2>(p, OFF_ROPE)[it] = make_float2(cosf(ang), sinf(ang));
    }
    for (int it = gtid; it < 512; it += gthreads) {
        const float b0 = p.in[I_HGLB][it], b1 = p.in[I_HGLB][512 + it];
        wsp<float>(p, OFF_LB)[it] = 1.f / (1.f + expf(b0 - b1));
    }
    float* zb = lds + wave * 64;
    float* hd3 = wsp<float>(p, OFF_HD3);
    const float fq = p.in[I_HYFREQ][lane];
    float w1r[33], w2r[64], w3r[64];
#pragma unroll
    for (int i = 0; i < 33; i++) w1r[i] = p.in[I_HYW1][i * 64 + lane];
#pragma unroll
    for (int i = 0; i < 64; i++) { w2r[i] = p.in[I_HYW2][i * 64 + lane]; w3r[i] = p.in[I_HYW3][i * 64 + lane]; }
    const float b1 = p.in[I_HYB1][lane], b2 = p.in[I_HYB2][lane], b3 = p.in[I_HYB3][lane];
    for (int row = blockIdx.x * NWAVE + wave; row < R; row += gridDim.x * NWAVE) {
        const int Ls = row < L ? L : NCX, t = row < L ? row : row - L;
        const float tn = (float)t / (float)(Ls - 1);
        const float wang = 6.283185307179586f * (float)t / (float)Ls;
        if (lane < 33) {
            float z;
            if (lane == 0) z = tn;
            else {
                const int b = (lane - 1) & 15;
                const float fr = 1e-4f + (float)b * ((15.f - 1e-4f) / 15.f);
                z = (lane <= 16) ? cosf(fr * wang) : -sinf(fr * wang);
            }
            zb[lane] = z;
        }
        __builtin_amdgcn_wave_barrier();
        float a = b1;
#pragma unroll
        for (int i = 0; i < 33; i++) a = fmaf(zb[i], w1r[i], a);
        float h = sinf(fq * a);
        __builtin_amdgcn_wave_barrier();
        zb[lane] = h;
        __builtin_amdgcn_wave_barrier();
        a = b2;
#pragma unroll
        for (int i = 0; i < 64; i++) a = fmaf(zb[i], w2r[i], a);
        h = sinf(fq * a);
        __builtin_amdgcn_wave_barrier();
        zb[lane] = h;
        __builtin_amdgcn_wave_barrier();
        a = b3;
#pragma unroll
        for (int i = 0; i < 64; i++) a = fmaf(zb[i], w3r[i], a);
        h = sinf(fq * a);
        hd3[(size_t)row * 64 + lane] = h;
        __builtin_amdgcn_wave_barrier();
    }
}

template <bool ROUTER>
__device__ __forceinline__ void prep_rows(const Params& p, float* lds, const float* xl, const float* xc, int nrows, const float* g, int layer, int j) {
    const int TIDX = tid_of_wave(p.wave_id);
    const int lane = TIDX & 63, wave = TIDX >> 6;
    float* rwT = lds;
    int* lcnt = (int*)(lds + 32 * 1024);
    if (ROUTER) {
        __syncthreads();
        if (TIDX < 32) lcnt[TIDX] = 0;
        const float* rw = p.in[I_RW] + (size_t)layer * 1024 * 32;
#pragma unroll 4
        for (int idx = TIDX; idx < 1024 * 8; idx += NT) {
            const int c = idx >> 3, e4 = (idx & 7) * 4;
            const float4 w = *(const float4*)(rw + (size_t)c * 32 + e4);
            rwT[(e4 + 0) * 1024 + c] = w.x; rwT[(e4 + 1) * 1024 + c] = w.y; rwT[(e4 + 2) * 1024 + c] = w.z; rwT[(e4 + 3) * 1024 + c] = w.w;
        }
        __syncthreads();
    }
    bf16_t* HB = wsp<bf16_t>(p, OFF_HB);
    for (int r = blockIdx.x * NWAVE + wave; r < nrows; r += gridDim.x * NWAVE) {
        const float* src = r < L ? xl + (size_t)r * D : xc + (size_t)(r - L) * D;
        const float* md = modp(p, layer, r < L ? 0 : 1, j);
        float4 v[4];
        float ss = 0.f;
#pragma unroll
        for (int i = 0; i < 4; i++) { v[i] = *(const float4*)(src + 256 * i + 4 * lane); ss += v[i].x * v[i].x + v[i].y * v[i].y + v[i].z * v[i].z + v[i].w * v[i].w; }
        ss = wave_sum(lane, ss);
        const float rinv = rsqrtf(ss * (1.f / 1024.f) + EPS);
#pragma unroll
        for (int i = 0; i < 4; i++) {
            const int c = 256 * i + 4 * lane;
            const float4 g4 = *(const float4*)(g + c), sc4 = *(const float4*)(md + 1024 + c), sh4 = *(const float4*)(md + c);
            v[i].x = v[i].x * rinv * g4.x * (1.f + sc4.x) + sh4.x; v[i].y = v[i].y * rinv * g4.y * (1.f + sc4.y) + sh4.y;
            v[i].z = v[i].z * rinv * g4.z * (1.f + sc4.z) + sh4.z; v[i].w = v[i].w * rinv * g4.w * (1.f + sc4.w) + sh4.w;
            u32x2_t o; o.x = pack_bf16(v[i].x, v[i].y); o.y = pack_bf16(v[i].z, v[i].w);
            *(u32x2_t*)(HB + (size_t)r * D + c) = o;
        }
        if (ROUTER) {
            float lg[32];
#pragma unroll
            for (int e = 0; e < 32; e++) {
                float a = 0.f;
#pragma unroll
                for (int i = 0; i < 4; i++) {
                    const float4 w = *(const float4*)(rwT + e * 1024 + 256 * i + 4 * lane);
                    a = fmaf(v[i].x, w.x, a); a = fmaf(v[i].y, w.y, a); a = fmaf(v[i].z, w.z, a); a = fmaf(v[i].w, w.w, a);
                }
                lg[e] = a;
                if ((e & 3) == 3) asm volatile("" ::: "memory");
            }
#pragma unroll
            for (int e = 0; e < 32; e++) lg[e] = wave_sum(lane, lg[e]) + p.in[I_RB][layer * 32 + e];
            unsigned used = 0u;
            float tv[4];
            int ti[4];
#pragma unroll
            for (int k = 0; k < 4; k++) {
                float best = -INFINITY;
                int bi = 0;
#pragma unroll
                for (int e = 0; e < 32; e++) {
                    const bool ok = !((used >> e) & 1u) && (lg[e] > best);
                    best = ok ? lg[e] : best;
                    bi = ok ? e : bi;
                }
                used |= 1u << bi;
                tv[k] = best;
                ti[k] = bi;
            }
            float es[4], den = 0.f;
#pragma unroll
            for (int k = 0; k < 4; k++) { es[k] = expf(tv[k] - tv[0]); den += es[k]; }
            if (lane < 4) {
                int e = ti[0];
                float gg = es[0];
#pragma unroll
                for (int k = 1; k < 4; k++) { e = (lane == k) ? ti[k] : e; gg = (lane == k) ? es[k] : gg; }
                const int pos = atomicAdd(&lcnt[e], 1);
                wsp<int>(p, OFF_TOPE)[r * 4 + lane] = e;
                wsp<float>(p, OFF_TOPG)[r * 4 + lane] = gg / den;
                wsp<int>(p, OFF_TOPP)[r * 4 + lane] = pos;
            }
        }
    }
    if (ROUTER) {
        __syncthreads();
        if (TIDX < 32) wsp<int>(p, OFF_BC)[((size_t)layer * 512 + blockIdx.x) * 32 + TIDX] = lcnt[TIDX];
    }
}

__device__ __forceinline__ void prep_router(const Params& p, unsigned char* smem, const float* xl, const float* xc, int nrows, const float* g, int layer, int j) {
    const int TIDX = tid_of_wave(p.wave_id);
    const int tid = TIDX, lane = tid & 63, wave = tid >> 6, hf = lane >> 5;
    float* HTl = (float*)smem;
    int* lcnt = (int*)(smem + 32 * 1028 * 4);
    float* LGT = (float*)(smem + 32 * 1028 * 4 + 128);
    const float* rw = p.in[I_RW] + (size_t)layer * 1024 * 32;
    const float* rb = p.in[I_RB] + layer * 32;
    bf16_t* HB = wsp<bf16_t>(p, OFF_HB);
    if (tid < 32) lcnt[tid] = 0;
    for (int grp = blockIdx.x; grp < nrows / 32; grp += gridDim.x) {
        __syncthreads();
        float4 xv[4][4];
#pragma unroll
        for (int q = 0; q < 4; q++) {
            const int r = grp * 32 + wave * 4 + q;
            const float* src = r < L ? xl + (size_t)r * D : xc + (size_t)(r - L) * D;
#pragma unroll
            for (int i = 0; i < 4; i++) xv[q][i] = *(const float4*)(src + 256 * i + 4 * lane);
        }
#pragma unroll
        for (int q = 0; q < 4; q++) {
            const int rl = wave * 4 + q, r = grp * 32 + rl;
            const float* md = modp(p, layer, r < L ? 0 : 1, j);
            float4 v[4];
            float ss = 0.f;
#pragma unroll
            for (int i = 0; i < 4; i++) { v[i] = xv[q][i]; ss += v[i].x * v[i].x + v[i].y * v[i].y + v[i].z * v[i].z + v[i].w * v[i].w; }
            ss = wave_sum(lane, ss);
            const float rinv = rsqrtf(ss * (1.f / 1024.f) + EPS);
#pragma unroll
            for (int i = 0; i < 4; i++) {
                const int c = 256 * i + 4 * lane;
                const float4 g4 = *(const float4*)(g + c), sc4 = *(const float4*)(md + 1024 + c), sh4 = *(const float4*)(md + c);
                v[i].x = v[i].x * rinv * g4.x * (1.f + sc4.x) + sh4.x; v[i].y = v[i].y * rinv * g4.y * (1.f + sc4.y) + sh4.y;
                v[i].z = v[i].z * rinv * g4.z * (1.f + sc4.z) + sh4.z; v[i].w = v[i].w * rinv * g4.w * (1.f + sc4.w) + sh4.w;
                u32x2_t o; o.x = pack_bf16(v[i].x, v[i].y); o.y = pack_bf16(v[i].z, v[i].w);
                *(u32x2_t*)(HB + (size_t)r * D + c) = o;
                *(float4*)(HTl + rl * 1028 + c) = v[i];
            }
        }
        __syncthreads();
        f32x16f acc;
#pragma unroll
        for (int q = 0; q < 16; q++) acc[q] = 0.f;
        {
            const float* ap = HTl + (lane & 31) * 1028 + wave * 128 + hf;
            const float* bp = rw + (size_t)(wave * 128 + hf) * 32 + (lane & 31);
#pragma unroll 16
            for (int kk = 0; kk < 64; kk++) acc = __builtin_amdgcn_mfma_f32_32x32x2f32(ap[2 * kk], bp[(size_t)kk * 64], acc, 0, 0, 0);
        }
        __syncthreads();
        {
            float* part = HTl + wave * 1024 + (lane & 31);
#pragma unroll
            for (int q = 0; q < 16; q++) part[CROW(q, hf) * 32] = acc[q];
        }
        __syncthreads();
#pragma unroll
        for (int q = 0; q < 2; q++) {
            const int o = tid + 512 * q;
            float a = rb[o & 31];
#pragma unroll
            for (int w8 = 0; w8 < 8; w8++) a += HTl[w8 * 1024 + o];
            LGT[(o >> 5) * 33 + (o & 31)] = a;
        }
        __syncthreads();
        if (tid < 32) {
            const int r = grp * 32 + tid;
            float lg[32];
#pragma unroll
            for (int e = 0; e < 32; e++) lg[e] = LGT[tid * 33 + e];
            unsigned used = 0u;
            float tv[4];
            int ti[4];
#pragma unroll
            for (int k = 0; k < 4; k++) {
                float best = -INFINITY;
                int bi = 0;
#pragma unroll
                for (int e = 0; e < 32; e++) {
                    const bool ok = !((used >> e) & 1u) && (lg[e] > best);
                    best = ok ? lg[e] : best;
                    bi = ok ? e : bi;
                }
                used |= 1u << bi;
                tv[k] = best;
                ti[k] = bi;
            }
            float es[4], den = 0.f;
#pragma unroll
            for (int k = 0; k < 4; k++) { es[k] = expf(tv[k] - tv[0]); den += es[k]; }
            const float rden = 1.f / den;
            int pos[4];
#pragma unroll
            for (int k = 0; k < 4; k++) pos[k] = atomicAdd(&lcnt[ti[k]], 1);
            *(int4*)(wsp<int>(p, OFF_TOPE) + r * 4) = make_int4(ti[0], ti[1], ti[2], ti[3]);
            *(float4*)(wsp<float>(p, OFF_TOPG) + r * 4) = make_float4(es[0] * rden, es[1] * rden, es[2] * rden, es[3] * rden);
            *(int4*)(wsp<int>(p, OFF_TOPP) + r * 4) = make_int4(pos[0], pos[1], pos[2], pos[3]);
        }
    }
    __syncthreads();
    if (tid < 32) wsp<int>(p, OFF_BC)[((size_t)layer * 512 + blockIdx.x) * 32 + tid] = lcnt[tid];
}

__device__ __forceinline__ void ph_filter_gemm_ctx(const Params& p, float* lds) {
    const float* hd3 = wsp<float>(p, OFF_HD3) + (size_t)L * 64;
    float* hhc = wsp<float>(p, OFF_HHC);
    const float mind = logf(1e-2f) / 1.5f, maxd = logf(1e-2f) / 0.3f;
    gemm_dense(p.wave_id, lds, hd3, 64, p.in[I_HYW4], 2048, NCX, 64, [&](int t, int col, float v) {
        const int o = col >> 10, side = (col >> 9) & 1, ch = col & 511;
        const float delta = fabsf(mind + (float)ch * ((maxd - mind) / 511.f));
        const float tn = (float)t / (float)(NCX - 1);
        const float val = v * expf(-tn * delta);
        if (side == 0) hhc[(size_t)(NCX + t) * 1024 + o * 512 + ch] = val;
        else if (t > 0) hhc[(size_t)(NCX - t) * 1024 + o * 512 + ch] = val;
        else hhc[o * 512 + ch] = 0.f;
    });
}
__device__ __forceinline__ void ph_filter_abs_ctx(const Params& p) {
    const int TIDX = tid_of_wave(p.wave_id);
    const float* hhc = wsp<float>(p, OFF_HHC);
    float* hnp = wsp<float>(p, OFF_HNP);
    for (int it = blockIdx.x; it < 4; it += gridDim.x) {
        const int chunk = it >> 1, col = (it & 1) * 512 + TIDX;
        const float* src = hhc + (size_t)chunk * 256 * 1024;
        float s = 0.f;
        for (int i = 0; i < 256; i++) s += fabsf(src[(size_t)i * 1024 + col]);
        hnp[(128 + chunk) * 1024 + col] = s;
    }
}
__device__ __forceinline__ void ph_filter_gemm_lat(const Params& p, unsigned char* smem) {
    const int TIDX = tid_of_wave(p.wave_id);
    float* As = (float*)smem;
    float* Bs = As + 64 * 132;
    const float* hd3 = wsp<float>(p, OFF_HD3);
    const float* w4 = p.in[I_HYW4];
    float* HT = wsp<float>(p, OFF_HT);
    const float mind = logf(1e-2f) / 1.5f, maxd = logf(1e-2f) / 0.3f;
    const int tid = TIDX, lane = tid & 63, wave = tid >> 6, hf = lane >> 5;
    for (int it = blockIdx.x; it < 16 * 128; it += gridDim.x) {
        const int c0 = (it & 15) * 128, t0 = (it >> 4) * 128;
        float av[16], bv[16];
#pragma unroll
        for (int q = 0; q < 16; q++) { const int idx = tid + 512 * q; av[q] = w4[(size_t)(idx >> 7) * 2048 + c0 + (idx & 127)]; bv[q] = hd3[(size_t)(t0 + (idx >> 6)) * 64 + (idx & 63)]; }
        __syncthreads();
#pragma unroll
        for (int q = 0; q < 16; q++) { const int idx = tid + 512 * q; As[(idx >> 7) * 132 + (idx & 127)] = av[q]; Bs[(idx & 63) * 132 + (idx >> 6)] = bv[q]; }
        __syncthreads();
        const int mt = wave >> 1, nt0 = (wave & 1) * 2;
        f32x16f acc0, acc1;
#pragma unroll
        for (int q = 0; q < 16; q++) { acc0[q] = 0.f; acc1[q] = 0.f; }
        const float* ap = As + hf * 132 + mt * 32 + (lane & 31);
        const float* bp = Bs + hf * 132 + nt0 * 32 + (lane & 31);
#pragma unroll 4
        for (int k0 = 0; k0 < 64; k0 += 2) {
            const float a = ap[k0 * 132], b0 = bp[k0 * 132], b1 = bp[k0 * 132 + 32];
            acc0 = __builtin_amdgcn_mfma_f32_32x32x2f32(a, b0, acc0, 0, 0, 0);
            acc1 = __builtin_amdgcn_mfma_f32_32x32x2f32(a, b1, acc1, 0, 0, 0);
        }
#pragma unroll
        for (int t2 = 0; t2 < 2; t2++) {
            const int t = t0 + (nt0 + t2) * 32 + (lane & 31);
            const float tn = (float)t / (float)(L - 1);
            int cb = c0 + mt * 32 + 4 * hf;
            asm volatile("" : "+v"(cb));
#pragma unroll
            for (int q = 0; q < 16; q++) {
                const int col = cb + (q & 3) + 8 * (q >> 2), ch = col & 511;
                const float delta = fabsf(mind + (float)ch * ((maxd - mind) / 511.f));
                HT[(size_t)col * L + t] = (t2 == 0 ? acc0[q] : acc1[q]) * __expf(-tn * delta);
            }
        }
    }
}

__device__ __forceinline__ float2 cmul(float2 a, float2 b) { return make_float2(a.x * b.x - a.y * b.y, a.x * b.y + a.y * b.x); }
__device__ __forceinline__ float2 cadd(float2 a, float2 b) { return make_float2(a.x + b.x, a.y + b.y); }
__device__ __forceinline__ float2 csub(float2 a, float2 b) { return make_float2(a.x - b.x, a.y - b.y); }
__device__ __forceinline__ float2 cconj(float2 a) { return make_float2(a.x, -a.y); }
__device__ __forceinline__ float2 twid(float frac) { return make_float2(__builtin_amdgcn_cosf(frac), -__builtin_amdgcn_sinf(frac)); }
constexpr int FM = 16384;
__device__ __forceinline__ int fphys(int j) { return j + (j >> 4); }
constexpr int FX_BYTES = (FM + FM / 16) * 8;
__device__ __forceinline__ void dft4(float2& x0, float2& x1, float2& x2, float2& x3) {
    const float2 y0 = cadd(x0, x2), y1 = csub(x0, x2), y2 = cadd(x1, x3), t = csub(x1, x3), y3 = make_float2(t.y, -t.x);
    x0 = cadd(y0, y2); x1 = cadd(y1, y3); x2 = csub(y0, y2); x3 = csub(y1, y3);
}
template <int LP>
__device__ __forceinline__ void fft_pass8(float2* X, int tid) {
    constexpr int pp = 1 << LP;
    float2 u[4][8];
    float2* xb0 = X + fphys(tid);
    float2* xb1 = xb0 + 6144;
    float2* xb2 = xb0 + 12288;
    asm volatile("" : "+v"(xb1), "+v"(xb2));
#define XR(off) ((off) < 6144 ? xb0[(off)] : ((off) < 12288 ? xb1[(off) - 6144] : xb2[(off) - 12288]))
#pragma unroll
    for (int b = 0; b < 4; b++)
#pragma unroll
        for (int r = 0; r < 8; r++) u[b][r] = XR(544 * b + 2176 * r);
    __syncthreads();
#pragma unroll
    for (int b = 0; b < 4; b++) {
        const int i = tid + 512 * b, k = i & (pp - 1), j = ((i - k) << 3) + k;
        const float2 w1 = twid(ldexpf((float)k, -(LP + 3)));
        const float2 w2 = cmul(w1, w1), w3 = cmul(w2, w1), w4 = cmul(w2, w2), w5 = cmul(w4, w1), w6 = cmul(w4, w2), w7 = cmul(w4, w3);
        const float2 u0 = u[b][0], u1 = cmul(u[b][1], w1), u2 = cmul(u[b][2], w2), u3 = cmul(u[b][3], w3);
        const float2 u4 = cmul(u[b][4], w4), u5 = cmul(u[b][5], w5), u6 = cmul(u[b][6], w6), u7 = cmul(u[b][7], w7);
        float2 a0 = cadd(u0, u4), a1 = cadd(u1, u5), a2 = cadd(u2, u6), a3 = cadd(u3, u7);
        float2 b0 = csub(u0, u4), t1 = csub(u1, u5), t2 = csub(u2, u6), t3 = csub(u3, u7);
        const float sq = 0.70710678118654752f;
        float2 b1 = make_float2(sq * (t1.x + t1.y), sq * (t1.y - t1.x));
        float2 b2 = make_float2(t2.y, -t2.x);
        float2 b3 = make_float2(sq * (t3.y - t3.x), -sq * (t3.x + t3.y));
        dft4(a0, a1, a2, a3);
        dft4(b0, b1, b2, b3);
        float2* yb = X + fphys(j);
#define FWO(r) ((r) * pp + (pp == 1 ? 0 : (pp == 8 ? ((r) >> 1) : (r) * pp / 16)))
        yb[FWO(0)] = a0; yb[FWO(1)] = b0; yb[FWO(2)] = a1; yb[FWO(3)] = b1; yb[FWO(4)] = a2; yb[FWO(5)] = b2; yb[FWO(6)] = a3; yb[FWO(7)] = b3;
#undef FWO
        __builtin_amdgcn_sched_barrier(0);
    }
    __syncthreads();
}
__device__ __forceinline__ void fft16k(float2* X, int tid) {
    asm volatile("" : "+v"(tid));
    fft_pass8<0>(X, tid); fft_pass8<3>(X, tid); fft_pass8<6>(X, tid); fft_pass8<9>(X, tid);
    float2* xb0 = X + fphys(tid);
    float2* xb1 = xb0 + 6144;
    float2* xb2 = xb0 + 12288;
    asm volatile("" : "+v"(xb1), "+v"(xb2));
#pragma unroll
    for (int b = 0; b < 8; b++) {
        const int i = tid + 512 * b;
        const float2 w1 = twid(ldexpf((float)i, -14));
        const float2 w2 = cmul(w1, w1), w3 = cmul(w2, w1);
        float2 x0 = XR(544 * b), x1 = cmul(XR(544 * b + 4352), w1), x2 = cmul(XR(544 * b + 8704), w2), x3 = cmul(XR(544 * b + 13056), w3);
        dft4(x0, x1, x2, x3);
        XR(544 * b) = x0; XR(544 * b + 4352) = x1; XR(544 * b + 8704) = x2; XR(544 * b + 13056) = x3;
        __builtin_amdgcn_sched_barrier(0);
    }
    __syncthreads();
#undef XR
}
__device__ __forceinline__ void ph_filter_fft(const Params& p, unsigned char* smem) {
    const int TIDX = tid_of_wave(p.wave_id);
    float2* X = (float2*)smem;
    float* red = (float*)(smem + FX_BYTES);
    const float* HT = wsp<float>(p, OFF_HT);
    float2* HF = wsp<float2>(p, OFF_HF);
    const int tid = TIDX, lane = tid & 63, wave = tid >> 6;
    constexpr int N2 = 2 * L;
    for (int it = blockIdx.x; it < 1024; it += gridDim.x) {
        const int o = it >> 9, ch = it & 511;
        const float* s0 = HT + ((size_t)(o * 2 + 0) * 512 + ch) * L;
        const float* s1 = HT + ((size_t)(o * 2 + 1) * 512 + ch) * L;
        __syncthreads();
        float sa = 0.f;
#pragma unroll 8
        for (int j = 0; j < 16; j++) {
            const int m = tid + 512 * j;
            const float2 v = *(const float2*)(s0 + 2 * m);
            sa += fabsf(v.x) + fabsf(v.y);
            X[fphys(m)] = v;
        }
#pragma unroll 8
        for (int j = 16; j < 32; j++) {
            const int m = tid + 512 * j;
            float2 v = make_float2(s1[N2 - 2 * m], s1[N2 - 2 * m - 1]);
            if (m == L / 2) v.x = 0.f;
            sa += fabsf(v.x) + fabsf(v.y);
            X[fphys(m)] = v;
        }
        sa = wave_sum(lane, sa);
        if (lane == 0) red[wave] = sa;
        __syncthreads();
        float nrm = 0.f;
#pragma unroll
        for (int w = 0; w < 8; w++) nrm += red[w];
        const float scale = 1.f / (nrm * (float)FM);
        fft16k(X, tid);
        float2* dst = HF + (size_t)it * FM;
#pragma unroll 1
        for (int k = tid; k <= FM / 2; k += 512) {
            if (k == 0) { const float2 b0 = X[0]; dst[0] = make_float2((b0.x + b0.y) * scale, (b0.x - b0.y) * scale); }
            else if (k == FM / 2) { const float2 b = X[fphys(k)]; dst[k] = make_float2(b.x * scale, -b.y * scale); }
            else {
                const float2 ak = X[fphys(k)], am = cconj(X[fphys(FM - k)]);
                const float2 e = make_float2(0.5f * (ak.x + am.x), 0.5f * (ak.y + am.y));
                const float2 od = make_float2(0.5f * (ak.x - am.x), 0.5f * (ak.y - am.y));
                const float2 oo = make_float2(od.y, -od.x);
                const float2 wo = cmul(twid(ldexpf((float)k, -15)), oo);
                const float2 hk = cadd(e, wo), hm = cconj(csub(e, wo));
                dst[k] = make_float2(hk.x * scale, hk.y * scale);
                dst[FM - k] = make_float2(hm.x * scale, hm.y * scale);
            }
        }
    }
}
__device__ __forceinline__ void hy_pw_pair(float2* X, const float2* __restrict__ HFc, int k) {
    const float2 hk = HFc[k], hm = HFc[FM - k];
    const float2 ak = X[fphys(k)], am = cconj(X[fphys(FM - k)]);
    const float2 e = make_float2(0.5f * (ak.x + am.x), 0.5f * (ak.y + am.y));
    const float2 od = make_float2(0.5f * (ak.x - am.x), 0.5f * (ak.y - am.y));
    const float2 oo = make_float2(od.y, -od.x);
    const float2 w = twid(ldexpf((float)k, -15));
    const float2 wo = cmul(w, oo);
    const float2 yk = cmul(cadd(e, wo), hk), ym = cmul(cconj(csub(e, wo)), hm);
    const float2 ymc = cconj(ym);
    const float2 P = make_float2(0.5f * (yk.x + ymc.x), 0.5f * (yk.y + ymc.y));
    const float2 Q = make_float2(0.5f * (yk.x - ymc.x), 0.5f * (yk.y - ymc.y));
    const float2 qw = cmul(Q, cconj(w));
    const float2 ck = make_float2(P.x - qw.y, P.y + qw.x);
    const float2 qcw = cmul(cconj(Q), w);
    const float2 cm = make_float2(P.x - qcw.y, -P.y + qcw.x);
    X[fphys(k)] = cconj(ck); X[fphys(FM - k)] = cconj(cm);
}
__device__ __forceinline__ void hy_pointwise(float2* X, const float2* __restrict__ HFc, int tid) {
    asm volatile("" : "+v"(tid));
#pragma unroll 5
    for (int j = 1; j < 16; j++) hy_pw_pair(X, HFc, tid + 512 * j);
    if (tid != 0) hy_pw_pair(X, HFc, tid);
    else {
        const float2 a0 = X[0], h = HFc[0];
        const float y0 = (a0.x + a0.y) * h.x, ym = (a0.x - a0.y) * h.y;
        X[0] = make_float2(0.5f * (y0 + ym), -0.5f * (y0 - ym));
        X[fphys(FM / 2)] = cmul(cconj(X[fphys(FM / 2)]), HFc[FM / 2]);
    }
}
__device__ __forceinline__ void ph_hyena_fft(const Params& p, unsigned char* smem) {
    const int TIDX = tid_of_wave(p.wave_id);
    float2* X = (float2*)smem;
    const float* UT = wsp<float>(p, OFF_U);
    const float2* HF = wsp<float2>(p, OFF_HF);
    unsigned* HYT = wsp<unsigned>(p, OFF_HYT);
    const int tid = TIDX;
    for (int ch = blockIdx.x; ch < 512; ch += gridDim.x) {
        float2 z[16];
#pragma unroll
        for (int j = 0; j < 16; j++) z[j] = ((const float2*)(UT + (size_t)ch * L))[tid + 512 * j];
#pragma unroll 1
        for (int o = 0; o < 2; o++) {
            __syncthreads();
#pragma unroll
            for (int j = 0; j < 16; j++) { X[fphys(tid + 512 * j)] = z[j]; X[fphys(8192 + tid + 512 * j)] = make_float2(0.f, 0.f); }
            __syncthreads();
            fft16k(X, tid);
            hy_pointwise(X, HF + (size_t)(o * 512 + ch) * FM, tid);
            __syncthreads();
            fft16k(X, tid);
            const float bias = p.in[I_HYFB][o * 512 + ch];
            const float2* gate = (const float2*)(UT + (size_t)(512 * (o + 1) + ch) * L);
#pragma unroll
            for (int j = 0; j < 16; j++) {
                const int m = tid + 512 * j;
                const float2 r = X[fphys(m)], g = gate[m];
                z[j] = make_float2(g.x * (r.x + z[j].x * bias), g.y * (-r.y + z[j].y * bias));
            }
        }
#pragma unroll
        for (int j = 0; j < 16; j++) HYT[(size_t)ch * (L / 2) + tid + 512 * j] = pack_bf16(z[j].x, z[j].y);
    }
}
__device__ __forceinline__ void ph_hy_transpose(const Params& p, unsigned char* smem) {
    const int TIDX = tid_of_wave(p.wave_id);
    bf16_t* T = (bf16_t*)smem;
    const bf16_t* HYT = wsp<bf16_t>(p, OFF_HYT);
    bf16_t* MB = wsp<bf16_t>(p, OFF_MB);
    const int tid = TIDX;
    for (int it = blockIdx.x; it < 8 * 256; it += gridDim.x) {
        const int c0 = (it & 7) * 64, t0 = (it >> 3) * 64;
        __syncthreads();
#pragma unroll
        for (int q = 0; q < 8; q++) { const int c = (tid >> 6) + 8 * q, t = tid & 63; T[c * 66 + t] = HYT[(size_t)(c0 + c) * L + t0 + t]; }
        __syncthreads();
#pragma unroll
        for (int q = 0; q < 8; q++) { const int t = (tid >> 6) + 8 * q, c = tid & 63; MB[(size_t)(t0 + t) * D + c0 + c] = T[c * 66 + t]; }
    }
}

__device__ __forceinline__ void ph_qk_dwconv(const Params& p) {
    const int TIDX = tid_of_wave(p.wave_id);
    const int lane = TIDX & 63, wave = TIDX >> 6;
    const bf16_t* P0 = wsp<bf16_t>(p, OFF_P);
    bf16_t* qn = wsp<bf16_t>(p, OFF_QN);
    bf16_t* kn = wsp<bf16_t>(p, OFF_KN);
    const float2* rope = wsp<float2>(p, OFF_ROPE);
    const float gk = p.in[I_KNORM][lane], gq = p.in[I_QNORM][lane];
    for (int r = blockIdx.x * NWAVE + wave; r < R; r += gridDim.x * NWAVE) {
        const bf16_t* pr = P0 + (size_t)r * EVEN_IN;
        float v[10];
#pragma unroll
        for (int s2 = 0; s2 < 10; s2++) v[s2] = bf2f(pr[(s2 < 2 ? s2 * 64 : 256 + (s2 - 2) * 64) + lane]);
        float2 cs = make_float2(1.f, 0.f);
        if (r < L) cs = rope[(lane < 32 ? (r >> 6) : (r & 63)) * 16 + (lane & 15)];
#pragma unroll
        for (int s2 = 0; s2 < 10; s2++) {
            const float ss = wave_sum(lane, v[s2] * v[s2]);
            float n = v[s2] * rsqrtf(ss * (1.f / 64.f) + EPS) * (s2 < 2 ? gk : gq);
            if (r < L) {
                const float partner = lane_xor(lane, n, 16);
                n = ((lane & 16) == 0) ? n * cs.x - partner * cs.y : partner * cs.y + n * cs.x;
            }
            if (s2 < 2) kn[(size_t)r * 128 + s2 * 64 + lane] = f2bf(n);
            else qn[(size_t)r * 512 + (s2 - 2) * 64 + lane] = f2bf(n * 0.125f);
        }
    }
    float* UC = wsp<float>(p, OFF_UC);
    const float* cw = p.in[I_HYCW];
    const float* cb = p.in[I_HYCB];
    for (int it = blockIdx.x * NT + TIDX; it < NCX * 1536; it += gridDim.x * NT) {
        const int r = L + it / 1536, c = it % 1536;
        float a = cb[c];
#pragma unroll
        for (int j = 0; j < 3; j++) {
            const int rr = r + j - 1;
            if (rr >= L && rr < R) a = fmaf(cw[j * 1536 + c], bf2f(P0[(size_t)rr * EVEN_IN + 768 + c]), a);
        }
        UC[it] = a;
    }
}
__device__ __forceinline__ void ph_dwconv_t(const Params& p, float* lds) {
    const int TIDX = tid_of_wave(p.wave_id);
    const bf16_t* P0 = wsp<bf16_t>(p, OFF_P);
    float* UT = wsp<float>(p, OFF_U);
    const float* cw = p.in[I_HYCW];
    const float* cb = p.in[I_HYCB];
    bf16_t* T = (bf16_t*)lds;
    const int tid = TIDX;
    pg8::u32x4 xr[3];
    auto fetch = [&](int it2) {
        const int c02 = (it2 % 24) * 64, t02 = (it2 / 24) * 128;
#pragma unroll
        for (int q = 0; q < 3; q++) {
            const int v = tid + NT * q, row = v >> 3, c8 = (v & 7) * 8, t = t02 - 1 + row;
            xr[q] = pg8::u32x4{0u, 0u, 0u, 0u};
            if (v < 130 * 8 && t >= 0 && t < L) xr[q] = *(const pg8::u32x4*)(P0 + (size_t)t * EVEN_IN + 768 + c02 + c8);
        }
    };
    if ((int)blockIdx.x < 24 * 128) fetch(blockIdx.x);
    for (int it = blockIdx.x; it < 24 * 128; it += gridDim.x) {
        const int c0 = (it % 24) * 64, t0 = (it / 24) * 128;
        __syncthreads();
#pragma unroll
        for (int q = 0; q < 3; q++) { const int v = tid + NT * q; if (v < 130 * 8) *(pg8::u32x4*)(T + (v >> 3) * 72 + (v & 7) * 8) = xr[q]; }
        __syncthreads();
        if (it + (int)gridDim.x < 24 * 128) fetch(it + gridDim.x);
#pragma unroll
        for (int ps = 0; ps < 4; ps++) {
            const int t4 = tid & 31, c = (tid >> 5) + 16 * ps;
            const float w0 = cw[c0 + c], w1 = cw[1536 + c0 + c], w2 = cw[3072 + c0 + c], bb = cb[c0 + c];
            const bf16_t* tp = T + (t4 * 4) * 72 + c;
            float x[6];
#pragma unroll
            for (int q = 0; q < 6; q++) x[q] = bf2f(tp[q * 72]);
            float4 o;
            o.x = fmaf(w0, x[0], fmaf(w1, x[1], fmaf(w2, x[2], bb)));
            o.y = fmaf(w0, x[1], fmaf(w1, x[2], fmaf(w2, x[3], bb)));
            o.z = fmaf(w0, x[2], fmaf(w1, x[3], fmaf(w2, x[4], bb)));
            o.w = fmaf(w0, x[3], fmaf(w1, x[4], fmaf(w2, x[5], bb)));
            *(float4*)(UT + (size_t)(c0 + c) * L + t0 + t4 * 4) = o;
        }
    }
}

__device__ __forceinline__ void ph_attention_mfma(const Params& p, unsigned char* smem) {
    const int TIDX = tid_of_wave(p.wave_id);
    bf16_t* Ks = (bf16_t*)smem;
    bf16_t* Vts = Ks + 64 * 72;
    const bf16_t* QN = wsp<bf16_t>(p, OFF_QN);
    const bf16_t* KN = wsp<bf16_t>(p, OFF_KN);
    const bf16_t* VB = wsp<bf16_t>(p, OFF_P) + 128;
    bf16_t* MB = wsp<bf16_t>(p, OFF_MB);
    const int tid = TIDX, lane = tid & 63, wave = tid >> 6, hf = lane >> 5, r = lane & 31;
    for (int it = blockIdx.x; it < 260; it += gridDim.x) {
        const bool isctx = it >= 256;
        const int qb = isctx ? (it - 256) >> 1 : it >> 1, kvh = it & 1;
        const int qrow0 = (isctx ? L : 0) + qb * 128;
        const int hq = kvh * 4 + (wave >> 1), qoff = (wave & 1) * 64;
        bf16x8_t qf[2][4];
#pragma unroll
        for (int b = 0; b < 2; b++)
#pragma unroll
            for (int ks = 0; ks < 4; ks++) qf[b][ks] = *(const bf16x8_t*)(QN + (size_t)(qrow0 + qoff + b * 32 + r) * 512 + hq * 64 + ks * 16 + 8 * hf);
        float mrun[2], lrun[2];
        mrun[0] = mrun[1] = p.in[I_SINK][hq];
        lrun[0] = lrun[1] = 1.f;
        f32x16 o[2][2];
#pragma unroll
        for (int dt = 0; dt < 2; dt++)
#pragma unroll
            for (int b = 0; b < 2; b++)
#pragma unroll
                for (int q = 0; q < 16; q++) o[dt][b][q] = 0.f;
        const int tlo = (!isctx && qb == 0) ? 6 : 4, thi = isctx ? 4 : ((qb == L / 128 - 1) ? 8 : 10);
        const int ntiles = 4 + (thi - tlo);
        const int kkey = tid >> 3, kd8 = (tid & 7) * 8, vkey = tid & 63, vd8 = (tid >> 6) * 8;
        pg8::u32x4 kreg, vreg;
        {
            const int krow0 = L;
            kreg = *(const pg8::u32x4*)(KN + (size_t)(krow0 + kkey) * 128 + kvh * 64 + kd8);
            vreg = *(const pg8::u32x4*)(VB + (size_t)(krow0 + vkey) * EVEN_IN + kvh * 64 + vd8);
        }
#pragma unroll 1
        for (int n = 0; n < ntiles; n++) {
            const int tix = n < 4 ? n : tlo + (n - 4);
            const bool local = tix >= 4;
            const int krow0 = local ? qb * 128 - 128 + (tix - 4) * 64 : L + tix * 64;
            __syncthreads();
            *(pg8::u32x4*)(Ks + kkey * 72 + kd8) = kreg;
            {
                bf16_t* dst = Vts + vd8 * 72 + vkey;
                dst[0] = (bf16_t)(vreg.x & 0xffff); dst[72] = (bf16_t)(vreg.x >> 16);
                dst[144] = (bf16_t)(vreg.y & 0xffff); dst[216] = (bf16_t)(vreg.y >> 16);
                dst[288] = (bf16_t)(vreg.z & 0xffff); dst[360] = (bf16_t)(vreg.z >> 16);
                dst[432] = (bf16_t)(vreg.w & 0xffff); dst[504] = (bf16_t)(vreg.w >> 16);
            }
            if (n + 1 < ntiles) {
                const int t2 = (n + 1) < 4 ? (n + 1) : tlo + (n + 1 - 4);
                const int kr2 = t2 >= 4 ? qb * 128 - 128 + (t2 - 4) * 64 : L + t2 * 64;
                kreg = *(const pg8::u32x4*)(KN + (size_t)(kr2 + kkey) * 128 + kvh * 64 + kd8);
                vreg = *(const pg8::u32x4*)(VB + (size_t)(kr2 + vkey) * EVEN_IN + kvh * 64 + vd8);
            }
            __syncthreads();
            f32x16 sc[2][2];
#pragma unroll
            for (int a = 0; a < 2; a++)
#pragma unroll
                for (int b = 0; b < 2; b++) {
#pragma unroll
                    for (int q = 0; q < 16; q++) sc[a][b][q] = 0.f;
#pragma unroll
                    for (int ks = 0; ks < 4; ks++) {
                        const bf16x8_t kf = *(const bf16x8_t*)(Ks + (a * 32 + r) * 72 + ks * 16 + 8 * hf);
                        sc[a][b] = __builtin_amdgcn_mfma_f32_32x32x16_bf16(kf, qf[b][ks], sc[a][b], 0, 0, 0);
                    }
                }
#pragma unroll
            for (int b = 0; b < 2; b++) {
                const int qpos = qb * 128 + qoff + b * 32 + r;
                float mx = mrun[b];
#pragma unroll
                for (int a = 0; a < 2; a++)
#pragma unroll
                    for (int q = 0; q < 16; q++) {
                        if (local) {
                            const int kpos = krow0 + a * 32 + CROW(q, hf);
                            const int dd = kpos - qpos;
                            const bool ok = kpos >= 0 && kpos < L && dd <= 128 && dd >= -128;
                            sc[a][b][q] = ok ? sc[a][b][q] : -INFINITY;
                        }
                        mx = fmaxf(mx, sc[a][b][q]);
                    }
                mx = fmaxf(mx, lane_xor(lane, mx, 32));
                const float corr = __expf(mrun[b] - mx);
                mrun[b] = mx;
                float sum = 0.f;
#pragma unroll
                for (int a = 0; a < 2; a++)
#pragma unroll
                    for (int q = 0; q < 16; q++) { const float pv = __expf(sc[a][b][q] - mx); sc[a][b][q] = pv; sum += pv; }
                sum += lane_xor(lane, sum, 32);
                lrun[b] = lrun[b] * corr + sum;
#pragma unroll
                for (int dt = 0; dt < 2; dt++)
#pragma unroll
                    for (int q = 0; q < 16; q++) o[dt][b][q] *= corr;
            }
#pragma unroll
            for (int a = 0; a < 2; a++)
#pragma unroll
                for (int si = 0; si < 2; si++) {
                    bf16x8_t pf[2];
#pragma unroll
                    for (int b = 0; b < 2; b++) {
                        pg8::u32x4 w;
                        w.x = pack_bf16(sc[a][b][8 * si + 0], sc[a][b][8 * si + 1]); w.y = pack_bf16(sc[a][b][8 * si + 2], sc[a][b][8 * si + 3]);
                        w.z = pack_bf16(sc[a][b][8 * si + 4], sc[a][b][8 * si + 5]); w.w = pack_bf16(sc[a][b][8 * si + 6], sc[a][b][8 * si + 7]);
                        pf[b] = __builtin_bit_cast(bf16x8_t, w);
                    }
#pragma unroll
                    for (int dt = 0; dt < 2; dt++) {
                        const bf16_t* vp = Vts + (dt * 32 + r) * 72 + a * 32 + 16 * si + 4 * hf;
                        const u32x2_t lo = *(const u32x2_t*)vp, hi = *(const u32x2_t*)(vp + 8);
                        pg8::u32x4 w; w.x = lo.x; w.y = lo.y; w.z = hi.x; w.w = hi.y;
                        const bf16x8_t vf = __builtin_bit_cast(bf16x8_t, w);
#pragma unroll
                        for (int b = 0; b < 2; b++) o[dt][b] = __builtin_amdgcn_mfma_f32_32x32x16_bf16(vf, pf[b], o[dt][b], 0, 0, 0);
                    }
                }
        }
#pragma unroll
        for (int b = 0; b < 2; b++) {
            const float rl = 1.f / lrun[b];
            bf16_t* dst = MB + (size_t)(qrow0 + qoff + b * 32 + r) * D + 512 + hq * 64 + 4 * hf;
#pragma unroll
            for (int dt = 0; dt < 2; dt++)
#pragma unroll
                for (int q4 = 0; q4 < 4; q4++) {
                    u32x2_t w;
                    w.x = pack_bf16(o[dt][b][4 * q4 + 0] * rl, o[dt][b][4 * q4 + 1] * rl);
                    w.y = pack_bf16(o[dt][b][4 * q4 + 2] * rl, o[dt][b][4 * q4 + 3] * rl);
                    *(u32x2_t*)(dst + dt * 32 + 8 * q4) = w;
                }
        }
    }
}

__device__ __forceinline__ void ph_hyena_conv(const Params& p, int o) {
    const int TIDX = tid_of_wave(p.wave_id);
    const int lane = TIDX & 63, wave = TIDX >> 6;
    const float* U = wsp<float>(p, OFF_UC) - (size_t)L * 1536;
    const float* hnp = wsp<float>(p, OFF_HNP);
    float* Z1 = wsp<float>(p, OFF_Z1);
    const float* zin = o == 0 ? U : Z1;
    const int zld = o == 0 ? 1536 : 512;
    const int nlat = 8 * (L / 64), nctx = 8 * (NCX / 64);
    for (int it = nlat + blockIdx.x; it < nlat + nctx; it += gridDim.x) {
        const bool lat = it < nlat;
        const int ii = lat ? it : it - nlat;
        const int Ls = lat ? L : NCX, base = lat ? 0 : L;
        const int ch = (ii & 7) * 64 + lane, t0 = (ii >> 3) * 64 + wave * 8;
        const float* hf = (lat ? wsp<float>(p, OFF_HH) : wsp<float>(p, OFF_HHC)) + o * 512 + ch;
        float nrm = 0.f;
        if (lat) { for (int c = 0; c < 128; c++) nrm += hnp[c * 1024 + o * 512 + ch]; }
        else { nrm = hnp[128 * 1024 + o * 512 + ch] + hnp[129 * 1024 + o * 512 + ch]; }
        float acc[8];
#pragma unroll
        for (int i = 0; i < 8; i++) acc[i] = 0.f;
#pragma unroll 4
        for (int s0 = 0; s0 < Ls; s0 += 8) {
            float zv[8], hv[15];
#pragma unroll
            for (int j = 0; j < 8; j++) zv[j] = zin[(size_t)(base + s0 + j) * zld + ch];
#pragma unroll
            for (int e = 0; e < 15; e++) hv[e] = hf[(size_t)(t0 - s0 + e - 7 + Ls) * 1024];
#pragma unroll
            for (int i = 0; i < 8; i++)
#pragma unroll
                for (int j = 0; j < 8; j++) acc[i] = fmaf(hv[i - j + 7], zv[j], acc[i]);
        }
        const float inv = 1.f / nrm;
        const float bias = p.in[I_HYFB][o * 512 + ch];
#pragma unroll
        for (int i = 0; i < 8; i++) {
            const int r = base + t0 + i;
            const float zc = acc[i] * inv;
            const float z = zin[(size_t)r * zld + ch];
            const float gate = U[(size_t)r * 1536 + 512 * (o + 1) + ch];
            const float res = gate * (zc + z * bias);
            if (o == 0) Z1[(size_t)r * 512 + ch] = res;
            else wsp<bf16_t>(p, OFF_MB)[(size_t)r * D + ch] = f2bf(res);
        }
    }
}

__device__ __forceinline__ void ph_moe_scatter(const Params& p, float* lds, int layer, int ntok) {
    const int TIDX = tid_of_wave(p.wave_id);
    int* sst = (int*)lds;
    int* pre = sst + 128;
    const int G = gridDim.x;
    const int* bc = wsp<int>(p, OFF_BC) + (size_t)layer * 512 * 32;
    int* tile_e = wsp<int>(p, OFF_TILEE) + layer * 512;
    __syncthreads();
    for (int i = TIDX; i < G * 32; i += NT) pre[i] = bc[i];
    __syncthreads();
    if (TIDX < 32) {
        int a = 0;
        for (int b = 0; b < G; b++) { const int c = pre[b * 32 + TIDX]; pre[b * 32 + TIDX] = a; a += c; }
        sst[64 + TIDX] = a;
    }
    __syncthreads();
    if (TIDX == 0) {
        int a = 0;
        for (int e = 0; e < 32; e++) {
            const int nt = (sst[64 + e] + 255) / 256;
            if (blockIdx.x == 0) for (int q = 0; q < nt; q++) tile_e[a / 256 + q] = e;
            const int st = a;
            a += nt * 256;
            sst[e] = st;
        }
        sst[32] = a;
    }
    __syncthreads();
    if (blockIdx.x == 0 && TIDX < 33) wsp<int>(p, OFF_STARTS)[layer * 64 + TIDX] = sst[TIDX];
    const int* te = wsp<int>(p, OFF_TOPE);
    int* tp = wsp<int>(p, OFF_TOPP);
    const bf16_t* HB = wsp<bf16_t>(p, OFF_HB);
    bf16_t* XG = wsp<bf16_t>(p, OFF_XG);
    const int lane = TIDX & 63, wave = TIDX >> 6;
    for (int it = blockIdx.x * NWAVE + wave; it < ntok * 4; it += gridDim.x * NWAVE) {
        const int tok = it >> 2, e = te[it];
        const int row = sst[e] + pre[((tok >> 5) % G) * 32 + e] + tp[it];
        if (lane == 0) tp[it] = row;
        const pg8::u32x4* src = (const pg8::u32x4*)(HB + (size_t)tok * D);
        pg8::u32x4* dst = (pg8::u32x4*)(XG + (size_t)row * D);
        dst[lane] = src[lane];
        dst[lane + 64] = src[lane + 64];
    }
    __syncthreads();
}
__device__ __forceinline__ void ph_moe_gemm1(const Params& p, PG8_LAS unsigned char* lds, int layer) {
    const int total = wsp<int>(p, OFF_STARTS)[layer * 64 + 32];
    pg8::MoeOrder S{wsp<int>(p, OFF_TILEE) + layer * 512, total / 256, 8, (int)gridDim.x, (int)blockIdx.x};
    pg8::Gemm g{wsp<bf16_t>(p, OFF_XG), wsp<bf16_t>(p, OFF_WGU) + (size_t)layer * 32 * 2048 * 1024, 1024};
    pg8::EpiMoe1 E{wsp<bf16_t>(p, OFF_ACTB), p.in[I_BGU] + (size_t)layer * 32 * 2048};
    pg8::gemm_phase(p.wave_id, lds, g, S, E);
}
__device__ __forceinline__ void ph_moe_gemm2(const Params& p, PG8_LAS unsigned char* lds, int layer) {
    const int total = wsp<int>(p, OFF_STARTS)[layer * 64 + 32];
    pg8::MoeOrder S{wsp<int>(p, OFF_TILEE) + layer * 512, total / 256, 4, (int)gridDim.x, (int)blockIdx.x};
    pg8::Gemm g{wsp<bf16_t>(p, OFF_ACTB), wsp<bf16_t>(p, OFF_WDN) + (size_t)layer * 32 * 1024 * 1024, 1024};
    pg8::EpiMoe2 E{wsp<bf16_t>(p, OFF_YR), p.in[I_BDN] + (size_t)layer * 32 * 1024};
    pg8::gemm_phase(p.wave_id, lds, g, S, E);
}
template <bool NEXTPREP>
__device__ __forceinline__ void ph_moe_combine(const Params& p, int layer, int nrows, const float* xi, float* xo, int nlayer) {
    const int TIDX = tid_of_wave(p.wave_id);
    const int lane = TIDX & 63, wave = TIDX >> 6;
    const int* tp = wsp<int>(p, OFF_TOPP);
    const float* tg = wsp<float>(p, OFF_TOPG);
    const bf16_t* YR = wsp<bf16_t>(p, OFF_YR);
    for (int r0 = blockIdx.x * NWAVE + wave; r0 < nrows; r0 += 2 * gridDim.x * NWAVE) {
      const int r1 = r0 + gridDim.x * NWAVE;
      const bool ok1 = r1 < nrows;
      const int rr[2] = {r0, ok1 ? r1 : r0};
      int4 rows2[2]; float4 gs2[2];
#pragma unroll
      for (int u = 0; u < 2; u++) { rows2[u] = *(const int4*)(tp + rr[u] * 4); gs2[u] = *(const float4*)(tg + rr[u] * 4); }
      pg8::u32x4 yv[2][4][2]; float4 xv[2][4];
#pragma unroll
      for (int u = 0; u < 2; u++) {
          const int rw[4] = {rows2[u].x, rows2[u].y, rows2[u].z, rows2[u].w};
#pragma unroll
          for (int k = 0; k < 4; k++)
#pragma unroll
              for (int i = 0; i < 2; i++) yv[u][k][i] = *(const pg8::u32x4*)(YR + (size_t)rw[k] * 1024 + 512 * i + 8 * lane);
#pragma unroll
          for (int i = 0; i < 4; i++) xv[u][i] = *(const float4*)(xi + (size_t)rr[u] * D + 512 * (i >> 1) + 8 * lane + 4 * (i & 1));
      }
#pragma unroll
      for (int u = 0; u < 2; u++) {
        if (u == 1 && !ok1) continue;
        const int r = rr[u];
        const float* gt = modp(p, layer, r < L ? 0 : 1, 1) + 2048;
        float v[16];
#pragma unroll
        for (int i = 0; i < 16; i++) v[i] = 0.f;
        const float gw[4] = {gs2[u].x, gs2[u].y, gs2[u].z, gs2[u].w};
#pragma unroll
        for (int k = 0; k < 4; k++)
#pragma unroll
            for (int i = 0; i < 2; i++) {
                const pg8::u32x4 y = yv[u][k][i];
                const unsigned w[4] = {y.x, y.y, y.z, y.w};
#pragma unroll
                for (int q = 0; q < 4; q++) {
                    v[8 * i + 2 * q] = fmaf(gw[k], bf2f((unsigned short)(w[q] & 0xffff)), v[8 * i + 2 * q]);
                    v[8 * i + 2 * q + 1] = fmaf(gw[k], bf2f((unsigned short)(w[q] >> 16)), v[8 * i + 2 * q + 1]);
                }
            }
        float ss = 0.f;
#pragma unroll
        for (int i = 0; i < 2; i++)
#pragma unroll
            for (int h4 = 0; h4 < 2; h4++) {
                const int c = 512 * i + 8 * lane + 4 * h4;
                const float4 x4 = xv[u][2 * i + h4], g4 = *(const float4*)(gt + c);
                float* vv = v + 8 * i + 4 * h4;
                vv[0] = x4.x + g4.x * vv[0]; vv[1] = x4.y + g4.y * vv[1]; vv[2] = x4.z + g4.z * vv[2]; vv[3] = x4.w + g4.w * vv[3];
                *(float4*)(xo + (size_t)r * D + c) = make_float4(vv[0], vv[1], vv[2], vv[3]);
                ss += vv[0] * vv[0] + vv[1] * vv[1] + vv[2] * vv[2] + vv[3] * vv[3];
            }
        if (NEXTPREP) {
            ss = wave_sum(lane, ss);
            const float rinv = rsqrtf(ss * (1.f / 1024.f) + EPS);
            const float* md = modp(p, nlayer, r < L ? 0 : 1, 0);
            const float* g = p.in[I_NORMG] + (nlayer * 2 + 0) * 1024;
#pragma unroll
            for (int i = 0; i < 2; i++) {
                const int c = 512 * i + 8 * lane;
                float hv[8];
#pragma unroll
                for (int h4 = 0; h4 < 2; h4++) {
                    const float4 g4 = *(const float4*)(g + c + 4 * h4), sc4 = *(const float4*)(md + 1024 + c + 4 * h4), sh4 = *(const float4*)(md + c + 4 * h4);
                    const float* vv = v + 8 * i + 4 * h4;
                    hv[4 * h4 + 0] = vv[0] * rinv * g4.x * (1.f + sc4.x) + sh4.x; hv[4 * h4 + 1] = vv[1] * rinv * g4.y * (1.f + sc4.y) + sh4.y;
                    hv[4 * h4 + 2] = vv[2] * rinv * g4.z * (1.f + sc4.z) + sh4.z; hv[4 * h4 + 3] = vv[3] * rinv * g4.w * (1.f + sc4.w) + sh4.w;
                }
                pg8::u32x4 o; o.x = pack_bf16(hv[0], hv[1]); o.y = pack_bf16(hv[2], hv[3]); o.z = pack_bf16(hv[4], hv[5]); o.w = pack_bf16(hv[6], hv[7]);
                *(pg8::u32x4*)(wsp<bf16_t>(p, OFF_HB) + (size_t)r * D + c) = o;
            }
        }
      }
    }
}

__device__ __forceinline__ void ph_streams(const Params& p) {
    const int TIDX = tid_of_wave(p.wave_id);
    const bf16_t* P1 = wsp<bf16_t>(p, OFF_P);
    bf16_t* XBC = wsp<bf16_t>(p, OFF_XBC);
    float* DT = wsp<float>(p, OFF_DT);
    const float* cw = p.in[I_SSDCW];
    const float* cb = p.in[I_SSDCB];
    const int gsz = gridDim.x * NT, g0 = blockIdx.x * NT + TIDX;
    for (int base = g0; base < R * 128; base += 4 * gsz) {
        pg8::u32x4 v[4][3];
#pragma unroll
        for (int u = 0; u < 4; u++) {
            const int it = base + u * gsz, r = it >> 7, c = (it & 127) * 8;
            const int lo = r < L ? 0 : L, hi = r < L ? L : R;
#pragma unroll
            for (int j = 0; j < 3; j++) {
                const int rr = r + j - 1;
                v[u][j] = pg8::u32x4{0u, 0u, 0u, 0u};
                if (it < R * 128 && rr >= lo && rr < hi) v[u][j] = *(const pg8::u32x4*)(P1 + (size_t)rr * ODD_IN + c);
            }
        }
#pragma unroll
        for (int u = 0; u < 4; u++) {
            const int it = base + u * gsz, r = it >> 7, c = (it & 127) * 8;
            if (it >= R * 128) continue;
            float a[8];
#pragma unroll
            for (int q = 0; q < 8; q++) a[q] = cb[c + q];
#pragma unroll
            for (int j = 0; j < 3; j++) {
                const unsigned w[4] = {v[u][j].x, v[u][j].y, v[u][j].z, v[u][j].w};
#pragma unroll
                for (int q = 0; q < 4; q++) {
                    a[2 * q] = fmaf(cw[j * 1024 + c + 2 * q], bf2f((unsigned short)(w[q] & 0xffff)), a[2 * q]);
                    a[2 * q + 1] = fmaf(cw[j * 1024 + c + 2 * q + 1], bf2f((unsigned short)(w[q] >> 16)), a[2 * q + 1]);
                }
            }
            pg8::u32x4 o;
            o.x = pack_bf16(silu_fast(a[0]), silu_fast(a[1])); o.y = pack_bf16(silu_fast(a[2]), silu_fast(a[3]));
            o.z = pack_bf16(silu_fast(a[4]), silu_fast(a[5])); o.w = pack_bf16(silu_fast(a[6]), silu_fast(a[7]));
            *(pg8::u32x4*)(XBC + (size_t)r * 1024 + c) = o;
        }
    }
    for (int it = g0; it < R * 16; it += gsz) {
        const int r = it >> 4, c = it & 15, d = c >> 3, h = c & 7;
        DT[(size_t)d * R * 8 + (size_t)r * 8 + h] = softplus_f(bf2f(P1[(size_t)r * ODD_IN + 1024 + c]) + p.in[I_DTB][d * 8 + h]);
    }
}
__device__ __forceinline__ float chunk_cumsum128(float a0, float a1, int lane, int d, float& c0, float& c1) {
    const float s = a0 + a1;
    float incl = s;
#pragma unroll
    for (int o = 1; o < 64; o <<= 1) { const float t = lane_get(incl, lane >= o ? lane - o : lane); if (lane >= o) incl += t; }
    const float total = lane_get(incl, 63);
    c0 = incl - s + a0; c1 = incl;
    if (d == 1) { c0 = total - (c0 - a0); c1 = total - (c1 - a1); }
    return total;
}

__device__ __forceinline__ void ph_ssd_s1(const Params& p, unsigned char* smem) {
    const int TIDX = tid_of_wave(p.wave_id);
    bf16_t* Bt = (bf16_t*)smem;
    bf16_t* XW = Bt + 128 * LDP;
    float* csb = (float*)(XW + 2 * 64 * LDP);
    const bf16_t* XBC = wsp<bf16_t>(p, OFF_XBC);
    const float* DT = wsp<float>(p, OFF_DT);
    bf16_t* ST = wsp<bf16_t>(p, OFF_SST);
    float* DEC = wsp<float>(p, OFF_SDEC);
    const int tid = TIDX, lane = tid & 63, wave = tid >> 6, hf = lane >> 5;
    for (int it = blockIdx.x; it < 130 * 8; it += gridDim.x) {
        const int c = it >> 3, hh = it & 7, g = hh >> 2, r0 = c * 128;
        const int s = tid >> 2, q4 = tid & 3;
        const bf16_t* xr = XBC + (size_t)(r0 + s) * 1024;
        pg8::u32x4 bv[4], xv[2];
#pragma unroll
        for (int j = 0; j < 4; j++) bv[j] = *(const pg8::u32x4*)(xr + 512 + g * 128 + q4 * 32 + 8 * j);
#pragma unroll
        for (int j = 0; j < 2; j++) xv[j] = *(const pg8::u32x4*)(xr + hh * 64 + q4 * 16 + 8 * j);
        __syncthreads();
        if (wave < 2) {
            const int d = wave;
            const float a = -expf(p.in[I_ALOG][d * 8 + hh]);
            const float dt0 = DT[(size_t)d * R * 8 + (size_t)(r0 + 2 * lane) * 8 + hh], dt1 = DT[(size_t)d * R * 8 + (size_t)(r0 + 2 * lane + 1) * 8 + hh];
            float c0, c1;
            const float total = chunk_cumsum128(dt0 * a, dt1 * a, lane, d, c0, c1);
            csb[d * 128 + 2 * lane] = __expf(total - c0) * dt0;
            csb[d * 128 + 2 * lane + 1] = __expf(total - c1) * dt1;
            if (lane == 0) DEC[(d * 130 + c) * 8 + hh] = __expf(total);
        }
#pragma unroll
        for (int j = 0; j < 4; j++) {
            const unsigned w[4] = {bv[j].x, bv[j].y, bv[j].z, bv[j].w};
            bf16_t* dst = Bt + (q4 * 32 + 8 * j) * LDP + s;
#pragma unroll
            for (int q = 0; q < 4; q++) { dst[(2 * q) * LDP] = (bf16_t)(w[q] & 0xffff); dst[(2 * q + 1) * LDP] = (bf16_t)(w[q] >> 16); }
        }
        __syncthreads();
        {
            const float w0 = csb[s], w1 = csb[128 + s];
#pragma unroll
            for (int j = 0; j < 2; j++) {
                const unsigned w[4] = {xv[j].x, xv[j].y, xv[j].z, xv[j].w};
                bf16_t* dst = XW + (q4 * 16 + 8 * j) * LDP + s;
#pragma unroll
                for (int q = 0; q < 4; q++) {
                    const float x0 = bf2f((unsigned short)(w[q] & 0xffff)), x1 = bf2f((unsigned short)(w[q] >> 16));
                    dst[(2 * q) * LDP] = f2bf(x0 * w0); dst[(2 * q + 1) * LDP] = f2bf(x1 * w0);
                    dst[64 * LDP + (2 * q) * LDP] = f2bf(x0 * w1); dst[64 * LDP + (2 * q + 1) * LDP] = f2bf(x1 * w1);
                }
            }
        }
        __syncthreads();
#pragma unroll 1
        for (int t2 = 0; t2 < 2; t2++) {
            const int tix = wave * 2 + t2, d = tix >> 3, mt = (tix >> 2) & 1, nt = tix & 3;
            f32x16 acc;
#pragma unroll
            for (int q = 0; q < 16; q++) acc[q] = 0.f;
            acc = mma32<8>(lane, XW + (d * 64 + mt * 32) * LDP, LDP, Bt + nt * 32 * LDP, LDP, acc);
            int rb = mt * 32 + 4 * hf;
            asm volatile("" : "+v"(rb));
            bf16_t* dst = ST + ((((size_t)d * 130 + c) * 8 + hh) * 64 + rb) * 128 + nt * 32 + (lane & 31);
#pragma unroll
            for (int q = 0; q < 16; q++) dst[((q & 3) + 8 * (q >> 2)) * 128] = f2bf(acc[q]);
        }
    }
}
__device__ __forceinline__ void ph_ssd_s2(const Params& p) {
    const int TIDX = tid_of_wave(p.wave_id);
    const bf16_t* __restrict__ ST = wsp<bf16_t>(p, OFF_SST);
    bf16_t* __restrict__ SIN = wsp<bf16_t>(p, OFF_SSIN);
    const float* __restrict__ DEC = wsp<float>(p, OFF_SDEC);
    for (int it = blockIdx.x * NT + TIDX; it < 65536; it += gridDim.x * NT) {
        const int n2 = it & 63, pp = (it >> 6) & 63, hh = (it >> 12) & 7, d = it >> 15;
        float s0 = 0.f, s1 = 0.f;
#pragma unroll 1
        for (int g0 = 0; g0 < 130; g0 += 26) {
            unsigned stv[26]; float dv[26];
#pragma unroll
            for (int j = 0; j < 26; j++) {
                const int step = g0 + j, c = d == 0 ? (step < 2 ? 128 + step : step - 2) : 129 - step;
                stv[j] = *(const unsigned*)(ST + ((((size_t)d * 130 + c) * 8 + hh) * 64 + pp) * 128 + 2 * n2);
                dv[j] = DEC[(d * 130 + c) * 8 + hh];
            }
#pragma unroll
            for (int j = 0; j < 26; j++) {
                const int step = g0 + j, c = d == 0 ? (step < 2 ? 128 + step : step - 2) : 129 - step;
                *(unsigned*)(SIN + ((((size_t)d * 130 + c) * 8 + hh) * 64 + pp) * 128 + 2 * n2) = pack_bf16(s0, s1);
                s0 = fmaf(s0, dv[j], bf2f((unsigned short)(stv[j] & 0xffff)));
                s1 = fmaf(s1, dv[j], bf2f((unsigned short)(stv[j] >> 16)));
            }
        }
    }
}
__device__ __forceinline__ void ph_ssd_s3(const Params& p, unsigned char* smem) {
    const int TIDX = tid_of_wave(p.wave_id);
    bf16_t* Cm = (bf16_t*)smem;
    bf16_t* Bm = Cm + 128 * LDP;
    bf16_t* Wm = Bm;
    bf16_t* Xt = Bm + 128 * LDP;
    bf16_t* Sn = Xt + 64 * LDP;
    float* csA = (float*)(Sn + 2 * 64 * LDP);
    float* dtA = csA + 8 * 128;
    const bf16_t* XBC = wsp<bf16_t>(p, OFF_XBC);
    const float* DT = wsp<float>(p, OFF_DT);
    const bf16_t* SIN = wsp<bf16_t>(p, OFF_SSIN);
    float* Y = wsp<float>(p, OFF_Y);
    const int tid = TIDX, lane = tid & 63, wave = tid >> 6, hf = lane >> 5;
    for (int it = blockIdx.x; it < 256; it += gridDim.x) {
        const int c = it >> 1, g = it & 1, r0 = c * 128;
        const int s = tid >> 2, q4 = tid & 3;
        const bf16_t* xr = XBC + (size_t)(r0 + s) * 1024;
        __syncthreads();
        {
            pg8::u32x4 bv[4], cv[4];
#pragma unroll
            for (int j = 0; j < 4; j++) { bv[j] = *(const pg8::u32x4*)(xr + 512 + g * 128 + q4 * 32 + 8 * j); cv[j] = *(const pg8::u32x4*)(xr + 768 + g * 128 + q4 * 32 + 8 * j); }
            {
                const int hh = g * 4 + (wave >> 1), d = wave & 1;
                const float a = -expf(p.in[I_ALOG][d * 8 + hh]);
                const float dt0 = DT[(size_t)d * R * 8 + (size_t)(r0 + 2 * lane) * 8 + hh], dt1 = DT[(size_t)d * R * 8 + (size_t)(r0 + 2 * lane + 1) * 8 + hh];
                float c0, c1;
                chunk_cumsum128(dt0 * a, dt1 * a, lane, d, c0, c1);
                csA[wave * 128 + 2 * lane] = c0; csA[wave * 128 + 2 * lane + 1] = c1;
                dtA[wave * 128 + 2 * lane] = dt0; dtA[wave * 128 + 2 * lane + 1] = dt1;
            }
#pragma unroll
            for (int j = 0; j < 4; j++) { *(pg8::u32x4*)(Bm + s * LDP + q4 * 32 + 8 * j) = bv[j]; *(pg8::u32x4*)(Cm + s * LDP + q4 * 32 + 8 * j) = cv[j]; }
        }
        __syncthreads();
        const int gmt = wave >> 1, gnt0 = (wave & 1) * 2;
        f32x16 G0, G1;
#pragma unroll
        for (int q = 0; q < 16; q++) { G0[q] = 0.f; G1[q] = 0.f; }
        G0 = mma32<8>(lane, Cm + gmt * 32 * LDP, LDP, Bm + gnt0 * 32 * LDP, LDP, G0);
        G1 = mma32<8>(lane, Cm + gmt * 32 * LDP, LDP, Bm + (gnt0 + 1) * 32 * LDP, LDP, G1);
#pragma unroll 1
        for (int h = 0; h < 4; h++) {
            const int hh = g * 4 + h;
            const int ymt = wave >> 1, ynt = wave & 1;
            f32x16 ytot;
#pragma unroll
            for (int q = 0; q < 16; q++) ytot[q] = 0.f;
            pg8::u32x4 xv[2], sv[2][2];
            {
                int tb = tid;
                asm volatile("" : "+v"(tb));
                const int s2 = tb >> 2, q42 = tb & 3;
#pragma unroll
                for (int j = 0; j < 2; j++) xv[j] = *(const pg8::u32x4*)(XBC + (size_t)(r0 + s2) * 1024 + hh * 64 + q42 * 16 + 8 * j);
#pragma unroll
                for (int d = 0; d < 2; d++) {
                    const bf16_t* src = SIN + ((((size_t)d * 130 + c) * 8 + hh) * 64) * 128;
#pragma unroll
                    for (int i = 0; i < 2; i++) { const int v = tb + 512 * i; sv[d][i] = *(const pg8::u32x4*)(src + (v >> 4) * 128 + (v & 15) * 8); }
                }
            }
#pragma unroll 1
            for (int d = 0; d < 2; d++) {
                __syncthreads();
                if (d == 0) {
                    int tb = tid;
                    asm volatile("" : "+v"(tb));
                    const int s2 = tb >> 2, q42 = tb & 3;
#pragma unroll
                    for (int j = 0; j < 2; j++) {
                        const unsigned w[4] = {xv[j].x, xv[j].y, xv[j].z, xv[j].w};
                        bf16_t* dst = Xt + (q42 * 16 + 8 * j) * LDP + s2;
#pragma unroll
                        for (int q = 0; q < 4; q++) { dst[(2 * q) * LDP] = (bf16_t)(w[q] & 0xffff); dst[(2 * q + 1) * LDP] = (bf16_t)(w[q] >> 16); }
                    }
#pragma unroll
                    for (int dd = 0; dd < 2; dd++)
#pragma unroll
                        for (int i = 0; i < 2; i++) { const int v = tb + 512 * i; *(pg8::u32x4*)(Sn + (dd * 64 + (v >> 4)) * LDP + (v & 15) * 8) = sv[dd][i]; }
                }
                const float* csb = csA + (h * 2 + d) * 128;
                const float* dtb = dtA + (h * 2 + d) * 128;
#pragma unroll
                for (int t2 = 0; t2 < 2; t2++) {
                    const int s3 = (gnt0 + t2) * 32 + (lane & 31);
                    const float css = csb[s3], dts = dtb[s3];
#pragma unroll
                    for (int q = 0; q < 16; q++) {
                        const int l = gmt * 32 + CROW(q, hf);
                        const bool ok = d == 0 ? (s3 <= l) : (s3 >= l);
                        const float gv = t2 == 0 ? G0[q] : G1[q];
                        const float w = ok ? gv * __expf(csb[l] - css) * dts : 0.f;
                        Wm[l * LDP + s3] = f2bf(w);
                    }
                }
                __syncthreads();
                f32x16 a2;
#pragma unroll
                for (int q = 0; q < 16; q++) a2[q] = 0.f;
                a2 = mma32<8>(lane, Cm + ymt * 32 * LDP, LDP, Sn + (d * 64 + ynt * 32) * LDP, LDP, a2);
#pragma unroll
                for (int q = 0; q < 16; q++) ytot[q] += __expf(csb[ymt * 32 + CROW(q, hf)]) * a2[q];
                ytot = mma32<8>(lane, Wm + ymt * 32 * LDP, LDP, Xt + ynt * 32 * LDP, LDP, ytot);
            }
            const float Dsum = p.in[I_SSDD][hh] + p.in[I_SSDD][8 + hh];
            {
                int lbase = r0 + ymt * 32 + 4 * hf;
                asm volatile("" : "+v"(lbase));
                const int cbase = hh * 64 + ynt * 32 + (lane & 31);
                float* yb = Y + (size_t)lbase * 512 + cbase;
                const bf16_t* xb = XBC + (size_t)lbase * 1024 + cbase;
#pragma unroll
                for (int q = 0; q < 16; q++) {
                    const int lo = (q & 3) + 8 * (q >> 2);
                    yb[lo * 512] = ytot[q] + Dsum * bf2f(xb[lo * 1024]);
                }
            }
        }
    }
}

constexpr int LDQ = 72;
__device__ __forceinline__ void ph_hg_s1(const Params& p, unsigned char* smem) {
    const int TIDX = tid_of_wave(p.wave_id);
    float* LG = (float*)smem;
    bf16_t* KbT = (bf16_t*)(smem + 65536);
    bf16_t* Vt = KbT + 2 * 128 * LDQ;
    const bf16_t* P1 = wsp<bf16_t>(p, OFF_P);
    const float* lbp = wsp<float>(p, OFF_LB);
    bf16_t* ST = wsp<bf16_t>(p, OFF_HST);
    float* DEC = wsp<float>(p, OFF_HDEC);
    const int tid = TIDX, lane = tid & 63, wave = tid >> 6, hf = lane >> 5;
    float fr[32];
    pg8::u32x4 vx[2];
    auto fetch = [&](int it2) {
        const int c2 = it2 >> 2, h2 = it2 & 3, r02 = c2 * 64;
#pragma unroll
        for (int i = 0; i < 32; i++) {
            const int d = i >> 4, e = tid + 512 * (i & 15), row = e >> 7, k = e & 127;
            fr[i] = bf2f(P1[(size_t)(r02 + row) * ODD_IN + 1040 + d * 512 + h2 * 128 + k]);
        }
#pragma unroll
        for (int q = 0; q < 2; q++) { const int vec = tid + 512 * q; vx[q] = *(const pg8::u32x4*)(P1 + (size_t)(r02 + (vec >> 4)) * ODD_IN + 2064 + h2 * 128 + (vec & 15) * 8); }
    };
    if ((int)blockIdx.x < 260 * 4) fetch(blockIdx.x);
    for (int it = blockIdx.x; it < 260 * 4; it += gridDim.x) {
        const int c = it >> 2, h = it & 3, r0 = c * 64;
        __syncthreads();
        float fv[32];
        {
            const float lbk = lbp[h * 128 + (tid & 127)];
#pragma unroll
            for (int i = 0; i < 32; i++) fv[i] = lbk + (1.f - lbk) * sigmoid_fast(fr[i]);
        }
#pragma unroll
        for (int q = 0; q < 2; q++) {
            const int vec = tid + 512 * q, s2 = vec >> 4, v0 = (vec & 15) * 8;
            const pg8::u32x4 x = vx[q];
            bf16_t* dst = Vt + v0 * LDQ + s2;
            dst[0] = (bf16_t)(x.x & 0xffff); dst[LDQ] = (bf16_t)(x.x >> 16); dst[2 * LDQ] = (bf16_t)(x.y & 0xffff); dst[3 * LDQ] = (bf16_t)(x.y >> 16);
            dst[4 * LDQ] = (bf16_t)(x.z & 0xffff); dst[5 * LDQ] = (bf16_t)(x.z >> 16); dst[6 * LDQ] = (bf16_t)(x.w & 0xffff); dst[7 * LDQ] = (bf16_t)(x.w >> 16);
        }
#pragma unroll
        for (int i = 0; i < 32; i++) LG[(i >> 4) * 8192 + tid + 512 * (i & 15)] = __logf(fv[i]);
        __syncthreads();
        if (tid < 256) {
            const int d = tid >> 7, k = tid & 127;
            float* col = LG + d * 8192 + k;
            float cum = 0.f;
#pragma unroll 8
            for (int i = 0; i < 64; i++) { const int row = d == 0 ? i : 63 - i; cum += col[row * 128]; col[row * 128] = cum; }
            DEC[(((size_t)d * 260 + c) * 4 + h) * 128 + k] = __expf(cum);
        }
        __syncthreads();
#pragma unroll
        for (int i = 0; i < 32; i++) {
            const int d = i >> 4, e = tid + 512 * (i & 15), row = e >> 7, k = e & 127;
            const float total = LG[d * 8192 + (d == 0 ? 63 : 0) * 128 + k], cum = LG[d * 8192 + e];
            KbT[(d * 128 + k) * LDQ + row] = f2bf((1.f - fv[i]) * __expf(total - cum));
        }
        if (it + (int)gridDim.x < 260 * 4) fetch(it + gridDim.x);
        __syncthreads();
#pragma unroll 1
        for (int q4 = 0; q4 < 4; q4++) {
            const int tix = wave * 4 + q4, d = tix >> 4, vt = (tix >> 2) & 3, kt = tix & 3;
            f32x16 acc;
#pragma unroll
            for (int q = 0; q < 16; q++) acc[q] = 0.f;
            acc = mma32<4>(lane, Vt + vt * 32 * LDQ, LDQ, KbT + (d * 128 + kt * 32) * LDQ, LDQ, acc);
            int rb = vt * 32 + 4 * hf;
            asm volatile("" : "+v"(rb));
            bf16_t* dst = ST + ((((size_t)d * 260 + c) * 4 + h) * 128 + rb) * 128 + kt * 32 + (lane & 31);
#pragma unroll
            for (int q = 0; q < 16; q++) dst[((q & 3) + 8 * (q >> 2)) * 128] = f2bf(acc[q]);
        }
    }
}
__device__ __forceinline__ void ph_hg_s2(const Params& p) {
    const int TIDX = tid_of_wave(p.wave_id);
    const bf16_t* __restrict__ ST = wsp<bf16_t>(p, OFF_HST);
    bf16_t* __restrict__ SIN = wsp<bf16_t>(p, OFF_HSIN);
    const float* __restrict__ DEC = wsp<float>(p, OFF_HDEC);
    const int gb = gridDim.x >= 256 ? (int)blockIdx.x - 128 : (int)blockIdx.x, gs = gridDim.x >= 256 ? 128 : (int)gridDim.x;
    for (int it = gb * NT + TIDX; it >= 0 && it < 65536; it += gs * NT) {
        const int k2 = it & 63, v = (it >> 6) & 127, h = (it >> 13) & 3, d = it >> 15;
        float s0 = 0.f, s1 = 0.f;
#pragma unroll 1
        for (int g0 = 0; g0 < 260; g0 += 26) {
            unsigned stv[26]; float2 dv[26];
#pragma unroll
            for (int j = 0; j < 26; j++) {
                const int step = g0 + j, c = d == 0 ? (step < 4 ? 256 + step : step - 4) : 259 - step;
                const size_t blk = ((size_t)d * 260 + c) * 4 + h;
                stv[j] = *(const unsigned*)(ST + (blk * 128 + v) * 128 + 2 * k2);
                dv[j] = *(const float2*)(DEC + blk * 128 + 2 * k2);
            }
#pragma unroll
            for (int j = 0; j < 26; j++) {
                const int step = g0 + j, c = d == 0 ? (step < 4 ? 256 + step : step - 4) : 259 - step;
                const size_t blk = ((size_t)d * 260 + c) * 4 + h;
                *(unsigned*)(SIN + (blk * 128 + v) * 128 + 2 * k2) = pack_bf16(s0, s1);
                s0 = fmaf(s0, dv[j].x, bf2f((unsigned short)(stv[j] & 0xffff)));
                s1 = fmaf(s1, dv[j].y, bf2f((unsigned short)(stv[j] >> 16)));
            }
        }
    }
}
__device__ __forceinline__ void ph_hg_s3(const Params& p, unsigned char* smem) {
    const int TIDX = tid_of_wave(p.wave_id);
    float* LG = (float*)smem;
    bf16_t* Qb = (bf16_t*)(smem + 32768);
    bf16_t* Kh = Qb + 64 * LDP;
    bf16_t* Vt = Kh + 64 * LDP;
    bf16_t* Am = Vt + 128 * LDQ;
    bf16_t* Sn = Am + 64 * LDQ;
    const bf16_t* P1 = wsp<bf16_t>(p, OFF_P);
    const float* lbp = wsp<float>(p, OFF_LB);
    const bf16_t* SIN = wsp<bf16_t>(p, OFF_HSIN);
    float* O = wsp<float>(p, OFF_O);
    const int tid = TIDX, lane = tid & 63, wave = tid >> 6, hf = lane >> 5;
    float fr[16], qr[16];
    pg8::u32x4 snv[4], vx[2];
    auto fetch = [&](int it2, int d2) {
        const int c2 = it2 >> 2, h2 = it2 & 3, r02 = c2 * 64;
#pragma unroll
        for (int i = 0; i < 16; i++) {
            const int e = tid + 512 * i, row = e >> 7, k = e & 127;
            fr[i] = bf2f(P1[(size_t)(r02 + row) * ODD_IN + 1040 + d2 * 512 + h2 * 128 + k]);
            qr[i] = bf2f(P1[(size_t)(r02 + row) * ODD_IN + 3088 + h2 * 128 + k]);
        }
        const bf16_t* src = SIN + ((((size_t)d2 * 260 + c2) * 4 + h2) * 128) * 128;
#pragma unroll
        for (int i = 0; i < 4; i++) { const int v = tid + 512 * i; snv[i] = *(const pg8::u32x4*)(src + (v >> 4) * 128 + (v & 15) * 8); }
        if (d2 == 0) {
#pragma unroll
            for (int q = 0; q < 2; q++) { const int vec = tid + 512 * q; vx[q] = *(const pg8::u32x4*)(P1 + (size_t)(r02 + (vec >> 4)) * ODD_IN + 2064 + h2 * 128 + (vec & 15) * 8); }
        }
    };
    const int nit = ((int)blockIdx.x < 1024) ? (1024 - (int)blockIdx.x + (int)gridDim.x - 1) / (int)gridDim.x : 0;
    if (nit > 0) fetch(blockIdx.x, 0);
    const int omt = wave >> 2, ont = wave & 3;
    f32x16 otot;
#pragma unroll 1
    for (int n = 0; n < 2 * nit; n++) {
        const int it = blockIdx.x + (n >> 1) * gridDim.x, d = n & 1;
        const int c = it >> 2, h = it & 3, r0 = c * 64;
        if (d == 0) {
#pragma unroll
            for (int q = 0; q < 16; q++) otot[q] = 0.f;
        }
        __syncthreads();
        float fv[16], qv[16];
        {
            const float lbk = lbp[h * 128 + (tid & 127)];
#pragma unroll
            for (int i = 0; i < 16; i++) { fv[i] = lbk + (1.f - lbk) * sigmoid_fast(fr[i]); qv[i] = silu_fast(qr[i]); }
        }
#pragma unroll
        for (int i = 0; i < 4; i++) { const int v = tid + 512 * i; *(pg8::u32x4*)(Sn + (v >> 4) * LDP + (v & 15) * 8) = snv[i]; }
        if (d == 0) {
#pragma unroll
            for (int q = 0; q < 2; q++) {
                const int vec = tid + 512 * q, s2 = vec >> 4, v0 = (vec & 15) * 8;
                const pg8::u32x4 x = vx[q];
                bf16_t* dst = Vt + v0 * LDQ + s2;
                dst[0] = (bf16_t)(x.x & 0xffff); dst[LDQ] = (bf16_t)(x.x >> 16); dst[2 * LDQ] = (bf16_t)(x.y & 0xffff); dst[3 * LDQ] = (bf16_t)(x.y >> 16);
                dst[4 * LDQ] = (bf16_t)(x.z & 0xffff); dst[5 * LDQ] = (bf16_t)(x.z >> 16); dst[6 * LDQ] = (bf16_t)(x.w & 0xffff); dst[7 * LDQ] = (bf16_t)(x.w >> 16);
            }
        }
#pragma unroll
        for (int i = 0; i < 16; i++) LG[tid + 512 * i] = __logf(fv[i]);
        __syncthreads();
        if (tid < 128) {
            float* col = LG + tid;
            float cum = 0.f;
#pragma unroll 8
            for (int i = 0; i < 64; i++) { const int row = d == 0 ? i : 63 - i; cum += col[row * 128]; col[row * 128] = cum; }
        }
        __syncthreads();
#pragma unroll
        for (int i = 0; i < 16; i++) {
            const int e = tid + 512 * i, row = e >> 7, k = e & 127;
            const float cum = LG[e];
            Qb[row * LDP + k] = f2bf(qv[i] * __expf(cum));
            Kh[row * LDP + k] = f2bf((1.f - fv[i]) * __expf(fminf(-cum, 80.f)));
        }
        if (n + 1 < 2 * nit) fetch(blockIdx.x + ((n + 1) >> 1) * gridDim.x, (n + 1) & 1);
        __syncthreads();
        if (wave < 4) {
            const int amt = wave >> 1, ant = wave & 1;
            f32x16 a;
#pragma unroll
            for (int q = 0; q < 16; q++) a[q] = 0.f;
            a = mma32<8>(lane, Qb + amt * 32 * LDP, LDP, Kh + ant * 32 * LDP, LDP, a);
            const int s2 = ant * 32 + (lane & 31);
#pragma unroll
            for (int q = 0; q < 16; q++) {
                const int t = amt * 32 + CROW(q, hf);
                const bool ok = d == 0 ? (s2 <= t) : (s2 >= t);
                Am[t * LDQ + s2] = f2bf(ok ? a[q] : 0.f);
            }
        }
        otot = mma32<8>(lane, Qb + omt * 32 * LDP, LDP, Sn + ont * 32 * LDP, LDP, otot);
        __syncthreads();
        otot = mma32<4>(lane, Am + omt * 32 * LDQ, LDQ, Vt + ont * 32 * LDQ, LDQ, otot);
        if (d == 1) {
            int lbase = r0 + omt * 32 + 4 * hf;
            asm volatile("" : "+v"(lbase));
            float* ob = O + (size_t)lbase * 512 + h * 128 + ont * 32 + (lane & 31);
#pragma unroll
            for (int q = 0; q < 16; q++) ob[((q & 3) + 8 * (q >> 2)) * 512] = otot[q];
        }
    }
}

__device__ __forceinline__ void ph_merge(const Params& p) {
    const int TIDX = tid_of_wave(p.wave_id);
    const int lane = TIDX & 63, wave = TIDX >> 6;
    const bf16_t* P1 = wsp<bf16_t>(p, OFF_P);
    const float* Y = wsp<float>(p, OFF_Y);
    const float* O = wsp<float>(p, OFF_O);
    bf16_t* MB = wsp<bf16_t>(p, OFF_MB);
    const int c = 8 * lane;
    for (int r = blockIdx.x * NWAVE + wave; r < L; r += gridDim.x * NWAVE) {
        const float4 y0 = *(const float4*)(Y + (size_t)r * 512 + c), y1 = *(const float4*)(Y + (size_t)r * 512 + c + 4);
        const float4 o0 = *(const float4*)(O + (size_t)r * 512 + c), o1 = *(const float4*)(O + (size_t)r * 512 + c + 4);
        const pg8::u32x4 zz = *(const pg8::u32x4*)(P1 + (size_t)r * ODD_IN + 2576 + c), gg = *(const pg8::u32x4*)(P1 + (size_t)r * ODD_IN + 3600 + c);
        const float yv[8] = {y0.x, y0.y, y0.z, y0.w, y1.x, y1.y, y1.z, y1.w};
        const float ov[8] = {o0.x, o0.y, o0.z, o0.w, o1.x, o1.y, o1.z, o1.w};
        const unsigned zw[4] = {zz.x, zz.y, zz.z, zz.w}, gw[4] = {gg.x, gg.y, gg.z, gg.w};
        float ys[8], gs[8], sy = 0.f, so = 0.f;
#pragma unroll
        for (int q = 0; q < 4; q++) {
            ys[2 * q] = yv[2 * q] * silu_fast(bf2f((unsigned short)(zw[q] & 0xffff)));
            ys[2 * q + 1] = yv[2 * q + 1] * silu_fast(bf2f((unsigned short)(zw[q] >> 16)));
            gs[2 * q] = silu_fast(bf2f((unsigned short)(gw[q] & 0xffff)));
            gs[2 * q + 1] = silu_fast(bf2f((unsigned short)(gw[q] >> 16)));
        }
#pragma unroll
        for (int q = 0; q < 8; q++) { sy = fmaf(ys[q], ys[q], sy); so = fmaf(ov[q], ov[q], so); }
        sy += dpp_f<0xB1>(sy); sy += dpp_f<0x4E>(sy); sy += dpp_f<0x141>(sy); sy += dpp_f<0x140>(sy);
        so += dpp_f<0xB1>(so); so += dpp_f<0x4E>(so); so += dpp_f<0x141>(so); so += dpp_f<0x140>(so);
        sy += lane_xor(lane, sy, 16);
        const float ry = rsqrtf(sy * (1.f / 256.f) + EPS), ro = rsqrtf(so * (1.f / 128.f) + EPS);
        const float4 n0 = *(const float4*)(p.in[I_SSDN] + c), n1 = *(const float4*)(p.in[I_SSDN] + c + 4);
        const float4 h0 = *(const float4*)(p.in[I_HGN] + c), h1 = *(const float4*)(p.in[I_HGN] + c + 4);
        const float nv[8] = {n0.x, n0.y, n0.z, n0.w, n1.x, n1.y, n1.z, n1.w}, hv[8] = {h0.x, h0.y, h0.z, h0.w, h1.x, h1.y, h1.z, h1.w};
        float m0[8], m1[8];
#pragma unroll
        for (int q = 0; q < 8; q++) { m0[q] = ys[q] * ry * nv[q]; m1[q] = ov[q] * ro * hv[q] * gs[q]; }
        pg8::u32x4 w0, w1;
        w0.x = pack_bf16(m0[0], m0[1]); w0.y = pack_bf16(m0[2], m0[3]); w0.z = pack_bf16(m0[4], m0[5]); w0.w = pack_bf16(m0[6], m0[7]);
        w1.x = pack_bf16(m1[0], m1[1]); w1.y = pack_bf16(m1[2], m1[3]); w1.z = pack_bf16(m1[4], m1[5]); w1.w = pack_bf16(m1[6], m1[7]);
        *(pg8::u32x4*)(MB + (size_t)r * D + c) = w0;
        *(pg8::u32x4*)(MB + (size_t)r * D + 512 + c) = w1;
    }
}

constexpr int N_PHASES = 22;
__global__ void __launch_bounds__(NT, 2) mega(KArgs ka) {
    extern __shared__ __attribute__((aligned(16))) unsigned char smem[];
    float* lds = (float*)smem;
    PG8_LAS unsigned char* glds = (PG8_LAS unsigned char*)smem;
    if (threadIdx.x < 4) ((unsigned*)(smem + LDS_BYTES - 16))[threadIdx.x] = 0u;
    __syncthreads();
    XcdBarrier gbar = xcd_barrier_post((unsigned*)(ka.ws + OFF_BAR), (volatile LAS3 unsigned*)(smem + LDS_BYTES - 16));
    Params p;
    p.in = (const float* const*)(ka.ws + OFF_TAB); p.out = ka.out; p.ws = ka.ws;
    p.wave_id = __builtin_amdgcn_readfirstlane(threadIdx.x >> 6);
    float* XA = wsp<float>(p, OFF_XA);
    float* XB = wsp<float>(p, OFF_XB);
    float* XC = wsp<float>(p, OFF_XC);
    bf16_t* PB = wsp<bf16_t>(p, OFF_P);
    const int G = gridDim.x, bid = blockIdx.x;
#ifndef ONLY
#define ONLY -1
#endif
#ifndef PHMASK
#define PHMASK 0xFFFFFFFFull
#endif
#define IN(k) ((ONLY < 0 || ONLY == (k)) && ((PHMASK >> (k)) & 1ull))
#ifndef REPMASK
#define REPMASK 0ull
#endif
#define NREP(k) (IN(k) ? ((((REPMASK) >> (k)) & 1ull) ? 2 : 1) : 0)
#ifndef PROBE_LO
#define PROBE_LO -1
#define PROBE_HI -1
#define PROBE_AMP 4
#endif
    volatile unsigned long long* tsl = (volatile unsigned long long*)(smem + LDS_BYTES - 512);
    int nstamp = 0;
#define STAMP() do { if (PROBE_LO >= 0) { if (tid_of_wave(p.wave_id) == 0) tsl[nstamp] = __builtin_amdgcn_s_memrealtime(); ++nstamp; } } while (0)
    STAMP();
#define SEAM(k) do { xcd_barrier(gbar, p.wave_id); STAMP(); } while (0)
#define SUBSTAMP() do { if (PROBE_LO >= 0) { __syncthreads(); STAMP(); } } while (0)
    if (blockIdx.x == 0 && threadIdx.x == 0) {
#pragma unroll
        for (int i = 0; i < N_IN; i++) ((const float**)(ka.ws + OFF_TAB))[i] = ka.in[i];
    }
    for (int _r = 0; _r < NREP(0); _r++) { if (_r) SEAM(0); ph_prologue(ka, lds); ph_convert_weights(ka);
    }
    SEAM(0);
    for (int _r = 0; _r < NREP(1); _r++) { if (_r) SEAM(1);
            prep_rows<false>(p, lds, p.in[I_X], p.in[I_CTX], R, p.in[I_NORMG] + 0, 0, 0); SUBSTAMP();
            ph_filter_gemm_lat(p, smem); ph_filter_gemm_ctx(p, lds);
    }
    SEAM(1);
    for (int _r = 0; _r < NREP(2); _r++) { if (_r) SEAM(2);
            { pg8::StaticOrder S; S.init(R, EVEN_IN, G, bid);
              pg8::gemm_phase(p.wave_id, glds, pg8::Gemm{wsp<bf16_t>(p, OFF_HB), wsp<bf16_t>(p, OFF_WINE), D}, S, pg8::EpiStoreBf16{PB, EVEN_IN, EVEN_IN}); } SUBSTAMP();
            ph_filter_fft(p, smem); ph_filter_abs_ctx(p);
    }
    SEAM(2);
    for (int _r = 0; _r < NREP(3); _r++) { if (_r) SEAM(3); ph_qk_dwconv(p); SUBSTAMP(); ph_dwconv_t(p, lds);
    }
    SEAM(3);
    for (int _r = 0; _r < NREP(4); _r++) { if (_r) SEAM(4); ph_hyena_fft(p, smem); SUBSTAMP(); ph_attention_mfma(p, smem); SUBSTAMP(); ph_hyena_conv(p, 0);
    }
    SEAM(4);
    for (int _r = 0; _r < NREP(5); _r++) { if (_r) SEAM(5); ph_hy_transpose(p, smem); ph_hyena_conv(p, 1);
    }
    SEAM(5);
    for (int _r = 0; _r < NREP(6); _r++) { if (_r) SEAM(6);
            { pg8::StaticOrder S; S.init(R, D, G, bid);
              pg8::gemm_phase(p.wave_id, glds, pg8::Gemm{wsp<bf16_t>(p, OFF_MB), wsp<bf16_t>(p, OFF_WOUT), D}, S,
                              pg8::EpiResid{p.in[I_X], p.in[I_CTX], modp(p, 0, 0, 0) + 2048, modp(p, 0, 1, 0) + 2048, XA}); }
    }
    SEAM(6);
    for (int _r = 0; _r < NREP(7); _r++) { if (_r) SEAM(7); prep_router(p, smem, XA, XA + (size_t)L * D, R, p.in[I_NORMG] + 1024, 0, 1);
    }
    SEAM(7);
    for (int _r = 0; _r < NREP(8); _r++) { if (_r) SEAM(8); ph_moe_scatter(p, lds, 0, R);
    }
    SEAM(8);
    for (int _r = 0; _r < NREP(9); _r++) { if (_r) SEAM(9); ph_moe_gemm1(p, glds, 0);
    }
    SEAM(9);
    for (int _r = 0; _r < NREP(10); _r++) { if (_r) SEAM(10); ph_moe_gemm2(p, glds, 0);
    }
    SEAM(10);
    for (int _r = 0; _r < NREP(11); _r++) { if (_r) SEAM(11); ph_moe_combine<true>(p, 0, R, XA, XB, 1);
    }
    SEAM(11);
    for (int _r = 0; _r < NREP(12); _r++) { if (_r) SEAM(12);
            { pg8::StaticOrder S; S.init(R, ODD_PAD, G, bid);
              pg8::gemm_phase(p.wave_id, glds, pg8::Gemm{wsp<bf16_t>(p, OFF_HB), wsp<bf16_t>(p, OFF_WINO), D}, S, pg8::EpiStoreBf16{PB, ODD_IN, ODD_IN}); }
    }
    SEAM(12);
    for (int _r = 0; _r < NREP(13); _r++) { if (_r) SEAM(13); ph_streams(p);
    }
    SEAM(13);
    for (int _r = 0; _r < NREP(14); _r++) { if (_r) SEAM(14); ph_ssd_s1(p, smem); SUBSTAMP(); ph_hg_s1(p, smem);
    }
    SEAM(14);
    for (int _r = 0; _r < NREP(22); _r++) { if (_r) SEAM(22); ph_ssd_s2(p); ph_hg_s2(p);
    }
    SEAM(22);
    for (int _r = 0; _r < NREP(23); _r++) { if (_r) SEAM(23); ph_ssd_s3(p, smem); SUBSTAMP(); ph_hg_s3(p, smem);
    }
    SEAM(23);
    for (int _r = 0; _r < NREP(15); _r++) { if (_r) SEAM(15); ph_merge(p);
    }
    SEAM(15);
    for (int _r = 0; _r < NREP(16); _r++) { if (_r) SEAM(16);
            { pg8::StaticOrder S; S.init(L, D, G, bid);
              pg8::gemm_phase(p.wave_id, glds, pg8::Gemm{wsp<bf16_t>(p, OFF_MB), wsp<bf16_t>(p, OFF_WOUT) + (size_t)D * D, D}, S,
                              pg8::EpiResid{XB, XB, modp(p, 1, 0, 0) + 2048, modp(p, 1, 0, 0) + 2048, XC}); }
    }
    SEAM(16);
    for (int _r = 0; _r < NREP(17); _r++) { if (_r) SEAM(17); prep_router(p, smem, XC, XC, L, p.in[I_NORMG] + 3 * 1024, 1, 1);
    }
    SEAM(17);
    for (int _r = 0; _r < NREP(18); _r++) { if (_r) SEAM(18); ph_moe_scatter(p, lds, 1, L);
    }
    SEAM(18);
    for (int _r = 0; _r < NREP(19); _r++) { if (_r) SEAM(19); ph_moe_gemm1(p, glds, 1);
    }
    SEAM(19);
    for (int _r = 0; _r < NREP(20); _r++) { if (_r) SEAM(20); ph_moe_gemm2(p, glds, 1);
    }
    SEAM(20);
    for (int _r = 0; _r < NREP(21); _r++) { if (_r) SEAM(21); ph_moe_combine<false>(p, 1, L, XC, p.out, 0);
    }
    if (PROBE_LO >= 0) {
        STAMP();
        __syncthreads();
        const unsigned long long dtk = tsl[PROBE_HI] - tsl[PROBE_LO];
        const unsigned long long t0 = __builtin_amdgcn_s_memrealtime();
        while (__builtin_amdgcn_s_memrealtime() - t0 < (unsigned long long)PROBE_AMP * dtk) __builtin_amdgcn_s_sleep(8);
    }
#undef IN
#undef SEAM
}

extern "C" void kernel_launch(void* const* d_in, const int* in_sizes, int n_in, void* d_out, int out_size, void* d_ws, size_t ws_size,
                              hipStream_t stream) {
    static int grid_blocks = 0;
    if (!grid_blocks) {
        int dev = 0, cus = 0, per_cu = 0;
        hipGetDevice(&dev);
        hipDeviceGetAttribute(&cus, hipDeviceAttributeMultiprocessorCount, dev);
        hipFuncSetAttribute((const void*)mega, hipFuncAttributeMaxDynamicSharedMemorySize, LDS_BYTES);
        hipOccupancyMaxActiveBlocksPerMultiprocessor(&per_cu, mega, NT, LDS_BYTES);
        if (per_cu < 1) per_cu = 1;
        grid_blocks = cus;
        if (ws_size < WS_END) fprintf(stderr, "kernel_launch: workspace too small: %zu < %zu\n", ws_size, (size_t)WS_END);
    }
    hipMemsetAsync((char*)d_ws + OFF_CTL, 0, 65536, stream);
    KArgs p{};
    for (int i = 0; i < N_IN; i++) p.in[i] = (const float*)d_in[i];
    p.out = (float*)d_out;
    p.ws = (unsigned char*)d_ws;
    hipLaunchKernelGGL(mega, dim3(grid_blocks), dim3(NT), LDS_BYTES, stream, p);
}
```

```cpp
#include <hip/hip_runtime.h>
#include <cstdio>
#include <cstdint>

constexpr int L = 16384, NCX = 256, R = L + NCX, D = 1024;
constexpr int EVEN_IN = 2304, ODD_IN = 4112;
constexpr int NT = 512, NWAVE = 8;
constexpr int NEXP = 32;
constexpr int NROWS = 74752;
constexpr int ODD_PAD = 4352;
constexpr int LDS_BYTES = 147456;
typedef unsigned short bf16_t;
constexpr float EPS = 1e-6f;

enum { I_X = 0, I_C, I_CTX, I_CCTX, I_NORMG, I_ADAW, I_ADAB, I_WOUT, I_WINE, I_HYCW, I_HYCB, I_HYW1, I_HYB1, I_HYW2, I_HYB2,
       I_HYW3, I_HYB3, I_HYW4, I_HYFREQ, I_HYFB, I_QNORM, I_KNORM, I_SINK, I_WINO, I_SSDCW, I_SSDCB, I_DTB, I_ALOG, I_SSDD,
       I_SSDN, I_HGLB, I_HGN, I_RW, I_RB, I_WGU, I_BGU, I_WDN, I_BDN, N_IN };

constexpr size_t al256(size_t x) { return (x + 255) & ~(size_t)255; }
constexpr size_t OFF_CTL = 0;
constexpr size_t OFF_BAR = 1024;
constexpr size_t OFF_TAB = 32768;
constexpr size_t OFF_MOD = 65536;
constexpr size_t OFF_LB = OFF_MOD + al256(4 * 24576);
constexpr size_t OFF_STARTS = OFF_LB + 4096;
constexpr size_t OFF_ROPE = OFF_STARTS + 4096;
constexpr size_t OFF_HNP = OFF_ROPE + 32768;
constexpr size_t OFF_HD3 = OFF_HNP + al256(4 * 130 * 1024);
constexpr size_t OFF_HH = OFF_HD3 + al256(4ull * R * 64);
constexpr size_t OFF_HHC = OFF_HH + al256(4ull * 2 * L * 1024);
constexpr size_t OFF_XA = OFF_HHC + al256(4ull * 512 * 1024);
constexpr size_t OFF_XB = OFF_XA + al256(4ull * R * D);
constexpr size_t OFF_XC = OFF_XA;
constexpr size_t OFF_H = OFF_XB + al256(4ull * R * D);
constexpr size_t OFF_P = OFF_H + al256(4ull * R * D);
constexpr size_t OFF_QN = OFF_P + al256(4ull * R * ODD_IN);
constexpr size_t OFF_KN = OFF_QN + al256(4ull * R * 512);
constexpr size_t OFF_U = OFF_KN + al256(4ull * R * 128);
constexpr size_t OFF_Z1 = OFF_U + al256(4ull * R * 1536);
constexpr size_t OFF_TOPE = OFF_Z1 + al256(4ull * R * 512);
constexpr size_t OFF_TOPG = OFF_TOPE + al256(4ull * R * 4);
constexpr size_t OFF_TOPP = OFF_TOPG + al256(4ull * R * 4);
constexpr size_t OFF_ROWTOK = OFF_TOPP + al256(4ull * R * 4);
constexpr size_t OFF_YR = OFF_ROWTOK + al256(4ull * 2 * NROWS);
constexpr size_t OFF_XBC = OFF_U;
constexpr size_t OFF_DT = OFF_YR + al256(4ull * NROWS * 1024);
constexpr size_t OFF_F = OFF_HH;
constexpr size_t OFF_Q1 = OFF_F + al256(4ull * 2 * R * 512);
constexpr size_t OFF_Y = OFF_DT + al256(4ull * 2 * R * 8);
constexpr size_t OFF_O = OFF_Y + al256(4ull * 2 * R * 512);
constexpr size_t OFF_TILEE = OFF_O + al256(4ull * 2 * R * 512);
constexpr size_t OFF_SDEC = OFF_TILEE + 4096;
constexpr size_t OFF_BC = OFF_SDEC + 16384;
constexpr size_t OFF_HDEC = OFF_BC + 2 * 512 * 32 * 4;
constexpr size_t OFF_HB = OFF_HDEC + al256(4ull * 2 * 260 * 4 * 128);
constexpr size_t OFF_MB = OFF_HB + al256(2ull * R * D);
constexpr size_t OFF_XG = OFF_MB + al256(2ull * R * D);
constexpr size_t OFF_ACTB = OFF_XG + al256(2ull * NROWS * D);
constexpr size_t OFF_SST = OFF_XG;
constexpr size_t OFF_SSIN = OFF_SST + al256(2ull * 2 * 130 * 8 * 64 * 128);
constexpr size_t OFF_HST = OFF_SSIN + al256(2ull * 2 * 130 * 8 * 64 * 128);
constexpr size_t OFF_HSIN = OFF_ACTB;
constexpr size_t OFF_VB = OFF_KN + 2ull * R * 128;
constexpr size_t OFF_HT = OFF_ACTB;
constexpr size_t OFF_HF = OFF_XG;
constexpr size_t OFF_UC = OFF_U + 4ull * 1536 * L;
constexpr size_t OFF_HYT = OFF_Z1;
constexpr size_t OFF_WINE = OFF_ACTB + al256(2ull * NROWS * D);
constexpr size_t OFF_WINO = OFF_WINE + al256(2ull * EVEN_IN * D);
constexpr size_t OFF_WOUT = OFF_WINO + al256(2ull * ODD_PAD * D);
constexpr size_t OFF_WGU = OFF_WOUT + al256(2ull * 2 * D * D);
constexpr size_t OFF_WDN = OFF_WGU + al256(2ull * 2 * 32 * 2048 * D);
constexpr size_t WS_END = OFF_WDN + al256(2ull * 2 * 32 * 1024 * D);

struct KArgs {
    const float* in[N_IN];
    float* out;
    unsigned char* ws;
};
struct Params {
    const float* const* in;
    float* out;
    unsigned char* ws;
    int wave_id;
};

__device__ __forceinline__ int tid_opaque() { int t = threadIdx.x; asm volatile("" : "+v"(t)); return t; }
__device__ __forceinline__ int tid_of_wave(int wave_id) { unsigned m = ~0u; asm volatile("" : "+s"(m));
    int t = wave_id * 64 + (int)__builtin_amdgcn_mbcnt_hi(m, __builtin_amdgcn_mbcnt_lo(m, 0u)); asm volatile("" : "+v"(t)); return t; }

#define XB_TMO      128
#define XB_XCNT(j)  (256  + 64 * (j))
#define XB_XSUB(j)  (1280 + 64 * (j))
#define XB_XGEN(j)  (2304 + 64 * (j))
#define XB_TOP      3328
#define XB_TOPGEN   3392
#define XCD_BAR_WORDS 3456
#define XB_SPIN_CAP (1u << 22)
#define LAS3 __attribute__((address_space(3)))
__device__ __forceinline__ unsigned xb_ld(unsigned* p) { return __hip_atomic_load(p, __ATOMIC_RELAXED, __HIP_MEMORY_SCOPE_AGENT); }
__device__ __forceinline__ unsigned xb_add(unsigned* p, unsigned v) { return __hip_atomic_fetch_add(p, v, __ATOMIC_RELAXED, __HIP_MEMORY_SCOPE_AGENT); }
__device__ __forceinline__ unsigned xb_xcc_id() { return (unsigned)__builtin_amdgcn_s_getreg((3 << 11) | 20) & 0xFu; }
#define XB_SPIN(cond, bar) do { unsigned _sp = 0; while (cond) { __builtin_amdgcn_s_sleep(1); \
    if ((++_sp & 255u) == 0u) { if (xb_ld(&(bar)[XB_TMO])) break; if (_sp > XB_SPIN_CAP) { atomicAdd(&(bar)[XB_TMO], 1u); break; } } } } while (0)
struct XcdBarrier { unsigned* bar; unsigned x; volatile LAS3 unsigned* st; };
__device__ __forceinline__ XcdBarrier xcd_barrier_post(unsigned* bar, volatile LAS3 unsigned* st) {
    XcdBarrier b; b.bar = bar; b.x = xb_xcc_id(); b.st = st;
    if (threadIdx.x == 0) (void)xb_add(&bar[XB_XCNT(b.x)], 1u);
    return b;
}
__device__ __forceinline__ void xcd_barrier_complete(unsigned* bar, unsigned x, unsigned& nloc, unsigned& nx) {
    const unsigned G = gridDim.x * gridDim.y * gridDim.z;
    unsigned sum, cnt, mine, sp = 0u;
    for (;;) {
        sum = 0u; cnt = 0u; mine = 0u;
#pragma unroll
        for (unsigned j = 0; j < 16; ++j) { const unsigned c = xb_ld(&bar[XB_XCNT(j)]); sum += c; cnt += (c > 0u) ? 1u : 0u; mine = (j == x) ? c : mine; }
        if (sum == G) break;
        __builtin_amdgcn_s_sleep(1);
        if ((++sp & 255u) == 0u) { if (xb_ld(&bar[XB_TMO])) break; if (sp > XB_SPIN_CAP) { atomicAdd(&bar[XB_TMO], 1u); break; } }
    }
    nloc = mine > 0u ? mine : 1u; nx = cnt > 0u ? cnt : 1u;
}
__device__ __forceinline__ void xcd_barrier(const XcdBarrier& b, int wave_id) {
    asm volatile("s_waitcnt vmcnt(0)" ::: "memory");
    __syncthreads();
    if (tid_of_wave(wave_id) == 0) {
        unsigned* bar = b.bar;
        __builtin_amdgcn_s_waitcnt(0);
        unsigned nloc = b.st[0], nx = b.st[1];
        if (nloc == 0u) { xcd_barrier_complete(bar, b.x, nloc, nx); b.st[0] = nloc; b.st[1] = nx; }
        const unsigned old = xb_add(&bar[XB_XSUB(b.x)], 1u);
        const unsigned gen = old / nloc;
        if (old + 1u == (gen + 1u) * nloc) {
            __builtin_amdgcn_fence(__ATOMIC_RELEASE, "agent");
            asm volatile("s_waitcnt vmcnt(0)" ::: "memory");
            const unsigned og = xb_add(&bar[XB_TOP], 1u);
            const unsigned tg = og / nx;
            if (og + 1u == (tg + 1u) * nx) xb_add(&bar[XB_TOPGEN], 1u);
            else XB_SPIN(xb_ld(&bar[XB_TOPGEN]) == tg, bar);
            __builtin_amdgcn_fence(__ATOMIC_ACQUIRE, "agent");
            xb_add(&bar[XB_XGEN(b.x)], 1u);
            asm volatile("s_waitcnt vmcnt(0)" ::: "memory");
        } else {
            XB_SPIN(xb_ld(&bar[XB_XGEN(b.x)]) == gen, bar);
            __builtin_amdgcn_fence(__ATOMIC_ACQUIRE, "agent");
            asm volatile("s_waitcnt vmcnt(0)" ::: "memory");
        }
    }
    __syncthreads();
}
__device__ __forceinline__ float silu_f(float x) { return x / (1.f + expf(-x)); }
__device__ __forceinline__ float sigmoid_f(float x) { return 1.f / (1.f + expf(-x)); }
__device__ __forceinline__ float sigmoid_fast(float x) { return __builtin_amdgcn_rcpf(1.f + __expf(-x)); }
__device__ __forceinline__ float silu_fast(float x) { return x * __builtin_amdgcn_rcpf(1.f + __expf(-x)); }
__device__ __forceinline__ float softplus_f(float x) { return x > 20.f ? x : log1pf(expf(x)); }
__device__ __forceinline__ float lane_xor(int lane, float v, int mask) { return __int_as_float(__builtin_amdgcn_ds_bpermute((lane ^ mask) << 2, __float_as_int(v))); }
__device__ __forceinline__ float lane_get(float v, int src) { return __int_as_float(__builtin_amdgcn_ds_bpermute(src << 2, __float_as_int(v))); }
template <int CTRL> __device__ __forceinline__ float dpp_f(float v) { return __int_as_float(__builtin_amdgcn_update_dpp(0, __float_as_int(v), CTRL, 0xF, 0xF, false)); }
__device__ __forceinline__ float wave_sum(int lane, float v) {
    v += dpp_f<0xB1>(v);
    v += dpp_f<0x4E>(v);
    v += dpp_f<0x141>(v);
    v += dpp_f<0x140>(v);
    v += lane_xor(lane, v, 16);
    v += lane_xor(lane, v, 32);
    return v;
}
__device__ __forceinline__ float wave_max(int lane, float v) {
    v = fmaxf(v, dpp_f<0xB1>(v));
    v = fmaxf(v, dpp_f<0x4E>(v));
    v = fmaxf(v, dpp_f<0x141>(v));
    v = fmaxf(v, dpp_f<0x140>(v));
    v = fmaxf(v, lane_xor(lane, v, 16));
    v = fmaxf(v, lane_xor(lane, v, 32));
    return v;
}
template <class T, class PT> __device__ __forceinline__ T* wsp(const PT& p, size_t off) { return (T*)(p.ws + off); }
__device__ __forceinline__ const float* modp(const Params& p, int layer, int cond, int j) {
    return wsp<float>(p, OFF_MOD) + (layer * 2 + cond) * 6144 + j * 3072;
}

__device__ __forceinline__ bf16_t f2bf(float f) { unsigned u = __float_as_uint(f); u += 0x7FFFu + ((u >> 16) & 1u); return (bf16_t)(u >> 16); }
__device__ __forceinline__ unsigned pack_bf16(float lo, float hi) { return (unsigned)f2bf(lo) | ((unsigned)f2bf(hi) << 16); }

namespace pg8 {
#define PG8_LAS __attribute__((address_space(3)))
typedef short bf16x8 __attribute__((ext_vector_type(8)));
typedef float f32x4 __attribute__((ext_vector_type(4)));
typedef unsigned u32x4 __attribute__((ext_vector_type(4)));
constexpr int BM = 256, BK = 64, HALF = 128, HTB = HALF * BK * 2, STAGE_BYTES = 8 * HTB, NXCD = 8, WGM = 8;
__device__ __forceinline__ int lds_byte(int r, int c) { const int st = (r >> 4) * 2 + (c >> 5), rr = r & 15, cc = c & 31, ob = rr * 64 + cc * 2; return st * 1024 + (ob ^ (((ob >> 9) & 1) << 5)); }
__device__ __forceinline__ void stage_rc(int b, int& Rr, int& C) { const int st = b / 1024, sb = b % 1024, swz = sb ^ (((sb >> 9) & 1) << 5); Rr = (st >> 1) * 16 + swz / 64; C = (st & 1) * 32 + (swz % 64) / 2; }
__device__ __forceinline__ int perm32(int rho) { const int n = rho >> 4, i = rho & 15; return 8 * (i >> 2) + 4 * n + (i & 3); }
struct Unit { int pm, pn, pb, e; };
struct Gemm { const bf16_t* A; const bf16_t* Bt; int K; };
struct StaticOrder {
    int nM, nN, nwg, G, c;
    __device__ void init(int M, int N, int G_, int c_) { nM = M / BM; nN = N / BM; nwg = nM * nN; G = G_; c = c_; }
    __device__ bool next(int i, Unit& u) const {
        const long Lx = (long)i * G + c; if (Lx >= nwg) return false;
        int wgid = (int)Lx; { const int q = nwg / NXCD, r = nwg % NXCD, xcd = wgid % NXCD, off = wgid / NXCD; wgid = (xcd < r ? xcd * (q + 1) : r * (q + 1) + (xcd - r) * q) + off; }
        const int nig = WGM * nN, gid = wgid / nig, fm = gid * WGM, gsz = (nM - fm) < WGM ? (nM - fm) : WGM;
        u.pm = fm + ((wgid % nig) % gsz); u.pn = (wgid % nig) / gsz; u.pb = u.pn; u.e = 0; return true;
    }
};
struct MoeOrder {
    const int* tile_e; int ntile, nN, G, c;
    __device__ bool next(int i, Unit& u) const {
        const long Lx = (long)i * G + c; if (Lx >= (long)ntile * nN) return false;
        u.pm = (int)(Lx / nN); u.pn = (int)(Lx % nN); u.e = tile_e[u.pm]; u.pb = u.e * nN + u.pn; return true;
    }
};
struct EpiStoreF32 {
    static constexpr bool PERM = false;
    float* C; int ldc; int nvalid;
    __device__ __forceinline__ void operator()(const f32x4 (&acc)[2][2][4][2], const Unit& u, int wr, int wc, int fr, int fq) const {
        const int row0 = u.pm * BM + wr * 64 + fr, col0 = u.pn * BM + wc * 32 + 4 * fq;
#pragma unroll
        for (int ai = 0; ai < 2; ++ai)
#pragma unroll
            for (int m = 0; m < 4; ++m) { float* rowp = C + (size_t)(row0 + ai * HALF + m * 16) * ldc + col0;
#pragma unroll
                for (int bj = 0; bj < 2; ++bj)
#pragma unroll
                    for (int n = 0; n < 2; ++n) if (col0 + bj * HALF + n * 16 < nvalid) *(f32x4*)(rowp + bj * HALF + n * 16) = acc[ai][bj][m][n]; }
    }
};
struct EpiStoreBf16 {
    static constexpr bool PERM = true;
    bf16_t* C; int ldc; int nvalid;
    __device__ __forceinline__ void operator()(const f32x4 (&acc)[2][2][4][2], const Unit& u, int wr, int wc, int fr, int fq) const {
        const int row0 = u.pm * BM + wr * 64 + fr, col0 = u.pn * BM + wc * 32 + 8 * fq;
#pragma unroll
        for (int ai = 0; ai < 2; ++ai)
#pragma unroll
            for (int m = 0; m < 4; ++m) { bf16_t* rowp = C + (size_t)(row0 + ai * HALF + m * 16) * ldc + col0;
#pragma unroll
                for (int bj = 0; bj < 2; ++bj) if (col0 + bj * HALF < nvalid) {
                    const f32x4 v0 = acc[ai][bj][m][0], v1 = acc[ai][bj][m][1];
                    u32x4 w; w.x = pack_bf16(v0[0], v0[1]); w.y = pack_bf16(v0[2], v0[3]); w.z = pack_bf16(v1[0], v1[1]); w.w = pack_bf16(v1[2], v1[3]);
                    *(u32x4*)(rowp + bj * HALF) = w; } }
    }
};
struct EpiResid {
    static constexpr bool PERM = false;
    const float* res_lat; const float* res_ctx; const float* gt_lat; const float* gt_ctx; float* out;
    __device__ __forceinline__ void operator()(const f32x4 (&acc)[2][2][4][2], const Unit& u, int wr, int wc, int fr, int fq) const {
        const int row0 = u.pm * BM + wr * 64 + fr, col0 = u.pn * BM + wc * 32 + 4 * fq;
        const bool ctx = (u.pm * BM) >= L;
        const float* gt = ctx ? gt_ctx : gt_lat;
        f32x4 gv[2][2];
#pragma unroll
        for (int bj = 0; bj < 2; ++bj)
#pragma unroll
            for (int n = 0; n < 2; ++n) gv[bj][n] = *(const f32x4*)(gt + col0 + bj * HALF + n * 16);
#pragma unroll
        for (int ai = 0; ai < 2; ++ai) {
            f32x4 rv[4][2][2];
#pragma unroll
            for (int m = 0; m < 4; ++m) { const int row = row0 + ai * HALF + m * 16;
                const float* rp = (ctx ? res_ctx + (size_t)(row - L) * D : res_lat + (size_t)row * D) + col0;
#pragma unroll
                for (int bj = 0; bj < 2; ++bj)
#pragma unroll
                    for (int n = 0; n < 2; ++n) rv[m][bj][n] = *(const f32x4*)(rp + bj * HALF + n * 16); }
#pragma unroll
            for (int m = 0; m < 4; ++m) { float* op = out + (size_t)(row0 + ai * HALF + m * 16) * D + col0;
#pragma unroll
                for (int bj = 0; bj < 2; ++bj)
#pragma unroll
                    for (int n = 0; n < 2; ++n) *(f32x4*)(op + bj * HALF + n * 16) = rv[m][bj][n] + gv[bj][n] * acc[ai][bj][m][n]; }
            asm volatile("" ::: "memory");
        }
    }
};
struct EpiMoe1 {
    static constexpr bool PERM = true;
    bf16_t* ACT; const float* bgu;
    __device__ __forceinline__ void operator()(const f32x4 (&acc)[2][2][4][2], const Unit& u, int wr, int wc, int fr, int fq) const {
        const int row0 = u.pm * BM + wr * 64 + fr, col0 = u.pn * HALF + wc * 32 + 8 * fq;
        const float* bg = bgu + (size_t)u.e * 2048 + col0;
        f32x4 bgv[2], buv[2];
#pragma unroll
        for (int n = 0; n < 2; ++n) { bgv[n] = *(const f32x4*)(bg + 4 * n); buv[n] = *(const f32x4*)(bg + 1024 + 4 * n); }
#pragma unroll
        for (int ai = 0; ai < 2; ++ai)
#pragma unroll
            for (int m = 0; m < 4; ++m) {
                float a[8];
#pragma unroll
                for (int n = 0; n < 2; ++n) { const f32x4 g4 = acc[ai][0][m][n] + bgv[n], u4 = acc[ai][1][m][n] + buv[n];
#pragma unroll
                    for (int j = 0; j < 4; ++j) { const float gate = fminf(g4[j], 7.f), up = fminf(fmaxf(u4[j], -7.f), 7.f);
                        a[n * 4 + j] = (up + 1.f) * gate * __builtin_amdgcn_rcpf(1.f + __expf(-1.702f * gate)); } }
                u32x4 w; w.x = pack_bf16(a[0], a[1]); w.y = pack_bf16(a[2], a[3]); w.z = pack_bf16(a[4], a[5]); w.w = pack_bf16(a[6], a[7]);
                *(u32x4*)(ACT + (size_t)(row0 + ai * HALF + m * 16) * 1024 + col0) = w;
                asm volatile("" ::: "memory"); }
    }
};
struct EpiMoe2 {
    static constexpr bool PERM = true;
    bf16_t* YR; const float* bdn;
    __device__ __forceinline__ void operator()(const f32x4 (&acc)[2][2][4][2], const Unit& u, int wr, int wc, int fr, int fq) const {
        const int row0 = u.pm * BM + wr * 64 + fr, col0 = u.pn * BM + wc * 32 + 8 * fq;
        const float* bd = bdn + (size_t)u.e * 1024 + col0;
        f32x4 bv[2][2];
#pragma unroll
        for (int bj = 0; bj < 2; ++bj)
#pragma unroll
            for (int n = 0; n < 2; ++n) bv[bj][n] = *(const f32x4*)(bd + bj * HALF + 4 * n);
#pragma unroll
        for (int ai = 0; ai < 2; ++ai)
#pragma unroll
            for (int m = 0; m < 4; ++m) { bf16_t* rowp = YR + (size_t)(row0 + ai * HALF + m * 16) * 1024 + col0;
#pragma unroll
                for (int bj = 0; bj < 2; ++bj) {
                    const f32x4 v0 = acc[ai][bj][m][0] + bv[bj][0], v1 = acc[ai][bj][m][1] + bv[bj][1];
                    u32x4 w; w.x = pack_bf16(v0[0], v0[1]); w.y = pack_bf16(v0[2], v0[3]); w.z = pack_bf16(v1[0], v1[1]); w.w = pack_bf16(v1[2], v1[3]);
                    *(u32x4*)(rowp + bj * HALF) = w; }
                asm volatile("" ::: "memory"); }
    }
};
template <class Epi, class Sched>
__device__ __forceinline__ void gemm_phase(int wave_id, PG8_LAS unsigned char* lds, const Gemm g, const Sched& S, const Epi& E) {
    const int TIDX = tid_of_wave(wave_id);
    const int tid = TIDX, wid = __builtin_amdgcn_readfirstlane(tid >> 6), lane = tid & 63, wr = wid >> 2, wc = wid & 3, fr = lane & 15, fq = lane >> 4;
    const int K = g.K, nt = K / BK;
    unsigned voffA[2], voffB[2];
#pragma unroll
    for (int i = 0; i < 2; ++i) { int Rr, C; stage_rc(tid * 16 + i * 8192, Rr, C); const int Rb = Epi::PERM ? ((Rr & ~31) + perm32(Rr & 31)) : Rr;
        voffA[i] = (unsigned)(Rr * K + C) * 2u; voffB[i] = (unsigned)(Rb * K + C) * 2u; }
    const size_t kstep = (size_t)(BK * 2);
    const size_t hstep = (size_t)HALF * K * 2;
    const size_t tstep = 2 * hstep;
    const unsigned ldsw = (unsigned)wid * 1024u;
    const int aoff = lds_byte(wr * 64 + fr, fq * 8), boff = lds_byte(wc * 32 + fr, fq * 8);
#define PG8_SA(b, h) (((b) * 2 + (h)) * HTB)
#define PG8_SB(b, h) ((4 + (b) * 2 + (h)) * HTB)
#define PG8_STAGE(bufoff, gbase, voff) do { _Pragma("unroll") for (int _i = 0; _i < 2; ++_i) \
        __builtin_amdgcn_global_load_lds((const unsigned*)((const char*)(gbase) + (voff)[_i]), (PG8_LAS unsigned*)(lds + (bufoff) + ldsw + _i * 8192), 16, 0, 0); } while (0)
#define PG8_LDA(dst, b, h) do { _Pragma("unroll") for (int m = 0; m < 4; ++m) _Pragma("unroll") for (int k = 0; k < 2; ++k) dst[m][k] = *(const PG8_LAS bf16x8*)(lds + PG8_SA(b, h) + aoff + m * 2048 + k * 1024); } while (0)
#define PG8_LDB(dst, b, h) do { _Pragma("unroll") for (int n = 0; n < 2; ++n) _Pragma("unroll") for (int k = 0; k < 2; ++k) dst[n][k] = *(const PG8_LAS bf16x8*)(lds + PG8_SB(b, h) + boff + n * 2048 + k * 1024); } while (0)
#define PG8_MMA(ai, bj, At, Bt) do { __builtin_amdgcn_s_setprio(1); _Pragma("unroll") for (int m = 0; m < 4; ++m) _Pragma("unroll") for (int n = 0; n < 2; ++n) _Pragma("unroll") for (int k = 0; k < 2; ++k) \
        acc[ai][bj][m][n] = __builtin_amdgcn_mfma_f32_16x16x32_bf16(Bt[n][k], At[m][k], acc[ai][bj][m][n], 0, 0, 0); __builtin_amdgcn_s_setprio(0); } while (0)
#define PG8_WAIT_V(n) asm volatile("s_waitcnt vmcnt(" #n ")" ::: "memory")
#define PG8_WAIT_L(n) asm volatile("s_waitcnt lgkmcnt(" #n ")" ::: "memory")
#define PG8_BAR __builtin_amdgcn_s_barrier()
#define PG8_SCHED __builtin_amdgcn_sched_barrier(0)
    Unit cur, nxt; int ui = 0;
    if (!S.next(0, cur)) return;
    f32x4 acc[2][2][4][2];
#pragma unroll
    for (int a = 0; a < 2; ++a)
#pragma unroll
        for (int b = 0; b < 2; ++b)
#pragma unroll
            for (int m = 0; m < 4; ++m)
#pragma unroll
                for (int n = 0; n < 2; ++n) acc[a][b][m][n] = (f32x4){0.f, 0.f, 0.f, 0.f};
    bf16x8 At[4][2], B0[2][2], B1[2][2];
    const char* cA = (const char*)g.A + (size_t)cur.pm * tstep; const char* cB = (const char*)g.Bt + (size_t)cur.pb * tstep;
    PG8_STAGE(PG8_SB(0, 0), cB, voffB); PG8_STAGE(PG8_SA(0, 0), cA, voffA); PG8_STAGE(PG8_SB(0, 1), cB + hstep, voffB); PG8_STAGE(PG8_SA(0, 1), cA + hstep, voffA);
    if (wr == 1) PG8_BAR;
    PG8_WAIT_V(4); PG8_BAR;
    PG8_STAGE(PG8_SB(1, 0), cB + kstep, voffB); PG8_STAGE(PG8_SA(1, 0), cA + kstep, voffA); PG8_STAGE(PG8_SB(1, 1), cB + hstep + kstep, voffB);
    PG8_WAIT_V(6); PG8_BAR;
    for (;;) {
        const bool has_next = S.next(ui + 1, nxt);
        const char* nA = has_next ? (const char*)g.A + (size_t)nxt.pm * tstep : cA; const char* nB = has_next ? (const char*)g.Bt + (size_t)nxt.pb * tstep : cB;
        for (int t = 0; t < nt; t += 2) {
            const bool last = (t == nt - 2);
            const char* a1 = cA + (size_t)(t + 1) * kstep;
            const char* a2 = last ? nA : cA + (size_t)(t + 2) * kstep; const char* b2 = last ? nB : cB + (size_t)(t + 2) * kstep;
            const char* a3 = a2 + kstep; const char* b3 = b2 + kstep;
            PG8_LDB(B0, 0, 0); PG8_SCHED; PG8_LDA(At, 0, 0); PG8_STAGE(PG8_SA(1, 1), a1 + hstep, voffA);
            PG8_WAIT_L(8); PG8_BAR; PG8_WAIT_L(0); PG8_MMA(0, 0, At, B0); PG8_BAR; PG8_SCHED;
            PG8_LDB(B1, 0, 1); PG8_STAGE(PG8_SB(0, 0), b2, voffB);
            PG8_BAR; PG8_WAIT_L(0); PG8_MMA(0, 1, At, B1); PG8_BAR;
            PG8_LDA(At, 0, 1); PG8_STAGE(PG8_SA(0, 0), a2, voffA);
            PG8_BAR; PG8_WAIT_L(0); PG8_MMA(1, 0, At, B0); PG8_BAR; PG8_SCHED;
            PG8_STAGE(PG8_SB(0, 1), b2 + hstep, voffB);
            PG8_WAIT_V(6); PG8_BAR; PG8_MMA(1, 1, At, B1); PG8_BAR;
            PG8_LDB(B0, 1, 0); PG8_SCHED; PG8_LDA(At, 1, 0); PG8_STAGE(PG8_SA(0, 1), a2 + hstep, voffA);
            PG8_WAIT_L(8); PG8_BAR; PG8_WAIT_L(0); PG8_MMA(0, 0, At, B0); PG8_BAR; PG8_SCHED;
            PG8_LDB(B1, 1, 1); PG8_STAGE(PG8_SB(1, 0), b3, voffB);
            PG8_BAR; PG8_WAIT_L(0); PG8_MMA(0, 1, At, B1); PG8_BAR;
            PG8_LDA(At, 1, 1); PG8_STAGE(PG8_SA(1, 0), a3, voffA);
            PG8_BAR; PG8_WAIT_L(0); PG8_MMA(1, 0, At, B0); PG8_BAR; PG8_SCHED;
            PG8_STAGE(PG8_SB(1, 1), b3 + hstep, voffB);
            PG8_WAIT_V(6); PG8_BAR; PG8_MMA(1, 1, At, B1); PG8_BAR;
        }
        E(acc, cur, wr, wc, fr, fq);
        if (!has_next) break;
#pragma unroll
        for (int a = 0; a < 2; ++a)
#pragma unroll
            for (int b = 0; b < 2; ++b)
#pragma unroll
                for (int m = 0; m < 4; ++m)
#pragma unroll
                    for (int n = 0; n < 2; ++n) acc[a][b][m][n] = (f32x4){0.f, 0.f, 0.f, 0.f};
        cur = nxt; cA = nA; cB = nB; ++ui;
    }
    PG8_WAIT_V(0);
    if (wr == 0) PG8_BAR;
    PG8_BAR;
#undef PG8_SA
#undef PG8_SB
#undef PG8_STAGE
#undef PG8_LDA
#undef PG8_LDB
#undef PG8_MMA
#undef PG8_WAIT_V
#undef PG8_WAIT_L
#undef PG8_BAR
#undef PG8_SCHED
}
}

typedef unsigned u32x2_t __attribute__((ext_vector_type(2)));
typedef short bf16x8_t __attribute__((ext_vector_type(8)));
typedef float f32x16 __attribute__((ext_vector_type(16)));
typedef float f32x16f __attribute__((ext_vector_type(16)));
constexpr int LDP = 132;
template <int KSTEPS>
__device__ __forceinline__ f32x16 mma32(int lane, const bf16_t* As, int lda, const bf16_t* Bs, int ldb, f32x16 acc) {
    const int r = lane & 31, hh = lane >> 5;
    const bf16_t* ap = As + r * lda + 8 * hh;
    const bf16_t* bp = Bs + r * ldb + 8 * hh;
#pragma unroll 2
    for (int ks = 0; ks < KSTEPS; ks++) {
        const u32x2_t a0 = *(const u32x2_t*)(ap + ks * 16), a1 = *(const u32x2_t*)(ap + ks * 16 + 4);
        const u32x2_t b0 = *(const u32x2_t*)(bp + ks * 16), b1 = *(const u32x2_t*)(bp + ks * 16 + 4);
        pg8::u32x4 aw, bw; aw.x = a0.x; aw.y = a0.y; aw.z = a1.x; aw.w = a1.y; bw.x = b0.x; bw.y = b0.y; bw.z = b1.x; bw.w = b1.y;
        const bf16x8_t a = __builtin_bit_cast(bf16x8_t, aw), b = __builtin_bit_cast(bf16x8_t, bw);
        acc = __builtin_amdgcn_mfma_f32_32x32x16_bf16(a, b, acc, 0, 0, 0);
    }
    return acc;
}
#define CROW(reg, hf) (((reg) & 3) + 8 * ((reg) >> 2) + 4 * (hf))
__device__ __forceinline__ float bf2f(unsigned short b) { return __uint_as_float(((unsigned)b) << 16); }
__device__ __forceinline__ void lds_st16(bf16_t* d, pg8::u32x4 v) { u32x2_t lo, hi; lo.x = v.x; lo.y = v.y; hi.x = v.z; hi.y = v.w; *(u32x2_t*)d = lo; *(u32x2_t*)(d + 4) = hi; }

template <class PT>
__device__ __forceinline__ void ph_convert_weights(const PT& p) {
    const int TIDX = tid_opaque();
    const int lane = TIDX & 63, wave = TIDX >> 6, nl = lane & 31, kh = lane >> 5;
    constexpr int G_INE = EVEN_IN / 32, G_INO = ODD_PAD / 32, G_OUT = 2 * D / 32, G_GU = 64 * 2048 / 32, G_DN = 64 * 1024 / 32;
    constexpr int GT = G_INE + G_INO + G_OUT + G_GU + G_DN;
    for (int it = blockIdx.x * NWAVE + wave; it < GT * 16; it += gridDim.x * NWAVE) {
        const int item = __builtin_amdgcn_readfirstlane(it);
        int g = item % GT; const int kg = item / GT;
        const float* src; bf16_t* dst; int N, col0, nvalid;
        if (g < G_INE) { src = p.in[I_WINE]; N = EVEN_IN; col0 = g * 32; nvalid = EVEN_IN; dst = wsp<bf16_t>(p, OFF_WINE) + (size_t)g * 32 * 1024; }
        else if ((g -= G_INE) < G_INO) { src = p.in[I_WINO]; N = ODD_IN; col0 = g * 32; nvalid = ODD_IN; dst = wsp<bf16_t>(p, OFF_WINO) + (size_t)g * 32 * 1024; }
        else if ((g -= G_INO) < G_OUT) { const int l = g / 32, gg = g % 32; src = p.in[I_WOUT] + (size_t)l * D * D; N = D; col0 = gg * 32; nvalid = D; dst = wsp<bf16_t>(p, OFF_WOUT) + ((size_t)l * 1024 + gg * 32) * 1024; }
        else if ((g -= G_OUT) < G_GU) { const int le = g / 64, gg = g % 64, drow = gg * 32, T = drow >> 8, within = drow & 255;
            src = p.in[I_WGU] + (size_t)le * 1024 * 2048; N = 2048; nvalid = 2048;
            col0 = within < 128 ? 128 * T + within : 1024 + 128 * T + (within - 128);
            dst = wsp<bf16_t>(p, OFF_WGU) + ((size_t)le * 2048 + drow) * 1024; }
        else { g -= G_GU; const int le = g / 32, gg = g % 32; src = p.in[I_WDN] + (size_t)le * 1024 * 1024; N = 1024; col0 = gg * 32; nvalid = 1024; dst = wsp<bf16_t>(p, OFF_WDN) + ((size_t)le * 1024 + gg * 32) * 1024; }
        const bool ok = col0 + nl < nvalid;
        const float* sp = src + (size_t)(kg * 64 + kh * 8) * N + col0 + nl;
        float a[4][8];
#pragma unroll
        for (int ch = 0; ch < 4; ch++)
#pragma unroll
            for (int q = 0; q < 8; q++) a[ch][q] = ok ? sp[(size_t)(16 * ch + q) * N] : 0.f;
#pragma unroll
        for (int ch = 0; ch < 4; ch++) {
            pg8::u32x4 w; w.x = pack_bf16(a[ch][0], a[ch][1]); w.y = pack_bf16(a[ch][2], a[ch][3]); w.z = pack_bf16(a[ch][4], a[ch][5]); w.w = pack_bf16(a[ch][6], a[ch][7]);
            *(pg8::u32x4*)(dst + (size_t)nl * 1024 + kg * 64 + 16 * ch + kh * 8) = w;
        }
    }
}

template <class AL, class BL, class EP>
__device__ __forceinline__ void gemm_tile_f32(int wave_id, float* lds, int K, AL aload, BL bload, EP epi) {
    const int TIDX = tid_of_wave(wave_id);
    float(*As)[132] = (float(*)[132])lds;
    float(*Bs)[132] = (float(*)[132])(lds + 16 * 132);
    const int tid = TIDX, tx = tid & 15, ty = tid >> 4;
    float acc[4][8];
#pragma unroll
    for (int i = 0; i < 4; i++)
#pragma unroll
        for (int j = 0; j < 8; j++) acc[i][j] = 0.f;
    for (int k0 = 0; k0 < K; k0 += 16) {
        float av[4], bv[4];
#pragma unroll
        for (int i = 0; i < 4; i++) av[i] = aload((tid >> 4) + 32 * i, k0 + (tid & 15));
#pragma unroll
        for (int i = 0; i < 4; i++) bv[i] = bload(k0 + (tid >> 7) + 4 * i, tid & 127);
        __syncthreads();
#pragma unroll
        for (int i = 0; i < 4; i++) As[tid & 15][(tid >> 4) + 32 * i] = av[i];
#pragma unroll
        for (int i = 0; i < 4; i++) Bs[(tid >> 7) + 4 * i][tid & 127] = bv[i];
        __syncthreads();
#pragma unroll
        for (int k = 0; k < 16; k++) {
            const float4 a = *(const float4*)&As[k][ty * 4];
            const float4 b0 = *(const float4*)&Bs[k][tx * 4];
            const float4 b1 = *(const float4*)&Bs[k][64 + tx * 4];
            const float aa[4] = {a.x, a.y, a.z, a.w};
            const float bb[8] = {b0.x, b0.y, b0.z, b0.w, b1.x, b1.y, b1.z, b1.w};
#pragma unroll
            for (int i = 0; i < 4; i++)
#pragma unroll
                for (int j = 0; j < 8; j++) acc[i][j] = fmaf(aa[i], bb[j], acc[i][j]);
        }
    }
    __syncthreads();
#pragma unroll
    for (int i = 0; i < 4; i++) epi(ty * 4 + i, tx, acc[i]);
}
__device__ __forceinline__ int lcol(int tx, int jc) { return tx * 4 + (jc & 3) + 64 * (jc >> 2); }

template <class EP>
__device__ __forceinline__ void gemm_dense(int wave_id, float* lds, const float* A, int lda, const float* B, int N, int M, int K, EP epi) {
    const int tm = M / 128, tn = (N + 127) / 128;
    for (int t = blockIdx.x; t < tm * tn; t += gridDim.x) {
        const int m0 = (t / tn) * 128, n0 = (t % tn) * 128;
        gemm_tile_f32(
            wave_id, lds, K, [&](int r, int k) { return A[(size_t)(m0 + r) * lda + k]; },
            [&](int k, int c) { return (n0 + c < N) ? B[(size_t)k * N + n0 + c] : 0.f; },
            [&](int r, int tx, const float(&a)[8]) {
#pragma unroll
                for (int jc = 0; jc < 8; jc++) {
                    const int c = n0 + lcol(tx, jc);
                    if (c < N) epi(m0 + r, c, a[jc]);
                }
            });
    }
}

template <class PT>
__device__ __forceinline__ void ph_prologue(const PT& p, float* lds) {
    const int TIDX = tid_opaque();
    const int tid = TIDX, lane = tid & 63, wave = tid >> 6;
    const int gthreads = gridDim.x * NT, gtid = blockIdx.x * NT + tid;
    float* mod = wsp<float>(p, OFF_MOD);
    {
        float* sc = lds + 1024;
        float* red = lds + 3072;
        for (int k = tid; k < 1024; k += NT) { sc[k] = silu_f(p.in[I_C][k]); sc[1024 + k] = silu_f(p.in[I_CCTX][k]); }
        __syncthreads();
        for (int it = blockIdx.x; it < 2 * 96; it += gridDim.x) {
            const int layer = it / 96, n = (it % 96) * 64 + lane;
            const float* w = p.in[I_ADAW] + (size_t)layer * 1024 * 6144 + (size_t)wave * 128 * 6144 + n;
            float a0 = 0.f, a1 = 0.f;
#pragma unroll 8
            for (int k = 0; k < 128; k++) {
                const float wv = w[(size_t)k * 6144];
                a0 = fmaf(sc[wave * 128 + k], wv, a0);
                a1 = fmaf(sc[1024 + wave * 128 + k], wv, a1);
            }
            red[(wave * 2 + 0) * 64 + lane] = a0;
            red[(wave * 2 + 1) * 64 + lane] = a1;
            __syncthreads();
            if (wave < 2) {
                float a = p.in[I_ADAB][layer * 6144 + n];
#pragma unroll
                for (int w8 = 0; w8 < 8; w8++) a += red[(w8 * 2 + wave) * 64 + lane];
                mod[(layer * 2 + wave) * 6144 + n] = a;
            }
            __syncthreads();
        }
    }
    for (int it = gtid; it < 4096; it += gthreads) {
        const int pos = it >> 4, i = it & 15;
        const float ang = (float)pos * powf(10000.f, -(float)i / 16.f);
        wsp<float2>(p, OFF_ROPE)[it] = make_float2(cosf(ang), sinf(ang));
    }
    for (int it = gtid; it < 512; it += gthreads) {
        const float b0 = p.in[I_HGLB][it], b1 = p.in[I_HGLB][512 + it];
        wsp<float>(p, OFF_LB)[it] = 1.f / (1.f + expf(b0 - b1));
    }
    float* zb = lds + wave * 64;
    float* hd3 = wsp<float>(p, OFF_HD3);
    const float fq = p.in[I_HYFREQ][lane];
    float w1r[33], w2r[64], w3r[64];
#pragma unroll
    for (int i = 0; i < 33; i++) w1r[i] = p.in[I_HYW1][i * 64 + lane];
#pragma unroll
    for (int i = 0; i < 64; i++) { w2r[i] = p.in[I_HYW2][i * 64 + lane]; w3r[i] = p.in[I_HYW3][i * 64 + lane]; }
    const float b1 = p.in[I_HYB1][lane], b2 = p.in[I_HYB2][lane], b3 = p.in[I_HYB3][lane];
    for (int row = blockIdx.x * NWAVE + wave; row < R; row += gridDim.x * NWAVE) {
        const int Ls = row < L ? L : NCX, t = row < L ? row : row - L;
        const float tn = (float)t / (float)(Ls - 1);
        const float wang = 6.283185307179586f * (float)t / (float)Ls;
        if (lane < 33) {
            float z;
            if (lane == 0) z = tn;
            else {
                const int b = (lane - 1) & 15;
                const float fr = 1e-4f + (float)b * ((15.f - 1e-4f) / 15.f);
                z = (lane <= 16) ? cosf(fr * wang) : -sinf(fr * wang);
            }
            zb[lane] = z;
        }
        __builtin_amdgcn_wave_barrier();
        float a = b1;
#pragma unroll
        for (int i = 0; i < 33; i++) a = fmaf(zb[i], w1r[i], a);
        float h = sinf(fq * a);
        __builtin_amdgcn_wave_barrier();
        zb[lane] = h;
        __builtin_amdgcn_wave_barrier();
        a = b2;
#pragma unroll
        for (int i = 0; i < 64; i++) a = fmaf(zb[i], w2r[i], a);
        h = sinf(fq * a);
        __builtin_amdgcn_wave_barrier();
        zb[lane] = h;
        __builtin_amdgcn_wave_barrier();
        a = b3;
#pragma unroll
        for (int i = 0; i < 64; i++) a = fmaf(zb[i], w3r[i], a);
        h = sinf(fq * a);
        hd3[(size_t)row * 64 + lane] = h;
        __builtin_amdgcn_wave_barrier();
    }
}

template <bool ROUTER>
__device__ __forceinline__ void prep_rows(const Params& p, float* lds, const float* xl, const float* xc, int nrows, const float* g, int layer, int j) {
    const int TIDX = tid_of_wave(p.wave_id);
    const int lane = TIDX & 63, wave = TIDX >> 6;
    float* rwT = lds;
    int* lcnt = (int*)(lds + 32 * 1024);
    if (ROUTER) {
        __syncthreads();
        if (TIDX < 32) lcnt[TIDX] = 0;
        const float* rw = p.in[I_RW] + (size_t)layer * 1024 * 32;
#pragma unroll 4
        for (int idx = TIDX; idx < 1024 * 8; idx += NT) {
            const int c = idx >> 3, e4 = (idx & 7) * 4;
            const float4 w = *(const float4*)(rw + (size_t)c * 32 + e4);
            rwT[(e4 + 0) * 1024 + c] = w.x; rwT[(e4 + 1) * 1024 + c] = w.y; rwT[(e4 + 2) * 1024 + c] = w.z; rwT[(e4 + 3) * 1024 + c] = w.w;
        }
        __syncthreads();
    }
    bf16_t* HB = wsp<bf16_t>(p, OFF_HB);
    for (int r = blockIdx.x * NWAVE + wave; r < nrows; r += gridDim.x * NWAVE) {
        const float* src = r < L ? xl + (size_t)r * D : xc + (size_t)(r - L) * D;
        const float* md = modp(p, layer, r < L ? 0 : 1, j);
        float4 v[4];
        float ss = 0.f;
#pragma unroll
        for (int i = 0; i < 4; i++) { v[i] = *(const float4*)(src + 256 * i + 4 * lane); ss += v[i].x * v[i].x + v[i].y * v[i].y + v[i].z * v[i].z + v[i].w * v[i].w; }
        ss = wave_sum(lane, ss);
        const float rinv = rsqrtf(ss * (1.f / 1024.f) + EPS);
#pragma unroll
        for (int i = 0; i < 4; i++) {
            const int c = 256 * i + 4 * lane;
            const float4 g4 = *(const float4*)(g + c), sc4 = *(const float4*)(md + 1024 + c), sh4 = *(const float4*)(md + c);
            v[i].x = v[i].x * rinv * g4.x * (1.f + sc4.x) + sh4.x; v[i].y = v[i].y * rinv * g4.y * (1.f + sc4.y) + sh4.y;
            v[i].z = v[i].z * rinv * g4.z * (1.f + sc4.z) + sh4.z; v[i].w = v[i].w * rinv * g4.w * (1.f + sc4.w) + sh4.w;
            u32x2_t o; o.x = pack_bf16(v[i].x, v[i].y); o.y = pack_bf16(v[i].z, v[i].w);
            *(u32x2_t*)(HB + (size_t)r * D + c) = o;
        }
        if (ROUTER) {
            float lg[32];
#pragma unroll
            for (int e = 0; e < 32; e++) {
                float a = 0.f;
#pragma unroll
                for (int i = 0; i < 4; i++) {
                    const float4 w = *(const float4*)(rwT + e * 1024 + 256 * i + 4 * lane);
                    a = fmaf(v[i].x, w.x, a); a = fmaf(v[i].y, w.y, a); a = fmaf(v[i].z, w.z, a); a = fmaf(v[i].w, w.w, a);
                }
                lg[e] = a;
                if ((e & 3) == 3) asm volatile("" ::: "memory");
            }
#pragma unroll
            for (int e = 0; e < 32; e++) lg[e] = wave_sum(lane, lg[e]) + p.in[I_RB][layer * 32 + e];
            unsigned used = 0u;
            float tv[4];
            int ti[4];
#pragma unroll
            for (int k = 0; k < 4; k++) {
                float best = -INFINITY;
                int bi = 0;
#pragma unroll
                for (int e = 0; e < 32; e++) {
                    const bool ok = !((used >> e) & 1u) && (lg[e] > best);
                    best = ok ? lg[e] : best;
                    bi = ok ? e : bi;
                }
                used |= 1u << bi;
                tv[k] = best;
                ti[k] = bi;
            }
            float es[4], den = 0.f;
#pragma unroll
            for (int k = 0; k < 4; k++) { es[k] = expf(tv[k] - tv[0]); den += es[k]; }
            if (lane < 4) {
                int e = ti[0];
                float gg = es[0];
#pragma unroll
                for (int k = 1; k < 4; k++) { e = (lane == k) ? ti[k] : e; gg = (lane == k) ? es[k] : gg; }
                const int pos = atomicAdd(&lcnt[e], 1);
                wsp<int>(p, OFF_TOPE)[r * 4 + lane] = e;
                wsp<float>(p, OFF_TOPG)[r * 4 + lane] = gg / den;
                wsp<int>(p, OFF_TOPP)[r * 4 + lane] = pos;
            }
        }
    }
    if (ROUTER) {
        __syncthreads();
        if (TIDX < 32) wsp<int>(p, OFF_BC)[((size_t)layer * 512 + blockIdx.x) * 32 + TIDX] = lcnt[TIDX];
    }
}

__device__ __forceinline__ void prep_router(const Params& p, unsigned char* smem, const float* xl, const float* xc, int nrows, const float* g, int layer, int j) {
    const int TIDX = tid_of_wave(p.wave_id);
    const int tid = TIDX, lane = tid & 63, wave = tid >> 6, hf = lane >> 5;
    float* HTl = (float*)smem;
    int* lcnt = (int*)(smem + 32 * 1028 * 4);
    float* LGT = (float*)(smem + 32 * 1028 * 4 + 128);
    const float* rw = p.in[I_RW] + (size_t)layer * 1024 * 32;
    const float* rb = p.in[I_RB] + layer * 32;
    bf16_t* HB = wsp<bf16_t>(p, OFF_HB);
    if (tid < 32) lcnt[tid] = 0;
    for (int grp = blockIdx.x; grp < nrows / 32; grp += gridDim.x) {
        __syncthreads();
        float4 xv[4][4];
#pragma unroll
        for (int q = 0; q < 4; q++) {
            const int r = grp * 32 + wave * 4 + q;
            const float* src = r < L ? xl + (size_t)r * D : xc + (size_t)(r - L) * D;
#pragma unroll
            for (int i = 0; i < 4; i++) xv[q][i] = *(const float4*)(src + 256 * i + 4 * lane);
        }
#pragma unroll
        for (int q = 0; q < 4; q++) {
            const int rl = wave * 4 + q, r = grp * 32 + rl;
            const float* md = modp(p, layer, r < L ? 0 : 1, j);
            float4 v[4];
            float ss = 0.f;
#pragma unroll
            for (int i = 0; i < 4; i++) { v[i] = xv[q][i]; ss += v[i].x * v[i].x + v[i].y * v[i].y + v[i].z * v[i].z + v[i].w * v[i].w; }
            ss = wave_sum(lane, ss);
            const float rinv = rsqrtf(ss * (1.f / 1024.f) + EPS);
#pragma unroll
            for (int i = 0; i < 4; i++) {
                const int c = 256 * i + 4 * lane;
                const float4 g4 = *(const float4*)(g + c), sc4 = *(const float4*)(md + 1024 + c), sh4 = *(const float4*)(md + c);
                v[i].x = v[i].x * rinv * g4.x * (1.f + sc4.x) + sh4.x; v[i].y = v[i].y * rinv * g4.y * (1.f + sc4.y) + sh4.y;
                v[i].z = v[i].z * rinv * g4.z * (1.f + sc4.z) + sh4.z; v[i].w = v[i].w * rinv * g4.w * (1.f + sc4.w) + sh4.w;
                u32x2_t o; o.x = pack_bf16(v[i].x, v[i].y); o.y = pack_bf16(v[i].z, v[i].w);
                *(u32x2_t*)(HB + (size_t)r * D + c) = o;
                *(float4*)(HTl + rl * 1028 + c) = v[i];
            }
        }
        __syncthreads();
        f32x16f acc;
#pragma unroll
        for (int q = 0; q < 16; q++) acc[q] = 0.f;
        {
            const float* ap = HTl + (lane & 31) * 1028 + wave * 128 + hf;
            const float* bp = rw + (size_t)(wave * 128 + hf) * 32 + (lane & 31);
#pragma unroll 16
            for (int kk = 0; kk < 64; kk++) acc = __builtin_amdgcn_mfma_f32_32x32x2f32(ap[2 * kk], bp[(size_t)kk * 64], acc, 0, 0, 0);
        }
        __syncthreads();
        {
            float* part = HTl + wave * 1024 + (lane & 31);
#pragma unroll
            for (int q = 0; q < 16; q++) part[CROW(q, hf) * 32] = acc[q];
        }
        __syncthreads();
#pragma unroll
        for (int q = 0; q < 2; q++) {
            const int o = tid + 512 * q;
            float a = rb[o & 31];
#pragma unroll
            for (int w8 = 0; w8 < 8; w8++) a += HTl[w8 * 1024 + o];
            LGT[(o >> 5) * 33 + (o & 31)] = a;
        }
        __syncthreads();
        if (tid < 32) {
            const int r = grp * 32 + tid;
            float lg[32];
#pragma unroll
            for (int e = 0; e < 32; e++) lg[e] = LGT[tid * 33 + e];
            unsigned used = 0u;
            float tv[4];
            int ti[4];
#pragma unroll
            for (int k = 0; k < 4; k++) {
                float best = -INFINITY;
                int bi = 0;
#pragma unroll
                for (int e = 0; e < 32; e++) {
                    const bool ok = !((used >> e) & 1u) && (lg[e] > best);
                    best = ok ? lg[e] : best;
                    bi = ok ? e : bi;
                }
                used |= 1u << bi;
                tv[k] = best;
                ti[k] = bi;
            }
            float es[4], den = 0.f;
#pragma unroll
            for (int k = 0; k < 4; k++) { es[k] = expf(tv[k] - tv[0]); den += es[k]; }
            const float rden = 1.f / den;
            int pos[4];
#pragma unroll
            for (int k = 0; k < 4; k++) pos[k] = atomicAdd(&lcnt[ti[k]], 1);
            *(int4*)(wsp<int>(p, OFF_TOPE) + r * 4) = make_int4(ti[0], ti[1], ti[2], ti[3]);
            *(float4*)(wsp<float>(p, OFF_TOPG) + r * 4) = make_float4(es[0] * rden, es[1] * rden, es[2] * rden, es[3] * rden);
            *(int4*)(wsp<int>(p, OFF_TOPP) + r * 4) = make_int4(pos[0], pos[1], pos[2], pos[3]);
        }
    }
    __syncthreads();
    if (tid < 32) wsp<int>(p, OFF_BC)[((size_t)layer * 512 + blockIdx.x) * 32 + tid] = lcnt[tid];
}

__device__ __forceinline__ void ph_filter_gemm_ctx(const Params& p, float* lds) {
    const float* hd3 = wsp<float>(p, OFF_HD3) + (size_t)L * 64;
    float* hhc = wsp<float>(p, OFF_HHC);
    const float mind = logf(1e-2f) / 1.5f, maxd = logf(1e-2f) / 0.3f;
    gemm_dense(p.wave_id, lds, hd3, 64, p.in[I_HYW4], 2048, NCX, 64, [&](int t, int col, float v) {
        const int o = col >> 10, side = (col >> 9) & 1, ch = col & 511;
        const float delta = fabsf(mind + (float)ch * ((maxd - mind) / 511.f));
        const float tn = (float)t / (float)(NCX - 1);
        const float val = v * expf(-tn * delta);
        if (side == 0) hhc[(size_t)(NCX + t) * 1024 + o * 512 + ch] = val;
        else if (t > 0) hhc[(size_t)(NCX - t) * 1024 + o * 512 + ch] = val;
        else hhc[o * 512 + ch] = 0.f;
    });
}
__device__ __forceinline__ void ph_filter_abs_ctx(const Params& p) {
    const int TIDX = tid_of_wave(p.wave_id);
    const float* hhc = wsp<float>(p, OFF_HHC);
    float* hnp = wsp<float>(p, OFF_HNP);
    for (int it = blockIdx.x; it < 4; it += gridDim.x) {
        const int chunk = it >> 1, col = (it & 1) * 512 + TIDX;
        const float* src = hhc + (size_t)chunk * 256 * 1024;
        float s = 0.f;
        for (int i = 0; i < 256; i++) s += fabsf(src[(size_t)i * 1024 + col]);
        hnp[(128 + chunk) * 1024 + col] = s;
    }
}
__device__ __forceinline__ void ph_filter_gemm_lat(const Params& p, unsigned char* smem) {
    const int TIDX = tid_of_wave(p.wave_id);
    float* As = (float*)smem;
    float* Bs = As + 64 * 133;
    const float* hd3 = wsp<float>(p, OFF_HD3);
    const float* w4 = p.in[I_HYW4];
    float* HT = wsp<float>(p, OFF_HT);
    const float mind = logf(1e-2f) / 1.5f, maxd = logf(1e-2f) / 0.3f;
    const int tid = TIDX, lane = tid & 63, wave = tid >> 6, hf = lane >> 5;
    for (int it = blockIdx.x; it < 16 * 128; it += gridDim.x) {
        const int c0 = (it & 15) * 128, t0 = (it >> 4) * 128;
        float av[16], bv[16];
#pragma unroll
        for (int q = 0; q < 16; q++) { const int idx = tid + 512 * q; av[q] = w4[(size_t)(idx >> 7) * 2048 + c0 + (idx & 127)]; bv[q] = hd3[(size_t)(t0 + (idx >> 6)) * 64 + (idx & 63)]; }
        __syncthreads();
#pragma unroll
        for (int q = 0; q < 16; q++) { const int idx = tid + 512 * q; As[(idx >> 7) * 133 + (idx & 127)] = av[q]; Bs[(idx & 63) * 133 + (idx >> 6)] = bv[q]; }
        __syncthreads();
        const int mt = wave >> 1, nt0 = (wave & 1) * 2;
        f32x16f acc0, acc1;
#pragma unroll
        for (int q = 0; q < 16; q++) { acc0[q] = 0.f; acc1[q] = 0.f; }
        const float* ap = As + hf * 133 + mt * 32 + (lane & 31);
        const float* bp = Bs + hf * 133 + nt0 * 32 + (lane & 31);
#pragma unroll 4
        for (int k0 = 0; k0 < 64; k0 += 2) {
            const float a = ap[k0 * 133], b0 = bp[k0 * 133], b1 = bp[k0 * 133 + 32];
            acc0 = __builtin_amdgcn_mfma_f32_32x32x2f32(a, b0, acc0, 0, 0, 0);
            acc1 = __builtin_amdgcn_mfma_f32_32x32x2f32(a, b1, acc1, 0, 0, 0);
        }
#pragma unroll
        for (int t2 = 0; t2 < 2; t2++) {
            const int t = t0 + (nt0 + t2) * 32 + (lane & 31);
            const float tn = (float)t / (float)(L - 1);
            int cb = c0 + mt * 32 + 4 * hf;
            asm volatile("" : "+v"(cb));
#pragma unroll
            for (int q = 0; q < 16; q++) {
                const int col = cb + (q & 3) + 8 * (q >> 2), ch = col & 511;
                const float delta = fabsf(mind + (float)ch * ((maxd - mind) / 511.f));
                HT[(size_t)col * L + t] = (t2 == 0 ? acc0[q] : acc1[q]) * __expf(-tn * delta);
            }
        }
    }
}

__device__ __forceinline__ float2 cmul(float2 a, float2 b) { return make_float2(a.x * b.x - a.y * b.y, a.x * b.y + a.y * b.x); }
__device__ __forceinline__ float2 cadd(float2 a, float2 b) { return make_float2(a.x + b.x, a.y + b.y); }
__device__ __forceinline__ float2 csub(float2 a, float2 b) { return make_float2(a.x - b.x, a.y - b.y); }
__device__ __forceinline__ float2 cconj(float2 a) { return make_float2(a.x, -a.y); }
__device__ __forceinline__ float2 twid(float frac) { return make_float2(__builtin_amdgcn_cosf(frac), -__builtin_amdgcn_sinf(frac)); }
constexpr int FM = 16384;
__device__ __forceinline__ int fphys(int j) { return j + (j >> 4); }
constexpr int FX_BYTES = (FM + FM / 16) * 8;
__device__ __forceinline__ void dft4(float2& x0, float2& x1, float2& x2, float2& x3) {
    const float2 y0 = cadd(x0, x2), y1 = csub(x0, x2), y2 = cadd(x1, x3), t = csub(x1, x3), y3 = make_float2(t.y, -t.x);
    x0 = cadd(y0, y2); x1 = cadd(y1, y3); x2 = csub(y0, y2); x3 = csub(y1, y3);
}
template <int LP>
__device__ __forceinline__ void fft_pass8(float2* X, int tid) {
    constexpr int pp = 1 << LP;
    float2 u[4][8];
    float2* xb0 = X + fphys(tid);
    float2* xb1 = xb0 + 6144;
    float2* xb2 = xb0 + 12288;
    asm volatile("" : "+v"(xb1), "+v"(xb2));
#define XR(off) ((off) < 6144 ? xb0[(off)] : ((off) < 12288 ? xb1[(off) - 6144] : xb2[(off) - 12288]))
#pragma unroll
    for (int b = 0; b < 4; b++)
#pragma unroll
        for (int r = 0; r < 8; r++) u[b][r] = XR(544 * b + 2176 * r);
    __syncthreads();
#pragma unroll
    for (int b = 0; b < 4; b++) {
        const int i = tid + 512 * b, k = i & (pp - 1), j = ((i - k) << 3) + k;
        const float2 w1 = twid(ldexpf((float)k, -(LP + 3)));
        const float2 w2 = cmul(w1, w1), w3 = cmul(w2, w1), w4 = cmul(w2, w2), w5 = cmul(w4, w1), w6 = cmul(w4, w2), w7 = cmul(w4, w3);
        const float2 u0 = u[b][0], u1 = cmul(u[b][1], w1), u2 = cmul(u[b][2], w2), u3 = cmul(u[b][3], w3);
        const float2 u4 = cmul(u[b][4], w4), u5 = cmul(u[b][5], w5), u6 = cmul(u[b][6], w6), u7 = cmul(u[b][7], w7);
        float2 a0 = cadd(u0, u4), a1 = cadd(u1, u5), a2 = cadd(u2, u6), a3 = cadd(u3, u7);
        float2 b0 = csub(u0, u4), t1 = csub(u1, u5), t2 = csub(u2, u6), t3 = csub(u3, u7);
        const float sq = 0.70710678118654752f;
        float2 b1 = make_float2(sq * (t1.x + t1.y), sq * (t1.y - t1.x));
        float2 b2 = make_float2(t2.y, -t2.x);
        float2 b3 = make_float2(sq * (t3.y - t3.x), -sq * (t3.x + t3.y));
        dft4(a0, a1, a2, a3);
        dft4(b0, b1, b2, b3);
        float2* yb = X + fphys(j);
#define FWO(r) ((r) * pp + (pp == 1 ? 0 : (pp == 8 ? ((r) >> 1) : (r) * pp / 16)))
        yb[FWO(0)] = a0; yb[FWO(1)] = b0; yb[FWO(2)] = a1; yb[FWO(3)] = b1; yb[FWO(4)] = a2; yb[FWO(5)] = b2; yb[FWO(6)] = a3; yb[FWO(7)] = b3;
#undef FWO
        __builtin_amdgcn_sched_barrier(0);
    }
    __syncthreads();
}
__device__ __forceinline__ void fft16k(float2* X, int tid) {
    asm volatile("" : "+v"(tid));
    fft_pass8<0>(X, tid); fft_pass8<3>(X, tid); fft_pass8<6>(X, tid); fft_pass8<9>(X, tid);
    float2* xb0 = X + fphys(tid);
    float2* xb1 = xb0 + 6144;
    float2* xb2 = xb0 + 12288;
    asm volatile("" : "+v"(xb1), "+v"(xb2));
#pragma unroll
    for (int b = 0; b < 8; b++) {
        const int i = tid + 512 * b;
        const float2 w1 = twid(ldexpf((float)i, -14));
        const float2 w2 = cmul(w1, w1), w3 = cmul(w2, w1);
        float2 x0 = XR(544 * b), x1 = cmul(XR(544 * b + 4352), w1), x2 = cmul(XR(544 * b + 8704), w2), x3 = cmul(XR(544 * b + 13056), w3);
        dft4(x0, x1, x2, x3);
        XR(544 * b) = x0; XR(544 * b + 4352) = x1; XR(544 * b + 8704) = x2; XR(544 * b + 13056) = x3;
        __builtin_amdgcn_sched_barrier(0);
    }
    __syncthreads();
#undef XR
}
__device__ __forceinline__ void ph_filter_fft(const Params& p, unsigned char* smem) {
    const int TIDX = tid_of_wave(p.wave_id);
    float2* X = (float2*)smem;
    float* red = (float*)(smem + FX_BYTES);
    const float* HT = wsp<float>(p, OFF_HT);
    float2* HF = wsp<float2>(p, OFF_HF);
    const int tid = TIDX, lane = tid & 63, wave = tid >> 6;
    constexpr int N2 = 2 * L;
    for (int it = blockIdx.x; it < 1024; it += gridDim.x) {
        const int o = it >> 9, ch = it & 511;
        const float* s0 = HT + ((size_t)(o * 2 + 0) * 512 + ch) * L;
        const float* s1 = HT + ((size_t)(o * 2 + 1) * 512 + ch) * L;
        __syncthreads();
        float sa = 0.f;
#pragma unroll 8
        for (int j = 0; j < 16; j++) {
            const int m = tid + 512 * j;
            const float2 v = *(const float2*)(s0 + 2 * m);
            sa += fabsf(v.x) + fabsf(v.y);
            X[fphys(m)] = v;
        }
#pragma unroll 8
        for (int j = 16; j < 32; j++) {
            const int m = tid + 512 * j;
            float2 v = make_float2(s1[N2 - 2 * m], s1[N2 - 2 * m - 1]);
            if (m == L / 2) v.x = 0.f;
            sa += fabsf(v.x) + fabsf(v.y);
            X[fphys(m)] = v;
        }
        sa = wave_sum(lane, sa);
        if (lane == 0) red[wave] = sa;
        __syncthreads();
        float nrm = 0.f;
#pragma unroll
        for (int w = 0; w < 8; w++) nrm += red[w];
        const float scale = 1.f / (nrm * (float)FM);
        fft16k(X, tid);
        float2* dst = HF + (size_t)it * FM;
#pragma unroll 1
        for (int k = tid; k <= FM / 2; k += 512) {
            if (k == 0) { const float2 b0 = X[0]; dst[0] = make_float2((b0.x + b0.y) * scale, (b0.x - b0.y) * scale); }
            else if (k == FM / 2) { const float2 b = X[fphys(k)]; dst[k] = make_float2(b.x * scale, -b.y * scale); }
            else {
                const float2 ak = X[fphys(k)], am = cconj(X[fphys(FM - k)]);
                const float2 e = make_float2(0.5f * (ak.x + am.x), 0.5f * (ak.y + am.y));
                const float2 od = make_float2(0.5f * (ak.x - am.x), 0.5f * (ak.y - am.y));
                const float2 oo = make_float2(od.y, -od.x);
                const float2 wo = cmul(twid(ldexpf((float)k, -15)), oo);
                const float2 hk = cadd(e, wo), hm = cconj(csub(e, wo));
                dst[k] = make_float2(hk.x * scale, hk.y * scale);
                dst[FM - k] = make_float2(hm.x * scale, hm.y * scale);
            }
        }
    }
}
__device__ __forceinline__ void hy_pw_pair(float2* X, const float2* __restrict__ HFc, int k) {
    const float2 hk = HFc[k], hm = HFc[FM - k];
    const float2 ak = X[fphys(k)], am = cconj(X[fphys(FM - k)]);
    const float2 e = make_float2(0.5f * (ak.x + am.x), 0.5f * (ak.y + am.y));
    const float2 od = make_float2(0.5f * (ak.x - am.x), 0.5f * (ak.y - am.y));
    const float2 oo = make_float2(od.y, -od.x);
    const float2 w = twid(ldexpf((float)k, -15));
    const float2 wo = cmul(w, oo);
    const float2 yk = cmul(cadd(e, wo), hk), ym = cmul(cconj(csub(e, wo)), hm);
    const float2 ymc = cconj(ym);
    const float2 P = make_float2(0.5f * (yk.x + ymc.x), 0.5f * (yk.y + ymc.y));
    const float2 Q = make_float2(0.5f * (yk.x - ymc.x), 0.5f * (yk.y - ymc.y));
    const float2 qw = cmul(Q, cconj(w));
    const float2 ck = make_float2(P.x - qw.y, P.y + qw.x);
    const float2 qcw = cmul(cconj(Q), w);
    const float2 cm = make_float2(P.x - qcw.y, -P.y + qcw.x);
    X[fphys(k)] = cconj(ck); X[fphys(FM - k)] = cconj(cm);
}
__device__ __forceinline__ void hy_pointwise(float2* X, const float2* __restrict__ HFc, int tid) {
    asm volatile("" : "+v"(tid));
#pragma unroll 5
    for (int j = 1; j < 16; j++) hy_pw_pair(X, HFc, tid + 512 * j);
    if (tid != 0) hy_pw_pair(X, HFc, tid);
    else {
        const float2 a0 = X[0], h = HFc[0];
        const float y0 = (a0.x + a0.y) * h.x, ym = (a0.x - a0.y) * h.y;
        X[0] = make_float2(0.5f * (y0 + ym), -0.5f * (y0 - ym));
        X[fphys(FM / 2)] = cmul(cconj(X[fphys(FM / 2)]), HFc[FM / 2]);
    }
}
__device__ __forceinline__ void ph_hyena_fft(const Params& p, unsigned char* smem) {
    const int TIDX = tid_of_wave(p.wave_id);
    float2* X = (float2*)smem;
    const float* UT = wsp<float>(p, OFF_U);
    const float2* HF = wsp<float2>(p, OFF_HF);
    unsigned* HYT = wsp<unsigned>(p, OFF_HYT);
    const int tid = TIDX;
    for (int ch = blockIdx.x; ch < 512; ch += gridDim.x) {
        float2 z[16];
#pragma unroll
        for (int j = 0; j < 16; j++) z[j] = ((const float2*)(UT + (size_t)ch * L))[tid + 512 * j];
#pragma unroll 1
        for (int o = 0; o < 2; o++) {
            __syncthreads();
#pragma unroll
            for (int j = 0; j < 16; j++) { X[fphys(tid + 512 * j)] = z[j]; X[fphys(8192 + tid + 512 * j)] = make_float2(0.f, 0.f); }
            __syncthreads();
            fft16k(X, tid);
            hy_pointwise(X, HF + (size_t)(o * 512 + ch) * FM, tid);
            __syncthreads();
            fft16k(X, tid);
            const float bias = p.in[I_HYFB][o * 512 + ch];
            const float2* gate = (const float2*)(UT + (size_t)(512 * (o + 1) + ch) * L);
#pragma unroll
            for (int j = 0; j < 16; j++) {
                const int m = tid + 512 * j;
                const float2 r = X[fphys(m)], g = gate[m];
                z[j] = make_float2(g.x * (r.x + z[j].x * bias), g.y * (-r.y + z[j].y * bias));
            }
        }
#pragma unroll
        for (int j = 0; j < 16; j++) HYT[(size_t)ch * (L / 2) + tid + 512 * j] = pack_bf16(z[j].x, z[j].y);
    }
}
__device__ __forceinline__ void ph_hy_transpose(const Params& p, unsigned char* smem) {
    const int TIDX = tid_of_wave(p.wave_id);
    bf16_t* T = (bf16_t*)smem;
    const bf16_t* HYT = wsp<bf16_t>(p, OFF_HYT);
    bf16_t* MB = wsp<bf16_t>(p, OFF_MB);
    const int tid = TIDX;
    for (int it = blockIdx.x; it < 8 * 256; it += gridDim.x) {
        const int c0 = (it & 7) * 64, t0 = (it >> 3) * 64;
        __syncthreads();
#pragma unroll
        for (int q = 0; q < 8; q++) { const int c = (tid >> 6) + 8 * q, t = tid & 63; T[c * 66 + t] = HYT[(size_t)(c0 + c) * L + t0 + t]; }
        __syncthreads();
#pragma unroll
        for (int q = 0; q < 8; q++) { const int t = (tid >> 6) + 8 * q, c = tid & 63; MB[(size_t)(t0 + t) * D + c0 + c] = T[c * 66 + t]; }
    }
}

__device__ __forceinline__ void ph_qk_dwconv(const Params& p) {
    const int TIDX = tid_of_wave(p.wave_id);
    const int lane = TIDX & 63, wave = TIDX >> 6;
    const bf16_t* P0 = wsp<bf16_t>(p, OFF_P);
    bf16_t* qn = wsp<bf16_t>(p, OFF_QN);
    bf16_t* kn = wsp<bf16_t>(p, OFF_KN);
    const float2* rope = wsp<float2>(p, OFF_ROPE);
    const float gk = p.in[I_KNORM][lane], gq = p.in[I_QNORM][lane];
    for (int r = blockIdx.x * NWAVE + wave; r < R; r += gridDim.x * NWAVE) {
        const bf16_t* pr = P0 + (size_t)r * EVEN_IN;
        float v[10];
#pragma unroll
        for (int s2 = 0; s2 < 10; s2++) v[s2] = bf2f(pr[(s2 < 2 ? s2 * 64 : 256 + (s2 - 2) * 64) + lane]);
        float2 cs = make_float2(1.f, 0.f);
        if (r < L) cs = rope[(lane < 32 ? (r >> 6) : (r & 63)) * 16 + (lane & 15)];
#pragma unroll
        for (int s2 = 0; s2 < 10; s2++) {
            const float ss = wave_sum(lane, v[s2] * v[s2]);
            float n = v[s2] * rsqrtf(ss * (1.f / 64.f) + EPS) * (s2 < 2 ? gk : gq);
            if (r < L) {
                const float partner = lane_xor(lane, n, 16);
                n = ((lane & 16) == 0) ? n * cs.x - partner * cs.y : partner * cs.y + n * cs.x;
            }
            if (s2 < 2) kn[(size_t)r * 128 + s2 * 64 + lane] = f2bf(n);
            else qn[(size_t)r * 512 + (s2 - 2) * 64 + lane] = f2bf(n * 0.125f);
        }
    }
    float* UC = wsp<float>(p, OFF_UC);
    const float* cw = p.in[I_HYCW];
    const float* cb = p.in[I_HYCB];
    for (int it = blockIdx.x * NT + TIDX; it < NCX * 1536; it += gridDim.x * NT) {
        const int r = L + it / 1536, c = it % 1536;
        float a = cb[c];
#pragma unroll
        for (int j = 0; j < 3; j++) {
            const int rr = r + j - 1;
            if (rr >= L && rr < R) a = fmaf(cw[j * 1536 + c], bf2f(P0[(size_t)rr * EVEN_IN + 768 + c]), a);
        }
        UC[it] = a;
    }
}
__device__ __forceinline__ void ph_dwconv_t(const Params& p, float* lds) {
    const int TIDX = tid_of_wave(p.wave_id);
    const bf16_t* P0 = wsp<bf16_t>(p, OFF_P);
    float* UT = wsp<float>(p, OFF_U);
    const float* cw = p.in[I_HYCW];
    const float* cb = p.in[I_HYCB];
    bf16_t* T = (bf16_t*)lds;
    const int tid = TIDX;
    pg8::u32x4 xr[3];
    auto fetch = [&](int it2) {
        const int c02 = (it2 % 24) * 64, t02 = (it2 / 24) * 128;
#pragma unroll
        for (int q = 0; q < 3; q++) {
            const int v = tid + NT * q, row = v >> 3, c8 = (v & 7) * 8, t = t02 - 1 + row;
            xr[q] = pg8::u32x4{0u, 0u, 0u, 0u};
            if (v < 130 * 8 && t >= 0 && t < L) xr[q] = *(const pg8::u32x4*)(P0 + (size_t)t * EVEN_IN + 768 + c02 + c8);
        }
    };
    if ((int)blockIdx.x < 24 * 128) fetch(blockIdx.x);
    for (int it = blockIdx.x; it < 24 * 128; it += gridDim.x) {
        const int c0 = (it % 24) * 64, t0 = (it / 24) * 128;
        __syncthreads();
#pragma unroll
        for (int q = 0; q < 3; q++) { const int v = tid + NT * q;
            if (v < 130 * 8) { bf16_t* d = T + (v >> 3) * 68 + (v & 7) * 8;
                u32x2_t lo, hi; lo.x = xr[q].x; lo.y = xr[q].y; hi.x = xr[q].z; hi.y = xr[q].w;
                *(u32x2_t*)d = lo; *(u32x2_t*)(d + 4) = hi; } }
        __syncthreads();
        if (it + (int)gridDim.x < 24 * 128) fetch(it + gridDim.x);
#pragma unroll
        for (int ps = 0; ps < 4; ps++) {
            const int tl = tid & 31, c = (tid >> 5) + 16 * ps;
            const float w0 = cw[c0 + c], w1 = cw[1536 + c0 + c], w2 = cw[3072 + c0 + c], bb = cb[c0 + c];
            float* dst = UT + (size_t)(c0 + c) * L + t0 + tl;
#pragma unroll
            for (int i = 0; i < 4; i++) {
                const bf16_t* tp = T + (tl + 32 * i) * 68 + c;
                dst[32 * i] = fmaf(w0, bf2f(tp[0]), fmaf(w1, bf2f(tp[68]), fmaf(w2, bf2f(tp[136]), bb)));
            }
        }
    }
}

__device__ __forceinline__ void ph_attention_mfma(const Params& p, unsigned char* smem) {
    const int TIDX = tid_of_wave(p.wave_id);
    bf16_t* Ks = (bf16_t*)smem;
    bf16_t* Vts = Ks + 64 * 72;
    const bf16_t* QN = wsp<bf16_t>(p, OFF_QN);
    const bf16_t* KN = wsp<bf16_t>(p, OFF_KN);
    const bf16_t* VB = wsp<bf16_t>(p, OFF_P) + 128;
    bf16_t* MB = wsp<bf16_t>(p, OFF_MB);
    const int tid = TIDX, lane = tid & 63, wave = tid >> 6, hf = lane >> 5, r = lane & 31;
    for (int it = blockIdx.x; it < 260; it += gridDim.x) {
        const bool isctx = it >= 256;
        const int qb = isctx ? (it - 256) >> 1 : it >> 1, kvh = it & 1;
        const int qrow0 = (isctx ? L : 0) + qb * 128;
        const int hq = kvh * 4 + (wave >> 1), qoff = (wave & 1) * 64;
        bf16x8_t qf[2][4];
#pragma unroll
        for (int b = 0; b < 2; b++)
#pragma unroll
            for (int ks = 0; ks < 4; ks++) qf[b][ks] = *(const bf16x8_t*)(QN + (size_t)(qrow0 + qoff + b * 32 + r) * 512 + hq * 64 + ks * 16 + 8 * hf);
        float mrun[2], lrun[2];
        mrun[0] = mrun[1] = p.in[I_SINK][hq];
        lrun[0] = lrun[1] = 1.f;
        f32x16 o[2][2];
#pragma unroll
        for (int dt = 0; dt < 2; dt++)
#pragma unroll
            for (int b = 0; b < 2; b++)
#pragma unroll
                for (int q = 0; q < 16; q++) o[dt][b][q] = 0.f;
        const int tlo = (!isctx && qb == 0) ? 6 : 4, thi = isctx ? 4 : ((qb == L / 128 - 1) ? 8 : 10);
        const int ntiles = 4 + (thi - tlo);
        const int kkey = tid >> 3, kd8 = (tid & 7) * 8, vkey = tid & 63, vd8 = (tid >> 6) * 8;
        pg8::u32x4 kreg, vreg;
        {
            const int krow0 = L;
            kreg = *(const pg8::u32x4*)(KN + (size_t)(krow0 + kkey) * 128 + kvh * 64 + kd8);
            vreg = *(const pg8::u32x4*)(VB + (size_t)(krow0 + vkey) * EVEN_IN + kvh * 64 + vd8);
        }
#pragma unroll 1
        for (int n = 0; n < ntiles; n++) {
            const int tix = n < 4 ? n : tlo + (n - 4);
            const bool local = tix >= 4;
            const int krow0 = local ? qb * 128 - 128 + (tix - 4) * 64 : L + tix * 64;
            __syncthreads();
            *(pg8::u32x4*)(Ks + kkey * 72 + kd8) = kreg;
            {
                bf16_t* dst = Vts + vd8 * 68 + vkey;
                dst[0] = (bf16_t)(vreg.x & 0xffff); dst[68] = (bf16_t)(vreg.x >> 16);
                dst[136] = (bf16_t)(vreg.y & 0xffff); dst[204] = (bf16_t)(vreg.y >> 16);
                dst[272] = (bf16_t)(vreg.z & 0xffff); dst[340] = (bf16_t)(vreg.z >> 16);
                dst[408] = (bf16_t)(vreg.w & 0xffff); dst[476] = (bf16_t)(vreg.w >> 16);
            }
            if (n + 1 < ntiles) {
                const int t2 = (n + 1) < 4 ? (n + 1) : tlo + (n + 1 - 4);
                const int kr2 = t2 >= 4 ? qb * 128 - 128 + (t2 - 4) * 64 : L + t2 * 64;
                kreg = *(const pg8::u32x4*)(KN + (size_t)(kr2 + kkey) * 128 + kvh * 64 + kd8);
                vreg = *(const pg8::u32x4*)(VB + (size_t)(kr2 + vkey) * EVEN_IN + kvh * 64 + vd8);
            }
            __syncthreads();
            f32x16 sc[2][2];
#pragma unroll
            for (int a = 0; a < 2; a++)
#pragma unroll
                for (int b = 0; b < 2; b++) {
#pragma unroll
                    for (int q = 0; q < 16; q++) sc[a][b][q] = 0.f;
#pragma unroll
                    for (int ks = 0; ks < 4; ks++) {
                        const bf16x8_t kf = *(const bf16x8_t*)(Ks + (a * 32 + r) * 72 + ks * 16 + 8 * hf);
                        sc[a][b] = __builtin_amdgcn_mfma_f32_32x32x16_bf16(kf, qf[b][ks], sc[a][b], 0, 0, 0);
                    }
                }
#pragma unroll
            for (int b = 0; b < 2; b++) {
                const int qpos = qb * 128 + qoff + b * 32 + r;
                float mx = mrun[b];
#pragma unroll
                for (int a = 0; a < 2; a++)
#pragma unroll
                    for (int q = 0; q < 16; q++) {
                        if (local) {
                            const int kpos = krow0 + a * 32 + CROW(q, hf);
                            const int dd = kpos - qpos;
                            const bool ok = kpos >= 0 && kpos < L && dd <= 128 && dd >= -128;
                            sc[a][b][q] = ok ? sc[a][b][q] : -INFINITY;
                        }
                        mx = fmaxf(mx, sc[a][b][q]);
                    }
                mx = fmaxf(mx, lane_xor(lane, mx, 32));
                const float corr = __expf(mrun[b] - mx);
                mrun[b] = mx;
                float sum = 0.f;
#pragma unroll
                for (int a = 0; a < 2; a++)
#pragma unroll
                    for (int q = 0; q < 16; q++) { const float pv = __expf(sc[a][b][q] - mx); sc[a][b][q] = pv; sum += pv; }
                sum += lane_xor(lane, sum, 32);
                lrun[b] = lrun[b] * corr + sum;
#pragma unroll
                for (int dt = 0; dt < 2; dt++)
#pragma unroll
                    for (int q = 0; q < 16; q++) o[dt][b][q] *= corr;
            }
#pragma unroll
            for (int a = 0; a < 2; a++)
#pragma unroll
                for (int si = 0; si < 2; si++) {
                    bf16x8_t pf[2];
#pragma unroll
                    for (int b = 0; b < 2; b++) {
                        pg8::u32x4 w;
                        w.x = pack_bf16(sc[a][b][8 * si + 0], sc[a][b][8 * si + 1]); w.y = pack_bf16(sc[a][b][8 * si + 2], sc[a][b][8 * si + 3]);
                        w.z = pack_bf16(sc[a][b][8 * si + 4], sc[a][b][8 * si + 5]); w.w = pack_bf16(sc[a][b][8 * si + 6], sc[a][b][8 * si + 7]);
                        pf[b] = __builtin_bit_cast(bf16x8_t, w);
                    }
#pragma unroll
                    for (int dt = 0; dt < 2; dt++) {
                        const bf16_t* vp = Vts + (dt * 32 + r) * 68 + a * 32 + 16 * si + 4 * hf;
                        const u32x2_t lo = *(const u32x2_t*)vp, hi = *(const u32x2_t*)(vp + 8);
                        pg8::u32x4 w; w.x = lo.x; w.y = lo.y; w.z = hi.x; w.w = hi.y;
                        const bf16x8_t vf = __builtin_bit_cast(bf16x8_t, w);
#pragma unroll
                        for (int b = 0; b < 2; b++) o[dt][b] = __builtin_amdgcn_mfma_f32_32x32x16_bf16(vf, pf[b], o[dt][b], 0, 0, 0);
                    }
                }
        }
#pragma unroll
        for (int b = 0; b < 2; b++) {
            const float rl = 1.f / lrun[b];
            bf16_t* dst = MB + (size_t)(qrow0 + qoff + b * 32 + r) * D + 512 + hq * 64 + 4 * hf;
#pragma unroll
            for (int dt = 0; dt < 2; dt++)
#pragma unroll
                for (int q4 = 0; q4 < 4; q4++) {
                    u32x2_t w;
                    w.x = pack_bf16(o[dt][b][4 * q4 + 0] * rl, o[dt][b][4 * q4 + 1] * rl);
                    w.y = pack_bf16(o[dt][b][4 * q4 + 2] * rl, o[dt][b][4 * q4 + 3] * rl);
                    *(u32x2_t*)(dst + dt * 32 + 8 * q4) = w;
                }
        }
    }
}

__device__ __forceinline__ void ph_hyena_conv(const Params& p, int o) {
    const int TIDX = tid_of_wave(p.wave_id);
    const int lane = TIDX & 63, wave = TIDX >> 6;
    const float* U = wsp<float>(p, OFF_UC) - (size_t)L * 1536;
    const float* hnp = wsp<float>(p, OFF_HNP);
    float* Z1 = wsp<float>(p, OFF_Z1);
    const float* zin = o == 0 ? U : Z1;
    const int zld = o == 0 ? 1536 : 512;
    const int nlat = 8 * (L / 64), nctx = 8 * (NCX / 64);
    for (int it = nlat + blockIdx.x; it < nlat + nctx; it += gridDim.x) {
        const bool lat = it < nlat;
        const int ii = lat ? it : it - nlat;
        const int Ls = lat ? L : NCX, base = lat ? 0 : L;
        const int ch = (ii & 7) * 64 + lane, t0 = (ii >> 3) * 64 + wave * 8;
        const float* hf = (lat ? wsp<float>(p, OFF_HH) : wsp<float>(p, OFF_HHC)) + o * 512 + ch;
        float nrm = 0.f;
        if (lat) { for (int c = 0; c < 128; c++) nrm += hnp[c * 1024 + o * 512 + ch]; }
        else { nrm = hnp[128 * 1024 + o * 512 + ch] + hnp[129 * 1024 + o * 512 + ch]; }
        float acc[8];
#pragma unroll
        for (int i = 0; i < 8; i++) acc[i] = 0.f;
#pragma unroll 4
        for (int s0 = 0; s0 < Ls; s0 += 8) {
            float zv[8], hv[15];
#pragma unroll
            for (int j = 0; j < 8; j++) zv[j] = zin[(size_t)(base + s0 + j) * zld + ch];
#pragma unroll
            for (int e = 0; e < 15; e++) hv[e] = hf[(size_t)(t0 - s0 + e - 7 + Ls) * 1024];
#pragma unroll
            for (int i = 0; i < 8; i++)
#pragma unroll
                for (int j = 0; j < 8; j++) acc[i] = fmaf(hv[i - j + 7], zv[j], acc[i]);
        }
        const float inv = 1.f / nrm;
        const float bias = p.in[I_HYFB][o * 512 + ch];
#pragma unroll
        for (int i = 0; i < 8; i++) {
            const int r = base + t0 + i;
            const float zc = acc[i] * inv;
            const float z = zin[(size_t)r * zld + ch];
            const float gate = U[(size_t)r * 1536 + 512 * (o + 1) + ch];
            const float res = gate * (zc + z * bias);
            if (o == 0) Z1[(size_t)r * 512 + ch] = res;
            else wsp<bf16_t>(p, OFF_MB)[(size_t)r * D + ch] = f2bf(res);
        }
    }
}

__device__ __forceinline__ void ph_moe_scatter(const Params& p, float* lds, int layer, int ntok) {
    const int TIDX = tid_of_wave(p.wave_id);
    int* sst = (int*)lds;
    int* pre = sst + 128;
    const int G = gridDim.x;
    const int* bc = wsp<int>(p, OFF_BC) + (size_t)layer * 512 * 32;
    int* tile_e = wsp<int>(p, OFF_TILEE) + layer * 512;
    __syncthreads();
    for (int i = TIDX; i < G * 32; i += NT) pre[i] = bc[i];
    __syncthreads();
    if (TIDX < 32) {
        int a = 0;
        for (int b = 0; b < G; b++) { const int c = pre[b * 32 + TIDX]; pre[b * 32 + TIDX] = a; a += c; }
        sst[64 + TIDX] = a;
    }
    __syncthreads();
    if (TIDX == 0) {
        int a = 0;
        for (int e = 0; e < 32; e++) {
            const int nt = (sst[64 + e] + 255) / 256;
            if (blockIdx.x == 0) for (int q = 0; q < nt; q++) tile_e[a / 256 + q] = e;
            const int st = a;
            a += nt * 256;
            sst[e] = st;
        }
        sst[32] = a;
    }
    __syncthreads();
    if (blockIdx.x == 0 && TIDX < 33) wsp<int>(p, OFF_STARTS)[layer * 64 + TIDX] = sst[TIDX];
    const int* te = wsp<int>(p, OFF_TOPE);
    int* tp = wsp<int>(p, OFF_TOPP);
    const bf16_t* HB = wsp<bf16_t>(p, OFF_HB);
    bf16_t* XG = wsp<bf16_t>(p, OFF_XG);
    const int lane = TIDX & 63, wave = TIDX >> 6;
    for (int it = blockIdx.x * NWAVE + wave; it < ntok * 4; it += gridDim.x * NWAVE) {
        const int tok = it >> 2, e = te[it];
        const int row = sst[e] + pre[((tok >> 5) % G) * 32 + e] + tp[it];
        if (lane == 0) tp[it] = row;
        const pg8::u32x4* src = (const pg8::u32x4*)(HB + (size_t)tok * D);
        pg8::u32x4* dst = (pg8::u32x4*)(XG + (size_t)row * D);
        dst[lane] = src[lane];
        dst[lane + 64] = src[lane + 64];
    }
    __syncthreads();
}
__device__ __forceinline__ void ph_moe_gemm1(const Params& p, PG8_LAS unsigned char* lds, int layer) {
    const int total = wsp<int>(p, OFF_STARTS)[layer * 64 + 32];
    pg8::MoeOrder S{wsp<int>(p, OFF_TILEE) + layer * 512, total / 256, 8, (int)gridDim.x, (int)blockIdx.x};
    pg8::Gemm g{wsp<bf16_t>(p, OFF_XG), wsp<bf16_t>(p, OFF_WGU) + (size_t)layer * 32 * 2048 * 1024, 1024};
    pg8::EpiMoe1 E{wsp<bf16_t>(p, OFF_ACTB), p.in[I_BGU] + (size_t)layer * 32 * 2048};
    pg8::gemm_phase(p.wave_id, lds, g, S, E);
}
__device__ __forceinline__ void ph_moe_gemm2(const Params& p, PG8_LAS unsigned char* lds, int layer) {
    const int total = wsp<int>(p, OFF_STARTS)[layer * 64 + 32];
    pg8::MoeOrder S{wsp<int>(p, OFF_TILEE) + layer * 512, total / 256, 4, (int)gridDim.x, (int)blockIdx.x};
    pg8::Gemm g{wsp<bf16_t>(p, OFF_ACTB), wsp<bf16_t>(p, OFF_WDN) + (size_t)layer * 32 * 1024 * 1024, 1024};
    pg8::EpiMoe2 E{wsp<bf16_t>(p, OFF_YR), p.in[I_BDN] + (size_t)layer * 32 * 1024};
    pg8::gemm_phase(p.wave_id, lds, g, S, E);
}
template <bool NEXTPREP>
__device__ __forceinline__ void ph_moe_combine(const Params& p, int layer, int nrows, const float* xi, float* xo, int nlayer) {
    const int TIDX = tid_of_wave(p.wave_id);
    const int lane = TIDX & 63, wave = TIDX >> 6;
    const int* tp = wsp<int>(p, OFF_TOPP);
    const float* tg = wsp<float>(p, OFF_TOPG);
    const bf16_t* YR = wsp<bf16_t>(p, OFF_YR);
    for (int r0 = blockIdx.x * NWAVE + wave; r0 < nrows; r0 += 2 * gridDim.x * NWAVE) {
      const int r1 = r0 + gridDim.x * NWAVE;
      const bool ok1 = r1 < nrows;
      const int rr[2] = {r0, ok1 ? r1 : r0};
      int4 rows2[2]; float4 gs2[2];
#pragma unroll
      for (int u = 0; u < 2; u++) { rows2[u] = *(const int4*)(tp + rr[u] * 4); gs2[u] = *(const float4*)(tg + rr[u] * 4); }
      pg8::u32x4 yv[2][4][2]; float4 xv[2][4];
#pragma unroll
      for (int u = 0; u < 2; u++) {
          const int rw[4] = {rows2[u].x, rows2[u].y, rows2[u].z, rows2[u].w};
#pragma unroll
          for (int k = 0; k < 4; k++)
#pragma unroll
              for (int i = 0; i < 2; i++) yv[u][k][i] = *(const pg8::u32x4*)(YR + (size_t)rw[k] * 1024 + 512 * i + 8 * lane);
#pragma unroll
          for (int i = 0; i < 4; i++) xv[u][i] = *(const float4*)(xi + (size_t)rr[u] * D + 512 * (i >> 1) + 8 * lane + 4 * (i & 1));
      }
#pragma unroll
      for (int u = 0; u < 2; u++) {
        if (u == 1 && !ok1) continue;
        const int r = rr[u];
        const float* gt = modp(p, layer, r < L ? 0 : 1, 1) + 2048;
        float v[16];
#pragma unroll
        for (int i = 0; i < 16; i++) v[i] = 0.f;
        const float gw[4] = {gs2[u].x, gs2[u].y, gs2[u].z, gs2[u].w};
#pragma unroll
        for (int k = 0; k < 4; k++)
#pragma unroll
            for (int i = 0; i < 2; i++) {
                const pg8::u32x4 y = yv[u][k][i];
                const unsigned w[4] = {y.x, y.y, y.z, y.w};
#pragma unroll
                for (int q = 0; q < 4; q++) {
                    v[8 * i + 2 * q] = fmaf(gw[k], bf2f((unsigned short)(w[q] & 0xffff)), v[8 * i + 2 * q]);
                    v[8 * i + 2 * q + 1] = fmaf(gw[k], bf2f((unsigned short)(w[q] >> 16)), v[8 * i + 2 * q + 1]);
                }
            }
        float ss = 0.f;
#pragma unroll
        for (int i = 0; i < 2; i++)
#pragma unroll
            for (int h4 = 0; h4 < 2; h4++) {
                const int c = 512 * i + 8 * lane + 4 * h4;
                const float4 x4 = xv[u][2 * i + h4], g4 = *(const float4*)(gt + c);
                float* vv = v + 8 * i + 4 * h4;
                vv[0] = x4.x + g4.x * vv[0]; vv[1] = x4.y + g4.y * vv[1]; vv[2] = x4.z + g4.z * vv[2]; vv[3] = x4.w + g4.w * vv[3];
                *(float4*)(xo + (size_t)r * D + c) = make_float4(vv[0], vv[1], vv[2], vv[3]);
                ss += vv[0] * vv[0] + vv[1] * vv[1] + vv[2] * vv[2] + vv[3] * vv[3];
            }
        if (NEXTPREP) {
            ss = wave_sum(lane, ss);
            const float rinv = rsqrtf(ss * (1.f / 1024.f) + EPS);
            const float* md = modp(p, nlayer, r < L ? 0 : 1, 0);
            const float* g = p.in[I_NORMG] + (nlayer * 2 + 0) * 1024;
#pragma unroll
            for (int i = 0; i < 2; i++) {
                const int c = 512 * i + 8 * lane;
                float hv[8];
#pragma unroll
                for (int h4 = 0; h4 < 2; h4++) {
                    const float4 g4 = *(const float4*)(g + c + 4 * h4), sc4 = *(const float4*)(md + 1024 + c + 4 * h4), sh4 = *(const float4*)(md + c + 4 * h4);
                    const float* vv = v + 8 * i + 4 * h4;
                    hv[4 * h4 + 0] = vv[0] * rinv * g4.x * (1.f + sc4.x) + sh4.x; hv[4 * h4 + 1] = vv[1] * rinv * g4.y * (1.f + sc4.y) + sh4.y;
                    hv[4 * h4 + 2] = vv[2] * rinv * g4.z * (1.f + sc4.z) + sh4.z; hv[4 * h4 + 3] = vv[3] * rinv * g4.w * (1.f + sc4.w) + sh4.w;
                }
                pg8::u32x4 o; o.x = pack_bf16(hv[0], hv[1]); o.y = pack_bf16(hv[2], hv[3]); o.z = pack_bf16(hv[4], hv[5]); o.w = pack_bf16(hv[6], hv[7]);
                *(pg8::u32x4*)(wsp<bf16_t>(p, OFF_HB) + (size_t)r * D + c) = o;
            }
        }
      }
    }
}

__device__ __forceinline__ void ph_streams(const Params& p) {
    const int TIDX = tid_of_wave(p.wave_id);
    const bf16_t* P1 = wsp<bf16_t>(p, OFF_P);
    bf16_t* XBC = wsp<bf16_t>(p, OFF_XBC);
    float* DT = wsp<float>(p, OFF_DT);
    const float* cw = p.in[I_SSDCW];
    const float* cb = p.in[I_SSDCB];
    const int gsz = gridDim.x * NT, g0 = blockIdx.x * NT + TIDX;
    for (int base = g0; base < R * 128; base += 4 * gsz) {
        pg8::u32x4 v[4][3];
#pragma unroll
        for (int u = 0; u < 4; u++) {
            const int it = base + u * gsz, r = it >> 7, c = (it & 127) * 8;
            const int lo = r < L ? 0 : L, hi = r < L ? L : R;
#pragma unroll
            for (int j = 0; j < 3; j++) {
                const int rr = r + j - 1;
                v[u][j] = pg8::u32x4{0u, 0u, 0u, 0u};
                if (it < R * 128 && rr >= lo && rr < hi) v[u][j] = *(const pg8::u32x4*)(P1 + (size_t)rr * ODD_IN + c);
            }
        }
#pragma unroll
        for (int u = 0; u < 4; u++) {
            const int it = base + u * gsz, r = it >> 7, c = (it & 127) * 8;
            if (it >= R * 128) continue;
            float a[8];
#pragma unroll
            for (int q = 0; q < 8; q++) a[q] = cb[c + q];
#pragma unroll
            for (int j = 0; j < 3; j++) {
                const unsigned w[4] = {v[u][j].x, v[u][j].y, v[u][j].z, v[u][j].w};
#pragma unroll
                for (int q = 0; q < 4; q++) {
                    a[2 * q] = fmaf(cw[j * 1024 + c + 2 * q], bf2f((unsigned short)(w[q] & 0xffff)), a[2 * q]);
                    a[2 * q + 1] = fmaf(cw[j * 1024 + c + 2 * q + 1], bf2f((unsigned short)(w[q] >> 16)), a[2 * q + 1]);
                }
            }
            pg8::u32x4 o;
            o.x = pack_bf16(silu_fast(a[0]), silu_fast(a[1])); o.y = pack_bf16(silu_fast(a[2]), silu_fast(a[3]));
            o.z = pack_bf16(silu_fast(a[4]), silu_fast(a[5])); o.w = pack_bf16(silu_fast(a[6]), silu_fast(a[7]));
            *(pg8::u32x4*)(XBC + (size_t)r * 1024 + c) = o;
        }
    }
    for (int it = g0; it < R * 16; it += gsz) {
        const int r = it >> 4, c = it & 15, d = c >> 3, h = c & 7;
        DT[(size_t)d * R * 8 + (size_t)r * 8 + h] = softplus_f(bf2f(P1[(size_t)r * ODD_IN + 1024 + c]) + p.in[I_DTB][d * 8 + h]);
    }
}
__device__ __forceinline__ float chunk_cumsum128(float a0, float a1, int lane, int d, float& c0, float& c1) {
    const float s = a0 + a1;
    float incl = s;
#pragma unroll
    for (int o = 1; o < 64; o <<= 1) { const float t = lane_get(incl, lane >= o ? lane - o : lane); if (lane >= o) incl += t; }
    const float total = lane_get(incl, 63);
    c0 = incl - s + a0; c1 = incl;
    if (d == 1) { c0 = total - (c0 - a0); c1 = total - (c1 - a1); }
    return total;
}

__device__ __forceinline__ void ph_ssd_s1(const Params& p, unsigned char* smem) {
    const int TIDX = tid_of_wave(p.wave_id);
    bf16_t* Bt = (bf16_t*)smem;
    bf16_t* XW = Bt + 128 * LDP;
    float* csb = (float*)(XW + 2 * 64 * LDP);
    const bf16_t* XBC = wsp<bf16_t>(p, OFF_XBC);
    const float* DT = wsp<float>(p, OFF_DT);
    bf16_t* ST = wsp<bf16_t>(p, OFF_SST);
    float* DEC = wsp<float>(p, OFF_SDEC);
    const int tid = TIDX, lane = tid & 63, wave = tid >> 6, hf = lane >> 5;
    for (int it = blockIdx.x; it < 130 * 8; it += gridDim.x) {
        const int c = it >> 3, hh = it & 7, g = hh >> 2, r0 = c * 128;
        const int s = tid >> 2, q4 = tid & 3;
        const bf16_t* xr = XBC + (size_t)(r0 + s) * 1024;
        pg8::u32x4 bv[4], xv[2];
#pragma unroll
        for (int j = 0; j < 4; j++) bv[j] = *(const pg8::u32x4*)(xr + 512 + g * 128 + q4 * 32 + 8 * j);
#pragma unroll
        for (int j = 0; j < 2; j++) xv[j] = *(const pg8::u32x4*)(xr + hh * 64 + q4 * 16 + 8 * j);
        __syncthreads();
        if (wave < 2) {
            const int d = wave;
            const float a = -expf(p.in[I_ALOG][d * 8 + hh]);
            const float dt0 = DT[(size_t)d * R * 8 + (size_t)(r0 + 2 * lane) * 8 + hh], dt1 = DT[(size_t)d * R * 8 + (size_t)(r0 + 2 * lane + 1) * 8 + hh];
            float c0, c1;
            const float total = chunk_cumsum128(dt0 * a, dt1 * a, lane, d, c0, c1);
            csb[d * 128 + 2 * lane] = __expf(total - c0) * dt0;
            csb[d * 128 + 2 * lane + 1] = __expf(total - c1) * dt1;
            if (lane == 0) DEC[(d * 130 + c) * 8 + hh] = __expf(total);
        }
#pragma unroll
        for (int j = 0; j < 4; j++) {
            const unsigned w[4] = {bv[j].x, bv[j].y, bv[j].z, bv[j].w};
            bf16_t* dst = Bt + (q4 * 32 + 8 * j) * LDP + s;
#pragma unroll
            for (int q = 0; q < 4; q++) { dst[(2 * q) * LDP] = (bf16_t)(w[q] & 0xffff); dst[(2 * q + 1) * LDP] = (bf16_t)(w[q] >> 16); }
        }
        __syncthreads();
        {
            const float w0 = csb[s], w1 = csb[128 + s];
#pragma unroll
            for (int j = 0; j < 2; j++) {
                const unsigned w[4] = {xv[j].x, xv[j].y, xv[j].z, xv[j].w};
                bf16_t* dst = XW + (q4 * 16 + 8 * j) * LDP + s;
#pragma unroll
                for (int q = 0; q < 4; q++) {
                    const float x0 = bf2f((unsigned short)(w[q] & 0xffff)), x1 = bf2f((unsigned short)(w[q] >> 16));
                    dst[(2 * q) * LDP] = f2bf(x0 * w0); dst[(2 * q + 1) * LDP] = f2bf(x1 * w0);
                    dst[64 * LDP + (2 * q) * LDP] = f2bf(x0 * w1); dst[64 * LDP + (2 * q + 1) * LDP] = f2bf(x1 * w1);
                }
            }
        }
        __syncthreads();
#pragma unroll 1
        for (int t2 = 0; t2 < 2; t2++) {
            const int tix = wave * 2 + t2, d = tix >> 3, mt = (tix >> 2) & 1, nt = tix & 3;
            f32x16 acc;
#pragma unroll
            for (int q = 0; q < 16; q++) acc[q] = 0.f;
            acc = mma32<8>(lane, XW + (d * 64 + mt * 32) * LDP, LDP, Bt + nt * 32 * LDP, LDP, acc);
            int rb = mt * 32 + 4 * hf;
            asm volatile("" : "+v"(rb));
            bf16_t* dst = ST + ((((size_t)d * 130 + c) * 8 + hh) * 64 + rb) * 128 + nt * 32 + (lane & 31);
#pragma unroll
            for (int q = 0; q < 16; q++) dst[((q & 3) + 8 * (q >> 2)) * 128] = f2bf(acc[q]);
        }
    }
}
__device__ __forceinline__ void ph_ssd_s2(const Params& p) {
    const int TIDX = tid_of_wave(p.wave_id);
    const bf16_t* __restrict__ ST = wsp<bf16_t>(p, OFF_SST);
    bf16_t* __restrict__ SIN = wsp<bf16_t>(p, OFF_SSIN);
    const float* __restrict__ DEC = wsp<float>(p, OFF_SDEC);
    for (int it = blockIdx.x * NT + TIDX; it < 65536; it += gridDim.x * NT) {
        const int n2 = it & 63, pp = (it >> 6) & 63, hh = (it >> 12) & 7, d = it >> 15;
        float s0 = 0.f, s1 = 0.f;
#pragma unroll 1
        for (int g0 = 0; g0 < 130; g0 += 26) {
            unsigned stv[26]; float dv[26];
#pragma unroll
            for (int j = 0; j < 26; j++) {
                const int step = g0 + j, c = d == 0 ? (step < 2 ? 128 + step : step - 2) : 129 - step;
                stv[j] = *(const unsigned*)(ST + ((((size_t)d * 130 + c) * 8 + hh) * 64 + pp) * 128 + 2 * n2);
                dv[j] = DEC[(d * 130 + c) * 8 + hh];
            }
#pragma unroll
            for (int j = 0; j < 26; j++) {
                const int step = g0 + j, c = d == 0 ? (step < 2 ? 128 + step : step - 2) : 129 - step;
                *(unsigned*)(SIN + ((((size_t)d * 130 + c) * 8 + hh) * 64 + pp) * 128 + 2 * n2) = pack_bf16(s0, s1);
                s0 = fmaf(s0, dv[j], bf2f((unsigned short)(stv[j] & 0xffff)));
                s1 = fmaf(s1, dv[j], bf2f((unsigned short)(stv[j] >> 16)));
            }
        }
    }
}
__device__ __forceinline__ void ph_ssd_s3(const Params& p, unsigned char* smem) {
    const int TIDX = tid_of_wave(p.wave_id);
    bf16_t* Cm = (bf16_t*)smem;
    bf16_t* Bm = Cm + 128 * LDP;
    bf16_t* Wm = Bm;
    bf16_t* Xt = Bm + 128 * LDP;
    bf16_t* Sn = Xt + 64 * LDP;
    float* csA = (float*)(Sn + 2 * 64 * LDP);
    float* dtA = csA + 8 * 128;
    const bf16_t* XBC = wsp<bf16_t>(p, OFF_XBC);
    const float* DT = wsp<float>(p, OFF_DT);
    const bf16_t* SIN = wsp<bf16_t>(p, OFF_SSIN);
    float* Y = wsp<float>(p, OFF_Y);
    const int tid = TIDX, lane = tid & 63, wave = tid >> 6, hf = lane >> 5;
    for (int it = blockIdx.x; it < 256; it += gridDim.x) {
        const int c = it >> 1, g = it & 1, r0 = c * 128;
        const int s = tid >> 2, q4 = tid & 3;
        const bf16_t* xr = XBC + (size_t)(r0 + s) * 1024;
        __syncthreads();
        {
            pg8::u32x4 bv[4], cv[4];
#pragma unroll
            for (int j = 0; j < 4; j++) { bv[j] = *(const pg8::u32x4*)(xr + 512 + g * 128 + q4 * 32 + 8 * j); cv[j] = *(const pg8::u32x4*)(xr + 768 + g * 128 + q4 * 32 + 8 * j); }
            {
                const int hh = g * 4 + (wave >> 1), d = wave & 1;
                const float a = -expf(p.in[I_ALOG][d * 8 + hh]);
                const float dt0 = DT[(size_t)d * R * 8 + (size_t)(r0 + 2 * lane) * 8 + hh], dt1 = DT[(size_t)d * R * 8 + (size_t)(r0 + 2 * lane + 1) * 8 + hh];
                float c0, c1;
                chunk_cumsum128(dt0 * a, dt1 * a, lane, d, c0, c1);
                csA[wave * 128 + 2 * lane] = c0; csA[wave * 128 + 2 * lane + 1] = c1;
                dtA[wave * 128 + 2 * lane] = dt0; dtA[wave * 128 + 2 * lane + 1] = dt1;
            }
#pragma unroll
            for (int j = 0; j < 4; j++) { lds_st16(Bm + s * LDP + q4 * 32 + 8 * j, bv[j]); lds_st16(Cm + s * LDP + q4 * 32 + 8 * j, cv[j]); }
        }
        __syncthreads();
        const int gmt = wave >> 1, gnt0 = (wave & 1) * 2;
        f32x16 G0, G1;
#pragma unroll
        for (int q = 0; q < 16; q++) { G0[q] = 0.f; G1[q] = 0.f; }
        G0 = mma32<8>(lane, Cm + gmt * 32 * LDP, LDP, Bm + gnt0 * 32 * LDP, LDP, G0);
        G1 = mma32<8>(lane, Cm + gmt * 32 * LDP, LDP, Bm + (gnt0 + 1) * 32 * LDP, LDP, G1);
        pg8::u32x4 xv[2], sv[2][2];
#pragma unroll 1
        for (int h = 0; h < 4; h++) {
            const int hh = g * 4 + h;
            const int ymt = wave >> 1, ynt = wave & 1;
            f32x16 ytot;
#pragma unroll
            for (int q = 0; q < 16; q++) ytot[q] = 0.f;
#define S3_FETCH(hq) do { int tb_ = tid; asm volatile("" : "+v"(tb_)); const int s2_ = tb_ >> 2, q42_ = tb_ & 3, hh_ = g * 4 + (hq); \
                _Pragma("unroll") for (int j = 0; j < 2; j++) xv[j] = *(const pg8::u32x4*)(XBC + (size_t)(r0 + s2_) * 1024 + hh_ * 64 + q42_ * 16 + 8 * j); \
                _Pragma("unroll") for (int d_ = 0; d_ < 2; d_++) { const bf16_t* src_ = SIN + ((((size_t)d_ * 130 + c) * 8 + hh_) * 64) * 128; \
                    _Pragma("unroll") for (int i = 0; i < 2; i++) { const int v_ = tb_ + 512 * i; sv[d_][i] = *(const pg8::u32x4*)(src_ + (v_ >> 4) * 128 + (v_ & 15) * 8); } } } while (0)
            if (h == 0) S3_FETCH(0);
#pragma unroll 1
            for (int d = 0; d < 2; d++) {
                __syncthreads();
                if (d == 0) {
                    int tb = tid;
                    asm volatile("" : "+v"(tb));
                    const int s2 = tb >> 2, q42 = tb & 3;
#pragma unroll
                    for (int j = 0; j < 2; j++) {
                        const unsigned w[4] = {xv[j].x, xv[j].y, xv[j].z, xv[j].w};
                        bf16_t* dst = Xt + (q42 * 16 + 8 * j) * LDP + s2;
#pragma unroll
                        for (int q = 0; q < 4; q++) { dst[(2 * q) * LDP] = (bf16_t)(w[q] & 0xffff); dst[(2 * q + 1) * LDP] = (bf16_t)(w[q] >> 16); }
                    }
#pragma unroll
                    for (int dd = 0; dd < 2; dd++)
#pragma unroll
                        for (int i = 0; i < 2; i++) { const int v = tb + 512 * i; lds_st16(Sn + (dd * 64 + (v >> 4)) * LDP + (v & 15) * 8, sv[dd][i]); }
                }
                const float* csb = csA + (h * 2 + d) * 128;
                const float* dtb = dtA + (h * 2 + d) * 128;
#pragma unroll
                for (int t2 = 0; t2 < 2; t2++) {
                    const int s3 = (gnt0 + t2) * 32 + (lane & 31);
                    const float css = csb[s3], dts = dtb[s3];
#pragma unroll
                    for (int q = 0; q < 16; q++) {
                        const int l = gmt * 32 + CROW(q, hf);
                        const bool ok = d == 0 ? (s3 <= l) : (s3 >= l);
                        const float gv = t2 == 0 ? G0[q] : G1[q];
                        const float w = ok ? gv * __expf(csb[l] - css) * dts : 0.f;
                        Wm[l * LDP + s3] = f2bf(w);
                    }
                }
                if (d == 1 && h < 3) S3_FETCH(h + 1);
                __syncthreads();
                f32x16 a2;
#pragma unroll
                for (int q = 0; q < 16; q++) a2[q] = 0.f;
                a2 = mma32<8>(lane, Cm + ymt * 32 * LDP, LDP, Sn + (d * 64 + ynt * 32) * LDP, LDP, a2);
#pragma unroll
                for (int q = 0; q < 16; q++) ytot[q] += __expf(csb[ymt * 32 + CROW(q, hf)]) * a2[q];
                ytot = mma32<8>(lane, Wm + ymt * 32 * LDP, LDP, Xt + ynt * 32 * LDP, LDP, ytot);
            }
            const float Dsum = p.in[I_SSDD][hh] + p.in[I_SSDD][8 + hh];
            {
                int lbase = r0 + ymt * 32 + 4 * hf;
                asm volatile("" : "+v"(lbase));
                const int cbase = hh * 64 + ynt * 32 + (lane & 31);
                float* yb = Y + (size_t)lbase * 512 + cbase;
                const bf16_t* xb = XBC + (size_t)lbase * 1024 + cbase;
#pragma unroll
                for (int q = 0; q < 16; q++) {
                    const int lo = (q & 3) + 8 * (q >> 2);
                    yb[lo * 512] = ytot[q] + Dsum * bf2f(xb[lo * 1024]);
                }
            }
        }
    }
}

constexpr int LDQ = 68;
__device__ __forceinline__ void ph_hg_s1(const Params& p, unsigned char* smem) {
    const int TIDX = tid_of_wave(p.wave_id);
    float* LG = (float*)smem;
    bf16_t* KbT = (bf16_t*)(smem + 65536);
    bf16_t* Vt = KbT + 2 * 128 * LDQ;
    const bf16_t* P1 = wsp<bf16_t>(p, OFF_P);
    const float* lbp = wsp<float>(p, OFF_LB);
    bf16_t* ST = wsp<bf16_t>(p, OFF_HST);
    float* DEC = wsp<float>(p, OFF_HDEC);
    const int tid = TIDX, lane = tid & 63, wave = tid >> 6, hf = lane >> 5;
    float fr[32];
    pg8::u32x4 vx[2];
    auto fetch = [&](int it2) {
        const int c2 = it2 >> 2, h2 = it2 & 3, r02 = c2 * 64;
#pragma unroll
        for (int i = 0; i < 32; i++) {
            const int d = i >> 4, e = tid + 512 * (i & 15), row = e >> 7, k = e & 127;
            fr[i] = bf2f(P1[(size_t)(r02 + row) * ODD_IN + 1040 + d * 512 + h2 * 128 + k]);
        }
#pragma unroll
        for (int q = 0; q < 2; q++) { const int vec = tid + 512 * q; vx[q] = *(const pg8::u32x4*)(P1 + (size_t)(r02 + (vec >> 4)) * ODD_IN + 2064 + h2 * 128 + (vec & 15) * 8); }
    };
    if ((int)blockIdx.x < 260 * 4) fetch(blockIdx.x);
    for (int it = blockIdx.x; it < 260 * 4; it += gridDim.x) {
        const int c = it >> 2, h = it & 3, r0 = c * 64;
        __syncthreads();
        float fv[32];
        {
            const float lbk = lbp[h * 128 + (tid & 127)];
#pragma unroll
            for (int i = 0; i < 32; i++) fv[i] = lbk + (1.f - lbk) * sigmoid_fast(fr[i]);
        }
#pragma unroll
        for (int q = 0; q < 2; q++) {
            const int vec = tid + 512 * q, s2 = vec >> 4, v0 = (vec & 15) * 8;
            const pg8::u32x4 x = vx[q];
            bf16_t* dst = Vt + v0 * LDQ + s2;
            dst[0] = (bf16_t)(x.x & 0xffff); dst[LDQ] = (bf16_t)(x.x >> 16); dst[2 * LDQ] = (bf16_t)(x.y & 0xffff); dst[3 * LDQ] = (bf16_t)(x.y >> 16);
            dst[4 * LDQ] = (bf16_t)(x.z & 0xffff); dst[5 * LDQ] = (bf16_t)(x.z >> 16); dst[6 * LDQ] = (bf16_t)(x.w & 0xffff); dst[7 * LDQ] = (bf16_t)(x.w >> 16);
        }
#pragma unroll
        for (int i = 0; i < 32; i++) LG[(i >> 4) * 8192 + tid + 512 * (i & 15)] = __logf(fv[i]);
        __syncthreads();
        if (tid < 256) {
            const int d = tid >> 7, k = tid & 127;
            float* col = LG + d * 8192 + k;
            float cum = 0.f;
#pragma unroll 8
            for (int i = 0; i < 64; i++) { const int row = d == 0 ? i : 63 - i; cum += col[row * 128]; col[row * 128] = cum; }
            DEC[(((size_t)d * 260 + c) * 4 + h) * 128 + k] = __expf(cum);
        }
        __syncthreads();
#pragma unroll
        for (int i = 0; i < 32; i++) {
            const int d = i >> 4, e = tid + 512 * (i & 15), row = e >> 7, k = e & 127;
            const float total = LG[d * 8192 + (d == 0 ? 63 : 0) * 128 + k], cum = LG[d * 8192 + e];
            KbT[(d * 128 + k) * LDQ + row] = f2bf((1.f - fv[i]) * __expf(total - cum));
        }
        if (it + (int)gridDim.x < 260 * 4) fetch(it + gridDim.x);
        __syncthreads();
#pragma unroll 1
        for (int q4 = 0; q4 < 4; q4++) {
            const int tix = wave * 4 + q4, d = tix >> 4, vt = (tix >> 2) & 3, kt = tix & 3;
            f32x16 acc;
#pragma unroll
            for (int q = 0; q < 16; q++) acc[q] = 0.f;
            acc = mma32<4>(lane, Vt + vt * 32 * LDQ, LDQ, KbT + (d * 128 + kt * 32) * LDQ, LDQ, acc);
            int rb = vt * 32 + 4 * hf;
            asm volatile("" : "+v"(rb));
            bf16_t* dst = ST + ((((size_t)d * 260 + c) * 4 + h) * 128 + rb) * 128 + kt * 32 + (lane & 31);
#pragma unroll
            for (int q = 0; q < 16; q++) dst[((q & 3) + 8 * (q >> 2)) * 128] = f2bf(acc[q]);
        }
    }
}
__device__ __forceinline__ void ph_hg_s2(const Params& p) {
    const int TIDX = tid_of_wave(p.wave_id);
    const bf16_t* __restrict__ ST = wsp<bf16_t>(p, OFF_HST);
    bf16_t* __restrict__ SIN = wsp<bf16_t>(p, OFF_HSIN);
    const float* __restrict__ DEC = wsp<float>(p, OFF_HDEC);
    const int gb = gridDim.x >= 256 ? (int)blockIdx.x - 128 : (int)blockIdx.x, gs = gridDim.x >= 256 ? 128 : (int)gridDim.x;
    for (int it = gb * NT + TIDX; it >= 0 && it < 65536; it += gs * NT) {
        const int k2 = it & 63, v = (it >> 6) & 127, h = (it >> 13) & 3, d = it >> 15;
        float s0 = 0.f, s1 = 0.f;
#pragma unroll 1
        for (int g0 = 0; g0 < 260; g0 += 26) {
            unsigned stv[26]; float2 dv[26];
#pragma unroll
            for (int j = 0; j < 26; j++) {
                const int step = g0 + j, c = d == 0 ? (step < 4 ? 256 + step : step - 4) : 259 - step;
                const size_t blk = ((size_t)d * 260 + c) * 4 + h;
                stv[j] = *(const unsigned*)(ST + (blk * 128 + v) * 128 + 2 * k2);
                dv[j] = *(const float2*)(DEC + blk * 128 + 2 * k2);
            }
#pragma unroll
            for (int j = 0; j < 26; j++) {
                const int step = g0 + j, c = d == 0 ? (step < 4 ? 256 + step : step - 4) : 259 - step;
                const size_t blk = ((size_t)d * 260 + c) * 4 + h;
                *(unsigned*)(SIN + (blk * 128 + v) * 128 + 2 * k2) = pack_bf16(s0, s1);
                s0 = fmaf(s0, dv[j].x, bf2f((unsigned short)(stv[j] & 0xffff)));
                s1 = fmaf(s1, dv[j].y, bf2f((unsigned short)(stv[j] >> 16)));
            }
        }
    }
}
__device__ __forceinline__ void ph_hg_s3(const Params& p, unsigned char* smem) {
    const int TIDX = tid_of_wave(p.wave_id);
    float* LG = (float*)smem;
    bf16_t* Qb = (bf16_t*)(smem + 32768);
    bf16_t* Kh = Qb + 64 * LDP;
    bf16_t* Vt = Kh + 64 * LDP;
    bf16_t* Am = Vt + 128 * LDQ;
    bf16_t* Sn = Am + 64 * LDQ;
    const bf16_t* P1 = wsp<bf16_t>(p, OFF_P);
    const float* lbp = wsp<float>(p, OFF_LB);
    const bf16_t* SIN = wsp<bf16_t>(p, OFF_HSIN);
    float* O = wsp<float>(p, OFF_O);
    const int tid = TIDX, lane = tid & 63, wave = tid >> 6, hf = lane >> 5;
    float fr[16], qr[16];
    pg8::u32x4 snv[4], vx[2];
    auto fetch = [&](int it2, int d2) {
        const int c2 = it2 >> 2, h2 = it2 & 3, r02 = c2 * 64;
#pragma unroll
        for (int i = 0; i < 16; i++) {
            const int e = tid + 512 * i, row = e >> 7, k = e & 127;
            fr[i] = bf2f(P1[(size_t)(r02 + row) * ODD_IN + 1040 + d2 * 512 + h2 * 128 + k]);
            qr[i] = bf2f(P1[(size_t)(r02 + row) * ODD_IN + 3088 + h2 * 128 + k]);
        }
        const bf16_t* src = SIN + ((((size_t)d2 * 260 + c2) * 4 + h2) * 128) * 128;
#pragma unroll
        for (int i = 0; i < 4; i++) { const int v = tid + 512 * i; snv[i] = *(const pg8::u32x4*)(src + (v >> 4) * 128 + (v & 15) * 8); }
        if (d2 == 0) {
#pragma unroll
            for (int q = 0; q < 2; q++) { const int vec = tid + 512 * q; vx[q] = *(const pg8::u32x4*)(P1 + (size_t)(r02 + (vec >> 4)) * ODD_IN + 2064 + h2 * 128 + (vec & 15) * 8); }
        }
    };
    const int nit = ((int)blockIdx.x < 1024) ? (1024 - (int)blockIdx.x + (int)gridDim.x - 1) / (int)gridDim.x : 0;
    if (nit > 0) fetch(blockIdx.x, 0);
    const int omt = wave >> 2, ont = wave & 3;
    f32x16 otot;
#pragma unroll 1
    for (int n = 0; n < 2 * nit; n++) {
        const int it = blockIdx.x + (n >> 1) * gridDim.x, d = n & 1;
        const int c = it >> 2, h = it & 3, r0 = c * 64;
        if (d == 0) {
#pragma unroll
            for (int q = 0; q < 16; q++) otot[q] = 0.f;
        }
        __syncthreads();
        float fv[16], qv[16];
        {
            const float lbk = lbp[h * 128 + (tid & 127)];
#pragma unroll
            for (int i = 0; i < 16; i++) { fv[i] = lbk + (1.f - lbk) * sigmoid_fast(fr[i]); qv[i] = silu_fast(qr[i]); }
        }
#pragma unroll
        for (int i = 0; i < 4; i++) { const int v = tid + 512 * i; lds_st16(Sn + (v >> 4) * LDP + (v & 15) * 8, snv[i]); }
        if (d == 0) {
#pragma unroll
            for (int q = 0; q < 2; q++) {
                const int vec = tid + 512 * q, s2 = vec >> 4, v0 = (vec & 15) * 8;
                const pg8::u32x4 x = vx[q];
                bf16_t* dst = Vt + v0 * LDQ + s2;
                dst[0] = (bf16_t)(x.x & 0xffff); dst[LDQ] = (bf16_t)(x.x >> 16); dst[2 * LDQ] = (bf16_t)(x.y & 0xffff); dst[3 * LDQ] = (bf16_t)(x.y >> 16);
                dst[4 * LDQ] = (bf16_t)(x.z & 0xffff); dst[5 * LDQ] = (bf16_t)(x.z >> 16); dst[6 * LDQ] = (bf16_t)(x.w & 0xffff); dst[7 * LDQ] = (bf16_t)(x.w >> 16);
            }
        }
#pragma unroll
        for (int i = 0; i < 16; i++) LG[tid + 512 * i] = __logf(fv[i]);
        __syncthreads();
        if (tid < 128) {
            float* col = LG + tid;
            float cum = 0.f;
#pragma unroll 8
            for (int i = 0; i < 64; i++) { const int row = d == 0 ? i : 63 - i; cum += col[row * 128]; col[row * 128] = cum; }
        }
        __syncthreads();
#pragma unroll
        for (int i = 0; i < 16; i++) {
            const int e = tid + 512 * i, row = e >> 7, k = e & 127;
            const float cum = LG[e];
            Qb[row * LDP + k] = f2bf(qv[i] * __expf(cum));
            Kh[row * LDP + k] = f2bf((1.f - fv[i]) * __expf(fminf(-cum, 80.f)));
        }
        if (n + 1 < 2 * nit) fetch(blockIdx.x + ((n + 1) >> 1) * gridDim.x, (n + 1) & 1);
        __syncthreads();
        if (wave < 4) {
            const int amt = wave >> 1, ant = wave & 1;
            f32x16 a;
#pragma unroll
            for (int q = 0; q < 16; q++) a[q] = 0.f;
            a = mma32<8>(lane, Qb + amt * 32 * LDP, LDP, Kh + ant * 32 * LDP, LDP, a);
            const int s2 = ant * 32 + (lane & 31);
#pragma unroll
            for (int q = 0; q < 16; q++) {
                const int t = amt * 32 + CROW(q, hf);
                const bool ok = d == 0 ? (s2 <= t) : (s2 >= t);
                Am[t * LDQ + s2] = f2bf(ok ? a[q] : 0.f);
            }
        }
        otot = mma32<8>(lane, Qb + omt * 32 * LDP, LDP, Sn + ont * 32 * LDP, LDP, otot);
        __syncthreads();
        otot = mma32<4>(lane, Am + omt * 32 * LDQ, LDQ, Vt + ont * 32 * LDQ, LDQ, otot);
        if (d == 1) {
            int lbase = r0 + omt * 32 + 4 * hf;
            asm volatile("" : "+v"(lbase));
            float* ob = O + (size_t)lbase * 512 + h * 128 + ont * 32 + (lane & 31);
#pragma unroll
            for (int q = 0; q < 16; q++) ob[((q & 3) + 8 * (q >> 2)) * 512] = otot[q];
        }
    }
}

__device__ __forceinline__ void ph_merge(const Params& p) {
    const int TIDX = tid_of_wave(p.wave_id);
    const int lane = TIDX & 63, wave = TIDX >> 6;
    const bf16_t* P1 = wsp<bf16_t>(p, OFF_P);
    const float* Y = wsp<float>(p, OFF_Y);
    const float* O = wsp<float>(p, OFF_O);
    bf16_t* MB = wsp<bf16_t>(p, OFF_MB);
    const int c = 8 * lane;
    for (int r = blockIdx.x * NWAVE + wave; r < L; r += gridDim.x * NWAVE) {
        const float4 y0 = *(const float4*)(Y + (size_t)r * 512 + c), y1 = *(const float4*)(Y + (size_t)r * 512 + c + 4);
        const float4 o0 = *(const float4*)(O + (size_t)r * 512 + c), o1 = *(const float4*)(O + (size_t)r * 512 + c + 4);
        const pg8::u32x4 zz = *(const pg8::u32x4*)(P1 + (size_t)r * ODD_IN + 2576 + c), gg = *(const pg8::u32x4*)(P1 + (size_t)r * ODD_IN + 3600 + c);
        const float yv[8] = {y0.x, y0.y, y0.z, y0.w, y1.x, y1.y, y1.z, y1.w};
        const float ov[8] = {o0.x, o0.y, o0.z, o0.w, o1.x, o1.y, o1.z, o1.w};
        const unsigned zw[4] = {zz.x, zz.y, zz.z, zz.w}, gw[4] = {gg.x, gg.y, gg.z, gg.w};
        float ys[8], gs[8], sy = 0.f, so = 0.f;
#pragma unroll
        for (int q = 0; q < 4; q++) {
            ys[2 * q] = yv[2 * q] * silu_fast(bf2f((unsigned short)(zw[q] & 0xffff)));
            ys[2 * q + 1] = yv[2 * q + 1] * silu_fast(bf2f((unsigned short)(zw[q] >> 16)));
            gs[2 * q] = silu_fast(bf2f((unsigned short)(gw[q] & 0xffff)));
            gs[2 * q + 1] = silu_fast(bf2f((unsigned short)(gw[q] >> 16)));
        }
#pragma unroll
        for (int q = 0; q < 8; q++) { sy = fmaf(ys[q], ys[q], sy); so = fmaf(ov[q], ov[q], so); }
        sy += dpp_f<0xB1>(sy); sy += dpp_f<0x4E>(sy); sy += dpp_f<0x141>(sy); sy += dpp_f<0x140>(sy);
        so += dpp_f<0xB1>(so); so += dpp_f<0x4E>(so); so += dpp_f<0x141>(so); so += dpp_f<0x140>(so);
        sy += lane_xor(lane, sy, 16);
        const float ry = rsqrtf(sy * (1.f / 256.f) + EPS), ro = rsqrtf(so * (1.f / 128.f) + EPS);
        const float4 n0 = *(const float4*)(p.in[I_SSDN] + c), n1 = *(const float4*)(p.in[I_SSDN] + c + 4);
        const float4 h0 = *(const float4*)(p.in[I_HGN] + c), h1 = *(const float4*)(p.in[I_HGN] + c + 4);
        const float nv[8] = {n0.x, n0.y, n0.z, n0.w, n1.x, n1.y, n1.z, n1.w}, hv[8] = {h0.x, h0.y, h0.z, h0.w, h1.x, h1.y, h1.z, h1.w};
        float m0[8], m1[8];
#pragma unroll
        for (int q = 0; q < 8; q++) { m0[q] = ys[q] * ry * nv[q]; m1[q] = ov[q] * ro * hv[q] * gs[q]; }
        pg8::u32x4 w0, w1;
        w0.x = pack_bf16(m0[0], m0[1]); w0.y = pack_bf16(m0[2], m0[3]); w0.z = pack_bf16(m0[4], m0[5]); w0.w = pack_bf16(m0[6], m0[7]);
        w1.x = pack_bf16(m1[0], m1[1]); w1.y = pack_bf16(m1[2], m1[3]); w1.z = pack_bf16(m1[4], m1[5]); w1.w = pack_bf16(m1[6], m1[7]);
        *(pg8::u32x4*)(MB + (size_t)r * D + c) = w0;
        *(pg8::u32x4*)(MB + (size_t)r * D + 512 + c) = w1;
    }
}

constexpr int N_PHASES = 22;
__global__ void __launch_bounds__(NT, 2) mega(KArgs ka) {
    extern __shared__ __attribute__((aligned(16))) unsigned char smem[];
    float* lds = (float*)smem;
    PG8_LAS unsigned char* glds = (PG8_LAS unsigned char*)smem;
    if (threadIdx.x < 4) ((unsigned*)(smem + LDS_BYTES - 16))[threadIdx.x] = 0u;
    __syncthreads();
    XcdBarrier gbar = xcd_barrier_post((unsigned*)(ka.ws + OFF_BAR), (volatile LAS3 unsigned*)(smem + LDS_BYTES - 16));
    Params p;
    p.in = (const float* const*)(ka.ws + OFF_TAB); p.out = ka.out; p.ws = ka.ws;
    p.wave_id = __builtin_amdgcn_readfirstlane(threadIdx.x >> 6);
    float* XA = wsp<float>(p, OFF_XA);
    float* XB = wsp<float>(p, OFF_XB);
    float* XC = wsp<float>(p, OFF_XC);
    bf16_t* PB = wsp<bf16_t>(p, OFF_P);
    const int G = gridDim.x, bid = blockIdx.x;
#ifndef ONLY
#define ONLY -1
#endif
#ifndef PHMASK
#define PHMASK 0xFFFFFFFFull
#endif
#define IN(k) ((ONLY < 0 || ONLY == (k)) && ((PHMASK >> (k)) & 1ull))
#ifndef REPMASK
#define REPMASK 0ull
#endif
#define NREP(k) (IN(k) ? ((((REPMASK) >> (k)) & 1ull) ? 2 : 1) : 0)
#ifndef PROBE_LO
#define PROBE_LO -1
#define PROBE_HI -1
#define PROBE_AMP 4
#endif
    volatile unsigned long long* tsl = (volatile unsigned long long*)(smem + LDS_BYTES - 512);
    int nstamp = 0;
#define STAMP() do { if (PROBE_LO >= 0) { if (tid_of_wave(p.wave_id) == 0) tsl[nstamp] = __builtin_amdgcn_s_memrealtime(); ++nstamp; } } while (0)
    STAMP();
#define SEAM(k) do { xcd_barrier(gbar, p.wave_id); STAMP(); } while (0)
#define SUBSTAMP() do { if (PROBE_LO >= 0) { __syncthreads(); STAMP(); } } while (0)
    if (blockIdx.x == 0 && threadIdx.x == 0) {
#pragma unroll
        for (int i = 0; i < N_IN; i++) ((const float**)(ka.ws + OFF_TAB))[i] = ka.in[i];
    }
    for (int _r = 0; _r < NREP(0); _r++) { if (_r) SEAM(0); ph_prologue(ka, lds); ph_convert_weights(ka);
    }
    SEAM(0);
    for (int _r = 0; _r < NREP(1); _r++) { if (_r) SEAM(1);
            prep_rows<false>(p, lds, p.in[I_X], p.in[I_CTX], R, p.in[I_NORMG] + 0, 0, 0); SUBSTAMP();
            ph_filter_gemm_lat(p, smem); ph_filter_gemm_ctx(p, lds);
    }
    SEAM(1);
    for (int _r = 0; _r < NREP(2); _r++) { if (_r) SEAM(2);
            { pg8::StaticOrder S; S.init(R, EVEN_IN, G, bid);
              pg8::gemm_phase(p.wave_id, glds, pg8::Gemm{wsp<bf16_t>(p, OFF_HB), wsp<bf16_t>(p, OFF_WINE), D}, S, pg8::EpiStoreBf16{PB, EVEN_IN, EVEN_IN}); } SUBSTAMP();
            ph_filter_fft(p, smem); ph_filter_abs_ctx(p);
    }
    SEAM(2);
    for (int _r = 0; _r < NREP(3); _r++) { if (_r) SEAM(3); ph_qk_dwconv(p); SUBSTAMP(); ph_dwconv_t(p, lds);
    }
    SEAM(3);
    for (int _r = 0; _r < NREP(4); _r++) { if (_r) SEAM(4); ph_hyena_fft(p, smem); SUBSTAMP(); ph_attention_mfma(p, smem); SUBSTAMP(); ph_hyena_conv(p, 0);
    }
    SEAM(4);
    for (int _r = 0; _r < NREP(5); _r++) { if (_r) SEAM(5); ph_hy_transpose(p, smem); ph_hyena_conv(p, 1);
    }
    SEAM(5);
    for (int _r = 0; _r < NREP(6); _r++) { if (_r) SEAM(6);
            { pg8::StaticOrder S; S.init(R, D, G, bid);
              pg8::gemm_phase(p.wave_id, glds, pg8::Gemm{wsp<bf16_t>(p, OFF_MB), wsp<bf16_t>(p, OFF_WOUT), D}, S,
                              pg8::EpiResid{p.in[I_X], p.in[I_CTX], modp(p, 0, 0, 0) + 2048, modp(p, 0, 1, 0) + 2048, XA}); }
    }
    SEAM(6);
    for (int _r = 0; _r < NREP(7); _r++) { if (_r) SEAM(7); prep_router(p, smem, XA, XA + (size_t)L * D, R, p.in[I_NORMG] + 1024, 0, 1);
    }
    SEAM(7);
    for (int _r = 0; _r < NREP(8); _r++) { if (_r) SEAM(8); ph_moe_scatter(p, lds, 0, R);
    }
    SEAM(8);
    for (int _r = 0; _r < NREP(9); _r++) { if (_r) SEAM(9); ph_moe_gemm1(p, glds, 0);
    }
    SEAM(9);
    for (int _r = 0; _r < NREP(10); _r++) { if (_r) SEAM(10); ph_moe_gemm2(p, glds, 0);
    }
    SEAM(10);
    for (int _r = 0; _r < NREP(11); _r++) { if (_r) SEAM(11); ph_moe_combine<true>(p, 0, R, XA, XB, 1);
    }
    SEAM(11);
    for (int _r = 0; _r < NREP(12); _r++) { if (_r) SEAM(12);
            { pg8::StaticOrder S; S.init(R, ODD_PAD, G, bid);
              pg8::gemm_phase(p.wave_id, glds, pg8::Gemm{wsp<bf16_t>(p, OFF_HB), wsp<bf16_t>(p, OFF_WINO), D}, S, pg8::EpiStoreBf16{PB, ODD_IN, ODD_IN}); }
    }
    SEAM(12);
    for (int _r = 0; _r < NREP(13); _r++) { if (_r) SEAM(13); ph_streams(p);
    }
    SEAM(13);
    for (int _r = 0; _r < NREP(14); _r++) { if (_r) SEAM(14); ph_ssd_s1(p, smem); SUBSTAMP(); ph_hg_s1(p, smem);
    }
    SEAM(14);
    for (int _r = 0; _r < NREP(22); _r++) { if (_r) SEAM(22); ph_ssd_s2(p); ph_hg_s2(p);
    }
    SEAM(22);
    for (int _r = 0; _r < NREP(23); _r++) { if (_r) SEAM(23); ph_ssd_s3(p, smem); SUBSTAMP(); ph_hg_s3(p, smem);
    }
    SEAM(23);
    for (int _r = 0; _r < NREP(15); _r++) { if (_r) SEAM(15); ph_merge(p);
    }
    SEAM(15);
    for (int _r = 0; _r < NREP(16); _r++) { if (_r) SEAM(16);
            { pg8::StaticOrder S; S.init(L, D, G, bid);
              pg8::gemm_phase(p.wave_id, glds, pg8::Gemm{wsp<bf16_t>(p, OFF_MB), wsp<bf16_t>(p, OFF_WOUT) + (size_t)D * D, D}, S,
                              pg8::EpiResid{XB, XB, modp(p, 1, 0, 0) + 2048, modp(p, 1, 0, 0) + 2048, XC}); }
    }
    SEAM(16);
    for (int _r = 0; _r < NREP(17); _r++) { if (_r) SEAM(17); prep_router(p, smem, XC, XC, L, p.in[I_NORMG] + 3 * 1024, 1, 1);
    }
    SEAM(17);
    for (int _r = 0; _r < NREP(18); _r++) { if (_r) SEAM(18); ph_moe_scatter(p, lds, 1, L);
    }
    SEAM(18);
    for (int _r = 0; _r < NREP(19); _r++) { if (_r) SEAM(19); ph_moe_gemm1(p, glds, 1);
    }
    SEAM(19);
    for (int _r = 0; _r < NREP(20); _r++) { if (_r) SEAM(20); ph_moe_gemm2(p, glds, 1);
    }
    SEAM(20);
    for (int _r = 0; _r < NREP(21); _r++) { if (_r) SEAM(21); ph_moe_combine<false>(p, 1, L, XC, p.out, 0);
    }
    if (PROBE_LO >= 0) {
        STAMP();
        __syncthreads();
        const unsigned long long dtk = tsl[PROBE_HI] - tsl[PROBE_LO];
        const unsigned long long t0 = __builtin_amdgcn_s_memrealtime();
        while (__builtin_amdgcn_s_memrealtime() - t0 < (unsigned long long)PROBE_AMP * dtk) __builtin_amdgcn_s_sleep(8);
    }
#undef IN
#undef SEAM
}

extern "C" void kernel_launch(void* const* d_in, const int* in_sizes, int n_in, void* d_out, int out_size, void* d_ws, size_t ws_size,
                              hipStream_t stream) {
    static int grid_blocks = 0;
    if (!grid_blocks) {
        int dev = 0, cus = 0, per_cu = 0;
        hipGetDevice(&dev);
        hipDeviceGetAttribute(&cus, hipDeviceAttributeMultiprocessorCount, dev);
        hipFuncSetAttribute((const void*)mega, hipFuncAttributeMaxDynamicSharedMemorySize, LDS_BYTES);
        hipOccupancyMaxActiveBlocksPerMultiprocessor(&per_cu, mega, NT, LDS_BYTES);
        if (per_cu < 1) per_cu = 1;
        grid_blocks = cus;
        if (ws_size < WS_END) fprintf(stderr, "kernel_launch: workspace too small: %zu < %zu\n", ws_size, (size_t)WS_END);
    }
    hipMemsetAsync((char*)d_ws + OFF_CTL, 0, 65536, stream);
    KArgs p{};
    for (int i = 0; i < N_IN; i++) p.in[i] = (const float*)d_in[i];
    p.out = (float*)d_out;
    p.ws = (unsigned char*)d_ws;
    hipLaunchKernelGGL(mega, dim3(grid_blocks), dim3(NT), LDS_BYTES, stream, p);
}
```
